# Optimizing an MI355X kernel written in HIP

```python
import jax, jax.numpy as jnp
from jax import lax
import numpy as np

D_MODEL = 1024
BATCH = 16
SEQ = 2048
DEPTH = 4

GRID_W = 64
CTX_LEN = 256
HEAD_DIM = 64
BRANCH_W = D_MODEL // 4
MIX_W = 4 * BRANCH_W
H_A = BRANCH_W // HEAD_DIM
G_D = BRANCH_W // HEAD_DIM
QKV_CONV = 3
SHORT_CONV = 3
CONF_CONV = 31
GDN_CHUNK = 64
GDN_CHUNK_LOG2 = 6
MLP_CHUNK = 128
EPS = 1e-6

A_COLS = 3 * BRANCH_W + 4 * H_A
B_COLS = 3 * BRANCH_W
C_COLS = 2 * BRANCH_W
D_COLS = 2 * BRANCH_W
IN_COLS = A_COLS + B_COLS + C_COLS + D_COLS + MIX_W

kernel_name = 'hybrid_parallel_group_flow_block'


def rmsnorm(x, g):
    xf = x.astype(jnp.float32)
    y = xf * lax.rsqrt(jnp.mean(xf * xf, axis=-1, keepdims=True) + EPS)
    return (y * g.astype(jnp.float32)).astype(x.dtype)


def layernorm(x, g, b):
    xf = x.astype(jnp.float32)
    mu = jnp.mean(xf, axis=-1, keepdims=True)
    xc = xf - mu
    var = jnp.mean(xc * xc, axis=-1, keepdims=True)
    y = xc * lax.rsqrt(var + EPS) * g.astype(jnp.float32) + b.astype(jnp.float32)
    return y.astype(x.dtype)


def l2norm(x):
    return x * lax.rsqrt(jnp.sum(x * x, axis=-1, keepdims=True) + EPS)


def dwconv(x, w):
    k = w.shape[0]
    return lax.conv_general_dilated(
        x, w[:, None, :].astype(x.dtype), window_strides=(1,),
        padding=[(k // 2, k // 2)], dimension_numbers=('NWC', 'WIO', 'NWC'),
        feature_group_count=x.shape[-1])


def to_col_major(x):
    bsz, t, ch = x.shape
    rows = t // GRID_W
    return x.reshape(bsz, rows, GRID_W, ch).transpose(0, 2, 1, 3).reshape(bsz, t, ch)


def from_col_major(x):
    bsz, t, ch = x.shape
    rows = t // GRID_W
    return x.reshape(bsz, GRID_W, rows, ch).transpose(0, 2, 1, 3).reshape(bsz, t, ch)


def gdn_chunked(q, k, v, g, beta, s0):
    bsz, t, h, dk = q.shape
    n = t // GDN_CHUNK

    def chunks(a):
        a = a.reshape((bsz, n, GDN_CHUNK) + a.shape[2:])
        return jnp.moveaxis(a, 3, 2)

    qc, kc, vc, gc, bc = (chunks(a) for a in (q, k, v, g, beta))
    gcum = jnp.cumsum(gc, axis=-1)
    idx = jnp.arange(GDN_CHUNK)
    incl = idx[:, None] >= idx[None, :]
    strict = idx[:, None] > idx[None, :]
    decay = jnp.exp(jnp.where(incl, gcum[..., :, None] - gcum[..., None, :], -jnp.inf))
    kb = kc * bc[..., None]
    lmat = -jnp.where(strict, jnp.einsum('bnhid,bnhjd->bnhij', kb, kc) * decay, 0.0)
    tinv = jnp.eye(GDN_CHUNK, dtype=jnp.float32) + lmat
    power = lmat
    for _ in range(GDN_CHUNK_LOG2 - 1):
        power = power @ power
        tinv = tinv + tinv @ power
    u = tinv @ (vc * bc[..., None])
    w = tinv @ (kb * jnp.exp(gcum)[..., None])
    attn = jnp.einsum('bnhid,bnhjd->bnhij', qc, kc) * decay
    qg = qc * jnp.exp(gcum)[..., None]
    kdec = kc * jnp.exp(gcum[..., -1:] - gcum)[..., None]
    glast = jnp.exp(gcum[..., -1])

    def step(s, xs):
        qg_i, kdec_i, u_i, w_i, attn_i, gl_i = xs
        v_new = u_i - w_i @ s
        o_i = qg_i @ s + attn_i @ v_new
        s = s * gl_i[..., None, None] + jnp.einsum('bhcd,bhce->bhde', kdec_i, v_new)
        return s, o_i

    xs = tuple(jnp.moveaxis(a, 1, 0) for a in (qg, kdec, u, w, attn, glast))
    s_fin, o = lax.scan(step, s0, xs)
    o = o.transpose(1, 0, 3, 2, 4).reshape(bsz, t, h, -1)
    return o, s_fin


def gdn_bidir(pa, s0_f, s0_b, conv_w, a_log, dt_bias):
    bsz, t, _ = pa.shape
    qkv = jax.nn.silu(dwconv(pa[..., :3 * BRANCH_W], conv_w)).astype(jnp.float32)
    q, k, v = (a.reshape(bsz, t, H_A, HEAD_DIM) for a in jnp.split(qkv, 3, axis=-1))
    q = l2norm(q) * (HEAD_DIM ** -0.5)
    k = l2norm(k)
    ab = pa[..., 3 * BRANCH_W:A_COLS].astype(jnp.float32).reshape(bsz, t, 4, H_A)
    g = -jnp.exp(a_log.astype(jnp.float32)) * jax.nn.softplus(ab[:, :, :2] + dt_bias.astype(jnp.float32))
    beta = jax.nn.sigmoid(ab[:, :, 2:])
    o_f, s_f = gdn_chunked(q, k, v, g[:, :, 0], beta[:, :, 0], s0_f)
    rev = lambda a: jnp.flip(a, axis=1)
    o_b, s_b = gdn_chunked(rev(q), rev(k), rev(v), rev(g[:, :, 1]), rev(beta[:, :, 1]), s0_b)
    return (o_f + rev(o_b)).astype(pa.dtype), s_f, s_b


def spatial_gate(u, v, w_s, b_s):
    bsz, t, _ = v.shape
    n = t // MLP_CHUNK
    vv = v.reshape(bsz, n, MLP_CHUNK, G_D, HEAD_DIM)
    mixed = jnp.einsum('gpq,bnqgd->bnpgd', w_s, vv) + b_s.T[None, None, :, :, None]
    return u * mixed.reshape(bsz, t, BRANCH_W)


def mixer_output(o_a, p, gdn_norm_g, short_conv_w, conf_conv_w, conf_conv_b, conf_ln_g,
                 conf_ln_b, smlp_ln_g, smlp_ln_b, smlp_w, smlp_b, w_out):
    bsz, t, _ = p.shape
    y_a = rmsnorm(o_a, gdn_norm_g).reshape(bsz, t, BRANCH_W)
    off = A_COLS
    b_gate, c_gate, x_in = jnp.split(p[..., off:off + B_COLS], 3, axis=-1)
    y_b = b_gate * dwconv(c_gate * x_in, short_conv_w)
    off += B_COLS
    glu_a, glu_b = jnp.split(p[..., off:off + C_COLS], 2, axis=-1)
    z = dwconv(glu_a * jax.nn.sigmoid(glu_b), conf_conv_w) + conf_conv_b
    y_c = jax.nn.silu(layernorm(z, conf_ln_g, conf_ln_b))
    off += C_COLS
    u, v = jnp.split(p[..., off:off + D_COLS], 2, axis=-1)
    y_d = spatial_gate(u, layernorm(v, smlp_ln_g, smlp_ln_b), smlp_w, smlp_b)
    y = jnp.concatenate([y_a, y_b, y_c, y_d], axis=-1) * jax.nn.silu(p[..., IN_COLS - MIX_W:])
    return y @ w_out


def setup_inputs(seed: int = 0) -> dict:
    key = jax.random.key(seed)
    ks = jax.random.split(key, 24)
    nrm = lambda k, s, sc: jax.random.normal(k, s, jnp.float32) * sc
    dt = jnp.exp(jax.random.uniform(ks[9], (DEPTH, 2, H_A), jnp.float32, np.log(1e-3), np.log(1e-1)))
    return {
        'x': nrm(ks[0], (BATCH, SEQ, D_MODEL), 1.0),
        'c': nrm(ks[1], (BATCH, D_MODEL), 1.0),
        'ctx': nrm(ks[2], (BATCH, CTX_LEN, D_MODEL), 1.0),
        'c_ctx': nrm(ks[3], (D_MODEL,), 1.0),
        'norm_g': 1.0 + nrm(ks[4], (DEPTH, D_MODEL), 0.05),
        'w_ada': nrm(ks[5], (DEPTH, D_MODEL, 3 * D_MODEL), 0.5 * D_MODEL ** -0.5),
        'b_ada': nrm(ks[6], (DEPTH, 3 * D_MODEL), 0.02),
        'w_in': nrm(ks[7], (DEPTH, D_MODEL, IN_COLS), D_MODEL ** -0.5),
        'qkv_conv_w': nrm(ks[8], (DEPTH, QKV_CONV, 3 * BRANCH_W), QKV_CONV ** -0.5),
        'a_log': jnp.log(jax.random.uniform(ks[10], (DEPTH, 2, H_A), jnp.float32, 1.0, 16.0)),
        'dt_bias': dt + jnp.log(-jnp.expm1(-dt)),
        'gdn_norm_g': 1.0 + nrm(ks[11], (DEPTH, HEAD_DIM), 0.05),
        'short_conv_w': nrm(ks[12], (DEPTH, SHORT_CONV, BRANCH_W), SHORT_CONV ** -0.5),
        'conf_conv_w': nrm(ks[13], (DEPTH, CONF_CONV, BRANCH_W), CONF_CONV ** -0.5),
        'conf_conv_b': nrm(ks[14], (DEPTH, BRANCH_W), 0.02),
        'conf_ln_g': 1.0 + nrm(ks[15], (DEPTH, BRANCH_W), 0.05),
        'conf_ln_b': nrm(ks[16], (DEPTH, BRANCH_W), 0.02),
        'smlp_ln_g': 1.0 + nrm(ks[17], (DEPTH, BRANCH_W), 0.05),
        'smlp_ln_b': nrm(ks[18], (DEPTH, BRANCH_W), 0.02),
        'smlp_w': nrm(ks[19], (DEPTH, G_D, MLP_CHUNK, MLP_CHUNK), MLP_CHUNK ** -0.5),
        'smlp_b': 1.0 + nrm(ks[20], (DEPTH, G_D, MLP_CHUNK), 0.02),
        'w_out': nrm(ks[21], (DEPTH, MIX_W, D_MODEL), MIX_W ** -0.5),
        'final_g': 1.0 + nrm(ks[22], (D_MODEL,), 0.05),
    }


def reference(x, c, ctx, c_ctx, norm_g, w_ada, b_ada, w_in, qkv_conv_w, a_log, dt_bias,
              gdn_norm_g, short_conv_w, conf_conv_w, conf_conv_b, conf_ln_g, conf_ln_b,
              smlp_ln_g, smlp_ln_b, smlp_w, smlp_b, w_out, final_g):
    bsz = x.shape[0]
    xc = ctx
    silu_c = jax.nn.silu(c)
    silu_cc = jax.nn.silu(c_ctx)
    s_zero = jnp.zeros((bsz, H_A, HEAD_DIM, HEAD_DIM), jnp.float32)
    for l in range(DEPTH):
        last = l == DEPTH - 1
        mod = silu_c @ w_ada[l] + b_ada[l]
        shift, scale, gate = jnp.split(mod[:, None, :], 3, axis=-1)
        mod_c = silu_cc @ w_ada[l] + b_ada[l]
        shift_c, scale_c, gate_c = jnp.split(mod_c, 3, axis=-1)
        h = rmsnorm(x, norm_g[l]) * (1.0 + scale) + shift
        hc = rmsnorm(xc, norm_g[l]) * (1.0 + scale_c) + shift_c
        col_major = l % 2 == 1
        if col_major:
            h = to_col_major(h)
        p = h @ w_in[l]
        pc = hc @ (w_in[l][:, :A_COLS] if last else w_in[l])
        o_ctx, s_f, s_b = gdn_bidir(pc[..., :A_COLS], s_zero, s_zero, qkv_conv_w[l], a_log[l], dt_bias[l])
        o_lat, _, _ = gdn_bidir(p[..., :A_COLS], s_f, s_b, qkv_conv_w[l], a_log[l], dt_bias[l])
        y = mixer_output(o_lat, p, gdn_norm_g[l], short_conv_w[l], conf_conv_w[l], conf_conv_b[l],
                         conf_ln_g[l], conf_ln_b[l], smlp_ln_g[l], smlp_ln_b[l], smlp_w[l],
                         smlp_b[l], w_out[l])
        if col_major:
            y = from_col_major(y)
        x = x + gate * y
        if not last:
            yc = mixer_output(o_ctx, pc, gdn_norm_g[l], short_conv_w[l], conf_conv_w[l], conf_conv_b[l],
                              conf_ln_g[l], conf_ln_b[l], smlp_ln_g[l], smlp_ln_b[l], smlp_w[l],
                              smlp_b[l], w_out[l])
            xc = xc + gate_c * yc
    return rmsnorm(x, final_g)
```

```cpp
#include <hip/hip_runtime.h>
#include <cstdio>
#include <cstdint>

typedef unsigned short bf16_t;
__device__ __forceinline__ float bf2f(bf16_t v) { return __uint_as_float(((unsigned)v) << 16); }
__device__ __forceinline__ bf16_t f2bf(float f) { unsigned u = __float_as_uint(f); return (bf16_t)((u + 0x7fffu + ((u >> 16) & 1u)) >> 16); }

constexpr int DM = 1024, NB = 16, SEQ = 2048, DEPTH = 4, CTXL = 256, HD = 64, BW = 256, HA = 4;
constexpr int INC = 3600, NPC = 3584, NTILE = 14;
constexpr int MLAT = NB * SEQ, MCTX = NB * CTXL, MTOT = MLAT + MCTX;
constexpr float EPS = 1e-6f;
__device__ __constant__ int c_tile_col[NTILE] = {0, 256, 512, 2576, 784, 1040, 1296, 1552, 1808, 2064, 2320, 2832, 3088, 3344};
enum { T_Q = 0, T_K = 1, T_V = 2, T_GA = 3, T_BG = 4, T_CG = 5, T_XI = 6, T_GLA = 7, T_GLB = 8, T_U = 9, T_VV = 10, T_GB = 11, T_GC = 12, T_GD = 13 };

constexpr size_t MiB = 1u << 20;
constexpr size_t WS_CTL = 0, WS_MOD = 1 * MiB, WS_AB = 2 * MiB, WS_GB = 5 * MiB, WS_STAT = 8 * MiB, WS_XC = 16 * MiB, WS_WIN = 32 * MiB, WS_WOUT = 60 * MiB,
                 WS_HY = 68 * MiB, WS_P = 140 * MiB, WS_OFB = 392 * MiB, WS_END = 512 * MiB;
constexpr size_t PTILE_ELEMS = (size_t)MTOT * 256;
constexpr size_t WS_QKV = WS_P + 4 * PTILE_ELEMS * 2;

struct Ptrs {
    const float *x, *c, *ctx, *c_ctx, *norm_g, *w_ada, *b_ada, *w_in, *qkv_conv_w, *a_log, *dt_bias, *gdn_norm_g, *short_conv_w, *conf_conv_w, *conf_conv_b,
        *conf_ln_g, *conf_ln_b, *smlp_ln_g, *smlp_ln_b, *smlp_w, *smlp_b, *w_out, *final_g;
    float* out; unsigned char* ws;
};

__device__ __forceinline__ float silu_f(float x) { return x / (1.f + expf(-x)); }
__device__ __forceinline__ float sigmoid_f(float x) { return 1.f / (1.f + expf(-x)); }
__device__ __forceinline__ float softplus_f(float x) { return x > 20.f ? x : log1pf(expf(x)); }

__device__ __forceinline__ float block_sum256(float v, float* red) {
#pragma unroll
    for (int o = 32; o > 0; o >>= 1) v += __shfl_xor(v, o);
    __syncthreads();
    if ((threadIdx.x & 63) == 0) red[threadIdx.x >> 6] = v;
    __syncthreads();
    return red[0] + red[1] + red[2] + red[3];
}
__device__ __forceinline__ float wave_sum(float v) {
#pragma unroll
    for (int o = 32; o > 0; o >>= 1) v += __shfl_xor(v, o);
    return v;
}

__device__ __forceinline__ void row_seq(int row, int& start, int& len) { if (row < MLAT) { start = row & ~(SEQ - 1); len = SEQ; } else { start = row & ~(CTXL - 1); len = CTXL; } }

namespace pg8 {
#define PG8_LAS __attribute__((address_space(3)))
typedef unsigned short bf16_t;
typedef short bf16x8 __attribute__((ext_vector_type(8)));
typedef float f32x4 __attribute__((ext_vector_type(4)));
typedef unsigned u32x4 __attribute__((ext_vector_type(4)));
constexpr int BM = 256, BK = 64, HALF = 128, HTB = HALF * BK * 2  , STAGE_BYTES = 8 * HTB, NXCD = 8, WGM = 8;

__host__ __device__ __forceinline__ int lds_byte(int r, int c) { const int st = (r >> 4) * 2 + (c >> 5), rr = r & 15, cc = c & 31, ob = rr * 64 + cc * 2; return st * 1024 + (ob ^ (((ob >> 9) & 1) << 5)); }
__host__ __device__ __forceinline__ void stage_rc(int b, int& R, int& C) { const int st = b / 1024, sb = b % 1024, swz = sb ^ (((sb >> 9) & 1) << 5); R = (st >> 1) * 16 + swz / 64; C = (st & 1) * 32 + (swz % 64) / 2; }
__host__ __device__ __forceinline__ int perm32(int rho) { const int n = rho >> 4, i = rho & 15; return 8 * (i >> 2) + 4 * n + (i & 3); }

struct Unit { int pm, pn; };
struct Gemm { const bf16_t* A; const bf16_t* Bt; int M, N, K; };

struct StaticOrder {
    int nM, nN, nwg, G, c;
    __host__ __device__ void init(int M, int N, int G_, int c_) { nM = M / BM; nN = N / BM; nwg = nM * nN; G = G_; c = c_; }
    __host__ __device__ bool next(int i, Unit& u) const {
        const long L = (long)i * G + c; if (L >= nwg) return false;
        int wgid = (int)L; { const int q = nwg / NXCD, r = nwg % NXCD, xcd = wgid % NXCD, off = wgid / NXCD; wgid = (xcd < r ? xcd * (q + 1) : r * (q + 1) + (xcd - r) * q) + off; }
        const int nig = WGM * nN, gid = wgid / nig, fm = gid * WGM, gsz = (nM - fm) < WGM ? (nM - fm) : WGM;
        u.pm = fm + ((wgid % nig) % gsz); u.pn = (wgid % nig) / gsz; return true;
    }
    __device__ __forceinline__ void a_ready(const Unit&) const {}
    __device__ __forceinline__ void done(const Unit&) const {}
};


__device__ __forceinline__ unsigned cvt_pk_bf16(float lo, float hi) { unsigned r; asm volatile("v_cvt_pk_bf16_f32 %0, %1, %2" : "=v"(r) : "v"(lo), "v"(hi)); return r; }
struct EpiP {
    static constexpr bool PERM = true, AFTER_DRAIN = false;
    bf16_t* P; size_t tile_elems;
    __device__ __forceinline__ void operator()(const f32x4 (&acc)[2][2][4][2], const Unit& u, int wr, int wc, int fr, int fq) const {
        const int row0 = u.pm * BM + wr * 64 + fr;
        bf16_t* base = P + (size_t)u.pn * tile_elems + wc * 32 + 8 * fq;
#pragma unroll
        for (int ai = 0; ai < 2; ++ai)
#pragma unroll
            for (int m = 0; m < 4; ++m) { bf16_t* rowp = base + (size_t)(row0 + ai * HALF + m * 16) * 256;
#pragma unroll
                for (int bj = 0; bj < 2; ++bj) { const f32x4 v0 = acc[ai][bj][m][0], v1 = acc[ai][bj][m][1];
                    u32x4 w; w.x = cvt_pk_bf16(v0[0], v0[1]); w.y = cvt_pk_bf16(v0[2], v0[3]); w.z = cvt_pk_bf16(v1[0], v1[1]); w.w = cvt_pk_bf16(v1[2], v1[3]);
                    *(u32x4*)(rowp + bj * HALF) = w; } }
    }
};
struct EpiResid {
    static constexpr bool PERM = true, AFTER_DRAIN = false;
    const float* x_old; float* x_new; const float* xc_old; float* xc_new; const float* mod_l; int odd, mlat, seq, dm;
    __device__ __forceinline__ void operator()(const f32x4 (&acc)[2][2][4][2], const Unit& u, int wr, int wc, int fr, int fq) const {
        const int rbase = u.pm * BM; const bool lat = rbase < mlat; const int b = lat ? rbase / seq : 16;
        const int col = u.pn * BM + wc * 32 + 8 * fq;
        const float* gate = mod_l + (size_t)b * 3072 + 2048 + col;
        f32x4 g[2][2];
#pragma unroll
        for (int bj = 0; bj < 2; ++bj)
#pragma unroll
            for (int n = 0; n < 2; ++n) g[bj][n] = *(const f32x4*)(gate + bj * HALF + 4 * n);
#pragma unroll
        for (int ai = 0; ai < 2; ++ai)
#pragma unroll
            for (int m = 0; m < 4; ++m) { const int r = rbase + ai * HALF + wr * 64 + m * 16 + fr;
                const float* oldp; float* newp;
                if (lat) { const int tp = r % seq; const int t = odd ? ((tp & 31) * 64 + (tp >> 5)) : tp; const size_t off = ((size_t)(r / seq) * seq + t) * dm + col; oldp = x_old + off; newp = x_new + off; }
                else { const size_t off = (size_t)(r - mlat) * dm + col; oldp = xc_old + off; newp = xc_new + off; }
#pragma unroll
                for (int bj = 0; bj < 2; ++bj)
#pragma unroll
                    for (int n = 0; n < 2; ++n) { const f32x4 o = *(const f32x4*)(oldp + bj * HALF + 4 * n); *(f32x4*)(newp + bj * HALF + 4 * n) = o + g[bj][n] * acc[ai][bj][m][n]; } }
    }
};

template <class Epi, class Sched, bool ALIGN_EPI = false, bool SP2 = false>
__device__ __forceinline__ void gemm_phase(PG8_LAS unsigned char* lds, const Gemm g, const Sched& S, const Epi& E) {
    int tid_ = threadIdx.x; asm volatile("" : "+v"(tid_));
    const int tid = tid_, wid = __builtin_amdgcn_readfirstlane(tid >> 6), lane = tid & 63, wr = wid >> 2, wc = wid & 3, fr = lane & 15, fq = lane >> 4;
    const int K = g.K, nt = K / BK;
    unsigned voffA[2], voffB[2];
#pragma unroll
    for (int i = 0; i < 2; ++i) { int R, C; stage_rc(tid * 16 + i * 8192, R, C); const int Rb = Epi::PERM ? ((R & ~31) + perm32(R & 31)) : R;
        voffA[i] = (unsigned)(R * K + C) * 2u; voffB[i] = (unsigned)(Rb * K + C) * 2u; }
    const size_t kstep = (size_t)(BK * 2);
    const size_t hstep = (size_t)HALF * K * 2;
    const size_t tstep = 2 * hstep;
    const unsigned ldsw = (unsigned)wid * 1024u;
    const int aoff = lds_byte(wr * 64 + fr, fq * 8), boff = lds_byte(wc * 32 + fr, fq * 8);
#define PG8_SA(b, h) (((b) * 2 + (h)) * HTB)
#define PG8_SB(b, h) ((4 + (b) * 2 + (h)) * HTB)
#define PG8_STAGE(bufoff, gbase, voff) do { _Pragma("unroll") for (int _i = 0; _i < 2; ++_i) \
        __builtin_amdgcn_global_load_lds((const unsigned*)((const char*)(gbase) + (voff)[_i]), (PG8_LAS unsigned*)(lds + (bufoff) + ldsw + _i * 8192), 16, 0, 0); } while (0)
#define PG8_LDA(dst, b, h) do { _Pragma("unroll") for (int m = 0; m < 4; ++m) _Pragma("unroll") for (int k = 0; k < 2; ++k) dst[m][k] = *(const PG8_LAS bf16x8*)(lds + PG8_SA(b, h) + aoff + m * 2048 + k * 1024); } while (0)
#define PG8_LDB(dst, b, h) do { _Pragma("unroll") for (int n = 0; n < 2; ++n) _Pragma("unroll") for (int k = 0; k < 2; ++k) dst[n][k] = *(const PG8_LAS bf16x8*)(lds + PG8_SB(b, h) + boff + n * 2048 + k * 1024); } while (0)
#define PG8_MMA(ai, bj, At, Bt) do { __builtin_amdgcn_s_setprio(1); _Pragma("unroll") for (int m = 0; m < 4; ++m) _Pragma("unroll") for (int n = 0; n < 2; ++n) _Pragma("unroll") for (int k = 0; k < 2; ++k) \
        acc[ai][bj][m][n] = __builtin_amdgcn_mfma_f32_16x16x32_bf16(Bt[n][k], At[m][k], acc[ai][bj][m][n], 0, 0, 0); __builtin_amdgcn_s_setprio(0); } while (0)
#define PG8_WAIT_V(n) asm volatile("s_waitcnt vmcnt(" #n ")" ::: "memory")
#define PG8_WAIT_L(n) asm volatile("s_waitcnt lgkmcnt(" #n ")" ::: "memory")
#define PG8_BAR __builtin_amdgcn_s_barrier()
#define PG8_SCHED __builtin_amdgcn_sched_barrier(0)
    Unit cur, nxt; int ui = 0;
    if (!S.next(0, cur)) return;
    f32x4 acc[2][2][4][2];
#pragma unroll
    for (int a = 0; a < 2; ++a)
#pragma unroll
        for (int b = 0; b < 2; ++b)
#pragma unroll
            for (int m = 0; m < 4; ++m)
#pragma unroll
                for (int n = 0; n < 2; ++n) acc[a][b][m][n] = (f32x4){0.f, 0.f, 0.f, 0.f};
    bf16x8 At[4][2], B0[2][2], B1[2][2];
    const char* cA = (const char*)g.A + (size_t)cur.pm * tstep; const char* cB = (const char*)g.Bt + (size_t)cur.pn * tstep;
    S.a_ready(cur);
    if constexpr (SP2) {
        PG8_STAGE(PG8_SB(0, 0), cB, voffB); PG8_STAGE(PG8_SB(0, 1), cB + hstep, voffB); PG8_STAGE(PG8_SA(0, 0), cA, voffA); PG8_STAGE(PG8_SA(0, 1), cA + hstep, voffA);
        if (wr == 1) PG8_BAR;
        PG8_WAIT_V(2); PG8_BAR;
        PG8_STAGE(PG8_SB(1, 0), cB + kstep, voffB); PG8_STAGE(PG8_SA(1, 0), cA + kstep, voffA); PG8_STAGE(PG8_SB(1, 1), cB + hstep + kstep, voffB);
        PG8_WAIT_V(6); PG8_BAR;
    } else {
        PG8_STAGE(PG8_SB(0, 0), cB, voffB); PG8_STAGE(PG8_SA(0, 0), cA, voffA); PG8_STAGE(PG8_SB(0, 1), cB + hstep, voffB); PG8_STAGE(PG8_SA(0, 1), cA + hstep, voffA);
        if (wr == 1) PG8_BAR;
        PG8_WAIT_V(4); PG8_BAR;
        PG8_STAGE(PG8_SB(1, 0), cB + kstep, voffB); PG8_STAGE(PG8_SA(1, 0), cA + kstep, voffA); PG8_STAGE(PG8_SB(1, 1), cB + hstep + kstep, voffB);
        PG8_WAIT_V(6); PG8_BAR;
    }
    for (;;) {
        const bool has_next = S.next(ui + 1, nxt);
        const char* nA = has_next ? (const char*)g.A + (size_t)nxt.pm * tstep : cA; const char* nB = has_next ? (const char*)g.Bt + (size_t)nxt.pn * tstep : cB;
        for (int t = 0; t < nt; t += 2) {
            const bool last = (t == nt - 2);
            const char* a1 = cA + (size_t)(t + 1) * kstep;
            const char* a2 = last ? nA : cA + (size_t)(t + 2) * kstep; const char* b2 = last ? nB : cB + (size_t)(t + 2) * kstep;
            const char* a3 = a2 + kstep; const char* b3 = b2 + kstep;
            if (last && has_next) S.a_ready(nxt);
            if constexpr (SP2) {
            PG8_LDB(B0, 0, 0); PG8_LDB(B1, 0, 1); PG8_SCHED; PG8_LDA(At, 0, 0); PG8_STAGE(PG8_SA(1, 1), a1 + hstep, voffA);
            PG8_WAIT_V(8); PG8_WAIT_L(0); PG8_BAR; PG8_MMA(0, 0, At, B0); PG8_MMA(0, 1, At, B1); PG8_BAR; PG8_SCHED;
            PG8_LDA(At, 0, 1); PG8_STAGE(PG8_SB(0, 0), b2, voffB); PG8_STAGE(PG8_SB(0, 1), b2 + hstep, voffB); PG8_STAGE(PG8_SA(0, 0), a2, voffA);
            PG8_WAIT_V(8); PG8_WAIT_L(0); PG8_BAR; PG8_MMA(1, 0, At, B0); PG8_MMA(1, 1, At, B1); PG8_BAR; PG8_SCHED;
            PG8_LDB(B0, 1, 0); PG8_LDB(B1, 1, 1); PG8_SCHED; PG8_LDA(At, 1, 0); PG8_STAGE(PG8_SA(0, 1), a2 + hstep, voffA);
            PG8_WAIT_V(8); PG8_WAIT_L(0); PG8_BAR; PG8_MMA(0, 0, At, B0); PG8_MMA(0, 1, At, B1); PG8_BAR; PG8_SCHED;
            PG8_LDA(At, 1, 1); PG8_STAGE(PG8_SB(1, 0), b3, voffB); PG8_STAGE(PG8_SB(1, 1), b3 + hstep, voffB); PG8_STAGE(PG8_SA(1, 0), a3, voffA);
            PG8_WAIT_V(8); PG8_WAIT_L(0); PG8_BAR; PG8_MMA(1, 0, At, B0); PG8_MMA(1, 1, At, B1); PG8_BAR; PG8_SCHED;
            } else {
            PG8_LDB(B0, 0, 0); PG8_SCHED; PG8_LDA(At, 0, 0); PG8_STAGE(PG8_SA(1, 1), a1 + hstep, voffA);
            PG8_WAIT_L(8); PG8_BAR; PG8_WAIT_L(0); PG8_MMA(0, 0, At, B0); PG8_BAR; PG8_SCHED;
            PG8_LDB(B1, 0, 1); PG8_STAGE(PG8_SB(0, 0), b2, voffB);
            PG8_BAR; PG8_WAIT_L(0); PG8_MMA(0, 1, At, B1); PG8_BAR;
            PG8_LDA(At, 0, 1); PG8_STAGE(PG8_SA(0, 0), a2, voffA);
            PG8_BAR; PG8_WAIT_L(0); PG8_MMA(1, 0, At, B0); PG8_BAR; PG8_SCHED;
            PG8_STAGE(PG8_SB(0, 1), b2 + hstep, voffB);
            PG8_WAIT_V(6); PG8_BAR; PG8_MMA(1, 1, At, B1); PG8_BAR;
            PG8_LDB(B0, 1, 0); PG8_SCHED; PG8_LDA(At, 1, 0); PG8_STAGE(PG8_SA(0, 1), a2 + hstep, voffA);
            PG8_WAIT_L(8); PG8_BAR; PG8_WAIT_L(0); PG8_MMA(0, 0, At, B0); PG8_BAR; PG8_SCHED;
            PG8_LDB(B1, 1, 1); PG8_STAGE(PG8_SB(1, 0), b3, voffB);
            PG8_BAR; PG8_WAIT_L(0); PG8_MMA(0, 1, At, B1); PG8_BAR;
            PG8_LDA(At, 1, 1); PG8_STAGE(PG8_SA(1, 0), a3, voffA);
            PG8_BAR; PG8_WAIT_L(0); PG8_MMA(1, 0, At, B0); PG8_BAR; PG8_SCHED;
            PG8_STAGE(PG8_SB(1, 1), b3 + hstep, voffB);
            PG8_WAIT_V(6); PG8_BAR; PG8_MMA(1, 1, At, B1); PG8_BAR;
            }
        }
        if constexpr (ALIGN_EPI) { if (wr == 0) PG8_BAR; }
        if constexpr (!Epi::AFTER_DRAIN) { E(acc, cur, wr, wc, fr, fq); S.done(cur); }
        if (!has_next) break;
#pragma unroll
        for (int a = 0; a < 2; ++a)
#pragma unroll
            for (int b = 0; b < 2; ++b)
#pragma unroll
                for (int m = 0; m < 4; ++m)
#pragma unroll
                    for (int n = 0; n < 2; ++n) acc[a][b][m][n] = (f32x4){0.f, 0.f, 0.f, 0.f};
        cur = nxt; cA = nA; cB = nB; ++ui;
        if constexpr (ALIGN_EPI) { if (wr == 1) PG8_BAR; }
    }
    PG8_WAIT_V(0);
    if constexpr (!ALIGN_EPI) { if (wr == 0) PG8_BAR; }
    PG8_BAR;
    if constexpr (Epi::AFTER_DRAIN) { E.fused(acc, cur, wr, wc, fr, fq, lds, wid, lane); S.done(cur); }
#undef PG8_SA
#undef PG8_SB
#undef PG8_STAGE
#undef PG8_LDA
#undef PG8_LDB
#undef PG8_MMA
#undef PG8_WAIT_V
#undef PG8_WAIT_L
#undef PG8_BAR
#undef PG8_SCHED
}
}

constexpr int NWAVES = 8;
constexpr int RING_BYTES = 131072, LDSCTL_OFF = RING_BYTES, MISC_OFF = LDSCTL_OFF + 320, LDS_BYTES = 147456;
constexpr int CW_BAR = 4096;
constexpr size_t CTL_ZERO_BYTES = 64 * 1024;
#define GAS __attribute__((address_space(1)))
#define LAS __attribute__((address_space(3)))
typedef unsigned v4u __attribute__((ext_vector_type(4)));
typedef float f32x4 __attribute__((ext_vector_type(4)));
typedef GAS unsigned gu32;
#define LDS_WAIT() asm volatile("s_waitcnt lgkmcnt(0)" ::: "memory")
#define VM_WAIT() asm volatile("s_waitcnt vmcnt(0)" ::: "memory")
__device__ __forceinline__ unsigned pk2(float lo, float hi) { return (unsigned)f2bf(lo) | ((unsigned)f2bf(hi) << 16); }

#define XB_TMO      128
#define XB_XCNT(j)  (256  + 64 * (j))
#define XB_XSUB(j)  (1280 + 64 * (j))
#define XB_XGEN(j)  (2304 + 64 * (j))
#define XB_TOP      3328
#define XB_TOPGEN   3392
#define XCD_BAR_WORDS 3456
#define XB_SPIN_CAP (1u << 22)

__device__ __forceinline__ unsigned xb_ld(unsigned* p)              { return __hip_atomic_load(p, __ATOMIC_RELAXED, __HIP_MEMORY_SCOPE_AGENT); }
__device__ __forceinline__ unsigned xb_add(unsigned* p, unsigned v) { return __hip_atomic_fetch_add(p, v, __ATOMIC_RELAXED, __HIP_MEMORY_SCOPE_AGENT); }
__device__ __forceinline__ unsigned xb_xcc_id() { return (unsigned)__builtin_amdgcn_s_getreg((3 << 11) | 20) & 0xFu; }
#define XB_SPIN(cond, bar) do { unsigned _sp = 0; while (cond) { __builtin_amdgcn_s_sleep(1); \
    if ((++_sp & 255u) == 0u) { if (xb_ld(&(bar)[XB_TMO])) break; if (_sp > XB_SPIN_CAP) { atomicAdd(&(bar)[XB_TMO], 1u); break; } } } } while (0)

struct XcdBarrier {
    unsigned* bar; unsigned x;
    volatile LAS unsigned* st;
};

__device__ __forceinline__ XcdBarrier xcd_barrier_post(unsigned* bar, volatile LAS unsigned* st) {
    XcdBarrier b; b.bar = bar; b.x = xb_xcc_id(); b.st = st;
    if (threadIdx.x == 0) (void)xb_add(&bar[XB_XCNT(b.x)], 1u);
    return b;
}
__device__ __forceinline__ void xcd_barrier_complete(unsigned* bar, unsigned x, unsigned& nloc, unsigned& nx) {
    const unsigned G = gridDim.x * gridDim.y * gridDim.z;
    unsigned sum, cnt, mine, sp = 0u;
    for (;;) {
        sum = 0u; cnt = 0u; mine = 0u;
#pragma unroll
        for (unsigned j = 0; j < 16; ++j) { const unsigned c = xb_ld(&bar[XB_XCNT(j)]); sum += c; cnt += (c > 0u) ? 1u : 0u; mine = (j == x) ? c : mine; }
        if (sum == G) break;
        __builtin_amdgcn_s_sleep(1);
        if ((++sp & 255u) == 0u) { if (xb_ld(&bar[XB_TMO])) break; if (sp > XB_SPIN_CAP) { atomicAdd(&bar[XB_TMO], 1u); break; } }
    }
    nloc = mine > 0u ? mine : 1u; nx = cnt > 0u ? cnt : 1u;
}

__device__ __forceinline__ void xcd_barrier(const XcdBarrier& b) {
    asm volatile("s_waitcnt vmcnt(0)" ::: "memory");
    __syncthreads();
    if (threadIdx.x == 0) {
        unsigned* bar = b.bar;
        __builtin_amdgcn_s_waitcnt(0);
        unsigned nloc = b.st[0], nx = b.st[1];
        if (nloc == 0u) { xcd_barrier_complete(bar, b.x, nloc, nx); b.st[0] = nloc; b.st[1] = nx; }
        const unsigned old = xb_add(&bar[XB_XSUB(b.x)], 1u);
        const unsigned gen = old / nloc;
        if (old + 1u == (gen + 1u) * nloc) {
            __builtin_amdgcn_fence(__ATOMIC_RELEASE, "agent");
            asm volatile("s_waitcnt vmcnt(0)" ::: "memory");
            const unsigned og = xb_add(&bar[XB_TOP], 1u);
            const unsigned tg = og / nx;
            if (og + 1u == (tg + 1u) * nx) xb_add(&bar[XB_TOPGEN], 1u);
            else XB_SPIN(xb_ld(&bar[XB_TOPGEN]) == tg, bar);
            __builtin_amdgcn_fence(__ATOMIC_ACQUIRE, "agent");
            xb_add(&bar[XB_XGEN(b.x)], 1u);
            asm volatile("s_waitcnt vmcnt(0)" ::: "memory");
        } else {
            XB_SPIN(xb_ld(&bar[XB_XGEN(b.x)]) == gen, bar);
            __builtin_amdgcn_fence(__ATOMIC_ACQUIRE, "agent");
            asm volatile("s_waitcnt vmcnt(0)" ::: "memory");
        }
    }
    __syncthreads();
}


struct Frame {
    LAS unsigned char* lds; volatile LAS unsigned* MISC; gu32* ctl;
    int tid, lane, wave, vcu, G;
    Ptrs p;
    __device__ __forceinline__ void refresh() { int t = threadIdx.x; asm volatile("" : "+v"(t)); tid = t; lane = t & 63; wave = __builtin_amdgcn_readfirstlane(t >> 6); }
};

__device__ __forceinline__ void transpose_item(const float* W, int ld, bf16_t* WT, LAS float* scr, int k0, int lane) {
#pragma unroll 8
    for (int i = 0; i < 32; ++i) { const int kk = 2 * i + (lane >> 5); scr[kk * 33 + (lane & 31)] = W[(size_t)(k0 + kk) * ld + (lane & 31)]; }
    LDS_WAIT(); asm volatile("" ::: "memory");
    const int c = lane & 7;
#pragma unroll
    for (int j = 0; j < 4; ++j) { const int n = (lane >> 3) + 8 * j; const LAS float* s = scr + (8 * c) * 33 + n;
        v4u o; o.x = pk2(s[0 * 33], s[1 * 33]); o.y = pk2(s[2 * 33], s[3 * 33]); o.z = pk2(s[4 * 33], s[5 * 33]); o.w = pk2(s[6 * 33], s[7 * 33]);
        *(GAS v4u*)(WT + (size_t)n * DM + k0 + 8 * c) = o; }
    LDS_WAIT(); asm volatile("" ::: "memory");
}
__device__ __forceinline__ void phase_pre(Frame& F) {
    const Ptrs& p = F.p;
    if (F.vcu < DEPTH * 48) {
        const int l = F.vcu / 48, n0 = (F.vcu % 48) * 64;
        LAS float* s = (LAS float*)F.lds;
        LAS float* red = s + 17 * DM;
        for (int i = F.tid; i < 17 * DM; i += NWAVES * 64) { const int b = i >> 10, k = i & 1023; s[i] = silu_f(b < 16 ? p.c[b * DM + k] : p.c_ctx[k]); }
        __syncthreads();
        const int kg = F.tid >> 6, col = F.tid & 63;
        float acc[17];
#pragma unroll
        for (int b = 0; b < 17; ++b) acc[b] = 0.f;
        const float* w = p.w_ada + (size_t)l * DM * 3072 + n0 + col;
#pragma unroll 4
        for (int kk = 0; kk < 128; ++kk) { const int k = kg * 128 + kk; const float wv = w[(size_t)k * 3072];
#pragma unroll
            for (int b = 0; b < 17; ++b) acc[b] += s[b * DM + k] * wv; }
#pragma unroll
        for (int b = 0; b < 17; ++b) red[(kg * 17 + b) * 64 + col] = acc[b];
        __syncthreads();
        float* mod = (float*)(p.ws + WS_MOD);
        for (int o = F.tid; o < 17 * 64; o += NWAVES * 64) { const int b = o >> 6, cc = o & 63; float sum = p.b_ada[l * 3072 + n0 + cc];
#pragma unroll
            for (int g = 0; g < 8; ++g) sum += red[(g * 17 + b) * 64 + cc];
            mod[(size_t)(l * 17 + b) * 3072 + n0 + cc] = sum; }
        __syncthreads();
    }
    LAS float* scr = (LAS float*)(F.lds + F.wave * 16384);
    const int gw = F.vcu * NWAVES + F.wave, NGW = F.G * NWAVES;
    constexpr int I_IN = 16 * (NPC / 32), I_OUT = 16 * (DM / 32), I_L = I_IN + I_OUT;
    for (int it = gw; it < DEPTH * I_L; it += NGW) {
        const int l = it / I_L; int r = it % I_L;
        if (r < I_IN) { const int kb = r / (NPC / 32), nb = r % (NPC / 32), n0 = 32 * nb;
            transpose_item(p.w_in + (size_t)l * DM * INC + c_tile_col[n0 >> 8] + (n0 & 255), INC, (bf16_t*)(p.ws + WS_WIN) + ((size_t)l * NPC + n0) * DM, scr, 64 * kb, F.lane); }
        else { r -= I_IN; const int kb = r / (DM / 32), nb = r % (DM / 32), n0 = 32 * nb;
            transpose_item(p.w_out + (size_t)l * DM * DM + n0, DM, (bf16_t*)(p.ws + WS_WOUT) + ((size_t)l * DM + n0) * DM, scr, 64 * kb, F.lane); }
    }
    { bf16_t* wsb = (bf16_t*)(p.ws + (9u << 20));
      for (int i = F.vcu * NWAVES * 64 + F.tid; i < DEPTH * 4 * 128 * 128 / 4; i += F.G * NWAVES * 64) { const f32x4 v = *(const f32x4*)(p.smlp_w + 4 * (size_t)i);
          unsigned long long o = (unsigned long long)pk2(v.x, v.y) | ((unsigned long long)pk2(v.z, v.w) << 32); *(GAS unsigned long long*)(wsb + 4 * (size_t)i) = o; } }
}

__device__ __forceinline__ void phase_norm(Frame& F, int l) {
    const Ptrs& p = F.p;
    LAS float* wab = (LAS float*)F.lds;
    for (int i = F.tid; i < 16 * DM; i += NWAVES * 64) { const int k = i >> 4, j = i & 15; wab[j * DM + k] = p.w_in[(size_t)l * DM * INC + (size_t)k * INC + 768 + j]; }
    __syncthreads();
    const int gw = F.vcu * NWAVES + F.wave, lane = F.lane;
    constexpr int RPW = MTOT / (256 * NWAVES);
    int curb = -1; f32x4 gs[4], sh[4];
    for (int r = gw * RPW; r < MTOT && r < (gw + 1) * RPW; ++r) {
        const float* src; int b;
        if (r < MLAT) { b = r >> 11; const int tp = r & 2047; const int t = (l & 1) ? ((tp & 31) * 64 + (tp >> 5)) : tp; src = (l == 0 ? p.x : p.out) + ((size_t)b * SEQ + t) * DM; }
        else { b = 16; src = (l == 0 ? p.ctx : (const float*)(p.ws + WS_XC)) + (size_t)(r - MLAT) * DM; }
        if (b != curb) { curb = b; const float* mod = (const float*)(p.ws + WS_MOD) + (size_t)(l * 17 + b) * 3072;
#pragma unroll
            for (int j = 0; j < 4; ++j) { const f32x4 g = *(const f32x4*)(p.norm_g + l * DM + 256 * j + 4 * lane), sc = *(const f32x4*)(mod + 1024 + 256 * j + 4 * lane);
                gs[j] = g * (sc + 1.0f); sh[j] = *(const f32x4*)(mod + 256 * j + 4 * lane); } }
        const GAS f32x4* xr = (const GAS f32x4*)src + lane;
        f32x4 v[4]; float ss = 0.f;
#pragma unroll
        for (int j = 0; j < 4; ++j) { v[j] = xr[64 * j]; ss += (v[j].x * v[j].x + v[j].y * v[j].y) + (v[j].z * v[j].z + v[j].w * v[j].w); }
        ss = wave_sum(ss);
        const float rstd = 1.0f / sqrtf(ss * (1.0f / DM) + EPS);
        GAS unsigned long long* o8 = (GAS unsigned long long*)((bf16_t*)(p.ws + WS_HY) + (size_t)r * DM) + lane;
#pragma unroll
        for (int j = 0; j < 4; ++j) { v[j] = v[j] * rstd * gs[j] + sh[j]; o8[64 * j] = (unsigned long long)pk2(v[j].x, v[j].y) | ((unsigned long long)pk2(v[j].z, v[j].w) << 32); }
        float acc[16];
#pragma unroll
        for (int n = 0; n < 16; ++n) { float a = 0.f;
#pragma unroll
            for (int j = 0; j < 4; ++j) { const f32x4 w4 = *(const LAS f32x4*)(wab + n * DM + 256 * j + 4 * lane); a += (v[j].x * w4.x + v[j].y * w4.y) + (v[j].z * w4.z + v[j].w * w4.w); }
            acc[n] = a; if ((n & 1) == 1) asm volatile("" ::: "memory"); }
        float r8[8], r4[4], r2[2], r1;
        { const bool up = lane & 32;
#pragma unroll
          for (int i = 0; i < 8; ++i) { const float keep = up ? acc[i + 8] : acc[i], send = up ? acc[i] : acc[i + 8]; r8[i] = keep + __shfl_xor(send, 32); } }
        { const bool up = lane & 16;
#pragma unroll
          for (int i = 0; i < 4; ++i) { const float keep = up ? r8[i + 4] : r8[i], send = up ? r8[i] : r8[i + 4]; r4[i] = keep + __shfl_xor(send, 16); } }
        { const bool up = lane & 8;
#pragma unroll
          for (int i = 0; i < 2; ++i) { const float keep = up ? r4[i + 2] : r4[i], send = up ? r4[i] : r4[i + 2]; r2[i] = keep + __shfl_xor(send, 8); } }
        { const bool up = lane & 4; const float keep = up ? r2[1] : r2[0], send = up ? r2[0] : r2[1]; r1 = keep + __shfl_xor(send, 4); }
        r1 += __shfl_xor(r1, 2); r1 += __shfl_xor(r1, 1);
        if ((lane & 3) == 0) ((float*)(p.ws + WS_AB))[(size_t)r * 16 + (lane >> 2)] = r1;
    }
    __syncthreads();
}

__device__ __forceinline__ void phase_final(Frame& F) {
    const Ptrs& p = F.p; const int lane = F.lane;
    const int gw = F.vcu * NWAVES + F.wave, NGW = F.G * NWAVES;
    f32x4 g[4];
#pragma unroll
    for (int j = 0; j < 4; ++j) g[j] = *(const f32x4*)(p.final_g + 256 * j + 4 * lane);
    for (int r = gw; r < MLAT; r += NGW) {
        GAS f32x4* xr = (GAS f32x4*)(p.out + (size_t)r * DM) + lane;
        f32x4 v[4]; float ss = 0.f;
#pragma unroll
        for (int j = 0; j < 4; ++j) { v[j] = xr[64 * j]; ss += (v[j].x * v[j].x + v[j].y * v[j].y) + (v[j].z * v[j].z + v[j].w * v[j].w); }
        ss = wave_sum(ss);
        const float rstd = 1.0f / sqrtf(ss * (1.0f / DM) + EPS);
#pragma unroll
        for (int j = 0; j < 4; ++j) xr[64 * j] = v[j] * rstd * g[j];
    }
}

__device__ __forceinline__ void phase_gemm1(Frame& F, int l) {
    const Ptrs& p = F.p;
    pg8::Gemm g{(const bf16_t*)(p.ws + WS_HY), (const bf16_t*)(p.ws + WS_WIN) + (size_t)l * NPC * DM, MTOT, NPC, DM};
    pg8::StaticOrder S; S.init(MTOT, NPC, F.G, (int)blockIdx.x);
    pg8::EpiP E{(bf16_t*)(p.ws + WS_P), PTILE_ELEMS};
    pg8::gemm_phase<pg8::EpiP, pg8::StaticOrder, true, true>(F.lds, g, S, E);
}
__device__ __forceinline__ void phase_gemm2(Frame& F, int l) {
    const Ptrs& p = F.p;
    const int M = (l == DEPTH - 1) ? MLAT : MTOT;
    pg8::Gemm g{(const bf16_t*)(p.ws + WS_HY), (const bf16_t*)(p.ws + WS_WOUT) + (size_t)l * DM * DM, M, DM, DM};
    pg8::StaticOrder S; S.init(M, DM, F.G, (int)blockIdx.x);
    pg8::EpiResid E{l == 0 ? p.x : p.out, p.out, l == 0 ? p.ctx : (const float*)(p.ws + WS_XC), (float*)(p.ws + WS_XC), (const float*)(p.ws + WS_MOD) + (size_t)l * 17 * 3072, l & 1, MLAT, SEQ, DM};
    pg8::gemm_phase<pg8::EpiResid, pg8::StaticOrder, true, true>(F.lds, g, S, E);
}


typedef short bf16x8 __attribute__((ext_vector_type(8)));
typedef short s16x4 __attribute__((ext_vector_type(4)));
typedef unsigned u32x2 __attribute__((ext_vector_type(2)));
__device__ __forceinline__ float fexp(float x) { return __builtin_amdgcn_exp2f(x * 1.44269504089f); }
__device__ __forceinline__ float fsigmoid(float x) { return __builtin_amdgcn_rcpf(1.f + fexp(-x)); }
__device__ __forceinline__ float fsilu(float x) { return x * fsigmoid(x); }
__device__ __forceinline__ float bflo(unsigned w) { return __uint_as_float(w << 16); }
__device__ __forceinline__ float bfhi(unsigned w) { return __uint_as_float(w & 0xffff0000u); }
__device__ __forceinline__ void unpack8(const v4u& w, float (&f)[8]) { f[0] = bflo(w.x); f[1] = bfhi(w.x); f[2] = bflo(w.y); f[3] = bfhi(w.y); f[4] = bflo(w.z); f[5] = bfhi(w.z); f[6] = bflo(w.w); f[7] = bfhi(w.w); }
__device__ __forceinline__ const bf16_t* ptile_d(const Ptrs& p, int t) { return (const bf16_t*)(p.ws + WS_P) + (size_t)t * PTILE_ELEMS; }
constexpr size_t WS_WSB = 9 * MiB;

__device__ __forceinline__ void mix_unit_B(Frame& F, int l, int row0) {
    const Ptrs& p = F.p; const int oct = F.tid & 31, tg = F.tid >> 5;
    int start, len; row_seq(row0, start, len);
    const bf16_t *CG = ptile_d(p, T_CG), *XI = ptile_d(p, T_XI), *BG = ptile_d(p, T_BG), *GB = ptile_d(p, T_GB);
    float w[3][8];
#pragma unroll
    for (int j = 0; j < 3; ++j) { const f32x4 a = *(const f32x4*)(p.short_conv_w + (size_t)(l * 3 + j) * BW + 8 * oct), b = *(const f32x4*)(p.short_conv_w + (size_t)(l * 3 + j) * BW + 8 * oct + 4);
        w[j][0] = a.x; w[j][1] = a.y; w[j][2] = a.z; w[j][3] = a.w; w[j][4] = b.x; w[j][5] = b.y; w[j][6] = b.z; w[j][7] = b.w; }
    const int r0 = row0 + tg * 8;
    float cx[10][8];
#pragma unroll
    for (int i = 0; i < 10; ++i) { const int r = r0 + i - 1;
        if (r >= start && r < start + len) { const v4u a = *(const GAS v4u*)(CG + (size_t)r * 256 + 8 * oct), b = *(const GAS v4u*)(XI + (size_t)r * 256 + 8 * oct); float fa[8], fb[8]; unpack8(a, fa); unpack8(b, fb);
#pragma unroll
            for (int e = 0; e < 8; ++e) cx[i][e] = fa[e] * fb[e]; }
        else {
#pragma unroll
            for (int e = 0; e < 8; ++e) cx[i][e] = 0.f; } }
#pragma unroll
    for (int i = 0; i < 8; ++i) { const int r = r0 + i;
        const v4u bgw = *(const GAS v4u*)(BG + (size_t)r * 256 + 8 * oct), gw = *(const GAS v4u*)(GB + (size_t)r * 256 + 8 * oct); float bg[8], gt[8], y[8]; unpack8(bgw, bg); unpack8(gw, gt);
#pragma unroll
        for (int e = 0; e < 8; ++e) y[e] = bg[e] * (w[0][e] * cx[i][e] + w[1][e] * cx[i + 1][e] + w[2][e] * cx[i + 2][e]) * fsilu(gt[e]);
        v4u o; o.x = pk2(y[0], y[1]); o.y = pk2(y[2], y[3]); o.z = pk2(y[4], y[5]); o.w = pk2(y[6], y[7]);
        *(GAS v4u*)((bf16_t*)(p.ws + WS_HY) + (size_t)r * DM + 256 + 8 * oct) = o; }
}

__device__ __forceinline__ void mix_unit_C(Frame& F, int l, int row0) {
    const Ptrs& p = F.p; const int tid = F.tid, lane = F.lane, wave = F.wave;
    int start, len; row_seq(row0, start, len);
    const bf16_t *GA = ptile_d(p, T_GLA), *GLB = ptile_d(p, T_GLB), *GC = ptile_d(p, T_GC);
    LAS float* glu = (LAS float*)F.lds;
    for (int idx = tid; idx < 94 * 32; idx += NWAVES * 64) { const int i = idx >> 5, oct = idx & 31, r = row0 - 15 + i;
        f32x4 o0 = {0.f, 0.f, 0.f, 0.f}, o1 = {0.f, 0.f, 0.f, 0.f};
        if (r >= start && r < start + len) { const v4u a = *(const GAS v4u*)(GA + (size_t)r * 256 + 8 * oct), b = *(const GAS v4u*)(GLB + (size_t)r * 256 + 8 * oct); float fa[8], fb[8]; unpack8(a, fa); unpack8(b, fb);
            o0 = (f32x4){fa[0] * fsigmoid(fb[0]), fa[1] * fsigmoid(fb[1]), fa[2] * fsigmoid(fb[2]), fa[3] * fsigmoid(fb[3])};
            o1 = (f32x4){fa[4] * fsigmoid(fb[4]), fa[5] * fsigmoid(fb[5]), fa[6] * fsigmoid(fb[6]), fa[7] * fsigmoid(fb[7])}; }
        *(LAS f32x4*)(glu + i * 256 + 8 * oct) = o0; *(LAS f32x4*)(glu + i * 256 + 8 * oct + 4) = o1; }
    __syncthreads();
    const int c = tid & 255, th = tid >> 8;
    float z[32];
    { float win[62];
#pragma unroll
      for (int i = 0; i < 62; ++i) win[i] = glu[(th * 32 + i) * 256 + c];
      const float bias = p.conf_conv_b[l * BW + c];
#pragma unroll
      for (int i = 0; i < 32; ++i) z[i] = bias;
#pragma unroll
      for (int j = 0; j < 31; ++j) { const float wj = p.conf_conv_w[(size_t)(l * 31 + j) * BW + c];
#pragma unroll
          for (int i = 0; i < 32; ++i) z[i] += wj * win[i + j]; } }
    __syncthreads();
#pragma unroll
    for (int i = 0; i < 32; ++i) glu[(th * 32 + i) * 256 + c] = z[i];
    __syncthreads();
    const f32x4 lg = *(const f32x4*)(p.conf_ln_g + l * BW + 4 * lane), lb = *(const f32x4*)(p.conf_ln_b + l * BW + 4 * lane);
#pragma unroll 2
    for (int i = 0; i < 8; ++i) { const int t = wave * 8 + i, r = row0 + t;
        const f32x4 zz = *(const LAS f32x4*)(glu + t * 256 + 4 * lane);
        const float mean = wave_sum((zz.x + zz.y) + (zz.z + zz.w)) * (1.f / 256.f);
        const f32x4 d = zz - mean;
        const float var = wave_sum((d.x * d.x + d.y * d.y) + (d.z * d.z + d.w * d.w)) * (1.f / 256.f);
        const float rstd = 1.0f / sqrtf(var + EPS);
        const f32x4 ln = d * rstd * lg + lb;
        const u32x2 gw = *(const GAS u32x2*)(GC + (size_t)r * 256 + 4 * lane);
        u32x2 o; o.x = pk2(fsilu(ln.x) * fsilu(bflo(gw.x)), fsilu(ln.y) * fsilu(bfhi(gw.x))); o.y = pk2(fsilu(ln.z) * fsilu(bflo(gw.y)), fsilu(ln.w) * fsilu(bfhi(gw.y)));
        *(GAS u32x2*)((bf16_t*)(p.ws + WS_HY) + (size_t)r * DM + 512 + 4 * lane) = o; }
    __syncthreads();
}

__device__ __forceinline__ void mix_unit_D(Frame& F, int l, int row0) {
    const Ptrs& p = F.p; const int lane = F.lane, wave = F.wave;
    constexpr int VS = 528;
    LAS unsigned char* vl = F.lds;
    const bf16_t *VV = ptile_d(p, T_VV), *U = ptile_d(p, T_U), *GD = ptile_d(p, T_GD);
    { const f32x4 lg = *(const f32x4*)(p.smlp_ln_g + l * BW + 4 * lane), lb = *(const f32x4*)(p.smlp_ln_b + l * BW + 4 * lane);
#pragma unroll 4
      for (int i = 0; i < 16; ++i) { const int q = wave * 16 + i;
        const u32x2 raw = *(const GAS u32x2*)(VV + (size_t)(row0 + q) * 256 + 4 * lane);
        const f32x4 v = {bflo(raw.x), bfhi(raw.x), bflo(raw.y), bfhi(raw.y)};
        const float mean = wave_sum((v.x + v.y) + (v.z + v.w)) * (1.f / 256.f);
        const f32x4 d = v - mean;
        const float var = wave_sum((d.x * d.x + d.y * d.y) + (d.z * d.z + d.w * d.w)) * (1.f / 256.f);
        const float rstd = 1.0f / sqrtf(var + EPS);
        const f32x4 y = d * rstd * lg + lb;
        u32x2 o; o.x = pk2(y.x, y.y); o.y = pk2(y.z, y.w);
        *(LAS u32x2*)(vl + q * VS + 8 * lane) = o; } }
    __syncthreads();
    const int g = wave >> 1, ph = wave & 1, li = lane & 15, lg4 = lane >> 4;
    f32x4 acc[4][4];
#pragma unroll
    for (int a = 0; a < 4; ++a)
#pragma unroll
        for (int b = 0; b < 4; ++b) acc[a][b] = (f32x4){0.f, 0.f, 0.f, 0.f};
    const bf16_t* W = (const bf16_t*)(p.ws + WS_WSB) + (size_t)(l * 4 + g) * 128 * 128;
#pragma unroll
    for (int ks = 0; ks < 4; ++ks) {
        bf16x8 af[4], bfr[4];
#pragma unroll
        for (int ct = 0; ct < 4; ++ct) { LAS unsigned char* a = vl + (32 * ks + 8 * lg4 + (li >> 2)) * VS + (64 * g + 16 * ct + 4 * (li & 3)) * 2;
            const s16x4 lo = __builtin_amdgcn_ds_read_tr16_b64_v4i16((LAS s16x4*)a), hi = __builtin_amdgcn_ds_read_tr16_b64_v4i16((LAS s16x4*)(a + 4 * VS));
            af[ct] = (bf16x8){lo[0], lo[1], lo[2], lo[3], hi[0], hi[1], hi[2], hi[3]}; }
#pragma unroll
        for (int pt = 0; pt < 4; ++pt) bfr[pt] = *(const GAS bf16x8*)(W + (size_t)(64 * ph + 16 * pt + li) * 128 + 32 * ks + 8 * lg4);
#pragma unroll
        for (int ct = 0; ct < 4; ++ct)
#pragma unroll
            for (int pt = 0; pt < 4; ++pt) acc[ct][pt] = __builtin_amdgcn_mfma_f32_16x16x32_bf16(af[ct], bfr[pt], acc[ct][pt], 0, 0, 0);
    }
#pragma unroll
    for (int pt = 0; pt < 4; ++pt) { const int prow = 64 * ph + 16 * pt + li, r = row0 + prow; const float bs = p.smlp_b[(l * 4 + g) * 128 + prow];
#pragma unroll
        for (int ct = 0; ct < 4; ++ct) { const int c = 64 * g + 16 * ct + 4 * lg4;
            const u32x2 uw = *(const GAS u32x2*)(U + (size_t)r * 256 + c), gw = *(const GAS u32x2*)(GD + (size_t)r * 256 + c);
            const f32x4 m = acc[ct][pt] + bs;
            u32x2 o; o.x = pk2(bflo(uw.x) * m.x * fsilu(bflo(gw.x)), bfhi(uw.x) * m.y * fsilu(bfhi(gw.x))); o.y = pk2(bflo(uw.y) * m.z * fsilu(bflo(gw.y)), bfhi(uw.y) * m.w * fsilu(bfhi(gw.y)));
            *(GAS u32x2*)((bf16_t*)(p.ws + WS_HY) + (size_t)r * DM + 768 + c) = o; } }
    __syncthreads();
}

__device__ __forceinline__ void phase_mix(Frame& F, int l) {
    constexpr int NC = MTOT / 64, ND = MTOT / 128, NBU = MTOT / 128;
    for (int u = F.vcu; u < NC + ND + NBU; u += F.G) {
        F.refresh();
        if (u < NC) mix_unit_C(F, l, u * 64);
        else if (u < NC + ND) mix_unit_D(F, l, (u - NC) * 128);
        else mix_unit_B(F, l, (u - NC - ND) * 128);
    }
}


constexpr size_t WS_REC = 212 * MiB, WS_OB16 = 476 * MiB;
constexpr int REC_BYTES = 53248, R_NW = 0, R_Q = 8192, R_U = 16384, R_VEC = 32768, R_ATTN = 33792, R_KT = 41984;
constexpr int NITEM = 2304;
constexpr int L_Q = 0, L_K = 4352, L_V = 8704, L_GKK = 13056, L_GQK = 17216, L_AM = 21376, L_SM = 30080, L_XS = 0;

__device__ __forceinline__ float dpp_xor1(float v) { return __int_as_float(__builtin_amdgcn_mov_dpp(__float_as_int(v), 0xB1, 0xF, 0xF, true)); }
__device__ __forceinline__ bf16x8 pack8(const f32x4& a, const f32x4& b) {
    v4u w; w.x = pg8::cvt_pk_bf16(a.x, a.y); w.y = pg8::cvt_pk_bf16(a.z, a.w); w.z = pg8::cvt_pk_bf16(b.x, b.y); w.w = pg8::cvt_pk_bf16(b.z, b.w); return __builtin_bit_cast(bf16x8, w); }

__device__ __forceinline__ void prep_item(Frame& F, int l, int item) {
    const Ptrs& p = F.p; const int tid = F.tid, lane = F.lane, wave = F.wave;
    int b, h, n, row0;
    if (item < 2048) { b = item >> 7; h = (item >> 5) & 3; n = item & 31; row0 = b * SEQ + 64 * n; }
    else { const int it = item - 2048; b = it >> 4; h = (it >> 2) & 3; n = it & 3; row0 = MLAT + b * CTXL + 64 * n; }
    int start, len; row_seq(row0, start, len);
    LAS float* lf = (LAS float*)F.lds;
    for (int idx = tid; idx < 64 * 24; idx += NWAVES * 64) {
        const int t = idx / 24, o = idx % 24, part = o >> 3, oo = o & 7;
        const bf16_t* T = ptile_d(p, part) + h * 64 + 8 * oo;
        const float* wc = p.qkv_conv_w + (size_t)l * 3 * 768 + part * 256 + h * 64 + 8 * oo;
        float acc[8];
#pragma unroll
        for (int e = 0; e < 8; ++e) acc[e] = 0.f;
#pragma unroll
        for (int j = 0; j < 3; ++j) { const int r = row0 + t + j - 1;
            if (r >= start && r < start + len) { const v4u raw = *(const GAS v4u*)(T + (size_t)r * 256); float x[8]; unpack8(raw, x);
                const f32x4 w0 = *(const f32x4*)(wc + j * 768), w1 = *(const f32x4*)(wc + j * 768 + 4);
                acc[0] += w0.x * x[0]; acc[1] += w0.y * x[1]; acc[2] += w0.z * x[2]; acc[3] += w0.w * x[3]; acc[4] += w1.x * x[4]; acc[5] += w1.y * x[5]; acc[6] += w1.z * x[6]; acc[7] += w1.w * x[7]; } }
        LAS float* dst = lf + part * 4352 + t * 68 + 8 * oo;
        *(LAS f32x4*)dst = (f32x4){silu_f(acc[0]), silu_f(acc[1]), silu_f(acc[2]), silu_f(acc[3])};
        *(LAS f32x4*)(dst + 4) = (f32x4){silu_f(acc[4]), silu_f(acc[5]), silu_f(acc[6]), silu_f(acc[7])};
    }
    if ((wave & 3) == 0) { const int dir = wave >> 2, i = lane, tok = dir ? 63 - i : i; const size_t row = (size_t)row0 + tok;
        const float* AB = (const float*)(p.ws + WS_AB) + row * 16;
        const float g = -expf(p.a_log[(l * 2 + dir) * 4 + h]) * softplus_f(AB[dir * 4 + h] + p.dt_bias[(l * 2 + dir) * 4 + h]);
        const float beta = sigmoid_f(AB[8 + dir * 4 + h]);
        float gc = g;
#pragma unroll
        for (int o = 1; o < 64; o <<= 1) { const float t = __shfl_up(gc, o); if (lane >= o) gc += t; }
        LAS float* sm = lf + L_SM + dir * 192; sm[i] = gc; sm[64 + i] = beta; sm[128 + i] = expf(gc); }
    __syncthreads();
    { const int row = tid >> 2, part = row >> 6, t = row & 63, qt = tid & 3; LAS float* src = lf + part * 4352 + t * 68 + 16 * qt;
      f32x4 v[4]; float ss = 0.f;
#pragma unroll
      for (int i = 0; i < 4; ++i) { v[i] = *(LAS f32x4*)(src + 4 * i); ss += (v[i].x * v[i].x + v[i].y * v[i].y) + (v[i].z * v[i].z + v[i].w * v[i].w); }
      ss += __shfl_xor(ss, 1); ss += __shfl_xor(ss, 2);
      const float sc = (1.0f / sqrtf(ss + EPS)) * (part == 0 ? 0.125f : 1.0f);
#pragma unroll
      for (int i = 0; i < 4; ++i) *(LAS f32x4*)(src + 4 * i) = v[i] * sc; }
    __syncthreads();
    { const int half = tid >> 8, td = tid & 255, i0 = 4 * (td >> 4), j0 = 4 * (td & 15);
      const LAS float* Ab = lf + (half ? L_Q : L_K); const LAS float* Kb = lf + L_K;
      float acc[4][4];
#pragma unroll
      for (int a = 0; a < 4; ++a)
#pragma unroll
          for (int c = 0; c < 4; ++c) acc[a][c] = 0.f;
#pragma unroll 4
      for (int d0 = 0; d0 < 64; d0 += 4) { f32x4 a[4], c[4];
#pragma unroll
          for (int ii = 0; ii < 4; ++ii) { a[ii] = *(const LAS f32x4*)(Ab + (i0 + ii) * 68 + d0); c[ii] = *(const LAS f32x4*)(Kb + (j0 + ii) * 68 + d0); }
#pragma unroll
          for (int ii = 0; ii < 4; ++ii)
#pragma unroll
              for (int jj = 0; jj < 4; ++jj) acc[ii][jj] += (a[ii].x * c[jj].x + a[ii].y * c[jj].y) + (a[ii].z * c[jj].z + a[ii].w * c[jj].w); }
      LAS float* G = lf + (half ? L_GQK : L_GKK);
#pragma unroll
      for (int ii = 0; ii < 4; ++ii)
#pragma unroll
          for (int jj = 0; jj < 4; ++jj) G[(i0 + ii) * 65 + j0 + jj] = acc[ii][jj]; }
    __syncthreads();
    const int dir = tid >> 8, td = tid & 255;
    const LAS float* sm = lf + L_SM + dir * 192;
    unsigned char* rec = p.ws + WS_REC + (size_t)(item * 2 + dir) * REC_BYTES;
    { const int i = td >> 2, jq = td & 3, ti = dir ? 63 - i : i; const float gi = sm[i], bi = sm[64 + i];
      LAS float* Ar = lf + L_AM + dir * 4352 + i * 68;
#pragma unroll 4
      for (int jj = 0; jj < 16; ++jj) { const int j = 16 * jq + jj, tj = dir ? 63 - j : j;
          const float v = (i > j) ? bi * lf[L_GKK + ti * 65 + tj] * fexp(gi - sm[j]) : 0.f;
          Ar[(j & 1) * 32 + (j >> 1)] = v; } }
#pragma unroll
    for (int k = 0; k < 2; ++k) { const int f = td + 256 * k, ms = f >> 6, ll = f & 63, m = ms >> 1, s = ms & 1, rr = 16 * m + (ll & 15), cb = 32 * s + 4 * (ll >> 4);
        float va[8], vq[8], vk[8];
        const int ti = dir ? 63 - rr : rr; const float gi = sm[rr];
#pragma unroll
        for (int e = 0; e < 8; ++e) { const int c = cb + 16 * (e >> 2) + (e & 3), tc = dir ? 63 - c : c;
            va[e] = (rr >= c) ? lf[L_GQK + ti * 65 + tc] * fexp(gi - sm[c]) : 0.f;
            vq[e] = lf[L_Q + ti * 68 + c];
            vk[e] = lf[L_K + tc * 68 + rr]; }
        v4u o; o.x = pk2(va[0], va[1]); o.y = pk2(va[2], va[3]); o.z = pk2(va[4], va[5]); o.w = pk2(va[6], va[7]); *(GAS v4u*)(rec + R_ATTN + f * 16) = o;
        o.x = pk2(vq[0], vq[1]); o.y = pk2(vq[2], vq[3]); o.z = pk2(vq[4], vq[5]); o.w = pk2(vq[6], vq[7]); *(GAS v4u*)(rec + R_Q + f * 16) = o;
        o.x = pk2(vk[0], vk[1]); o.y = pk2(vk[2], vk[3]); o.z = pk2(vk[4], vk[5]); o.w = pk2(vk[6], vk[7]); *(GAS v4u*)(rec + R_KT + f * 16) = o; }
    if (td < 64) { float* vec = (float*)(rec + R_VEC); vec[td] = sm[128 + td]; vec[64 + td] = expf(sm[63] - sm[td]); if (td == 0) vec[128] = expf(sm[63]); }
    const int col = td >> 1, par = td & 1;
    float x[32];
#pragma unroll
    for (int jj = 0; jj < 32; ++jj) { const int j = 2 * jj + par, tj = dir ? 63 - j : j;
        x[jj] = col < 64 ? lf[L_V + tj * 68 + col] * sm[64 + j] : lf[L_K + tj * 68 + (col - 64)] * sm[64 + j] * sm[128 + j]; }
    __syncthreads();
    { const LAS float* Ar = lf + L_AM + dir * 4352 + par * 32;
#pragma unroll
      for (int i = 0; i < 64; ++i) { float acc = 0.f;
#pragma unroll
          for (int q = 0; q < (((i + 1) >> 1) + 3) / 4; ++q) { const f32x4 a = *(const LAS f32x4*)(Ar + i * 68 + 4 * q);
              acc += (a.x * x[4 * q] + a.y * x[4 * q + 1]) + (a.z * x[4 * q + 2] + a.w * x[4 * q + 3]); }
          const float tot = acc + dpp_xor1(acc);
          x[i >> 1] = ((i & 1) == par) ? x[i >> 1] - tot : x[i >> 1]; }
      LAS float* XS = lf + L_XS + dir * 8448;
#pragma unroll
      for (int jj = 0; jj < 32; ++jj) XS[(2 * jj + par) * 132 + col] = x[jj]; }
    __syncthreads();
    { const LAS float* XS = lf + L_XS + dir * 8448;
#pragma unroll
      for (int k = 0; k < 2; ++k) { const int f = td + 256 * k, ms = f >> 6, ll = f & 63, m = ms >> 1, s = ms & 1, rr = 16 * m + (ll & 15), cb = 32 * s + 4 * (ll >> 4);
          float v[8];
#pragma unroll
          for (int e = 0; e < 8; ++e) v[e] = -XS[rr * 132 + 64 + cb + 16 * (e >> 2) + (e & 3)];
          v4u o; o.x = pk2(v[0], v[1]); o.y = pk2(v[2], v[3]); o.z = pk2(v[4], v[5]); o.w = pk2(v[6], v[7]); *(GAS v4u*)(rec + R_NW + f * 16) = o; }
#pragma unroll
      for (int k = 0; k < 4; ++k) { const int u = td + 256 * k, w = u >> 8, m = (u >> 6) & 3, ll = u & 63, r0 = 16 * m + 4 * (ll >> 4), c = 16 * w + (ll & 15);
          const f32x4 o = {XS[r0 * 132 + c], XS[(r0 + 1) * 132 + c], XS[(r0 + 2) * 132 + c], XS[(r0 + 3) * 132 + c]};
          *(GAS f32x4*)(rec + R_U + u * 16) = o; } }
    __syncthreads();
}
__device__ __forceinline__ void phase_prep(Frame& F, int l) {
    for (int it = F.vcu; it < NITEM; it += F.G) { F.refresh(); prep_item(F, l, it); }
}

__device__ __forceinline__ void phase_scan(Frame& F, int l) {
    const Ptrs& p = F.p;
    if (F.vcu >= 128 || F.wave >= 4) return;
    const int s = F.vcu, b = s >> 3, h = (s >> 1) & 3, dir = s & 1, w = F.wave, lane = F.lane, li = lane & 15, g4 = lane >> 4;
    f32x4 S[4];
#pragma unroll
    for (int m = 0; m < 4; ++m) S[m] = (f32x4){0.f, 0.f, 0.f, 0.f};
    bf16_t* O = (bf16_t*)(p.ws + WS_OB16) + (size_t)dir * MTOT * 256;
    for (int step = 0; step < 36; ++step) {
        int cid, row0;
        if (step < 4) { const int n = dir ? 3 - step : step; cid = 2048 + (b * 4 + h) * 4 + n; row0 = MLAT + b * CTXL + 64 * n; }
        else { const int n = dir ? 35 - step : step - 4; cid = (b * 4 + h) * 32 + n; row0 = b * SEQ + 64 * n; }
        const unsigned char* rec = p.ws + WS_REC + (size_t)(cid * 2 + dir) * REC_BYTES;
        bf16x8 nw[4][2], qf[4][2], at[4][2], kt[4][2]; f32x4 av[4], ao[4], a2[4], egc4[4], edl4[4];
#pragma unroll
        for (int m = 0; m < 4; ++m) {
#pragma unroll
            for (int s2 = 0; s2 < 2; ++s2) { nw[m][s2] = *(const GAS bf16x8*)(rec + R_NW + ((m * 2 + s2) * 64 + lane) * 16); qf[m][s2] = *(const GAS bf16x8*)(rec + R_Q + ((m * 2 + s2) * 64 + lane) * 16); }
            av[m] = *(const GAS f32x4*)(rec + R_U + ((w * 4 + m) * 64 + lane) * 16); ao[m] = (f32x4){0.f, 0.f, 0.f, 0.f}; }
        const float gl = *(const GAS float*)(rec + R_VEC + 512);
        bf16x8 Bs[2] = {pack8(S[0], S[1]), pack8(S[2], S[3])};
#pragma unroll
        for (int m = 0; m < 4; ++m) {
#pragma unroll
            for (int s2 = 0; s2 < 2; ++s2) { at[m][s2] = *(const GAS bf16x8*)(rec + R_ATTN + ((m * 2 + s2) * 64 + lane) * 16); kt[m][s2] = *(const GAS bf16x8*)(rec + R_KT + ((m * 2 + s2) * 64 + lane) * 16); }
            edl4[m] = *(const GAS f32x4*)(rec + R_VEC + 256 + (16 * m + 4 * g4) * 4); }
#pragma unroll
        for (int m = 0; m < 4; ++m)
#pragma unroll
            for (int s2 = 0; s2 < 2; ++s2) { av[m] = __builtin_amdgcn_mfma_f32_16x16x32_bf16(nw[m][s2], Bs[s2], av[m], 0, 0, 0); ao[m] = __builtin_amdgcn_mfma_f32_16x16x32_bf16(qf[m][s2], Bs[s2], ao[m], 0, 0, 0); }
        asm volatile("" ::: "memory");
#pragma unroll
        for (int m = 0; m < 4; ++m) { egc4[m] = *(const GAS f32x4*)(rec + R_VEC + (16 * m + 4 * g4) * 4); a2[m] = (f32x4){0.f, 0.f, 0.f, 0.f}; }
        bf16x8 Bv[2] = {pack8(av[0], av[1]), pack8(av[2], av[3])};
        bf16x8 Bvs[2] = {pack8(av[0] * edl4[0], av[1] * edl4[1]), pack8(av[2] * edl4[2], av[3] * edl4[3])};
#pragma unroll
        for (int m = 0; m < 4; ++m) S[m] = S[m] * gl;
#pragma unroll
        for (int m = 0; m < 4; ++m)
#pragma unroll
            for (int s2 = 0; s2 < 2; ++s2) { a2[m] = __builtin_amdgcn_mfma_f32_16x16x32_bf16(at[m][s2], Bv[s2], a2[m], 0, 0, 0); S[m] = __builtin_amdgcn_mfma_f32_16x16x32_bf16(kt[m][s2], Bvs[s2], S[m], 0, 0, 0); }
#pragma unroll
        for (int m = 0; m < 4; ++m) { const f32x4 o = egc4[m] * ao[m] + a2[m];
#pragma unroll
            for (int r = 0; r < 4; ++r) { const int i = 16 * m + 4 * g4 + r, tok = dir ? 63 - i : i;
                O[(size_t)(row0 + tok) * 256 + h * 64 + 16 * w + li] = f2bf(o[r]); } }
        asm volatile("" ::: "memory");
    }
}

__device__ __forceinline__ void phase_comb(Frame& F, int l) {
    const Ptrs& p = F.p; const int lane = F.lane;
    const int gw = F.vcu * NWAVES + F.wave, NGW = F.G * NWAVES;
    const bf16_t* OF = (const bf16_t*)(p.ws + WS_OB16); const bf16_t* OB = OF + (size_t)MTOT * 256; const bf16_t* GA = ptile_d(p, T_GA);
    const f32x4 ng = *(const f32x4*)(p.gdn_norm_g + l * 64 + 4 * (lane & 15));
    const int nrow = (l == DEPTH - 1) ? MLAT : MTOT;
    for (int r = gw; r < nrow; r += NGW) {
        const u32x2 a = *(const GAS u32x2*)(OF + (size_t)r * 256 + 4 * lane), c = *(const GAS u32x2*)(OB + (size_t)r * 256 + 4 * lane), gt = *(const GAS u32x2*)(GA + (size_t)r * 256 + 4 * lane);
        const f32x4 o = {bflo(a.x) + bflo(c.x), bfhi(a.x) + bfhi(c.x), bflo(a.y) + bflo(c.y), bfhi(a.y) + bfhi(c.y)};
        float ss = (o.x * o.x + o.y * o.y) + (o.z * o.z + o.w * o.w);
        ss += __shfl_xor(ss, 1); ss += __shfl_xor(ss, 2); ss += __shfl_xor(ss, 4); ss += __shfl_xor(ss, 8);
        const float rs = 1.0f / sqrtf(ss * (1.f / 64.f) + EPS);
        u32x2 y; y.x = pk2(o.x * rs * ng.x * fsilu(bflo(gt.x)), o.y * rs * ng.y * fsilu(bfhi(gt.x))); y.y = pk2(o.z * rs * ng.z * fsilu(bflo(gt.y)), o.w * rs * ng.w * fsilu(bfhi(gt.y)));
        *(GAS u32x2*)((bf16_t*)(p.ws + WS_HY) + (size_t)r * DM + 4 * lane) = y;
    }
}

constexpr int PH_FINAL = 1 + 7 * DEPTH, PH_END = PH_FINAL + 1;
struct Args { Ptrs p; int ph_lo, ph_hi; };
__global__ void __launch_bounds__(NWAVES * 64, 2) mega(Args args) {
    extern __shared__ __attribute__((aligned(16))) unsigned char lds[];
    Frame F;
    F.lds = (LAS unsigned char*)lds; F.MISC = (volatile LAS unsigned*)(F.lds + MISC_OFF);
    F.tid = threadIdx.x; F.lane = F.tid & 63; F.wave = __builtin_amdgcn_readfirstlane(F.tid >> 6);
    F.G = gridDim.x; { const int bx = blockIdx.x; F.vcu = (F.G % 8 == 0) ? (bx % 8) * (F.G / 8) + bx / 8 : bx; }
    F.p = args.p; F.ctl = (gu32*)(args.p.ws + WS_CTL);
    for (int u = F.tid; u < (LDS_BYTES - LDSCTL_OFF) / 4; u += NWAVES * 64) ((LAS unsigned*)(F.lds + LDSCTL_OFF))[u] = 0u;
    __syncthreads();
    const bool multi = args.ph_hi - args.ph_lo > 1;
    XcdBarrier bar; bar.bar = (unsigned*)(F.ctl + CW_BAR); bar.x = 0; bar.st = nullptr;
    if (multi) bar = xcd_barrier_post((unsigned*)(F.ctl + CW_BAR), F.MISC + 8);
    for (int ph = args.ph_lo; ph < args.ph_hi; ++ph) {
        F.refresh();
        if (ph == 0) phase_pre(F);
        else if (ph == PH_FINAL) phase_final(F);
        else { const int l = (ph - 1) / 7, s = (ph - 1) % 7;
            if (s == 0) phase_norm(F, l);
            else if (s == 1) phase_gemm1(F, l);
            else if (s == 2) phase_mix(F, l);
            else if (s == 3) phase_prep(F, l);
            else if (s == 4) phase_scan(F, l);
            else if (s == 5) phase_comb(F, l);
            else if (s == 6) phase_gemm2(F, l);
        }
        if (ph + 1 < args.ph_hi) xcd_barrier(bar);
    }
}

extern "C" void kernel_launch(void* const* d_in, const int* in_sizes, int n_in, void* d_out, int out_size, void* d_ws, size_t ws_size, hipStream_t stream) {
    static int grid = 0;
    if (grid == 0) {
        if (n_in != 23 || out_size != MLAT * DM || ws_size < WS_END) { fprintf(stderr, "kernel_launch: unexpected shapes (n_in %d out %d ws %zu)\n", n_in, out_size, ws_size); grid = -1; return; }
        int dev = 0, cus = 0;
        if (hipGetDevice(&dev) != hipSuccess || hipDeviceGetAttribute(&cus, hipDeviceAttributeMultiprocessorCount, dev) != hipSuccess) { grid = -1; return; }
        if (hipFuncSetAttribute((const void*)mega, hipFuncAttributeMaxDynamicSharedMemorySize, LDS_BYTES) != hipSuccess) { fprintf(stderr, "kernel_launch: hipFuncSetAttribute failed\n"); grid = -1; return; }
        grid = cus;
        if (grid != 256) fprintf(stderr, "kernel_launch: %d CUs (built for 256)\n", grid);
    }
    if (grid < 0) return;
    hipMemsetAsync((char*)d_ws + WS_CTL, 0, CTL_ZERO_BYTES, stream);
    Args a{};
    const float** f = (const float**)&a.p;
    for (int i = 0; i < 23; ++i) f[i] = (const float*)d_in[i];
    a.p.out = (float*)d_out; a.p.ws = (unsigned char*)d_ws;
    a.ph_lo = 0; a.ph_hi = PH_END;
    hipLaunchKernelGGL(mega, dim3(grid), dim3(NWAVES * 64), LDS_BYTES, stream, a);
}
```

```cpp
#include <hip/hip_runtime.h>
#include <cstdio>
#include <cstdint>

typedef unsigned short bf16_t;
__device__ __forceinline__ float bf2f(bf16_t v) { return __uint_as_float(((unsigned)v) << 16); }
typedef __bf16 nbf16x2 __attribute__((ext_vector_type(2)));
typedef __bf16 nbf16x8 __attribute__((ext_vector_type(8)));
typedef float nf32x2 __attribute__((ext_vector_type(2)));
typedef float nf32x8 __attribute__((ext_vector_type(8)));
__device__ __forceinline__ bf16_t f2bf(float f) { return __builtin_bit_cast(bf16_t, (__bf16)f); }

constexpr int DM = 1024, NB = 16, SEQ = 2048, DEPTH = 4, CTXL = 256, HD = 64, BW = 256, HA = 4;
constexpr int INC = 3600, NPC = 3584, NTILE = 14;
constexpr int MLAT = NB * SEQ, MCTX = NB * CTXL, MTOT = MLAT + MCTX;
constexpr float EPS = 1e-6f;
__device__ __constant__ int c_tile_col[NTILE] = {0, 256, 512, 2576, 784, 1040, 1296, 1552, 1808, 2064, 2320, 2832, 3088, 3344};
enum { T_Q = 0, T_K = 1, T_V = 2, T_GA = 3, T_BG = 4, T_CG = 5, T_XI = 6, T_GLA = 7, T_GLB = 8, T_U = 9, T_VV = 10, T_GB = 11, T_GC = 12, T_GD = 13 };

constexpr size_t MiB = 1u << 20;
constexpr size_t WS_CTL = 0, WS_MOD = 1 * MiB, WS_AB = 2 * MiB, WS_GB = 5 * MiB, WS_STAT = 8 * MiB, WS_XC = 16 * MiB, WS_WIN = 32 * MiB, WS_WOUT = 60 * MiB,
                 WS_HY = 68 * MiB, WS_P = 140 * MiB, WS_OFB = 392 * MiB, WS_END = 512 * MiB;
constexpr size_t PTILE_ELEMS = (size_t)MTOT * 256;
constexpr size_t WS_QKV = WS_P + 4 * PTILE_ELEMS * 2;

struct Ptrs {
    const float *x, *c, *ctx, *c_ctx, *norm_g, *w_ada, *b_ada, *w_in, *qkv_conv_w, *a_log, *dt_bias, *gdn_norm_g, *short_conv_w, *conf_conv_w, *conf_conv_b,
        *conf_ln_g, *conf_ln_b, *smlp_ln_g, *smlp_ln_b, *smlp_w, *smlp_b, *w_out, *final_g;
    float* out; unsigned char* ws;
};

__device__ __forceinline__ float silu_f(float x) { return x / (1.f + expf(-x)); }
__device__ __forceinline__ float sigmoid_f(float x) { return 1.f / (1.f + expf(-x)); }
__device__ __forceinline__ float softplus_f(float x) { return x > 20.f ? x : log1pf(expf(x)); }

__device__ __forceinline__ float block_sum256(float v, float* red) {
#pragma unroll
    for (int o = 32; o > 0; o >>= 1) v += __shfl_xor(v, o);
    __syncthreads();
    if ((threadIdx.x & 63) == 0) red[threadIdx.x >> 6] = v;
    __syncthreads();
    return red[0] + red[1] + red[2] + red[3];
}
__device__ __forceinline__ float wave_sum(float v) {
#pragma unroll
    for (int o = 32; o > 0; o >>= 1) v += __shfl_xor(v, o);
    return v;
}

__device__ __forceinline__ void row_seq(int row, int& start, int& len) { if (row < MLAT) { start = row & ~(SEQ - 1); len = SEQ; } else { start = row & ~(CTXL - 1); len = CTXL; } }

namespace pg8 {
#define PG8_LAS __attribute__((address_space(3)))
typedef unsigned short bf16_t;
typedef short bf16x8 __attribute__((ext_vector_type(8)));
typedef float f32x4 __attribute__((ext_vector_type(4)));
typedef unsigned u32x4 __attribute__((ext_vector_type(4)));
constexpr int BM = 256, BK = 64, HALF = 128, HTB = HALF * BK * 2  , STAGE_BYTES = 8 * HTB, NXCD = 8, WGM = 8;

__host__ __device__ __forceinline__ int lds_byte(int r, int c) { const int st = (r >> 4) * 2 + (c >> 5), rr = r & 15, cc = c & 31, ob = rr * 64 + cc * 2; return st * 1024 + (ob ^ (((ob >> 9) & 1) << 5)); }
__host__ __device__ __forceinline__ void stage_rc(int b, int& R, int& C) { const int st = b / 1024, sb = b % 1024, swz = sb ^ (((sb >> 9) & 1) << 5); R = (st >> 1) * 16 + swz / 64; C = (st & 1) * 32 + (swz % 64) / 2; }
__host__ __device__ __forceinline__ int perm32(int rho) { const int n = rho >> 4, i = rho & 15; return 8 * (i >> 2) + 4 * n + (i & 3); }

struct Unit { int pm, pn; };
struct Gemm { const bf16_t* A; const bf16_t* Bt; int M, N, K; };

struct StaticOrder {
    int nM, nN, nwg, G, c;
    __host__ __device__ void init(int M, int N, int G_, int c_) { nM = M / BM; nN = N / BM; nwg = nM * nN; G = G_; c = c_; }
    __host__ __device__ bool next(int i, Unit& u) const {
        const long L = (long)i * G + c; if (L >= nwg) return false;
        int wgid = (int)L; { const int q = nwg / NXCD, r = nwg % NXCD, xcd = wgid % NXCD, off = wgid / NXCD; wgid = (xcd < r ? xcd * (q + 1) : r * (q + 1) + (xcd - r) * q) + off; }
        const int nig = WGM * nN, gid = wgid / nig, fm = gid * WGM, gsz = (nM - fm) < WGM ? (nM - fm) : WGM;
        u.pm = fm + ((wgid % nig) % gsz); u.pn = (wgid % nig) / gsz; return true;
    }
    __device__ __forceinline__ void a_ready(const Unit&) const {}
    __device__ __forceinline__ void done(const Unit&) const {}
};


__device__ __forceinline__ unsigned cvt_pk_bf16(float lo, float hi) { return __builtin_bit_cast(unsigned, __builtin_convertvector((nf32x2){lo, hi}, nbf16x2)); }
struct EpiP {
    static constexpr bool PERM = true, AFTER_DRAIN = false;
    bf16_t* P; size_t tile_elems;
    __device__ __forceinline__ void operator()(const f32x4 (&acc)[2][2][4][2], const Unit& u, int wr, int wc, int fr, int fq) const {
        const int row0 = u.pm * BM + wr * 64 + fr;
        bf16_t* base = P + (size_t)u.pn * tile_elems + wc * 32 + 8 * fq;
#pragma unroll
        for (int ai = 0; ai < 2; ++ai)
#pragma unroll
            for (int m = 0; m < 4; ++m) { bf16_t* rowp = base + (size_t)(row0 + ai * HALF + m * 16) * 256;
#pragma unroll
                for (int bj = 0; bj < 2; ++bj) { const f32x4 v0 = acc[ai][bj][m][0], v1 = acc[ai][bj][m][1];
                    u32x4 w; w.x = cvt_pk_bf16(v0[0], v0[1]); w.y = cvt_pk_bf16(v0[2], v0[3]); w.z = cvt_pk_bf16(v1[0], v1[1]); w.w = cvt_pk_bf16(v1[2], v1[3]);
                    *(u32x4*)(rowp + bj * HALF) = w; } }
    }
};
struct EpiResid {
    static constexpr bool PERM = true, AFTER_DRAIN = false;
    const float* x_old; float* x_new; const float* xc_old; float* xc_new; const float* mod_l; int odd, mlat, seq, dm;
    __device__ __forceinline__ void operator()(const f32x4 (&acc)[2][2][4][2], const Unit& u, int wr, int wc, int fr, int fq) const {
        const int rbase = u.pm * BM; const bool lat = rbase < mlat; const int b = lat ? rbase / seq : 16;
        const int col = u.pn * BM + wc * 32 + 8 * fq;
        const float* gate = mod_l + (size_t)b * 3072 + 2048 + col;
        f32x4 g[2][2];
#pragma unroll
        for (int bj = 0; bj < 2; ++bj)
#pragma unroll
            for (int n = 0; n < 2; ++n) g[bj][n] = *(const f32x4*)(gate + bj * HALF + 4 * n);
#pragma unroll
        for (int ai = 0; ai < 2; ++ai)
#pragma unroll
            for (int m = 0; m < 4; ++m) { const int r = rbase + ai * HALF + wr * 64 + m * 16 + fr;
                const float* oldp; float* newp;
                if (lat) { const int tp = r % seq; const int t = odd ? ((tp & 31) * 64 + (tp >> 5)) : tp; const size_t off = ((size_t)(r / seq) * seq + t) * dm + col; oldp = x_old + off; newp = x_new + off; }
                else { const size_t off = (size_t)(r - mlat) * dm + col; oldp = xc_old + off; newp = xc_new + off; }
#pragma unroll
                for (int bj = 0; bj < 2; ++bj)
#pragma unroll
                    for (int n = 0; n < 2; ++n) { const f32x4 o = *(const f32x4*)(oldp + bj * HALF + 4 * n); *(f32x4*)(newp + bj * HALF + 4 * n) = o + g[bj][n] * acc[ai][bj][m][n]; } }
    }
};

template <class Epi, class Sched, bool ALIGN_EPI = false, bool SP2 = false>
__device__ __forceinline__ void gemm_phase(PG8_LAS unsigned char* lds, const Gemm g, const Sched& S, const Epi& E) {
    int tid_ = threadIdx.x; asm volatile("" : "+v"(tid_));
    const int tid = tid_, wid = __builtin_amdgcn_readfirstlane(tid >> 6), lane = tid & 63, wr = wid >> 2, wc = wid & 3, fr = lane & 15, fq = lane >> 4;
    const int K = g.K, nt = K / BK;
    unsigned voffA[2], voffB[2];
#pragma unroll
    for (int i = 0; i < 2; ++i) { int R, C; stage_rc(tid * 16 + i * 8192, R, C); const int Rb = Epi::PERM ? ((R & ~31) + perm32(R & 31)) : R;
        voffA[i] = (unsigned)(R * K + C) * 2u; voffB[i] = (unsigned)(Rb * K + C) * 2u; }
    const size_t kstep = (size_t)(BK * 2);
    const size_t hstep = (size_t)HALF * K * 2;
    const size_t tstep = 2 * hstep;
    const unsigned ldsw = (unsigned)wid * 1024u;
    const int aoff = lds_byte(wr * 64 + fr, fq * 8), boff = lds_byte(wc * 32 + fr, fq * 8);
#define PG8_SA(b, h) (((b) * 2 + (h)) * HTB)
#define PG8_SB(b, h) ((4 + (b) * 2 + (h)) * HTB)
#define PG8_STAGE(bufoff, gbase, voff) do { _Pragma("unroll") for (int _i = 0; _i < 2; ++_i) \
        __builtin_amdgcn_global_load_lds((const unsigned*)((const char*)(gbase) + (voff)[_i]), (PG8_LAS unsigned*)(lds + (bufoff) + ldsw + _i * 8192), 16, 0, 0); } while (0)
#define PG8_LDA(dst, b, h) do { _Pragma("unroll") for (int m = 0; m < 4; ++m) _Pragma("unroll") for (int k = 0; k < 2; ++k) dst[m][k] = *(const PG8_LAS bf16x8*)(lds + PG8_SA(b, h) + aoff + m * 2048 + k * 1024); } while (0)
#define PG8_LDB(dst, b, h) do { _Pragma("unroll") for (int n = 0; n < 2; ++n) _Pragma("unroll") for (int k = 0; k < 2; ++k) dst[n][k] = *(const PG8_LAS bf16x8*)(lds + PG8_SB(b, h) + boff + n * 2048 + k * 1024); } while (0)
#define PG8_MMA(ai, bj, At, Bt) do { __builtin_amdgcn_s_setprio(1); _Pragma("unroll") for (int m = 0; m < 4; ++m) _Pragma("unroll") for (int n = 0; n < 2; ++n) _Pragma("unroll") for (int k = 0; k < 2; ++k) \
        acc[ai][bj][m][n] = __builtin_amdgcn_mfma_f32_16x16x32_bf16(Bt[n][k], At[m][k], acc[ai][bj][m][n], 0, 0, 0); __builtin_amdgcn_s_setprio(0); } while (0)
#define PG8_WAIT_V(n) asm volatile("s_waitcnt vmcnt(" #n ")" ::: "memory")
#define PG8_WAIT_L(n) asm volatile("s_waitcnt lgkmcnt(" #n ")" ::: "memory")
#define PG8_BAR __builtin_amdgcn_s_barrier()
#define PG8_SCHED __builtin_amdgcn_sched_barrier(0)
    Unit cur, nxt; int ui = 0;
    if (!S.next(0, cur)) return;
    f32x4 acc[2][2][4][2];
#pragma unroll
    for (int a = 0; a < 2; ++a)
#pragma unroll
        for (int b = 0; b < 2; ++b)
#pragma unroll
            for (int m = 0; m < 4; ++m)
#pragma unroll
                for (int n = 0; n < 2; ++n) acc[a][b][m][n] = (f32x4){0.f, 0.f, 0.f, 0.f};
    bf16x8 At[4][2], B0[2][2], B1[2][2];
    const char* cA = (const char*)g.A + (size_t)cur.pm * tstep; const char* cB = (const char*)g.Bt + (size_t)cur.pn * tstep;
    S.a_ready(cur);
    if constexpr (SP2) {
        PG8_STAGE(PG8_SB(0, 0), cB, voffB); PG8_STAGE(PG8_SB(0, 1), cB + hstep, voffB); PG8_STAGE(PG8_SA(0, 0), cA, voffA); PG8_STAGE(PG8_SA(0, 1), cA + hstep, voffA);
        if (wr == 1) PG8_BAR;
        PG8_WAIT_V(2); PG8_BAR;
        PG8_STAGE(PG8_SB(1, 0), cB + kstep, voffB); PG8_STAGE(PG8_SA(1, 0), cA + kstep, voffA); PG8_STAGE(PG8_SB(1, 1), cB + hstep + kstep, voffB);
        PG8_WAIT_V(6); PG8_BAR;
    } else {
        PG8_STAGE(PG8_SB(0, 0), cB, voffB); PG8_STAGE(PG8_SA(0, 0), cA, voffA); PG8_STAGE(PG8_SB(0, 1), cB + hstep, voffB); PG8_STAGE(PG8_SA(0, 1), cA + hstep, voffA);
        if (wr == 1) PG8_BAR;
        PG8_WAIT_V(4); PG8_BAR;
        PG8_STAGE(PG8_SB(1, 0), cB + kstep, voffB); PG8_STAGE(PG8_SA(1, 0), cA + kstep, voffA); PG8_STAGE(PG8_SB(1, 1), cB + hstep + kstep, voffB);
        PG8_WAIT_V(6); PG8_BAR;
    }
    for (;;) {
        const bool has_next = S.next(ui + 1, nxt);
        const char* nA = has_next ? (const char*)g.A + (size_t)nxt.pm * tstep : cA; const char* nB = has_next ? (const char*)g.Bt + (size_t)nxt.pn * tstep : cB;
        for (int t = 0; t < nt; t += 2) {
            const bool last = (t == nt - 2);
            const char* a1 = cA + (size_t)(t + 1) * kstep;
            const char* a2 = last ? nA : cA + (size_t)(t + 2) * kstep; const char* b2 = last ? nB : cB + (size_t)(t + 2) * kstep;
            const char* a3 = a2 + kstep; const char* b3 = b2 + kstep;
            if (last && has_next) S.a_ready(nxt);
            if constexpr (SP2) {
            PG8_LDB(B0, 0, 0); PG8_LDB(B1, 0, 1); PG8_SCHED; PG8_LDA(At, 0, 0); PG8_STAGE(PG8_SA(1, 1), a1 + hstep, voffA);
            PG8_WAIT_V(8); PG8_WAIT_L(0); PG8_BAR; PG8_MMA(0, 0, At, B0); PG8_MMA(0, 1, At, B1); PG8_BAR; PG8_SCHED;
            PG8_LDA(At, 0, 1); PG8_STAGE(PG8_SB(0, 0), b2, voffB); PG8_STAGE(PG8_SB(0, 1), b2 + hstep, voffB); PG8_STAGE(PG8_SA(0, 0), a2, voffA);
            PG8_WAIT_V(8); PG8_WAIT_L(0); PG8_BAR; PG8_MMA(1, 0, At, B0); PG8_MMA(1, 1, At, B1); PG8_BAR; PG8_SCHED;
            PG8_LDB(B0, 1, 0); PG8_LDB(B1, 1, 1); PG8_SCHED; PG8_LDA(At, 1, 0); PG8_STAGE(PG8_SA(0, 1), a2 + hstep, voffA);
            PG8_WAIT_V(8); PG8_WAIT_L(0); PG8_BAR; PG8_MMA(0, 0, At, B0); PG8_MMA(0, 1, At, B1); PG8_BAR; PG8_SCHED;
            PG8_LDA(At, 1, 1); PG8_STAGE(PG8_SB(1, 0), b3, voffB); PG8_STAGE(PG8_SB(1, 1), b3 + hstep, voffB); PG8_STAGE(PG8_SA(1, 0), a3, voffA);
            PG8_WAIT_V(8); PG8_WAIT_L(0); PG8_BAR; PG8_MMA(1, 0, At, B0); PG8_MMA(1, 1, At, B1); PG8_BAR; PG8_SCHED;
            } else {
            PG8_LDB(B0, 0, 0); PG8_SCHED; PG8_LDA(At, 0, 0); PG8_STAGE(PG8_SA(1, 1), a1 + hstep, voffA);
            PG8_WAIT_L(8); PG8_BAR; PG8_WAIT_L(0); PG8_MMA(0, 0, At, B0); PG8_BAR; PG8_SCHED;
            PG8_LDB(B1, 0, 1); PG8_STAGE(PG8_SB(0, 0), b2, voffB);
            PG8_BAR; PG8_WAIT_L(0); PG8_MMA(0, 1, At, B1); PG8_BAR;
            PG8_LDA(At, 0, 1); PG8_STAGE(PG8_SA(0, 0), a2, voffA);
            PG8_BAR; PG8_WAIT_L(0); PG8_MMA(1, 0, At, B0); PG8_BAR; PG8_SCHED;
            PG8_STAGE(PG8_SB(0, 1), b2 + hstep, voffB);
            PG8_WAIT_V(6); PG8_BAR; PG8_MMA(1, 1, At, B1); PG8_BAR;
            PG8_LDB(B0, 1, 0); PG8_SCHED; PG8_LDA(At, 1, 0); PG8_STAGE(PG8_SA(0, 1), a2 + hstep, voffA);
            PG8_WAIT_L(8); PG8_BAR; PG8_WAIT_L(0); PG8_MMA(0, 0, At, B0); PG8_BAR; PG8_SCHED;
            PG8_LDB(B1, 1, 1); PG8_STAGE(PG8_SB(1, 0), b3, voffB);
            PG8_BAR; PG8_WAIT_L(0); PG8_MMA(0, 1, At, B1); PG8_BAR;
            PG8_LDA(At, 1, 1); PG8_STAGE(PG8_SA(1, 0), a3, voffA);
            PG8_BAR; PG8_WAIT_L(0); PG8_MMA(1, 0, At, B0); PG8_BAR; PG8_SCHED;
            PG8_STAGE(PG8_SB(1, 1), b3 + hstep, voffB);
            PG8_WAIT_V(6); PG8_BAR; PG8_MMA(1, 1, At, B1); PG8_BAR;
            }
        }
        if constexpr (ALIGN_EPI) { if (wr == 0) PG8_BAR; }
        if constexpr (!Epi::AFTER_DRAIN) { E(acc, cur, wr, wc, fr, fq); S.done(cur); }
        if (!has_next) break;
#pragma unroll
        for (int a = 0; a < 2; ++a)
#pragma unroll
            for (int b = 0; b < 2; ++b)
#pragma unroll
                for (int m = 0; m < 4; ++m)
#pragma unroll
                    for (int n = 0; n < 2; ++n) acc[a][b][m][n] = (f32x4){0.f, 0.f, 0.f, 0.f};
        cur = nxt; cA = nA; cB = nB; ++ui;
        if constexpr (ALIGN_EPI) { if (wr == 1) PG8_BAR; }
    }
    PG8_WAIT_V(0);
    if constexpr (!ALIGN_EPI) { if (wr == 0) PG8_BAR; }
    PG8_BAR;
    if constexpr (Epi::AFTER_DRAIN) { E.fused(acc, cur, wr, wc, fr, fq, lds, wid, lane); S.done(cur); }
#undef PG8_SA
#undef PG8_SB
#undef PG8_STAGE
#undef PG8_LDA
#undef PG8_LDB
#undef PG8_MMA
#undef PG8_WAIT_V
#undef PG8_WAIT_L
#undef PG8_BAR
#undef PG8_SCHED
}
}

constexpr int NWAVES = 8;
constexpr int RING_BYTES = 131072, LDSCTL_OFF = RING_BYTES, MISC_OFF = LDSCTL_OFF + 320, LDS_BYTES = 147456;
constexpr int CW_BAR = 4096;
constexpr size_t CTL_ZERO_BYTES = 64 * 1024;
#define GAS __attribute__((address_space(1)))
#define LAS __attribute__((address_space(3)))
typedef unsigned v4u __attribute__((ext_vector_type(4)));
typedef float f32x4 __attribute__((ext_vector_type(4)));
typedef GAS unsigned gu32;
#define LDS_WAIT() asm volatile("s_waitcnt lgkmcnt(0)" ::: "memory")
#define VM_WAIT() asm volatile("s_waitcnt vmcnt(0)" ::: "memory")
__device__ __forceinline__ unsigned pk2(float lo, float hi) { return __builtin_bit_cast(unsigned, __builtin_convertvector((nf32x2){lo, hi}, nbf16x2)); }

#define XB_TMO      128
#define XB_XCNT(j)  (256  + 64 * (j))
#define XB_XSUB(j)  (1280 + 64 * (j))
#define XB_XGEN(j)  (2304 + 64 * (j))
#define XB_TOP      3328
#define XB_TOPGEN   3392
#define XCD_BAR_WORDS 3456
#define XB_SPIN_CAP (1u << 22)

__device__ __forceinline__ unsigned xb_ld(unsigned* p)              { return __hip_atomic_load(p, __ATOMIC_RELAXED, __HIP_MEMORY_SCOPE_AGENT); }
__device__ __forceinline__ unsigned xb_add(unsigned* p, unsigned v) { return __hip_atomic_fetch_add(p, v, __ATOMIC_RELAXED, __HIP_MEMORY_SCOPE_AGENT); }
__device__ __forceinline__ unsigned xb_xcc_id() { return (unsigned)__builtin_amdgcn_s_getreg((3 << 11) | 20) & 0xFu; }
#define XB_SPIN(cond, bar) do { unsigned _sp = 0; while (cond) { __builtin_amdgcn_s_sleep(1); \
    if ((++_sp & 255u) == 0u) { if (xb_ld(&(bar)[XB_TMO])) break; if (_sp > XB_SPIN_CAP) { atomicAdd(&(bar)[XB_TMO], 1u); break; } } } } while (0)

struct XcdBarrier {
    unsigned* bar; unsigned x;
    volatile LAS unsigned* st;
};

__device__ __forceinline__ XcdBarrier xcd_barrier_post(unsigned* bar, volatile LAS unsigned* st) {
    XcdBarrier b; b.bar = bar; b.x = xb_xcc_id(); b.st = st;
    if (threadIdx.x == 0) (void)xb_add(&bar[XB_XCNT(b.x)], 1u);
    return b;
}
__device__ __forceinline__ void xcd_barrier_complete(unsigned* bar, unsigned x, unsigned& nloc, unsigned& nx) {
    const unsigned G = gridDim.x * gridDim.y * gridDim.z;
    unsigned sum, cnt, mine, sp = 0u;
    for (;;) {
        sum = 0u; cnt = 0u; mine = 0u;
#pragma unroll
        for (unsigned j = 0; j < 16; ++j) { const unsigned c = xb_ld(&bar[XB_XCNT(j)]); sum += c; cnt += (c > 0u) ? 1u : 0u; mine = (j == x) ? c : mine; }
        if (sum == G) break;
        __builtin_amdgcn_s_sleep(1);
        if ((++sp & 255u) == 0u) { if (xb_ld(&bar[XB_TMO])) break; if (sp > XB_SPIN_CAP) { atomicAdd(&bar[XB_TMO], 1u); break; } }
    }
    nloc = mine > 0u ? mine : 1u; nx = cnt > 0u ? cnt : 1u;
}

__device__ __forceinline__ void xcd_barrier(const XcdBarrier& b) {
    asm volatile("s_waitcnt vmcnt(0)" ::: "memory");
    __syncthreads();
    if (threadIdx.x == 0) {
        unsigned* bar = b.bar;
        __builtin_amdgcn_s_waitcnt(0);
        unsigned nloc = b.st[0], nx = b.st[1];
        if (nloc == 0u) { xcd_barrier_complete(bar, b.x, nloc, nx); b.st[0] = nloc; b.st[1] = nx; }
        const unsigned old = xb_add(&bar[XB_XSUB(b.x)], 1u);
        const unsigned gen = old / nloc;
        if (old + 1u == (gen + 1u) * nloc) {
            __builtin_amdgcn_fence(__ATOMIC_RELEASE, "agent");
            asm volatile("s_waitcnt vmcnt(0)" ::: "memory");
            const unsigned og = xb_add(&bar[XB_TOP], 1u);
            const unsigned tg = og / nx;
            if (og + 1u == (tg + 1u) * nx) xb_add(&bar[XB_TOPGEN], 1u);
            else XB_SPIN(xb_ld(&bar[XB_TOPGEN]) == tg, bar);
            __builtin_amdgcn_fence(__ATOMIC_ACQUIRE, "agent");
            xb_add(&bar[XB_XGEN(b.x)], 1u);
            asm volatile("s_waitcnt vmcnt(0)" ::: "memory");
        } else {
            XB_SPIN(xb_ld(&bar[XB_XGEN(b.x)]) == gen, bar);
            __builtin_amdgcn_fence(__ATOMIC_ACQUIRE, "agent");
            asm volatile("s_waitcnt vmcnt(0)" ::: "memory");
        }
    }
    __syncthreads();
}


struct Frame {
    LAS unsigned char* lds; volatile LAS unsigned* MISC; gu32* ctl;
    int tid, lane, wave, vcu, G;
    Ptrs p;
    __device__ __forceinline__ void refresh() { int t = threadIdx.x; asm volatile("" : "+v"(t)); tid = t; lane = t & 63; wave = __builtin_amdgcn_readfirstlane(t >> 6); }
};

__device__ __forceinline__ void transpose_item(const float* W, int ld, bf16_t* WT, LAS float* scr, int k0, int lane) {
#pragma unroll 8
    for (int i = 0; i < 32; ++i) { const int kk = 2 * i + (lane >> 5); scr[kk * 33 + (lane & 31)] = W[(size_t)(k0 + kk) * ld + (lane & 31)]; }
    LDS_WAIT(); asm volatile("" ::: "memory");
    const int c = lane & 7;
#pragma unroll
    for (int j = 0; j < 4; ++j) { const int n = (lane >> 3) + 8 * j; const LAS float* s = scr + (8 * c) * 33 + n;
        v4u o; o.x = pk2(s[0 * 33], s[1 * 33]); o.y = pk2(s[2 * 33], s[3 * 33]); o.z = pk2(s[4 * 33], s[5 * 33]); o.w = pk2(s[6 * 33], s[7 * 33]);
        *(GAS v4u*)(WT + (size_t)n * DM + k0 + 8 * c) = o; }
    LDS_WAIT(); asm volatile("" ::: "memory");
}
__device__ __forceinline__ void phase_pre(Frame& F) {
    const Ptrs& p = F.p;
    if (F.vcu < DEPTH * 48) {
        const int l = F.vcu / 48, n0 = (F.vcu % 48) * 64;
        LAS float* s = (LAS float*)F.lds;
        LAS float* red = s + 17 * DM;
        for (int i = F.tid; i < 17 * DM; i += NWAVES * 64) { const int b = i >> 10, k = i & 1023; s[i] = silu_f(b < 16 ? p.c[b * DM + k] : p.c_ctx[k]); }
        __syncthreads();
        const int kg = F.tid >> 6, col = F.tid & 63;
        float acc[17];
#pragma unroll
        for (int b = 0; b < 17; ++b) acc[b] = 0.f;
        const float* w = p.w_ada + (size_t)l * DM * 3072 + n0 + col;
#pragma unroll 4
        for (int kk = 0; kk < 128; ++kk) { const int k = kg * 128 + kk; const float wv = w[(size_t)k * 3072];
#pragma unroll
            for (int b = 0; b < 17; ++b) acc[b] += s[b * DM + k] * wv; }
#pragma unroll
        for (int b = 0; b < 17; ++b) red[(kg * 17 + b) * 64 + col] = acc[b];
        __syncthreads();
        float* mod = (float*)(p.ws + WS_MOD);
        for (int o = F.tid; o < 17 * 64; o += NWAVES * 64) { const int b = o >> 6, cc = o & 63; float sum = p.b_ada[l * 3072 + n0 + cc];
#pragma unroll
            for (int g = 0; g < 8; ++g) sum += red[(g * 17 + b) * 64 + cc];
            mod[(size_t)(l * 17 + b) * 3072 + n0 + cc] = sum; }
        __syncthreads();
    }
    LAS float* scr = (LAS float*)(F.lds + F.wave * 16384);
    const int gw = F.vcu * NWAVES + F.wave, NGW = F.G * NWAVES;
    constexpr int I_IN = 16 * (NPC / 32), I_OUT = 16 * (DM / 32), I_L = I_IN + I_OUT;
    for (int it = gw; it < DEPTH * I_L; it += NGW) {
        const int l = it / I_L; int r = it % I_L;
        if (r < I_IN) { const int kb = r / (NPC / 32), nb = r % (NPC / 32), n0 = 32 * nb;
            transpose_item(p.w_in + (size_t)l * DM * INC + c_tile_col[n0 >> 8] + (n0 & 255), INC, (bf16_t*)(p.ws + WS_WIN) + ((size_t)l * NPC + n0) * DM, scr, 64 * kb, F.lane); }
        else { r -= I_IN; const int kb = r / (DM / 32), nb = r % (DM / 32), n0 = 32 * nb;
            transpose_item(p.w_out + (size_t)l * DM * DM + n0, DM, (bf16_t*)(p.ws + WS_WOUT) + ((size_t)l * DM + n0) * DM, scr, 64 * kb, F.lane); }
    }
    { bf16_t* wsb = (bf16_t*)(p.ws + (9u << 20));
      for (int i = F.vcu * NWAVES * 64 + F.tid; i < DEPTH * 4 * 128 * 128 / 4; i += F.G * NWAVES * 64) { const f32x4 v = *(const f32x4*)(p.smlp_w + 4 * (size_t)i);
          unsigned long long o = (unsigned long long)pk2(v.x, v.y) | ((unsigned long long)pk2(v.z, v.w) << 32); *(GAS unsigned long long*)(wsb + 4 * (size_t)i) = o; } }
}

__device__ __forceinline__ void phase_norm(Frame& F, int l) {
    const Ptrs& p = F.p;
    LAS float* wab = (LAS float*)F.lds;
    for (int i = F.tid; i < 16 * DM; i += NWAVES * 64) { const int k = i >> 4, j = i & 15; wab[j * DM + k] = p.w_in[(size_t)l * DM * INC + (size_t)k * INC + 768 + j]; }
    __syncthreads();
    const int gw = F.vcu * NWAVES + F.wave, lane = F.lane;
    constexpr int RPW = MTOT / (256 * NWAVES);
    int curb = -1; f32x4 gs[4], sh[4];
    const int rbeg = gw * RPW, rend = (gw + 1) * RPW < MTOT ? (gw + 1) * RPW : MTOT;
    f32x4 vn[4]; int bn = 0;
#define NORM_SRC(r_, b_, src_) do { if ((r_) < MLAT) { b_ = (r_) >> 11; const int tp_ = (r_) & 2047; const int t_ = (l & 1) ? ((tp_ & 31) * 64 + (tp_ >> 5)) : tp_; src_ = (l == 0 ? p.x : p.out) + ((size_t)b_ * SEQ + t_) * DM; } \
        else { b_ = 16; src_ = (l == 0 ? p.ctx : (const float*)(p.ws + WS_XC)) + (size_t)((r_) - MLAT) * DM; } } while (0)
    if (rbeg < rend) { const float* src; NORM_SRC(rbeg, bn, src); const GAS f32x4* xr = (const GAS f32x4*)src + lane;
#pragma unroll
        for (int j = 0; j < 4; ++j) vn[j] = xr[64 * j]; }
    for (int r = rbeg; r < rend; ++r) {
        const int b = bn; f32x4 v[4]; float ss = 0.f;
#pragma unroll
        for (int j = 0; j < 4; ++j) v[j] = vn[j];
        if (r + 1 < rend) { const float* src; NORM_SRC(r + 1, bn, src); const GAS f32x4* xr = (const GAS f32x4*)src + lane;
#pragma unroll
            for (int j = 0; j < 4; ++j) vn[j] = xr[64 * j]; }
        if (b != curb) { curb = b; const float* mod = (const float*)(p.ws + WS_MOD) + (size_t)(l * 17 + b) * 3072;
#pragma unroll
            for (int j = 0; j < 4; ++j) { const f32x4 g = *(const f32x4*)(p.norm_g + l * DM + 256 * j + 4 * lane), sc = *(const f32x4*)(mod + 1024 + 256 * j + 4 * lane);
                gs[j] = g * (sc + 1.0f); sh[j] = *(const f32x4*)(mod + 256 * j + 4 * lane); } }
#pragma unroll
        for (int j = 0; j < 4; ++j) { ss += (v[j].x * v[j].x + v[j].y * v[j].y) + (v[j].z * v[j].z + v[j].w * v[j].w); }
        ss = wave_sum(ss);
        const float rstd = 1.0f / sqrtf(ss * (1.0f / DM) + EPS);
        GAS unsigned long long* o8 = (GAS unsigned long long*)((bf16_t*)(p.ws + WS_HY) + (size_t)r * DM) + lane;
#pragma unroll
        for (int j = 0; j < 4; ++j) { v[j] = v[j] * rstd * gs[j] + sh[j]; o8[64 * j] = (unsigned long long)pk2(v[j].x, v[j].y) | ((unsigned long long)pk2(v[j].z, v[j].w) << 32); }
        float acc[16];
#pragma unroll
        for (int n = 0; n < 16; ++n) { float a = 0.f;
#pragma unroll
            for (int j = 0; j < 4; ++j) { const f32x4 w4 = *(const LAS f32x4*)(wab + n * DM + 256 * j + 4 * lane); a += (v[j].x * w4.x + v[j].y * w4.y) + (v[j].z * w4.z + v[j].w * w4.w); }
            acc[n] = a; if ((n & 1) == 1) asm volatile("" ::: "memory"); }
        float r8[8], r4[4], r2[2], r1;
        { const bool up = lane & 32;
#pragma unroll
          for (int i = 0; i < 8; ++i) { const float keep = up ? acc[i + 8] : acc[i], send = up ? acc[i] : acc[i + 8]; r8[i] = keep + __shfl_xor(send, 32); } }
        { const bool up = lane & 16;
#pragma unroll
          for (int i = 0; i < 4; ++i) { const float keep = up ? r8[i + 4] : r8[i], send = up ? r8[i] : r8[i + 4]; r4[i] = keep + __shfl_xor(send, 16); } }
        { const bool up = lane & 8;
#pragma unroll
          for (int i = 0; i < 2; ++i) { const float keep = up ? r4[i + 2] : r4[i], send = up ? r4[i] : r4[i + 2]; r2[i] = keep + __shfl_xor(send, 8); } }
        { const bool up = lane & 4; const float keep = up ? r2[1] : r2[0], send = up ? r2[0] : r2[1]; r1 = keep + __shfl_xor(send, 4); }
        r1 += __shfl_xor(r1, 2); r1 += __shfl_xor(r1, 1);
        if ((lane & 3) == 0) ((float*)(p.ws + WS_AB))[(size_t)r * 16 + (lane >> 2)] = r1;
    }
    __syncthreads();
}

__device__ __forceinline__ void phase_final(Frame& F) {
    const Ptrs& p = F.p; const int lane = F.lane;
    const int gw = F.vcu * NWAVES + F.wave, NGW = F.G * NWAVES;
    f32x4 g[4];
#pragma unroll
    for (int j = 0; j < 4; ++j) g[j] = *(const f32x4*)(p.final_g + 256 * j + 4 * lane);
    f32x4 vn[4];
    if (gw < MLAT) { const GAS f32x4* xr = (const GAS f32x4*)(p.out + (size_t)gw * DM) + lane;
#pragma unroll
        for (int j = 0; j < 4; ++j) vn[j] = xr[64 * j]; }
    for (int r = gw; r < MLAT; r += NGW) {
        GAS f32x4* xr = (GAS f32x4*)(p.out + (size_t)r * DM) + lane;
        f32x4 v[4]; float ss = 0.f;
#pragma unroll
        for (int j = 0; j < 4; ++j) { v[j] = vn[j]; ss += (v[j].x * v[j].x + v[j].y * v[j].y) + (v[j].z * v[j].z + v[j].w * v[j].w); }
        if (r + NGW < MLAT) { const GAS f32x4* xn = (const GAS f32x4*)(p.out + (size_t)(r + NGW) * DM) + lane;
#pragma unroll
            for (int j = 0; j < 4; ++j) vn[j] = xn[64 * j]; }
        ss = wave_sum(ss);
        const float rstd = 1.0f / sqrtf(ss * (1.0f / DM) + EPS);
#pragma unroll
        for (int j = 0; j < 4; ++j) xr[64 * j] = v[j] * rstd * g[j];
    }
}

__device__ __forceinline__ void phase_gemm1(Frame& F, int l) {
    const Ptrs& p = F.p;
    pg8::Gemm g{(const bf16_t*)(p.ws + WS_HY), (const bf16_t*)(p.ws + WS_WIN) + (size_t)l * NPC * DM, MTOT, NPC, DM};
    pg8::StaticOrder S; S.init(MTOT, NPC, F.G, (int)blockIdx.x);
    pg8::EpiP E{(bf16_t*)(p.ws + WS_P), PTILE_ELEMS};
    pg8::gemm_phase<pg8::EpiP, pg8::StaticOrder, true, true>(F.lds, g, S, E);
}
__device__ __forceinline__ void phase_gemm2(Frame& F, int l) {
    const Ptrs& p = F.p;
    const int M = (l == DEPTH - 1) ? MLAT : MTOT;
    pg8::Gemm g{(const bf16_t*)(p.ws + WS_HY), (const bf16_t*)(p.ws + WS_WOUT) + (size_t)l * DM * DM, M, DM, DM};
    pg8::StaticOrder S; S.init(M, DM, F.G, (int)blockIdx.x);
    pg8::EpiResid E{l == 0 ? p.x : p.out, p.out, l == 0 ? p.ctx : (const float*)(p.ws + WS_XC), (float*)(p.ws + WS_XC), (const float*)(p.ws + WS_MOD) + (size_t)l * 17 * 3072, l & 1, MLAT, SEQ, DM};
    pg8::gemm_phase<pg8::EpiResid, pg8::StaticOrder, true, true>(F.lds, g, S, E);
}


typedef short bf16x8 __attribute__((ext_vector_type(8)));
typedef short s16x4 __attribute__((ext_vector_type(4)));
typedef unsigned u32x2 __attribute__((ext_vector_type(2)));
__device__ __forceinline__ float fexp(float x) { return __builtin_amdgcn_exp2f(x * 1.44269504089f); }
__device__ __forceinline__ float fsigmoid(float x) { return __builtin_amdgcn_rcpf(1.f + fexp(-x)); }
__device__ __forceinline__ float fsilu(float x) { return x * fsigmoid(x); }
__device__ __forceinline__ float bflo(unsigned w) { return __uint_as_float(w << 16); }
__device__ __forceinline__ float bfhi(unsigned w) { return __uint_as_float(w & 0xffff0000u); }
__device__ __forceinline__ void unpack8(const v4u& w, float (&f)[8]) { f[0] = bflo(w.x); f[1] = bfhi(w.x); f[2] = bflo(w.y); f[3] = bfhi(w.y); f[4] = bflo(w.z); f[5] = bfhi(w.z); f[6] = bflo(w.w); f[7] = bfhi(w.w); }
__device__ __forceinline__ const bf16_t* ptile_d(const Ptrs& p, int t) { return (const bf16_t*)(p.ws + WS_P) + (size_t)t * PTILE_ELEMS; }
constexpr size_t WS_WSB = 9 * MiB;

__device__ __forceinline__ void mix_unit_B(Frame& F, int l, int row0) {
    const Ptrs& p = F.p; const int oct = F.tid & 31, tg = F.tid >> 5;
    int start, len; row_seq(row0, start, len);
    const bf16_t *CG = ptile_d(p, T_CG), *XI = ptile_d(p, T_XI), *BG = ptile_d(p, T_BG), *GB = ptile_d(p, T_GB);
    float w[3][8];
#pragma unroll
    for (int j = 0; j < 3; ++j) { const f32x4 a = *(const f32x4*)(p.short_conv_w + (size_t)(l * 3 + j) * BW + 8 * oct), b = *(const f32x4*)(p.short_conv_w + (size_t)(l * 3 + j) * BW + 8 * oct + 4);
        w[j][0] = a.x; w[j][1] = a.y; w[j][2] = a.z; w[j][3] = a.w; w[j][4] = b.x; w[j][5] = b.y; w[j][6] = b.z; w[j][7] = b.w; }
    const int r0 = row0 + tg * 8;
    float cx[10][8];
    { v4u ca[10], xa[10];
#pragma unroll
      for (int i = 0; i < 10; ++i) { int r = r0 + i - 1; r = r < start ? start : (r >= start + len ? start + len - 1 : r); ca[i] = *(const GAS v4u*)(CG + (size_t)r * 256 + 8 * oct); xa[i] = *(const GAS v4u*)(XI + (size_t)r * 256 + 8 * oct); }
#pragma unroll
      for (int i = 0; i < 10; ++i) { float fa[8], fb[8]; unpack8(ca[i], fa); unpack8(xa[i], fb);
#pragma unroll
          for (int e = 0; e < 8; ++e) cx[i][e] = fa[e] * fb[e]; }
      const bool lo_ok = r0 - 1 >= start, hi_ok = r0 + 8 < start + len;
#pragma unroll
      for (int e = 0; e < 8; ++e) { cx[0][e] = lo_ok ? cx[0][e] : 0.f; cx[9][e] = hi_ok ? cx[9][e] : 0.f; } }
#pragma unroll
    for (int i = 0; i < 8; ++i) { const int r = r0 + i;
        const v4u bgw = *(const GAS v4u*)(BG + (size_t)r * 256 + 8 * oct), gw = *(const GAS v4u*)(GB + (size_t)r * 256 + 8 * oct); float bg[8], gt[8], y[8]; unpack8(bgw, bg); unpack8(gw, gt);
#pragma unroll
        for (int e = 0; e < 8; ++e) y[e] = bg[e] * (w[0][e] * cx[i][e] + w[1][e] * cx[i + 1][e] + w[2][e] * cx[i + 2][e]) * fsilu(gt[e]);
        v4u o; o.x = pk2(y[0], y[1]); o.y = pk2(y[2], y[3]); o.z = pk2(y[4], y[5]); o.w = pk2(y[6], y[7]);
        *(GAS v4u*)((bf16_t*)(p.ws + WS_HY) + (size_t)r * DM + 256 + 8 * oct) = o; }
}

__device__ __forceinline__ void mix_unit_C(Frame& F, int l, int row0) {
    const Ptrs& p = F.p; const int tid = F.tid, lane = F.lane, wave = F.wave;
    int start, len; row_seq(row0, start, len);
    const bf16_t *GA = ptile_d(p, T_GLA), *GLB = ptile_d(p, T_GLB), *GC = ptile_d(p, T_GC);
    LAS float* glu = (LAS float*)F.lds;
    { v4u la[6], lb[6];
#pragma unroll
      for (int k = 0; k < 6; ++k) { const int idx = tid + k * NWAVES * 64, i = idx >> 5, oct = idx & 31; int r = row0 - 15 + i; r = r < start ? start : (r >= start + len ? start + len - 1 : r);
          la[k] = *(const GAS v4u*)(GA + (size_t)r * 256 + 8 * oct); lb[k] = *(const GAS v4u*)(GLB + (size_t)r * 256 + 8 * oct); }
#pragma unroll
      for (int k = 0; k < 6; ++k) { const int idx = tid + k * NWAVES * 64, i = idx >> 5, oct = idx & 31, r = row0 - 15 + i;
          if (i < 94) { const bool ok = r >= start && r < start + len; float fa[8], fb[8]; unpack8(la[k], fa); unpack8(lb[k], fb);
              const f32x4 o0 = {ok ? fa[0] * fsigmoid(fb[0]) : 0.f, ok ? fa[1] * fsigmoid(fb[1]) : 0.f, ok ? fa[2] * fsigmoid(fb[2]) : 0.f, ok ? fa[3] * fsigmoid(fb[3]) : 0.f};
              const f32x4 o1 = {ok ? fa[4] * fsigmoid(fb[4]) : 0.f, ok ? fa[5] * fsigmoid(fb[5]) : 0.f, ok ? fa[6] * fsigmoid(fb[6]) : 0.f, ok ? fa[7] * fsigmoid(fb[7]) : 0.f};
              *(LAS f32x4*)(glu + i * 256 + 8 * oct) = o0; *(LAS f32x4*)(glu + i * 256 + 8 * oct + 4) = o1; } } }
    __syncthreads();
    const int c = tid & 255, th = tid >> 8;
    float z[32];
    { float win[62];
#pragma unroll
      for (int i = 0; i < 62; ++i) win[i] = glu[(th * 32 + i) * 256 + c];
      const float bias = p.conf_conv_b[l * BW + c];
#pragma unroll
      for (int i = 0; i < 32; ++i) z[i] = bias;
#pragma unroll
      for (int j = 0; j < 31; ++j) { const float wj = p.conf_conv_w[(size_t)(l * 31 + j) * BW + c];
#pragma unroll
          for (int i = 0; i < 32; ++i) z[i] += wj * win[i + j]; } }
    __syncthreads();
#pragma unroll
    for (int i = 0; i < 32; ++i) glu[(th * 32 + i) * 256 + c] = z[i];
    __syncthreads();
    const f32x4 lg = *(const f32x4*)(p.conf_ln_g + l * BW + 4 * lane), lb = *(const f32x4*)(p.conf_ln_b + l * BW + 4 * lane);
#pragma unroll 2
    for (int i = 0; i < 8; ++i) { const int t = wave * 8 + i, r = row0 + t;
        const f32x4 zz = *(const LAS f32x4*)(glu + t * 256 + 4 * lane);
        const float mean = wave_sum((zz.x + zz.y) + (zz.z + zz.w)) * (1.f / 256.f);
        const f32x4 d = zz - mean;
        const float var = wave_sum((d.x * d.x + d.y * d.y) + (d.z * d.z + d.w * d.w)) * (1.f / 256.f);
        const float rstd = 1.0f / sqrtf(var + EPS);
        const f32x4 ln = d * rstd * lg + lb;
        const u32x2 gw = *(const GAS u32x2*)(GC + (size_t)r * 256 + 4 * lane);
        u32x2 o; o.x = pk2(fsilu(ln.x) * fsilu(bflo(gw.x)), fsilu(ln.y) * fsilu(bfhi(gw.x))); o.y = pk2(fsilu(ln.z) * fsilu(bflo(gw.y)), fsilu(ln.w) * fsilu(bfhi(gw.y)));
        *(GAS u32x2*)((bf16_t*)(p.ws + WS_HY) + (size_t)r * DM + 512 + 4 * lane) = o; }
    __syncthreads();
}

__device__ __forceinline__ void mix_unit_D(Frame& F, int l, int row0) {
    const Ptrs& p = F.p; const int lane = F.lane, wave = F.wave;
    constexpr int VS = 528;
    LAS unsigned char* vl = F.lds;
    const bf16_t *VV = ptile_d(p, T_VV), *U = ptile_d(p, T_U), *GD = ptile_d(p, T_GD);
    { const f32x4 lg = *(const f32x4*)(p.smlp_ln_g + l * BW + 4 * lane), lb = *(const f32x4*)(p.smlp_ln_b + l * BW + 4 * lane);
      u32x2 rawv[16];
#pragma unroll
      for (int i = 0; i < 16; ++i) rawv[i] = *(const GAS u32x2*)(VV + (size_t)(row0 + wave * 16 + i) * 256 + 4 * lane);
#pragma unroll
      for (int i = 0; i < 16; ++i) { const int q = wave * 16 + i; const u32x2 raw = rawv[i];
        const f32x4 v = {bflo(raw.x), bfhi(raw.x), bflo(raw.y), bfhi(raw.y)};
        const float mean = wave_sum((v.x + v.y) + (v.z + v.w)) * (1.f / 256.f);
        const f32x4 d = v - mean;
        const float var = wave_sum((d.x * d.x + d.y * d.y) + (d.z * d.z + d.w * d.w)) * (1.f / 256.f);
        const float rstd = 1.0f / sqrtf(var + EPS);
        const f32x4 y = d * rstd * lg + lb;
        u32x2 o; o.x = pk2(y.x, y.y); o.y = pk2(y.z, y.w);
        *(LAS u32x2*)(vl + q * VS + 8 * lane) = o; } }
    __syncthreads();
    const int g = wave >> 1, ph = wave & 1, li = lane & 15, lg4 = lane >> 4;
    f32x4 acc[4][4];
#pragma unroll
    for (int a = 0; a < 4; ++a)
#pragma unroll
        for (int b = 0; b < 4; ++b) acc[a][b] = (f32x4){0.f, 0.f, 0.f, 0.f};
    const bf16_t* W = (const bf16_t*)(p.ws + WS_WSB) + (size_t)(l * 4 + g) * 128 * 128;
#pragma unroll
    for (int ks = 0; ks < 4; ++ks) {
        bf16x8 af[4], bfr[4];
#pragma unroll
        for (int ct = 0; ct < 4; ++ct) { LAS unsigned char* a = vl + (32 * ks + 8 * lg4 + (li >> 2)) * VS + (64 * g + 16 * ct + 4 * (li & 3)) * 2;
            const s16x4 lo = __builtin_amdgcn_ds_read_tr16_b64_v4i16((LAS s16x4*)a), hi = __builtin_amdgcn_ds_read_tr16_b64_v4i16((LAS s16x4*)(a + 4 * VS));
            af[ct] = (bf16x8){lo[0], lo[1], lo[2], lo[3], hi[0], hi[1], hi[2], hi[3]}; }
#pragma unroll
        for (int pt = 0; pt < 4; ++pt) bfr[pt] = *(const GAS bf16x8*)(W + (size_t)(64 * ph + 16 * pt + li) * 128 + 32 * ks + 8 * lg4);
#pragma unroll
        for (int ct = 0; ct < 4; ++ct)
#pragma unroll
            for (int pt = 0; pt < 4; ++pt) acc[ct][pt] = __builtin_amdgcn_mfma_f32_16x16x32_bf16(af[ct], bfr[pt], acc[ct][pt], 0, 0, 0);
    }
#pragma unroll
    for (int pt = 0; pt < 4; ++pt) { const int prow = 64 * ph + 16 * pt + li, r = row0 + prow; const float bs = p.smlp_b[(l * 4 + g) * 128 + prow];
#pragma unroll
        for (int ct = 0; ct < 4; ++ct) { const int c = 64 * g + 16 * ct + 4 * lg4;
            const u32x2 uw = *(const GAS u32x2*)(U + (size_t)r * 256 + c), gw = *(const GAS u32x2*)(GD + (size_t)r * 256 + c);
            const f32x4 m = acc[ct][pt] + bs;
            u32x2 o; o.x = pk2(bflo(uw.x) * m.x * fsilu(bflo(gw.x)), bfhi(uw.x) * m.y * fsilu(bfhi(gw.x))); o.y = pk2(bflo(uw.y) * m.z * fsilu(bflo(gw.y)), bfhi(uw.y) * m.w * fsilu(bfhi(gw.y)));
            *(GAS u32x2*)((bf16_t*)(p.ws + WS_HY) + (size_t)r * DM + 768 + c) = o; } }
    __syncthreads();
}

__device__ __forceinline__ void phase_mix(Frame& F, int l) {
    constexpr int NC = MTOT / 64, ND = MTOT / 128, NBU = MTOT / 128;
    for (int u = F.vcu; u < NC + ND + NBU; u += F.G) {
        F.refresh();
        if (u < NC) mix_unit_C(F, l, u * 64);
        else if (u < NC + ND) mix_unit_D(F, l, (u - NC) * 128);
        else mix_unit_B(F, l, (u - NC - ND) * 128);
    }
}


constexpr size_t WS_REC = 212 * MiB, WS_OB16 = 476 * MiB;
constexpr int REC_BYTES = 53248, R_NW = 0, R_Q = 8192, R_U = 16384, R_VEC = 32768, R_ATTN = 33792, R_KT = 41984;
constexpr int NITEM = 2304;
constexpr int L_Q = 0, L_K = 4352, L_V = 8704, L_GKK = 13056, L_GQK = 17408, L_QB = 21760, L_KB = 24064, L_AO = 21760, L_AD = 26368, L_DF = 28928, L_SM = 30208, L_XS = 0, GS = 68, SMD = 256;

__device__ __forceinline__ float dpp_xor1(float v) { return __int_as_float(__builtin_amdgcn_mov_dpp(__float_as_int(v), 0xB1, 0xF, 0xF, true)); }
__device__ __forceinline__ bf16x8 pack8(const f32x4& a, const f32x4& b) {
    return __builtin_bit_cast(bf16x8, __builtin_convertvector((nf32x8){a.x, a.y, a.z, a.w, b.x, b.y, b.z, b.w}, nbf16x8)); }

__device__ __forceinline__ void prep_decode(int item, int& b, int& h, int& row0) {
    if (item < 2048) { b = item >> 7; h = (item >> 5) & 3; const int n = item & 31; row0 = b * SEQ + 64 * n; }
    else { const int it = item - 2048; b = it >> 4; h = (it >> 2) & 3; const int n = it & 3; row0 = MLAT + b * CTXL + 64 * n; }
}
__device__ __forceinline__ void prep_load(Frame& F, int l, int item, v4u (&raw)[6], float (&abn)[2]) {
    const Ptrs& p = F.p; int b, h, row0; prep_decode(item, b, h, row0); int start, len; row_seq(row0, start, len);
    const int tq = F.tid < 384 ? F.tid : 383, tg = tq / 24, o = tq % 24, part = o >> 3, oo = o & 7;
    const bf16_t* T = ptile_d(p, part) + h * 64 + 8 * oo;
#pragma unroll
    for (int i = 0; i < 6; ++i) { int r = row0 + 4 * tg - 1 + i; r = r < start ? start : (r >= start + len ? start + len - 1 : r); raw[i] = *(const GAS v4u*)(T + (size_t)r * 256); }
    if ((F.wave & 3) == 0) { const int dir = F.wave >> 2, tok = dir ? 63 - F.lane : F.lane; const float* AB = (const float*)(p.ws + WS_AB) + ((size_t)row0 + tok) * 16;
        abn[0] = AB[dir * 4 + h]; abn[1] = AB[8 + dir * 4 + h]; }
}
__device__ __forceinline__ void prep_item(Frame& F, int l, int item, v4u (&raw)[6], float (&abn)[2], int next_item) {
    const Ptrs& p = F.p; const int tid = F.tid, lane = F.lane, wave = F.wave;
    int b, h, row0; prep_decode(item, b, h, row0);
    int start, len; row_seq(row0, start, len);
    LAS float* lf = (LAS float*)F.lds;
    if (tid < 384) { const int tg = tid / 24, o = tid % 24, part = o >> 3, oo = o & 7;
        const float* wc = p.qkv_conv_w + (size_t)l * 3 * 768 + part * 256 + h * 64 + 8 * oo;
        float w[3][8], x[6][8];
#pragma unroll
        for (int j = 0; j < 3; ++j) { const f32x4 w0 = *(const f32x4*)(wc + j * 768), w1 = *(const f32x4*)(wc + j * 768 + 4);
            w[j][0] = w0.x; w[j][1] = w0.y; w[j][2] = w0.z; w[j][3] = w0.w; w[j][4] = w1.x; w[j][5] = w1.y; w[j][6] = w1.z; w[j][7] = w1.w; }
#pragma unroll
        for (int i = 0; i < 6; ++i) unpack8(raw[i], x[i]);
        const bool lo_ok = row0 + 4 * tg - 1 >= start, hi_ok = row0 + 4 * tg + 4 < start + len;
#pragma unroll
        for (int e = 0; e < 8; ++e) { x[0][e] = lo_ok ? x[0][e] : 0.f; x[5][e] = hi_ok ? x[5][e] : 0.f; }
#pragma unroll
        for (int t = 0; t < 4; ++t) { float a[8];
#pragma unroll
            for (int e = 0; e < 8; ++e) a[e] = fsilu(w[0][e] * x[t][e] + w[1][e] * x[t + 1][e] + w[2][e] * x[t + 2][e]);
            LAS float* dst = lf + part * 4352 + (4 * tg + t) * 68 + 8 * oo;
            *(LAS f32x4*)dst = (f32x4){a[0], a[1], a[2], a[3]}; *(LAS f32x4*)(dst + 4) = (f32x4){a[4], a[5], a[6], a[7]}; } }
    if ((wave & 3) == 0) { const int dir = wave >> 2, i = lane;
        const float g = -expf(p.a_log[(l * 2 + dir) * 4 + h]) * softplus_f(abn[0] + p.dt_bias[(l * 2 + dir) * 4 + h]);
        const float beta = sigmoid_f(abn[1]);
        float gc = g;
#pragma unroll
        for (int o = 1; o < 64; o <<= 1) { const float t = __shfl_up(gc, o); if (lane >= o) gc += t; }
        LAS float* sm = lf + L_SM + dir * SMD; const float eg = expf(gc); sm[i] = gc; sm[64 + i] = beta; sm[128 + i] = eg; sm[192 + i] = beta * eg; }
    prep_load(F, l, next_item, raw, abn);
    __syncthreads();
    { const int row = tid >> 2, part = row >> 6, t = row & 63, qt = tid & 3; LAS float* src = lf + part * 4352 + t * 68 + 16 * qt;
      f32x4 v[4]; float ss = 0.f;
#pragma unroll
      for (int i = 0; i < 4; ++i) { v[i] = *(LAS f32x4*)(src + 4 * i); ss += (v[i].x * v[i].x + v[i].y * v[i].y) + (v[i].z * v[i].z + v[i].w * v[i].w); }
      ss += __shfl_xor(ss, 1); ss += __shfl_xor(ss, 2);
      const float sc = (1.0f / sqrtf(ss + EPS)) * (part == 0 ? 0.125f : 1.0f);
#pragma unroll
      for (int i = 0; i < 4; ++i) { v[i] = v[i] * sc; *(LAS f32x4*)(src + 4 * i) = v[i]; }
      LAS unsigned char* bdst = (LAS unsigned char*)(lf + (part ? L_KB : L_QB)) + t * 144 + 32 * qt;
      v4u o; o.x = pk2(v[0].x, v[0].y); o.y = pk2(v[0].z, v[0].w); o.z = pk2(v[1].x, v[1].y); o.w = pk2(v[1].z, v[1].w); *(LAS v4u*)bdst = o;
      o.x = pk2(v[2].x, v[2].y); o.y = pk2(v[2].z, v[2].w); o.z = pk2(v[3].x, v[3].y); o.w = pk2(v[3].z, v[3].w); *(LAS v4u*)(bdst + 16) = o; }
    __syncthreads();
    { const int mat = wave >> 2, it = wave & 3, li = lane & 15, g4 = lane >> 4;
      const LAS unsigned char* Ab = (const LAS unsigned char*)(lf + (mat ? L_QB : L_KB)); const LAS unsigned char* Kb = (const LAS unsigned char*)(lf + L_KB);
      bf16x8 af[2];
#pragma unroll
      for (int s2 = 0; s2 < 2; ++s2) af[s2] = *(const LAS bf16x8*)(Ab + (16 * it + li) * 144 + (32 * s2 + 8 * g4) * 2);
      LAS float* G = lf + (mat ? L_GQK : L_GKK);
#pragma unroll
      for (int jt = 0; jt < 4; ++jt) { f32x4 acc = {0.f, 0.f, 0.f, 0.f};
#pragma unroll
          for (int s2 = 0; s2 < 2; ++s2) { const bf16x8 bq = *(const LAS bf16x8*)(Kb + (16 * jt + li) * 144 + (32 * s2 + 8 * g4) * 2); acc = __builtin_amdgcn_mfma_f32_16x16x32_bf16(af[s2], bq, acc, 0, 0, 0); }
#pragma unroll
          for (int r = 0; r < 4; ++r) G[(16 * it + 4 * g4 + r) * GS + 16 * jt + li] = acc[r]; } }
    __syncthreads();
    const int dir = tid >> 8, td = tid & 255;
    const LAS float* sm = lf + L_SM + dir * SMD;
    unsigned char* rec = p.ws + WS_REC + (size_t)(item * 2 + dir) * REC_BYTES;
    { const int i = td >> 2, jq = td & 3, ti = dir ? 63 - i : i; const float gi = sm[i], bi = sm[64 + i];
      const LAS float* grow = lf + L_GKK + ti * GS + (dir ? 48 - 16 * jq : 16 * jq);
      float gv[16], gc[16];
#pragma unroll
      for (int k = 0; k < 4; ++k) { const f32x4 a = *(const LAS f32x4*)(grow + 4 * k), c = *(const LAS f32x4*)(sm + 16 * jq + 4 * k);
          gv[4 * k] = a.x; gv[4 * k + 1] = a.y; gv[4 * k + 2] = a.z; gv[4 * k + 3] = a.w; gc[4 * k] = c.x; gc[4 * k + 1] = c.y; gc[4 * k + 2] = c.z; gc[4 * k + 3] = c.w; }
      float val[16];
#pragma unroll
      for (int jj = 0; jj < 16; ++jj) { const int j = 16 * jq + jj; const float G = dir ? gv[15 - jj] : gv[jj];
          const float v = bi * G * fexp(fminf(gi - gc[jj], 0.f)); val[jj] = (i > j) ? v : 0.f; }
      { const bool below = jq < (i >> 4);
        v4u o0, o1; o0.x = below ? pk2(-val[0], -val[1]) : 0u; o0.y = below ? pk2(-val[2], -val[3]) : 0u; o0.z = below ? pk2(-val[4], -val[5]) : 0u; o0.w = below ? pk2(-val[6], -val[7]) : 0u;
        o1.x = below ? pk2(-val[8], -val[9]) : 0u; o1.y = below ? pk2(-val[10], -val[11]) : 0u; o1.z = below ? pk2(-val[12], -val[13]) : 0u; o1.w = below ? pk2(-val[14], -val[15]) : 0u;
        LAS unsigned char* ao = (LAS unsigned char*)(lf + L_AO) + dir * 9216 + i * 144 + 32 * jq; *(LAS v4u*)ao = o0; *(LAS v4u*)(ao + 16) = o1; }
      if (jq == (i >> 4)) { LAS float* ad = lf + L_AD + dir * 1280 + (i >> 4) * 320 + (i & 15) * 20;
#pragma unroll
          for (int k = 0; k < 4; ++k) *(LAS f32x4*)(ad + 4 * k) = (f32x4){val[4 * k], val[4 * k + 1], val[4 * k + 2], val[4 * k + 3]}; } }
#pragma unroll
    for (int k = 0; k < 2; ++k) { const int f = td + 256 * k, ms = f >> 6, ll = f & 63, m = ms >> 1, s = ms & 1, rr = 16 * m + (ll & 15), cb = 32 * s + 4 * (ll >> 4);
        float va[8], vq[8], vk[8];
        const int ti = dir ? 63 - rr : rr; const float gi = sm[rr];
#pragma unroll
        for (int hh = 0; hh < 2; ++hh) { const int c0 = cb + 16 * hh;
            const f32x4 g4 = *(const LAS f32x4*)(lf + L_GQK + ti * GS + (dir ? 60 - c0 : c0)), s4 = *(const LAS f32x4*)(sm + c0), q4 = *(const LAS f32x4*)(lf + L_Q + ti * 68 + c0);
            const float gq[4] = {dir ? g4.w : g4.x, dir ? g4.z : g4.y, dir ? g4.y : g4.z, dir ? g4.x : g4.w}, sc[4] = {s4.x, s4.y, s4.z, s4.w}, qq[4] = {q4.x, q4.y, q4.z, q4.w};
#pragma unroll
            for (int e = 0; e < 4; ++e) { const int c = c0 + e, tc = dir ? 63 - c : c;
                const float v = gq[e] * fexp(fminf(gi - sc[e], 0.f)); va[4 * hh + e] = (rr >= c) ? v : 0.f;
                vq[4 * hh + e] = qq[e];
                vk[4 * hh + e] = lf[L_K + tc * 68 + rr]; } }
        v4u o; o.x = pk2(va[0], va[1]); o.y = pk2(va[2], va[3]); o.z = pk2(va[4], va[5]); o.w = pk2(va[6], va[7]); *(GAS v4u*)(rec + R_ATTN + f * 16) = o;
        o.x = pk2(vq[0], vq[1]); o.y = pk2(vq[2], vq[3]); o.z = pk2(vq[4], vq[5]); o.w = pk2(vq[6], vq[7]); *(GAS v4u*)(rec + R_Q + f * 16) = o;
        o.x = pk2(vk[0], vk[1]); o.y = pk2(vk[2], vk[3]); o.z = pk2(vk[4], vk[5]); o.w = pk2(vk[6], vk[7]); *(GAS v4u*)(rec + R_KT + f * 16) = o; }
    if (td < 64) { float* vec = (float*)(rec + R_VEC); vec[td] = sm[128 + td]; vec[64 + td] = expf(sm[63] - sm[td]); if (td == 0) vec[128] = expf(sm[63]); }
    const int li = lane & 15, g4 = lane >> 4, nt0 = 2 * (wave & 3);
    f32x4 Rt[2][4];
#pragma unroll
    for (int t = 0; t < 2; ++t) { const int nt = nt0 + t; const LAS float* src = lf + (nt < 4 ? L_V + 16 * nt + li : L_K + 16 * (nt - 4) + li); const LAS float* scl = sm + (nt < 4 ? 64 : 192);
#pragma unroll
        for (int m = 0; m < 4; ++m) { const f32x4 sc = *(const LAS f32x4*)(scl + 16 * m + 4 * g4); const int i0 = 16 * m + 4 * g4;
            Rt[t][m] = (f32x4){src[(dir ? 63 - i0 : i0) * 68] * sc.x, src[(dir ? 62 - i0 : i0 + 1) * 68] * sc.y, src[(dir ? 61 - i0 : i0 + 2) * 68] * sc.z, src[(dir ? 60 - i0 : i0 + 3) * 68] * sc.w}; } }
    __syncthreads();
    if ((wave & 3) == 0) { const int blk = lane >> 4, c = lane & 15; const LAS float* Ad = lf + L_AD + dir * 1280 + blk * 320;
        float x[16];
#pragma unroll
        for (int r = 0; r < 16; ++r) x[r] = 0.f;
#pragma unroll
        for (int r = 0; r < 16; ++r) { float acc = (r == c) ? 1.f : 0.f;
#pragma unroll
            for (int q = 0; q < (r + 3) / 4; ++q) { const f32x4 a = *(const LAS f32x4*)(Ad + r * 20 + 4 * q); acc -= (a.x * x[4 * q] + a.y * x[4 * q + 1]) + (a.z * x[4 * q + 2] + a.w * x[4 * q + 3]); }
            x[r] = acc; }
        LAS bf16_t* DF = (LAS bf16_t*)(lf + L_DF) + dir * 1280 + blk * 320;
#pragma unroll
        for (int r = 0; r < 16; ++r) DF[r * 20 + c] = f2bf(x[r]); }
    __syncthreads();
    { const LAS unsigned char* ao = (const LAS unsigned char*)(lf + L_AO) + dir * 9216; const LAS unsigned char* df = (const LAS unsigned char*)(lf + L_DF) + dir * 2560;
      const f32x4 zero4 = {0.f, 0.f, 0.f, 0.f};
      f32x4 X[2][4];
#pragma unroll
      for (int t = 0; t < 2; ++t)
#pragma unroll
          for (int m = 0; m < 4; ++m) X[t][m] = zero4;
#pragma unroll
      for (int m = 0; m < 4; ++m) {
          const u32x2 dw = *(const LAS u32x2*)(df + m * 640 + li * 40 + g4 * 8);
          const bf16x8 dfrag = __builtin_bit_cast(bf16x8, (v4u){dw.x, dw.y, 0u, 0u});
          f32x4 acc[2] = {Rt[0][m], Rt[1][m]};
#pragma unroll
          for (int s2 = 0; s2 < (m + 1) / 2; ++s2) { const u32x2 lo = *(const LAS u32x2*)(ao + (16 * m + li) * 144 + (32 * s2 + 4 * g4) * 2), hi = *(const LAS u32x2*)(ao + (16 * m + li) * 144 + (32 * s2 + 16 + 4 * g4) * 2);
              const bf16x8 afrag = __builtin_bit_cast(bf16x8, (v4u){lo.x, lo.y, hi.x, hi.y});
#pragma unroll
              for (int t = 0; t < 2; ++t) acc[t] = __builtin_amdgcn_mfma_f32_16x16x32_bf16(afrag, pack8(X[t][2 * s2], X[t][2 * s2 + 1]), acc[t], 0, 0, 0); }
#pragma unroll
          for (int t = 0; t < 2; ++t) X[t][m] = __builtin_amdgcn_mfma_f32_16x16x32_bf16(dfrag, pack8(acc[t], zero4), zero4, 0, 0, 0); }
      LAS float* XS = lf + L_XS + dir * 8448;
#pragma unroll
      for (int t = 0; t < 2; ++t)
#pragma unroll
          for (int m = 0; m < 4; ++m)
#pragma unroll
              for (int r = 0; r < 4; ++r) XS[(16 * m + 4 * g4 + r) * 132 + 16 * (nt0 + t) + li] = X[t][m][r]; }
    __syncthreads();
    { const LAS float* XS = lf + L_XS + dir * 8448;
#pragma unroll
      for (int k = 0; k < 2; ++k) { const int f = td + 256 * k, ms = f >> 6, ll = f & 63, m = ms >> 1, s = ms & 1, rr = 16 * m + (ll & 15), cb = 32 * s + 4 * (ll >> 4);
          float v[8];
#pragma unroll
          for (int e = 0; e < 8; ++e) v[e] = -XS[rr * 132 + 64 + cb + 16 * (e >> 2) + (e & 3)];
          v4u o; o.x = pk2(v[0], v[1]); o.y = pk2(v[2], v[3]); o.z = pk2(v[4], v[5]); o.w = pk2(v[6], v[7]); *(GAS v4u*)(rec + R_NW + f * 16) = o; }
#pragma unroll
      for (int k = 0; k < 4; ++k) { const int u = td + 256 * k, w = u >> 8, m = (u >> 6) & 3, ll = u & 63, r0 = 16 * m + 4 * (ll >> 4), c = 16 * w + (ll & 15);
          const f32x4 o = {XS[r0 * 132 + c], XS[(r0 + 1) * 132 + c], XS[(r0 + 2) * 132 + c], XS[(r0 + 3) * 132 + c]};
          *(GAS f32x4*)(rec + R_U + u * 16) = o; } }
    __syncthreads();
}
__device__ __forceinline__ void phase_prep(Frame& F, int l) {
    v4u raw[6]; float abn[2] = {0.f, 0.f};
    F.refresh();
    if (F.vcu < NITEM) prep_load(F, l, F.vcu, raw, abn);
    for (int it = F.vcu; it < NITEM; it += F.G) { F.refresh(); prep_item(F, l, it, raw, abn, it + F.G < NITEM ? it + F.G : it); }
}

__device__ __forceinline__ void phase_scan(Frame& F, int l) {
    const Ptrs& p = F.p;
    if (F.vcu >= 128 || F.wave >= 4) return;
    const int s = F.vcu, b = s >> 3, h = (s >> 1) & 3, dir = s & 1, w = F.wave, lane = F.lane, li = lane & 15, g4 = lane >> 4;
    f32x4 S[4];
#pragma unroll
    for (int m = 0; m < 4; ++m) S[m] = (f32x4){0.f, 0.f, 0.f, 0.f};
    bf16_t* O = (bf16_t*)(p.ws + WS_OB16) + (size_t)dir * MTOT * 256;
    for (int step = 0; step < 36; ++step) {
        int cid, row0;
        if (step < 4) { const int n = dir ? 3 - step : step; cid = 2048 + (b * 4 + h) * 4 + n; row0 = MLAT + b * CTXL + 64 * n; }
        else { const int n = dir ? 35 - step : step - 4; cid = (b * 4 + h) * 32 + n; row0 = b * SEQ + 64 * n; }
        const unsigned char* rec = p.ws + WS_REC + (size_t)(cid * 2 + dir) * REC_BYTES;
        bf16x8 nw[4][2], qf[4][2], at[4][2], kt[4][2]; f32x4 av[4], ao[4], a2[4], egc4[4], edl4[4];
#pragma unroll
        for (int m = 0; m < 4; ++m) {
#pragma unroll
            for (int s2 = 0; s2 < 2; ++s2) { nw[m][s2] = *(const GAS bf16x8*)(rec + R_NW + ((m * 2 + s2) * 64 + lane) * 16); qf[m][s2] = *(const GAS bf16x8*)(rec + R_Q + ((m * 2 + s2) * 64 + lane) * 16); }
            av[m] = *(const GAS f32x4*)(rec + R_U + ((w * 4 + m) * 64 + lane) * 16); ao[m] = (f32x4){0.f, 0.f, 0.f, 0.f}; }
        const float gl = *(const GAS float*)(rec + R_VEC + 512);
        bf16x8 Bs[2] = {pack8(S[0], S[1]), pack8(S[2], S[3])};
#pragma unroll
        for (int m = 0; m < 4; ++m) {
#pragma unroll
            for (int s2 = 0; s2 < 2; ++s2) { at[m][s2] = *(const GAS bf16x8*)(rec + R_ATTN + ((m * 2 + s2) * 64 + lane) * 16); kt[m][s2] = *(const GAS bf16x8*)(rec + R_KT + ((m * 2 + s2) * 64 + lane) * 16); }
            edl4[m] = *(const GAS f32x4*)(rec + R_VEC + 256 + (16 * m + 4 * g4) * 4); }
#pragma unroll
        for (int m = 0; m < 4; ++m)
#pragma unroll
            for (int s2 = 0; s2 < 2; ++s2) { av[m] = __builtin_amdgcn_mfma_f32_16x16x32_bf16(nw[m][s2], Bs[s2], av[m], 0, 0, 0); ao[m] = __builtin_amdgcn_mfma_f32_16x16x32_bf16(qf[m][s2], Bs[s2], ao[m], 0, 0, 0); }
        asm volatile("" ::: "memory");
#pragma unroll
        for (int m = 0; m < 4; ++m) { egc4[m] = *(const GAS f32x4*)(rec + R_VEC + (16 * m + 4 * g4) * 4); a2[m] = (f32x4){0.f, 0.f, 0.f, 0.f}; }
        bf16x8 Bv[2] = {pack8(av[0], av[1]), pack8(av[2], av[3])};
        bf16x8 Bvs[2] = {pack8(av[0] * edl4[0], av[1] * edl4[1]), pack8(av[2] * edl4[2], av[3] * edl4[3])};
#pragma unroll
        for (int m = 0; m < 4; ++m) S[m] = S[m] * gl;
#pragma unroll
        for (int m = 0; m < 4; ++m)
#pragma unroll
            for (int s2 = 0; s2 < 2; ++s2) { a2[m] = __builtin_amdgcn_mfma_f32_16x16x32_bf16(at[m][s2], Bv[s2], a2[m], 0, 0, 0); S[m] = __builtin_amdgcn_mfma_f32_16x16x32_bf16(kt[m][s2], Bvs[s2], S[m], 0, 0, 0); }
#pragma unroll
        for (int m = 0; m < 4; ++m) { const f32x4 o = egc4[m] * ao[m] + a2[m];
#pragma unroll
            for (int r = 0; r < 4; ++r) { const int i = 16 * m + 4 * g4 + r, tok = dir ? 63 - i : i;
                O[(size_t)(row0 + tok) * 256 + h * 64 + 16 * w + li] = f2bf(o[r]); } }
        asm volatile("" ::: "memory");
    }
}

__device__ __forceinline__ void phase_comb(Frame& F, int l) {
    const Ptrs& p = F.p; const int lane = F.lane;
    const int gw = F.vcu * NWAVES + F.wave, NGW = F.G * NWAVES;
    const bf16_t* OF = (const bf16_t*)(p.ws + WS_OB16); const bf16_t* OB = OF + (size_t)MTOT * 256; const bf16_t* GA = ptile_d(p, T_GA);
    const f32x4 ng = *(const f32x4*)(p.gdn_norm_g + l * 64 + 4 * (lane & 15));
    const int nrow = (l == DEPTH - 1) ? MLAT : MTOT;
    u32x2 an, cn, gn;
    if (gw < nrow) { an = *(const GAS u32x2*)(OF + (size_t)gw * 256 + 4 * lane); cn = *(const GAS u32x2*)(OB + (size_t)gw * 256 + 4 * lane); gn = *(const GAS u32x2*)(GA + (size_t)gw * 256 + 4 * lane); }
    for (int r = gw; r < nrow; r += NGW) {
        const u32x2 a = an, c = cn, gt = gn;
        if (r + NGW < nrow) { const size_t r2 = (size_t)(r + NGW); an = *(const GAS u32x2*)(OF + r2 * 256 + 4 * lane); cn = *(const GAS u32x2*)(OB + r2 * 256 + 4 * lane); gn = *(const GAS u32x2*)(GA + r2 * 256 + 4 * lane); }
        const f32x4 o = {bflo(a.x) + bflo(c.x), bfhi(a.x) + bfhi(c.x), bflo(a.y) + bflo(c.y), bfhi(a.y) + bfhi(c.y)};
        float ss = (o.x * o.x + o.y * o.y) + (o.z * o.z + o.w * o.w);
        ss += __shfl_xor(ss, 1); ss += __shfl_xor(ss, 2); ss += __shfl_xor(ss, 4); ss += __shfl_xor(ss, 8);
        const float rs = 1.0f / sqrtf(ss * (1.f / 64.f) + EPS);
        u32x2 y; y.x = pk2(o.x * rs * ng.x * fsilu(bflo(gt.x)), o.y * rs * ng.y * fsilu(bfhi(gt.x))); y.y = pk2(o.z * rs * ng.z * fsilu(bflo(gt.y)), o.w * rs * ng.w * fsilu(bfhi(gt.y)));
        *(GAS u32x2*)((bf16_t*)(p.ws + WS_HY) + (size_t)r * DM + 4 * lane) = y;
    }
}

constexpr int PH_FINAL = 1 + 7 * DEPTH, PH_END = PH_FINAL + 1;
struct Args { Ptrs p; int ph_lo, ph_hi; };
__global__ void __launch_bounds__(NWAVES * 64, 2) mega(Args args) {
    extern __shared__ __attribute__((aligned(16))) unsigned char lds[];
    Frame F;
    F.lds = (LAS unsigned char*)lds; F.MISC = (volatile LAS unsigned*)(F.lds + MISC_OFF);
    F.tid = threadIdx.x; F.lane = F.tid & 63; F.wave = __builtin_amdgcn_readfirstlane(F.tid >> 6);
    F.G = gridDim.x; { const int bx = blockIdx.x; F.vcu = (F.G % 8 == 0) ? (bx % 8) * (F.G / 8) + bx / 8 : bx; }
    F.p = args.p; F.ctl = (gu32*)(args.p.ws + WS_CTL);
    for (int u = F.tid; u < (LDS_BYTES - LDSCTL_OFF) / 4; u += NWAVES * 64) ((LAS unsigned*)(F.lds + LDSCTL_OFF))[u] = 0u;
    __syncthreads();
    const bool multi = args.ph_hi - args.ph_lo > 1;
    XcdBarrier bar; bar.bar = (unsigned*)(F.ctl + CW_BAR); bar.x = 0; bar.st = nullptr;
    if (multi) bar = xcd_barrier_post((unsigned*)(F.ctl + CW_BAR), F.MISC + 8);
    for (int ph = args.ph_lo; ph < args.ph_hi; ++ph) {
        F.refresh();
        if (ph == 0) phase_pre(F);
        else if (ph == PH_FINAL) phase_final(F);
        else { const int l = (ph - 1) / 7, s = (ph - 1) % 7;
            if (s == 0) phase_norm(F, l);
            else if (s == 1) phase_gemm1(F, l);
            else if (s == 2) phase_mix(F, l);
            else if (s == 3) phase_prep(F, l);
            else if (s == 4) phase_scan(F, l);
            else if (s == 5) phase_comb(F, l);
            else if (s == 6) phase_gemm2(F, l);
        }
        if (ph + 1 < args.ph_hi) xcd_barrier(bar);
    }
}

extern "C" void kernel_launch(void* const* d_in, const int* in_sizes, int n_in, void* d_out, int out_size, void* d_ws, size_t ws_size, hipStream_t stream) {
    static int grid = 0;
    if (grid == 0) {
        if (n_in != 23 || out_size != MLAT * DM || ws_size < WS_END) { fprintf(stderr, "kernel_launch: unexpected shapes (n_in %d out %d ws %zu)\n", n_in, out_size, ws_size); grid = -1; return; }
        int dev = 0, cus = 0;
        if (hipGetDevice(&dev) != hipSuccess || hipDeviceGetAttribute(&cus, hipDeviceAttributeMultiprocessorCount, dev) != hipSuccess) { grid = -1; return; }
        if (hipFuncSetAttribute((const void*)mega, hipFuncAttributeMaxDynamicSharedMemorySize, LDS_BYTES) != hipSuccess) { fprintf(stderr, "kernel_launch: hipFuncSetAttribute failed\n"); grid = -1; return; }
        grid = cus;
        if (grid != 256) fprintf(stderr, "kernel_launch: %d CUs (built for 256)\n", grid);
    }
    if (grid < 0) return;
    hipMemsetAsync((char*)d_ws + WS_CTL, 0, CTL_ZERO_BYTES, stream);
    Args a{};
    const float** f = (const float**)&a.p;
    for (int i = 0; i < 23; ++i) f[i] = (const float*)d_in[i];
    a.p.out = (float*)d_out; a.p.ws = (unsigned char*)d_ws;
    a.ph_lo = 0; a.ph_hi = PH_END;
    hipLaunchKernelGGL(mega, dim3(grid), dim3(NWAVES * 64), LDS_BYTES, stream, a);
}
```

```cpp
#include <hip/hip_runtime.h>
#include <cstdio>
#include <cstdint>

typedef unsigned short bf16_t;
__device__ __forceinline__ float bf2f(bf16_t v) { return __uint_as_float(((unsigned)v) << 16); }
typedef __bf16 nbf16x2 __attribute__((ext_vector_type(2)));
typedef __bf16 nbf16x8 __attribute__((ext_vector_type(8)));
typedef float nf32x2 __attribute__((ext_vector_type(2)));
typedef float nf32x8 __attribute__((ext_vector_type(8)));
__device__ __forceinline__ bf16_t f2bf(float f) { return __builtin_bit_cast(bf16_t, (__bf16)f); }

constexpr int DM = 1024, NB = 16, SEQ = 2048, DEPTH = 4, CTXL = 256, HD = 64, BW = 256, HA = 4;
constexpr int INC = 3600, NPC = 3584, NTILE = 14;
constexpr int MLAT = NB * SEQ, MCTX = NB * CTXL, MTOT = MLAT + MCTX;
constexpr float EPS = 1e-6f;
__device__ __constant__ int c_tile_col[NTILE] = {0, 256, 512, 2576, 784, 1040, 1296, 1552, 1808, 2064, 2320, 2832, 3088, 3344};
enum { T_Q = 0, T_K = 1, T_V = 2, T_GA = 3, T_BG = 4, T_CG = 5, T_XI = 6, T_GLA = 7, T_GLB = 8, T_U = 9, T_VV = 10, T_GB = 11, T_GC = 12, T_GD = 13 };

constexpr size_t MiB = 1u << 20;
constexpr size_t WS_CTL = 0, WS_MOD = 1 * MiB, WS_AB = 2 * MiB, WS_GB = 5 * MiB, WS_STAT = 8 * MiB, WS_XC = 16 * MiB, WS_WIN = 32 * MiB, WS_WOUT = 60 * MiB,
                 WS_HY = 68 * MiB, WS_P = 140 * MiB, WS_OFB = 392 * MiB, WS_END = 512 * MiB;
constexpr size_t PTILE_ELEMS = (size_t)MTOT * 256;
constexpr size_t WS_QKV = WS_P + 4 * PTILE_ELEMS * 2;

struct Ptrs {
    const float *x, *c, *ctx, *c_ctx, *norm_g, *w_ada, *b_ada, *w_in, *qkv_conv_w, *a_log, *dt_bias, *gdn_norm_g, *short_conv_w, *conf_conv_w, *conf_conv_b,
        *conf_ln_g, *conf_ln_b, *smlp_ln_g, *smlp_ln_b, *smlp_w, *smlp_b, *w_out, *final_g;
    float* out; unsigned char* ws;
};

__device__ __forceinline__ float silu_f(float x) { return x / (1.f + expf(-x)); }
__device__ __forceinline__ float sigmoid_f(float x) { return 1.f / (1.f + expf(-x)); }
__device__ __forceinline__ float softplus_f(float x) { return x > 20.f ? x : log1pf(expf(x)); }

__device__ __forceinline__ float block_sum256(float v, float* red) {
#pragma unroll
    for (int o = 32; o > 0; o >>= 1) v += __shfl_xor(v, o);
    __syncthreads();
    if ((threadIdx.x & 63) == 0) red[threadIdx.x >> 6] = v;
    __syncthreads();
    return red[0] + red[1] + red[2] + red[3];
}
template <int CTRL> __device__ __forceinline__ float dpp_f(float v) { return __int_as_float(__builtin_amdgcn_mov_dpp(__float_as_int(v), CTRL, 0xF, 0xF, true)); }
__device__ __forceinline__ float row16_sum(float v) {
    v += dpp_f<0xB1>(v); v += dpp_f<0x4E>(v); v += dpp_f<0x141>(v); v += dpp_f<0x140>(v); return v; }
__device__ __forceinline__ float wave_sum(float v) {
    v = row16_sum(v);
    { auto r = __builtin_amdgcn_permlane16_swap(__float_as_uint(v), __float_as_uint(v), false, false); v = __uint_as_float(r[0]) + __uint_as_float(r[1]); }
    { auto r = __builtin_amdgcn_permlane32_swap(__float_as_uint(v), __float_as_uint(v), false, false); v = __uint_as_float(r[0]) + __uint_as_float(r[1]); }
    return v; }

__device__ __forceinline__ void row_seq(int row, int& start, int& len) { if (row < MLAT) { start = row & ~(SEQ - 1); len = SEQ; } else { start = row & ~(CTXL - 1); len = CTXL; } }

namespace pg8 {
#define PG8_LAS __attribute__((address_space(3)))
typedef unsigned short bf16_t;
typedef short bf16x8 __attribute__((ext_vector_type(8)));
typedef float f32x4 __attribute__((ext_vector_type(4)));
typedef unsigned u32x4 __attribute__((ext_vector_type(4)));
constexpr int BM = 256, BK = 64, HALF = 128, HTB = HALF * BK * 2  , STAGE_BYTES = 8 * HTB, NXCD = 8, WGM = 8;

__host__ __device__ __forceinline__ int lds_byte(int r, int c) { const int st = (r >> 4) * 2 + (c >> 5), rr = r & 15, cc = c & 31, ob = rr * 64 + cc * 2; return st * 1024 + (ob ^ (((ob >> 9) & 1) << 5)); }
__host__ __device__ __forceinline__ void stage_rc(int b, int& R, int& C) { const int st = b / 1024, sb = b % 1024, swz = sb ^ (((sb >> 9) & 1) << 5); R = (st >> 1) * 16 + swz / 64; C = (st & 1) * 32 + (swz % 64) / 2; }
__host__ __device__ __forceinline__ int perm32(int rho) { const int n = rho >> 4, i = rho & 15; return 8 * (i >> 2) + 4 * n + (i & 3); }

struct Unit { int pm, pn; };
struct Gemm { const bf16_t* A; const bf16_t* Bt; int M, N, K; };

struct StaticOrder {
    int nM, nN, nwg, G, c;
    __host__ __device__ void init(int M, int N, int G_, int c_) { nM = M / BM; nN = N / BM; nwg = nM * nN; G = G_; c = c_; }
    __host__ __device__ bool next(int i, Unit& u) const {
        const long L = (long)i * G + c; if (L >= nwg) return false;
        int wgid = (int)L; { const int q = nwg / NXCD, r = nwg % NXCD, xcd = wgid % NXCD, off = wgid / NXCD; wgid = (xcd < r ? xcd * (q + 1) : r * (q + 1) + (xcd - r) * q) + off; }
        const int nig = WGM * nN, gid = wgid / nig, fm = gid * WGM, gsz = (nM - fm) < WGM ? (nM - fm) : WGM;
        u.pm = fm + ((wgid % nig) % gsz); u.pn = (wgid % nig) / gsz; return true;
    }
    __device__ __forceinline__ void a_ready(const Unit&) const {}
    __device__ __forceinline__ void done(const Unit&) const {}
};


__device__ __forceinline__ unsigned cvt_pk_bf16(float lo, float hi) { return __builtin_bit_cast(unsigned, __builtin_convertvector((nf32x2){lo, hi}, nbf16x2)); }
struct EpiP {
    static constexpr bool PERM = true, AFTER_DRAIN = false;
    bf16_t* P; size_t tile_elems;
    __device__ __forceinline__ void operator()(const f32x4 (&acc)[2][2][4][2], const Unit& u, int wr, int wc, int fr, int fq) const {
        const int row0 = u.pm * BM + wr * 64 + fr;
        bf16_t* base = P + (size_t)u.pn * tile_elems + wc * 32 + 8 * fq;
#pragma unroll
        for (int ai = 0; ai < 2; ++ai)
#pragma unroll
            for (int m = 0; m < 4; ++m) { bf16_t* rowp = base + (size_t)(row0 + ai * HALF + m * 16) * 256;
#pragma unroll
                for (int bj = 0; bj < 2; ++bj) { const f32x4 v0 = acc[ai][bj][m][0], v1 = acc[ai][bj][m][1];
                    u32x4 w; w.x = cvt_pk_bf16(v0[0], v0[1]); w.y = cvt_pk_bf16(v0[2], v0[3]); w.z = cvt_pk_bf16(v1[0], v1[1]); w.w = cvt_pk_bf16(v1[2], v1[3]);
                    *(u32x4*)(rowp + bj * HALF) = w; } }
    }
};
struct EpiResid {
    static constexpr bool PERM = true, AFTER_DRAIN = false;
    const float* x_old; float* x_new; const float* xc_old; float* xc_new; const float* mod_l; int odd, mlat, seq, dm;
    __device__ __forceinline__ void operator()(const f32x4 (&acc)[2][2][4][2], const Unit& u, int wr, int wc, int fr, int fq) const {
        const int rbase = u.pm * BM; const bool lat = rbase < mlat; const int b = lat ? rbase / seq : 16;
        const int col = u.pn * BM + wc * 32 + 8 * fq;
        const float* gate = mod_l + (size_t)b * 3072 + 2048 + col;
        f32x4 g[2][2];
#pragma unroll
        for (int bj = 0; bj < 2; ++bj)
#pragma unroll
            for (int n = 0; n < 2; ++n) g[bj][n] = *(const f32x4*)(gate + bj * HALF + 4 * n);
#pragma unroll
        for (int ai = 0; ai < 2; ++ai)
#pragma unroll
            for (int m = 0; m < 4; ++m) { const int r = rbase + ai * HALF + wr * 64 + m * 16 + fr;
                const float* oldp; float* newp;
                if (lat) { const int tp = r % seq; const int t = odd ? ((tp & 31) * 64 + (tp >> 5)) : tp; const size_t off = ((size_t)(r / seq) * seq + t) * dm + col; oldp = x_old + off; newp = x_new + off; }
                else { const size_t off = (size_t)(r - mlat) * dm + col; oldp = xc_old + off; newp = xc_new + off; }
#pragma unroll
                for (int bj = 0; bj < 2; ++bj)
#pragma unroll
                    for (int n = 0; n < 2; ++n) { const f32x4 o = *(const f32x4*)(oldp + bj * HALF + 4 * n); *(f32x4*)(newp + bj * HALF + 4 * n) = o + g[bj][n] * acc[ai][bj][m][n]; } }
    }
};

template <class Epi, class Sched, bool ALIGN_EPI = false, bool SP2 = false>
__device__ __forceinline__ void gemm_phase(PG8_LAS unsigned char* lds, const Gemm g, const Sched& S, const Epi& E) {
    int tid_ = threadIdx.x; asm volatile("" : "+v"(tid_));
    const int tid = tid_, wid = __builtin_amdgcn_readfirstlane(tid >> 6), lane = tid & 63, wr = wid >> 2, wc = wid & 3, fr = lane & 15, fq = lane >> 4;
    const int K = g.K, nt = K / BK;
    unsigned voffA[2], voffB[2];
#pragma unroll
    for (int i = 0; i < 2; ++i) { int R, C; stage_rc(tid * 16 + i * 8192, R, C); const int Rb = Epi::PERM ? ((R & ~31) + perm32(R & 31)) : R;
        voffA[i] = (unsigned)(R * K + C) * 2u; voffB[i] = (unsigned)(Rb * K + C) * 2u; }
    const size_t kstep = (size_t)(BK * 2);
    const size_t hstep = (size_t)HALF * K * 2;
    const size_t tstep = 2 * hstep;
    const unsigned ldsw = (unsigned)wid * 1024u;
    const int aoff = lds_byte(wr * 64 + fr, fq * 8), boff = lds_byte(wc * 32 + fr, fq * 8);
#define PG8_SA(b, h) (((b) * 2 + (h)) * HTB)
#define PG8_SB(b, h) ((4 + (b) * 2 + (h)) * HTB)
#define PG8_STAGE(bufoff, gbase, voff) do { _Pragma("unroll") for (int _i = 0; _i < 2; ++_i) \
        __builtin_amdgcn_global_load_lds((const unsigned*)((const char*)(gbase) + (voff)[_i]), (PG8_LAS unsigned*)(lds + (bufoff) + ldsw + _i * 8192), 16, 0, 0); } while (0)
#define PG8_LDA(dst, b, h) do { _Pragma("unroll") for (int m = 0; m < 4; ++m) _Pragma("unroll") for (int k = 0; k < 2; ++k) dst[m][k] = *(const PG8_LAS bf16x8*)(lds + PG8_SA(b, h) + aoff + m * 2048 + k * 1024); } while (0)
#define PG8_LDB(dst, b, h) do { _Pragma("unroll") for (int n = 0; n < 2; ++n) _Pragma("unroll") for (int k = 0; k < 2; ++k) dst[n][k] = *(const PG8_LAS bf16x8*)(lds + PG8_SB(b, h) + boff + n * 2048 + k * 1024); } while (0)
#define PG8_MMA(ai, bj, At, Bt) do { __builtin_amdgcn_s_setprio(1); _Pragma("unroll") for (int m = 0; m < 4; ++m) _Pragma("unroll") for (int n = 0; n < 2; ++n) _Pragma("unroll") for (int k = 0; k < 2; ++k) \
        acc[ai][bj][m][n] = __builtin_amdgcn_mfma_f32_16x16x32_bf16(Bt[n][k], At[m][k], acc[ai][bj][m][n], 0, 0, 0); __builtin_amdgcn_s_setprio(0); } while (0)
#define PG8_WAIT_V(n) asm volatile("s_waitcnt vmcnt(" #n ")" ::: "memory")
#define PG8_WAIT_L(n) asm volatile("s_waitcnt lgkmcnt(" #n ")" ::: "memory")
#define PG8_BAR __builtin_amdgcn_s_barrier()
#define PG8_SCHED __builtin_amdgcn_sched_barrier(0)
    Unit cur, nxt; int ui = 0;
    if (!S.next(0, cur)) return;
    f32x4 acc[2][2][4][2];
#pragma unroll
    for (int a = 0; a < 2; ++a)
#pragma unroll
        for (int b = 0; b < 2; ++b)
#pragma unroll
            for (int m = 0; m < 4; ++m)
#pragma unroll
                for (int n = 0; n < 2; ++n) acc[a][b][m][n] = (f32x4){0.f, 0.f, 0.f, 0.f};
    bf16x8 At[4][2], B0[2][2], B1[2][2];
    const char* cA = (const char*)g.A + (size_t)cur.pm * tstep; const char* cB = (const char*)g.Bt + (size_t)cur.pn * tstep;
    S.a_ready(cur);
    if constexpr (SP2) {
        PG8_STAGE(PG8_SB(0, 0), cB, voffB); PG8_STAGE(PG8_SB(0, 1), cB + hstep, voffB); PG8_STAGE(PG8_SA(0, 0), cA, voffA); PG8_STAGE(PG8_SA(0, 1), cA + hstep, voffA);
        if (wr == 1) PG8_BAR;
        PG8_WAIT_V(2); PG8_BAR;
        PG8_STAGE(PG8_SB(1, 0), cB + kstep, voffB); PG8_STAGE(PG8_SA(1, 0), cA + kstep, voffA); PG8_STAGE(PG8_SB(1, 1), cB + hstep + kstep, voffB);
        PG8_WAIT_V(6); PG8_BAR;
    } else {
        PG8_STAGE(PG8_SB(0, 0), cB, voffB); PG8_STAGE(PG8_SA(0, 0), cA, voffA); PG8_STAGE(PG8_SB(0, 1), cB + hstep, voffB); PG8_STAGE(PG8_SA(0, 1), cA + hstep, voffA);
        if (wr == 1) PG8_BAR;
        PG8_WAIT_V(4); PG8_BAR;
        PG8_STAGE(PG8_SB(1, 0), cB + kstep, voffB); PG8_STAGE(PG8_SA(1, 0), cA + kstep, voffA); PG8_STAGE(PG8_SB(1, 1), cB + hstep + kstep, voffB);
        PG8_WAIT_V(6); PG8_BAR;
    }
    for (;;) {
        const bool has_next = S.next(ui + 1, nxt);
        const char* nA = has_next ? (const char*)g.A + (size_t)nxt.pm * tstep : cA; const char* nB = has_next ? (const char*)g.Bt + (size_t)nxt.pn * tstep : cB;
        for (int t = 0; t < nt; t += 2) {
            const bool last = (t == nt - 2);
            const char* a1 = cA + (size_t)(t + 1) * kstep;
            const char* a2 = last ? nA : cA + (size_t)(t + 2) * kstep; const char* b2 = last ? nB : cB + (size_t)(t + 2) * kstep;
            const char* a3 = a2 + kstep; const char* b3 = b2 + kstep;
            if (last && has_next) S.a_ready(nxt);
            if constexpr (SP2) {
            PG8_LDB(B0, 0, 0); PG8_LDB(B1, 0, 1); PG8_SCHED; PG8_LDA(At, 0, 0); PG8_STAGE(PG8_SA(1, 1), a1 + hstep, voffA);
            PG8_WAIT_V(8); PG8_WAIT_L(0); PG8_BAR; PG8_MMA(0, 0, At, B0); PG8_MMA(0, 1, At, B1); PG8_BAR; PG8_SCHED;
            PG8_LDA(At, 0, 1); PG8_STAGE(PG8_SB(0, 0), b2, voffB); PG8_STAGE(PG8_SB(0, 1), b2 + hstep, voffB); PG8_STAGE(PG8_SA(0, 0), a2, voffA);
            PG8_WAIT_V(8); PG8_WAIT_L(0); PG8_BAR; PG8_MMA(1, 0, At, B0); PG8_MMA(1, 1, At, B1); PG8_BAR; PG8_SCHED;
            PG8_LDB(B0, 1, 0); PG8_LDB(B1, 1, 1); PG8_SCHED; PG8_LDA(At, 1, 0); PG8_STAGE(PG8_SA(0, 1), a2 + hstep, voffA);
            PG8_WAIT_V(8); PG8_WAIT_L(0); PG8_BAR; PG8_MMA(0, 0, At, B0); PG8_MMA(0, 1, At, B1); PG8_BAR; PG8_SCHED;
            PG8_LDA(At, 1, 1); PG8_STAGE(PG8_SB(1, 0), b3, voffB); PG8_STAGE(PG8_SB(1, 1), b3 + hstep, voffB); PG8_STAGE(PG8_SA(1, 0), a3, voffA);
            PG8_WAIT_V(8); PG8_WAIT_L(0); PG8_BAR; PG8_MMA(1, 0, At, B0); PG8_MMA(1, 1, At, B1); PG8_BAR; PG8_SCHED;
            } else {
            PG8_LDB(B0, 0, 0); PG8_SCHED; PG8_LDA(At, 0, 0); PG8_STAGE(PG8_SA(1, 1), a1 + hstep, voffA);
            PG8_WAIT_L(8); PG8_BAR; PG8_WAIT_L(0); PG8_MMA(0, 0, At, B0); PG8_BAR; PG8_SCHED;
            PG8_LDB(B1, 0, 1); PG8_STAGE(PG8_SB(0, 0), b2, voffB);
            PG8_BAR; PG8_WAIT_L(0); PG8_MMA(0, 1, At, B1); PG8_BAR;
            PG8_LDA(At, 0, 1); PG8_STAGE(PG8_SA(0, 0), a2, voffA);
            PG8_BAR; PG8_WAIT_L(0); PG8_MMA(1, 0, At, B0); PG8_BAR; PG8_SCHED;
            PG8_STAGE(PG8_SB(0, 1), b2 + hstep, voffB);
            PG8_WAIT_V(6); PG8_BAR; PG8_MMA(1, 1, At, B1); PG8_BAR;
            PG8_LDB(B0, 1, 0); PG8_SCHED; PG8_LDA(At, 1, 0); PG8_STAGE(PG8_SA(0, 1), a2 + hstep, voffA);
            PG8_WAIT_L(8); PG8_BAR; PG8_WAIT_L(0); PG8_MMA(0, 0, At, B0); PG8_BAR; PG8_SCHED;
            PG8_LDB(B1, 1, 1); PG8_STAGE(PG8_SB(1, 0), b3, voffB);
            PG8_BAR; PG8_WAIT_L(0); PG8_MMA(0, 1, At, B1); PG8_BAR;
            PG8_LDA(At, 1, 1); PG8_STAGE(PG8_SA(1, 0), a3, voffA);
            PG8_BAR; PG8_WAIT_L(0); PG8_MMA(1, 0, At, B0); PG8_BAR; PG8_SCHED;
            PG8_STAGE(PG8_SB(1, 1), b3 + hstep, voffB);
            PG8_WAIT_V(6); PG8_BAR; PG8_MMA(1, 1, At, B1); PG8_BAR;
            }
        }
        if constexpr (ALIGN_EPI) { if (wr == 0) PG8_BAR; }
        if constexpr (!Epi::AFTER_DRAIN) { E(acc, cur, wr, wc, fr, fq); S.done(cur); }
        if (!has_next) break;
#pragma unroll
        for (int a = 0; a < 2; ++a)
#pragma unroll
            for (int b = 0; b < 2; ++b)
#pragma unroll
                for (int m = 0; m < 4; ++m)
#pragma unroll
                    for (int n = 0; n < 2; ++n) acc[a][b][m][n] = (f32x4){0.f, 0.f, 0.f, 0.f};
        cur = nxt; cA = nA; cB = nB; ++ui;
        if constexpr (ALIGN_EPI) { if (wr == 1) PG8_BAR; }
    }
    PG8_WAIT_V(0);
    if constexpr (!ALIGN_EPI) { if (wr == 0) PG8_BAR; }
    PG8_BAR;
    if constexpr (Epi::AFTER_DRAIN) { E.fused(acc, cur, wr, wc, fr, fq, lds, wid, lane); S.done(cur); }
#undef PG8_SA
#undef PG8_SB
#undef PG8_STAGE
#undef PG8_LDA
#undef PG8_LDB
#undef PG8_MMA
#undef PG8_WAIT_V
#undef PG8_WAIT_L
#undef PG8_BAR
#undef PG8_SCHED
}
}

constexpr int NWAVES = 8;
constexpr int RING_BYTES = 159744, LDSCTL_OFF = RING_BYTES, MISC_OFF = LDSCTL_OFF + 320, LDS_BYTES = 163840;
constexpr int CW_BAR = 4096;
constexpr size_t CTL_ZERO_BYTES = 64 * 1024;
#define GAS __attribute__((address_space(1)))
#define LAS __attribute__((address_space(3)))
typedef unsigned v4u __attribute__((ext_vector_type(4)));
typedef float f32x4 __attribute__((ext_vector_type(4)));
typedef GAS unsigned gu32;
#define LDS_WAIT() asm volatile("s_waitcnt lgkmcnt(0)" ::: "memory")
#define VM_WAIT() asm volatile("s_waitcnt vmcnt(0)" ::: "memory")
__device__ __forceinline__ unsigned pk2(float lo, float hi) { return __builtin_bit_cast(unsigned, __builtin_convertvector((nf32x2){lo, hi}, nbf16x2)); }

#define XB_TMO      128
#define XB_XCNT(j)  (256  + 64 * (j))
#define XB_XSUB(j)  (1280 + 64 * (j))
#define XB_XGEN(j)  (2304 + 64 * (j))
#define XB_TOP      3328
#define XB_TOPGEN   3392
#define XCD_BAR_WORDS 3456
#define XB_SPIN_CAP (1u << 22)

__device__ __forceinline__ unsigned xb_ld(unsigned* p)              { return __hip_atomic_load(p, __ATOMIC_RELAXED, __HIP_MEMORY_SCOPE_AGENT); }
__device__ __forceinline__ unsigned xb_add(unsigned* p, unsigned v) { return __hip_atomic_fetch_add(p, v, __ATOMIC_RELAXED, __HIP_MEMORY_SCOPE_AGENT); }
__device__ __forceinline__ unsigned xb_xcc_id() { return (unsigned)__builtin_amdgcn_s_getreg((3 << 11) | 20) & 0xFu; }
#define XB_SPIN(cond, bar) do { unsigned _sp = 0; while (cond) { __builtin_amdgcn_s_sleep(1); \
    if ((++_sp & 255u) == 0u) { if (xb_ld(&(bar)[XB_TMO])) break; if (_sp > XB_SPIN_CAP) { atomicAdd(&(bar)[XB_TMO], 1u); break; } } } } while (0)

struct XcdBarrier {
    unsigned* bar; unsigned x;
    volatile LAS unsigned* st;
};

__device__ __forceinline__ XcdBarrier xcd_barrier_post(unsigned* bar, volatile LAS unsigned* st) {
    XcdBarrier b; b.bar = bar; b.x = xb_xcc_id(); b.st = st;
    if (threadIdx.x == 0) (void)xb_add(&bar[XB_XCNT(b.x)], 1u);
    return b;
}
__device__ __forceinline__ void xcd_barrier_complete(unsigned* bar, unsigned x, unsigned& nloc, unsigned& nx) {
    const unsigned G = gridDim.x * gridDim.y * gridDim.z;
    unsigned sum, cnt, mine, sp = 0u;
    for (;;) {
        sum = 0u; cnt = 0u; mine = 0u;
#pragma unroll
        for (unsigned j = 0; j < 16; ++j) { const unsigned c = xb_ld(&bar[XB_XCNT(j)]); sum += c; cnt += (c > 0u) ? 1u : 0u; mine = (j == x) ? c : mine; }
        if (sum == G) break;
        __builtin_amdgcn_s_sleep(1);
        if ((++sp & 255u) == 0u) { if (xb_ld(&bar[XB_TMO])) break; if (sp > XB_SPIN_CAP) { atomicAdd(&bar[XB_TMO], 1u); break; } }
    }
    nloc = mine > 0u ? mine : 1u; nx = cnt > 0u ? cnt : 1u;
}

__device__ __forceinline__ void xcd_barrier(const XcdBarrier& b) {
    asm volatile("s_waitcnt vmcnt(0)" ::: "memory");
    __syncthreads();
    if (threadIdx.x == 0) {
        unsigned* bar = b.bar;
        __builtin_amdgcn_s_waitcnt(0);
        unsigned nloc = b.st[0], nx = b.st[1];
        if (nloc == 0u) { xcd_barrier_complete(bar, b.x, nloc, nx); b.st[0] = nloc; b.st[1] = nx; }
        const unsigned old = xb_add(&bar[XB_XSUB(b.x)], 1u);
        const unsigned gen = old / nloc;
        if (old + 1u == (gen + 1u) * nloc) {
            __builtin_amdgcn_fence(__ATOMIC_RELEASE, "agent");
            asm volatile("s_waitcnt vmcnt(0)" ::: "memory");
            const unsigned og = xb_add(&bar[XB_TOP], 1u);
            const unsigned tg = og / nx;
            if (og + 1u == (tg + 1u) * nx) xb_add(&bar[XB_TOPGEN], 1u);
            else XB_SPIN(xb_ld(&bar[XB_TOPGEN]) == tg, bar);
            __builtin_amdgcn_fence(__ATOMIC_ACQUIRE, "agent");
            xb_add(&bar[XB_XGEN(b.x)], 1u);
            asm volatile("s_waitcnt vmcnt(0)" ::: "memory");
        } else {
            XB_SPIN(xb_ld(&bar[XB_XGEN(b.x)]) == gen, bar);
            __builtin_amdgcn_fence(__ATOMIC_ACQUIRE, "agent");
            asm volatile("s_waitcnt vmcnt(0)" ::: "memory");
        }
    }
    __syncthreads();
}


struct Frame {
    LAS unsigned char* lds; volatile LAS unsigned* MISC; gu32* ctl;
    int tid, lane, wave, vcu, G;
    Ptrs p;
    __device__ __forceinline__ void refresh() { int t = threadIdx.x; asm volatile("" : "+v"(t)); tid = t; lane = t & 63; wave = __builtin_amdgcn_readfirstlane(t >> 6); }
};

__device__ __forceinline__ void transpose_item(const float* W, int ld, bf16_t* WT, LAS float* scr, int k0, int lane) {
    float tv[32];
#pragma unroll
    for (int i = 0; i < 32; ++i) tv[i] = W[(size_t)(k0 + 2 * i + (lane >> 5)) * ld + (lane & 31)];
#pragma unroll
    for (int i = 0; i < 32; ++i) scr[(2 * i + (lane >> 5)) * 33 + (lane & 31)] = tv[i];
    LDS_WAIT(); asm volatile("" ::: "memory");
    const int c = lane & 7;
#pragma unroll
    for (int j = 0; j < 4; ++j) { const int n = (lane >> 3) + 8 * j; const LAS float* s = scr + (8 * c) * 33 + n;
        v4u o; o.x = pk2(s[0 * 33], s[1 * 33]); o.y = pk2(s[2 * 33], s[3 * 33]); o.z = pk2(s[4 * 33], s[5 * 33]); o.w = pk2(s[6 * 33], s[7 * 33]);
        *(GAS v4u*)(WT + (size_t)n * DM + k0 + 8 * c) = o; }
    LDS_WAIT(); asm volatile("" ::: "memory");
}
__device__ __forceinline__ void convert_weights(Frame& F, int l, int gw, int NGW) {
    const Ptrs& p = F.p;
    LAS float* scr = (LAS float*)(F.lds + F.wave * 16384);
    constexpr int I_IN = 16 * (NPC / 32), I_OUT = 16 * (DM / 32), I_L = I_IN + I_OUT;
    for (int it = gw; it < I_L; it += NGW) { int r = it;
        if (r < I_IN) { const int kb = r / (NPC / 32), nb = r % (NPC / 32), n0 = 32 * nb;
            transpose_item(p.w_in + (size_t)l * DM * INC + c_tile_col[n0 >> 8] + (n0 & 255), INC, (bf16_t*)(p.ws + WS_WIN) + ((size_t)l * NPC + n0) * DM, scr, 64 * kb, F.lane); }
        else { r -= I_IN; const int kb = r / (DM / 32), nb = r % (DM / 32), n0 = 32 * nb;
            transpose_item(p.w_out + (size_t)l * DM * DM + n0, DM, (bf16_t*)(p.ws + WS_WOUT) + ((size_t)l * DM + n0) * DM, scr, 64 * kb, F.lane); }
    }
}
__device__ __forceinline__ void phase_pre(Frame& F) {
    const Ptrs& p = F.p;
    if (F.vcu < DEPTH * 48) {
        const int l = F.vcu / 48, n0 = (F.vcu % 48) * 64;
        LAS float* s = (LAS float*)F.lds;
        LAS float* red = s + 17 * DM;
        for (int i = F.tid; i < 17 * DM; i += NWAVES * 64) { const int b = i >> 10, k = i & 1023; s[i] = silu_f(b < 16 ? p.c[b * DM + k] : p.c_ctx[k]); }
        __syncthreads();
        const int kg = F.tid >> 6, col = F.tid & 63;
        float acc[17];
#pragma unroll
        for (int b = 0; b < 17; ++b) acc[b] = 0.f;
        const float* w = p.w_ada + (size_t)l * DM * 3072 + n0 + col;
        for (int k0 = kg * 128; k0 < kg * 128 + 128; k0 += 16) { float wv[16];
#pragma unroll
            for (int kk = 0; kk < 16; ++kk) wv[kk] = w[(size_t)(k0 + kk) * 3072];
#pragma unroll
            for (int kk = 0; kk < 16; ++kk)
#pragma unroll
                for (int b = 0; b < 17; ++b) acc[b] += s[b * DM + k0 + kk] * wv[kk]; }
#pragma unroll
        for (int b = 0; b < 17; ++b) red[(kg * 17 + b) * 64 + col] = acc[b];
        __syncthreads();
        float* mod = (float*)(p.ws + WS_MOD);
        for (int o = F.tid; o < 17 * 64; o += NWAVES * 64) { const int b = o >> 6, cc = o & 63; float sum = p.b_ada[l * 3072 + n0 + cc];
#pragma unroll
            for (int g = 0; g < 8; ++g) sum += red[(g * 17 + b) * 64 + cc];
            mod[(size_t)(l * 17 + b) * 3072 + n0 + cc] = sum; }
        __syncthreads();
    }
    convert_weights(F, 0, F.vcu * NWAVES + F.wave, F.G * NWAVES);
    { bf16_t* wsb = (bf16_t*)(p.ws + (9u << 20));
      for (int i = F.vcu * NWAVES * 64 + F.tid; i < DEPTH * 4 * 128 * 128 / 4; i += F.G * NWAVES * 64) { const f32x4 v = *(const f32x4*)(p.smlp_w + 4 * (size_t)i);
          unsigned long long o = (unsigned long long)pk2(v.x, v.y) | ((unsigned long long)pk2(v.z, v.w) << 32); *(GAS unsigned long long*)(wsb + 4 * (size_t)i) = o; } }
}

__device__ __forceinline__ void phase_norm(Frame& F, int l) {
    const Ptrs& p = F.p;
    LAS float* wab = (LAS float*)F.lds;
    for (int i = F.tid; i < 16 * DM; i += NWAVES * 64) { const int k = i >> 4, j = i & 15; wab[j * DM + k] = p.w_in[(size_t)l * DM * INC + (size_t)k * INC + 768 + j]; }
    __syncthreads();
    const int gw = F.vcu * NWAVES + F.wave, lane = F.lane;
    constexpr int RPW = MTOT / (256 * NWAVES);
    int curb = -1; f32x4 gs[4], sh[4];
    const int rbeg = gw * RPW, rend = (gw + 1) * RPW < MTOT ? (gw + 1) * RPW : MTOT;
    f32x4 vn[2][4]; int bn[2] = {0, 0};
#define NORM_SRC(r_, b_, src_) do { if ((r_) < MLAT) { b_ = (r_) >> 11; const int tp_ = (r_) & 2047; const int t_ = (l & 1) ? ((tp_ & 31) * 64 + (tp_ >> 5)) : tp_; src_ = (l == 0 ? p.x : p.out) + ((size_t)b_ * SEQ + t_) * DM; } \
        else { b_ = 16; src_ = (l == 0 ? p.ctx : (const float*)(p.ws + WS_XC)) + (size_t)((r_) - MLAT) * DM; } } while (0)
#define NORM_LOAD(r_, slot_) do { if ((r_) < rend) { const float* src_; NORM_SRC(r_, bn[slot_], src_); const GAS f32x4* xr_ = (const GAS f32x4*)src_ + lane; \
        _Pragma("unroll") for (int j = 0; j < 4; ++j) vn[slot_][j] = xr_[64 * j]; } } while (0)
    NORM_LOAD(rbeg, 0); NORM_LOAD(rbeg + 1, 1);
    for (int r0 = rbeg; r0 < rend; r0 += 2) {
#pragma unroll
      for (int u = 0; u < 2; ++u) { const int r = r0 + u; if (r < rend) {
        const int b = bn[u]; f32x4 v[4]; float ss = 0.f;
#pragma unroll
        for (int j = 0; j < 4; ++j) v[j] = vn[u][j];
        NORM_LOAD(r + 2, u);
        if (b != curb) { curb = b; const float* mod = (const float*)(p.ws + WS_MOD) + (size_t)(l * 17 + b) * 3072;
#pragma unroll
            for (int j = 0; j < 4; ++j) { const f32x4 g = *(const f32x4*)(p.norm_g + l * DM + 256 * j + 4 * lane), sc = *(const f32x4*)(mod + 1024 + 256 * j + 4 * lane);
                gs[j] = g * (sc + 1.0f); sh[j] = *(const f32x4*)(mod + 256 * j + 4 * lane); } }
#pragma unroll
        for (int j = 0; j < 4; ++j) { ss += (v[j].x * v[j].x + v[j].y * v[j].y) + (v[j].z * v[j].z + v[j].w * v[j].w); }
        ss = wave_sum(ss);
        const float rstd = 1.0f / sqrtf(ss * (1.0f / DM) + EPS);
        GAS unsigned long long* o8 = (GAS unsigned long long*)((bf16_t*)(p.ws + WS_HY) + (size_t)r * DM) + lane;
#pragma unroll
        for (int j = 0; j < 4; ++j) { v[j] = v[j] * rstd * gs[j] + sh[j]; o8[64 * j] = (unsigned long long)pk2(v[j].x, v[j].y) | ((unsigned long long)pk2(v[j].z, v[j].w) << 32); }
        float acc[16];
#pragma unroll
        for (int n = 0; n < 16; ++n) { float a = 0.f;
#pragma unroll
            for (int j = 0; j < 4; ++j) { const f32x4 w4 = *(const LAS f32x4*)(wab + n * DM + 256 * j + 4 * lane); a += (v[j].x * w4.x + v[j].y * w4.y) + (v[j].z * w4.z + v[j].w * w4.w); }
            acc[n] = a; if ((n & 3) == 3) asm volatile("" ::: "memory"); }
        float r8[8], r4[4], r2[2], r1;
#pragma unroll
        for (int i = 0; i < 8; ++i) { auto q = __builtin_amdgcn_permlane32_swap(__float_as_uint(acc[i]), __float_as_uint(acc[i + 8]), false, false); r8[i] = __uint_as_float(q[0]) + __uint_as_float(q[1]); }
#pragma unroll
        for (int i = 0; i < 4; ++i) { auto q = __builtin_amdgcn_permlane16_swap(__float_as_uint(r8[i]), __float_as_uint(r8[i + 4]), false, false); r4[i] = __uint_as_float(q[0]) + __uint_as_float(q[1]); }
        { const bool up = lane & 8;
#pragma unroll
          for (int i = 0; i < 2; ++i) { const float keep = up ? r4[i + 2] : r4[i], send = up ? r4[i] : r4[i + 2]; r2[i] = keep + dpp_f<0x128>(send); } }
        { const bool up = lane & 4; const float keep = up ? r2[1] : r2[0], send = up ? r2[0] : r2[1]; r1 = keep + __shfl_xor(send, 4); }
        r1 += dpp_f<0x4E>(r1); r1 += dpp_f<0xB1>(r1);
        if ((lane & 3) == 0) ((float*)(p.ws + WS_AB))[(size_t)r * 16 + (lane >> 2)] = r1;
      } }
    }
    __syncthreads();
}

__device__ __forceinline__ void phase_final(Frame& F) {
    const Ptrs& p = F.p; const int lane = F.lane;
    const int gw = F.vcu * NWAVES + F.wave, NGW = F.G * NWAVES;
    f32x4 g[4];
#pragma unroll
    for (int j = 0; j < 4; ++j) g[j] = *(const f32x4*)(p.final_g + 256 * j + 4 * lane);
    f32x4 vn[4];
    if (gw < MLAT) { const GAS f32x4* xr = (const GAS f32x4*)(p.out + (size_t)gw * DM) + lane;
#pragma unroll
        for (int j = 0; j < 4; ++j) vn[j] = xr[64 * j]; }
    for (int r = gw; r < MLAT; r += NGW) {
        GAS f32x4* xr = (GAS f32x4*)(p.out + (size_t)r * DM) + lane;
        f32x4 v[4]; float ss = 0.f;
#pragma unroll
        for (int j = 0; j < 4; ++j) { v[j] = vn[j]; ss += (v[j].x * v[j].x + v[j].y * v[j].y) + (v[j].z * v[j].z + v[j].w * v[j].w); }
        if (r + NGW < MLAT) { const GAS f32x4* xn = (const GAS f32x4*)(p.out + (size_t)(r + NGW) * DM) + lane;
#pragma unroll
            for (int j = 0; j < 4; ++j) vn[j] = xn[64 * j]; }
        ss = wave_sum(ss);
        const float rstd = 1.0f / sqrtf(ss * (1.0f / DM) + EPS);
#pragma unroll
        for (int j = 0; j < 4; ++j) xr[64 * j] = v[j] * rstd * g[j];
    }
}

__device__ __forceinline__ void phase_gemm1(Frame& F, int l) {
    const Ptrs& p = F.p;
    pg8::Gemm g{(const bf16_t*)(p.ws + WS_HY), (const bf16_t*)(p.ws + WS_WIN) + (size_t)l * NPC * DM, MTOT, NPC, DM};
    pg8::StaticOrder S; S.init(MTOT, NPC, F.G, (int)blockIdx.x);
    pg8::EpiP E{(bf16_t*)(p.ws + WS_P), PTILE_ELEMS};
    pg8::gemm_phase<pg8::EpiP, pg8::StaticOrder, true, true>(F.lds, g, S, E);
}
__device__ __forceinline__ void phase_gemm2(Frame& F, int l) {
    const Ptrs& p = F.p;
    const int M = (l == DEPTH - 1) ? MLAT : MTOT;
    pg8::Gemm g{(const bf16_t*)(p.ws + WS_HY), (const bf16_t*)(p.ws + WS_WOUT) + (size_t)l * DM * DM, M, DM, DM};
    pg8::StaticOrder S; S.init(M, DM, F.G, (int)blockIdx.x);
    pg8::EpiResid E{l == 0 ? p.x : p.out, p.out, l == 0 ? p.ctx : (const float*)(p.ws + WS_XC), (float*)(p.ws + WS_XC), (const float*)(p.ws + WS_MOD) + (size_t)l * 17 * 3072, l & 1, MLAT, SEQ, DM};
    pg8::gemm_phase<pg8::EpiResid, pg8::StaticOrder, true, true>(F.lds, g, S, E);
}


typedef short bf16x8 __attribute__((ext_vector_type(8)));
typedef short s16x4 __attribute__((ext_vector_type(4)));
typedef unsigned u32x2 __attribute__((ext_vector_type(2)));
__device__ __forceinline__ float fexp(float x) { return __builtin_amdgcn_exp2f(x * 1.44269504089f); }
__device__ __forceinline__ float fsigmoid(float x) { return __builtin_amdgcn_rcpf(1.f + fexp(-x)); }
__device__ __forceinline__ float fsilu(float x) { return x * fsigmoid(x); }
__device__ __forceinline__ float bflo(unsigned w) { return __uint_as_float(w << 16); }
__device__ __forceinline__ float bfhi(unsigned w) { return __uint_as_float(w & 0xffff0000u); }
__device__ __forceinline__ void unpack8(const v4u& w, float (&f)[8]) { f[0] = bflo(w.x); f[1] = bfhi(w.x); f[2] = bflo(w.y); f[3] = bfhi(w.y); f[4] = bflo(w.z); f[5] = bfhi(w.z); f[6] = bflo(w.w); f[7] = bfhi(w.w); }
__device__ __forceinline__ const bf16_t* ptile_d(const Ptrs& p, int t) { return (const bf16_t*)(p.ws + WS_P) + (size_t)t * PTILE_ELEMS; }
constexpr size_t WS_WSB = 9 * MiB;

__device__ __forceinline__ void mix_unit_B(Frame& F, int l, int row0) {
    const Ptrs& p = F.p; const int oct = F.tid & 31, tg = F.tid >> 5;
    int start, len; row_seq(row0, start, len);
    const bf16_t *CG = ptile_d(p, T_CG), *XI = ptile_d(p, T_XI), *BG = ptile_d(p, T_BG), *GB = ptile_d(p, T_GB);
    float w[3][8];
#pragma unroll
    for (int j = 0; j < 3; ++j) { const f32x4 a = *(const f32x4*)(p.short_conv_w + (size_t)(l * 3 + j) * BW + 8 * oct), b = *(const f32x4*)(p.short_conv_w + (size_t)(l * 3 + j) * BW + 8 * oct + 4);
        w[j][0] = a.x; w[j][1] = a.y; w[j][2] = a.z; w[j][3] = a.w; w[j][4] = b.x; w[j][5] = b.y; w[j][6] = b.z; w[j][7] = b.w; }
    const int r0 = row0 + tg * 8;
    float cx[10][8];
    { v4u ca[10], xa[10];
#pragma unroll
      for (int i = 0; i < 10; ++i) { int r = r0 + i - 1; r = r < start ? start : (r >= start + len ? start + len - 1 : r); ca[i] = *(const GAS v4u*)(CG + (size_t)r * 256 + 8 * oct); xa[i] = *(const GAS v4u*)(XI + (size_t)r * 256 + 8 * oct); }
#pragma unroll
      for (int i = 0; i < 10; ++i) { float fa[8], fb[8]; unpack8(ca[i], fa); unpack8(xa[i], fb);
#pragma unroll
          for (int e = 0; e < 8; ++e) cx[i][e] = fa[e] * fb[e]; }
      const bool lo_ok = r0 - 1 >= start, hi_ok = r0 + 8 < start + len;
#pragma unroll
      for (int e = 0; e < 8; ++e) { cx[0][e] = lo_ok ? cx[0][e] : 0.f; cx[9][e] = hi_ok ? cx[9][e] : 0.f; } }
#pragma unroll
    for (int i = 0; i < 8; ++i) { const int r = r0 + i;
        const v4u bgw = *(const GAS v4u*)(BG + (size_t)r * 256 + 8 * oct), gw = *(const GAS v4u*)(GB + (size_t)r * 256 + 8 * oct); float bg[8], gt[8], y[8]; unpack8(bgw, bg); unpack8(gw, gt);
#pragma unroll
        for (int e = 0; e < 8; ++e) y[e] = bg[e] * (w[0][e] * cx[i][e] + w[1][e] * cx[i + 1][e] + w[2][e] * cx[i + 2][e]) * fsilu(gt[e]);
        v4u o; o.x = pk2(y[0], y[1]); o.y = pk2(y[2], y[3]); o.z = pk2(y[4], y[5]); o.w = pk2(y[6], y[7]);
        *(GAS v4u*)((bf16_t*)(p.ws + WS_HY) + (size_t)r * DM + 256 + 8 * oct) = o; }
}

__device__ __forceinline__ void mix_unit_C(Frame& F, int l, int row0) {
    const Ptrs& p = F.p; const int tid = F.tid, lane = F.lane, wave = F.wave;
    int start, len; row_seq(row0, start, len);
    const bf16_t *GA = ptile_d(p, T_GLA), *GLB = ptile_d(p, T_GLB), *GC = ptile_d(p, T_GC);
    LAS float* glu = (LAS float*)F.lds;
    { v4u la[6], lb[6];
#pragma unroll
      for (int k = 0; k < 6; ++k) { const int idx = tid + k * NWAVES * 64, i = idx >> 5, oct = idx & 31; int r = row0 - 15 + i; r = r < start ? start : (r >= start + len ? start + len - 1 : r);
          la[k] = *(const GAS v4u*)(GA + (size_t)r * 256 + 8 * oct); lb[k] = *(const GAS v4u*)(GLB + (size_t)r * 256 + 8 * oct); }
#pragma unroll
      for (int k = 0; k < 6; ++k) { const int idx = tid + k * NWAVES * 64, i = idx >> 5, oct = idx & 31, r = row0 - 15 + i;
          if (i < 94) { const bool ok = r >= start && r < start + len; float fa[8], fb[8]; unpack8(la[k], fa); unpack8(lb[k], fb);
              const f32x4 o0 = {ok ? fa[0] * fsigmoid(fb[0]) : 0.f, ok ? fa[1] * fsigmoid(fb[1]) : 0.f, ok ? fa[2] * fsigmoid(fb[2]) : 0.f, ok ? fa[3] * fsigmoid(fb[3]) : 0.f};
              const f32x4 o1 = {ok ? fa[4] * fsigmoid(fb[4]) : 0.f, ok ? fa[5] * fsigmoid(fb[5]) : 0.f, ok ? fa[6] * fsigmoid(fb[6]) : 0.f, ok ? fa[7] * fsigmoid(fb[7]) : 0.f};
              *(LAS f32x4*)(glu + i * 256 + 8 * oct) = o0; *(LAS f32x4*)(glu + i * 256 + 8 * oct + 4) = o1; } } }
    __syncthreads();
    const int c = tid & 255, th = tid >> 8;
    float z[32];
    { float win[62];
#pragma unroll
      for (int i = 0; i < 62; ++i) win[i] = glu[(th * 32 + i) * 256 + c];
      const float bias = p.conf_conv_b[l * BW + c];
#pragma unroll
      for (int i = 0; i < 32; ++i) z[i] = bias;
#pragma unroll
      for (int j = 0; j < 31; ++j) { const float wj = p.conf_conv_w[(size_t)(l * 31 + j) * BW + c];
#pragma unroll
          for (int i = 0; i < 32; ++i) z[i] += wj * win[i + j]; } }
    __syncthreads();
#pragma unroll
    for (int i = 0; i < 32; ++i) glu[(th * 32 + i) * 256 + c] = z[i];
    __syncthreads();
    const f32x4 lg = *(const f32x4*)(p.conf_ln_g + l * BW + 4 * lane), lb = *(const f32x4*)(p.conf_ln_b + l * BW + 4 * lane);
#pragma unroll 2
    for (int i = 0; i < 8; ++i) { const int t = wave * 8 + i, r = row0 + t;
        const f32x4 zz = *(const LAS f32x4*)(glu + t * 256 + 4 * lane);
        const float mean = wave_sum((zz.x + zz.y) + (zz.z + zz.w)) * (1.f / 256.f);
        const f32x4 d = zz - mean;
        const float var = wave_sum((d.x * d.x + d.y * d.y) + (d.z * d.z + d.w * d.w)) * (1.f / 256.f);
        const float rstd = 1.0f / sqrtf(var + EPS);
        const f32x4 ln = d * rstd * lg + lb;
        const u32x2 gw = *(const GAS u32x2*)(GC + (size_t)r * 256 + 4 * lane);
        u32x2 o; o.x = pk2(fsilu(ln.x) * fsilu(bflo(gw.x)), fsilu(ln.y) * fsilu(bfhi(gw.x))); o.y = pk2(fsilu(ln.z) * fsilu(bflo(gw.y)), fsilu(ln.w) * fsilu(bfhi(gw.y)));
        *(GAS u32x2*)((bf16_t*)(p.ws + WS_HY) + (size_t)r * DM + 512 + 4 * lane) = o; }
    __syncthreads();
}

__device__ __forceinline__ void mix_unit_D(Frame& F, int l, int row0) {
    const Ptrs& p = F.p; const int lane = F.lane, wave = F.wave;
    constexpr int VS = 528;
    LAS unsigned char* vl = F.lds;
    const bf16_t *VV = ptile_d(p, T_VV), *U = ptile_d(p, T_U), *GD = ptile_d(p, T_GD);
    { const f32x4 lg = *(const f32x4*)(p.smlp_ln_g + l * BW + 4 * lane), lb = *(const f32x4*)(p.smlp_ln_b + l * BW + 4 * lane);
      u32x2 rawv[16];
#pragma unroll
      for (int i = 0; i < 16; ++i) rawv[i] = *(const GAS u32x2*)(VV + (size_t)(row0 + wave * 16 + i) * 256 + 4 * lane);
#pragma unroll
      for (int i = 0; i < 16; ++i) { const int q = wave * 16 + i; const u32x2 raw = rawv[i];
        const f32x4 v = {bflo(raw.x), bfhi(raw.x), bflo(raw.y), bfhi(raw.y)};
        const float mean = wave_sum((v.x + v.y) + (v.z + v.w)) * (1.f / 256.f);
        const f32x4 d = v - mean;
        const float var = wave_sum((d.x * d.x + d.y * d.y) + (d.z * d.z + d.w * d.w)) * (1.f / 256.f);
        const float rstd = 1.0f / sqrtf(var + EPS);
        const f32x4 y = d * rstd * lg + lb;
        u32x2 o; o.x = pk2(y.x, y.y); o.y = pk2(y.z, y.w);
        *(LAS u32x2*)(vl + q * VS + 8 * lane) = o; } }
    __syncthreads();
    const int g = wave >> 1, ph = wave & 1, li = lane & 15, lg4 = lane >> 4;
    f32x4 acc[4][4];
#pragma unroll
    for (int a = 0; a < 4; ++a)
#pragma unroll
        for (int b = 0; b < 4; ++b) acc[a][b] = (f32x4){0.f, 0.f, 0.f, 0.f};
    const bf16_t* W = (const bf16_t*)(p.ws + WS_WSB) + (size_t)(l * 4 + g) * 128 * 128;
#pragma unroll
    for (int ks = 0; ks < 4; ++ks) {
        bf16x8 af[4], bfr[4];
#pragma unroll
        for (int ct = 0; ct < 4; ++ct) { LAS unsigned char* a = vl + (32 * ks + 8 * lg4 + (li >> 2)) * VS + (64 * g + 16 * ct + 4 * (li & 3)) * 2;
            const s16x4 lo = __builtin_amdgcn_ds_read_tr16_b64_v4i16((LAS s16x4*)a), hi = __builtin_amdgcn_ds_read_tr16_b64_v4i16((LAS s16x4*)(a + 4 * VS));
            af[ct] = (bf16x8){lo[0], lo[1], lo[2], lo[3], hi[0], hi[1], hi[2], hi[3]}; }
#pragma unroll
        for (int pt = 0; pt < 4; ++pt) bfr[pt] = *(const GAS bf16x8*)(W + (size_t)(64 * ph + 16 * pt + li) * 128 + 32 * ks + 8 * lg4);
#pragma unroll
        for (int ct = 0; ct < 4; ++ct)
#pragma unroll
            for (int pt = 0; pt < 4; ++pt) acc[ct][pt] = __builtin_amdgcn_mfma_f32_16x16x32_bf16(af[ct], bfr[pt], acc[ct][pt], 0, 0, 0);
    }
#pragma unroll
    for (int pt = 0; pt < 4; ++pt) { const int prow = 64 * ph + 16 * pt + li, r = row0 + prow; const float bs = p.smlp_b[(l * 4 + g) * 128 + prow];
#pragma unroll
        for (int ct = 0; ct < 4; ++ct) { const int c = 64 * g + 16 * ct + 4 * lg4;
            const u32x2 uw = *(const GAS u32x2*)(U + (size_t)r * 256 + c), gw = *(const GAS u32x2*)(GD + (size_t)r * 256 + c);
            const f32x4 m = acc[ct][pt] + bs;
            u32x2 o; o.x = pk2(bflo(uw.x) * m.x * fsilu(bflo(gw.x)), bfhi(uw.x) * m.y * fsilu(bfhi(gw.x))); o.y = pk2(bflo(uw.y) * m.z * fsilu(bflo(gw.y)), bfhi(uw.y) * m.w * fsilu(bfhi(gw.y)));
            *(GAS u32x2*)((bf16_t*)(p.ws + WS_HY) + (size_t)r * DM + 768 + c) = o; } }
    __syncthreads();
}

__device__ __forceinline__ void phase_mix(Frame& F, int l) {
    constexpr int NC = MTOT / 64, ND = MTOT / 128, NBU = MTOT / 128;
    for (int u = F.vcu; u < NC + ND + NBU; u += F.G) {
        F.refresh();
        if (u < NC) mix_unit_C(F, l, u * 64);
        else if (u < NC + ND) mix_unit_D(F, l, (u - NC) * 128);
        else mix_unit_B(F, l, (u - NC - ND) * 128);
    }
}


constexpr size_t WS_REC = 212 * MiB, WS_OB16 = 476 * MiB;
constexpr int REC_BYTES = 53248, R_NW = 0, R_Q = 8192, R_U = 16384, R_VEC = 32768, R_ATTN = 33792, R_KT = 41984;
constexpr int NITEM = 2304;
constexpr int L_Q = 0, L_K = 4352, L_V = 8704, L_GKK = 13056, L_GQK = 17408, L_QB = 21760, L_KB = 24064, L_AO = 21760, L_AD = 26368, L_DF = 28928, L_SM = 30208, L_XS = 0, GS = 68, SMD = 256;

__device__ __forceinline__ float dpp_xor1(float v) { return __int_as_float(__builtin_amdgcn_mov_dpp(__float_as_int(v), 0xB1, 0xF, 0xF, true)); }
__device__ __forceinline__ bf16x8 pack8(const f32x4& a, const f32x4& b) {
    return __builtin_bit_cast(bf16x8, __builtin_convertvector((nf32x8){a.x, a.y, a.z, a.w, b.x, b.y, b.z, b.w}, nbf16x8)); }

__device__ __forceinline__ void prep_decode(int item, int& b, int& h, int& row0) {
    if (item < 2048) { b = item >> 7; h = (item >> 5) & 3; const int n = item & 31; row0 = b * SEQ + 64 * n; }
    else { const int it = item - 2048; b = it >> 4; h = (it >> 2) & 3; const int n = it & 3; row0 = MLAT + b * CTXL + 64 * n; }
}
__device__ __forceinline__ void prep_load(Frame& F, int l, int item, v4u (&raw)[6], float (&abn)[2]) {
    const Ptrs& p = F.p; int b, h, row0; prep_decode(item, b, h, row0); int start, len; row_seq(row0, start, len);
    const int tq = F.tid < 384 ? F.tid : 383, tg = tq / 24, o = tq % 24, part = o >> 3, oo = o & 7;
    const bf16_t* T = ptile_d(p, part) + h * 64 + 8 * oo;
#pragma unroll
    for (int i = 0; i < 6; ++i) { int r = row0 + 4 * tg - 1 + i; r = r < start ? start : (r >= start + len ? start + len - 1 : r); raw[i] = *(const GAS v4u*)(T + (size_t)r * 256); }
    if ((F.wave & 3) == 0) { const int dir = F.wave >> 2, tok = dir ? 63 - F.lane : F.lane; const float* AB = (const float*)(p.ws + WS_AB) + ((size_t)row0 + tok) * 16;
        abn[0] = AB[dir * 4 + h]; abn[1] = AB[8 + dir * 4 + h]; }
}
__device__ __forceinline__ void prep_item(Frame& F, int l, int item, v4u (&raw)[6], float (&abn)[2], int next_item) {
    const Ptrs& p = F.p; const int tid = F.tid, lane = F.lane, wave = F.wave;
    int b, h, row0; prep_decode(item, b, h, row0);
    int start, len; row_seq(row0, start, len);
    LAS float* lf = (LAS float*)F.lds;
    if (tid < 384) { const int tg = tid / 24, o = tid % 24, part = o >> 3, oo = o & 7;
        const float* wc = p.qkv_conv_w + (size_t)l * 3 * 768 + part * 256 + h * 64 + 8 * oo;
        float w[3][8], x[6][8];
#pragma unroll
        for (int j = 0; j < 3; ++j) { const f32x4 w0 = *(const f32x4*)(wc + j * 768), w1 = *(const f32x4*)(wc + j * 768 + 4);
            w[j][0] = w0.x; w[j][1] = w0.y; w[j][2] = w0.z; w[j][3] = w0.w; w[j][4] = w1.x; w[j][5] = w1.y; w[j][6] = w1.z; w[j][7] = w1.w; }
#pragma unroll
        for (int i = 0; i < 6; ++i) unpack8(raw[i], x[i]);
        const bool lo_ok = row0 + 4 * tg - 1 >= start, hi_ok = row0 + 4 * tg + 4 < start + len;
#pragma unroll
        for (int e = 0; e < 8; ++e) { x[0][e] = lo_ok ? x[0][e] : 0.f; x[5][e] = hi_ok ? x[5][e] : 0.f; }
#pragma unroll
        for (int t = 0; t < 4; ++t) { float a[8];
#pragma unroll
            for (int e = 0; e < 8; ++e) a[e] = fsilu(w[0][e] * x[t][e] + w[1][e] * x[t + 1][e] + w[2][e] * x[t + 2][e]);
            LAS float* dst = lf + part * 4352 + (4 * tg + t) * 68 + 8 * oo;
            *(LAS f32x4*)dst = (f32x4){a[0], a[1], a[2], a[3]}; *(LAS f32x4*)(dst + 4) = (f32x4){a[4], a[5], a[6], a[7]}; } }
    if ((wave & 3) == 0) { const int dir = wave >> 2, i = lane;
        const float g = -expf(p.a_log[(l * 2 + dir) * 4 + h]) * softplus_f(abn[0] + p.dt_bias[(l * 2 + dir) * 4 + h]);
        const float beta = sigmoid_f(abn[1]);
        float gc = g;
#pragma unroll
        for (int o = 1; o < 64; o <<= 1) { const float t = __shfl_up(gc, o); if (lane >= o) gc += t; }
        LAS float* sm = lf + L_SM + dir * SMD; const float eg = expf(gc); sm[i] = gc; sm[64 + i] = beta; sm[128 + i] = eg; sm[192 + i] = beta * eg; }
    prep_load(F, l, next_item, raw, abn);
    __syncthreads();
    { const int row = tid >> 2, part = row >> 6, t = row & 63, qt = tid & 3; LAS float* src = lf + part * 4352 + t * 68 + 16 * qt;
      f32x4 v[4]; float ss = 0.f;
#pragma unroll
      for (int i = 0; i < 4; ++i) { v[i] = *(LAS f32x4*)(src + 4 * i); ss += (v[i].x * v[i].x + v[i].y * v[i].y) + (v[i].z * v[i].z + v[i].w * v[i].w); }
      ss += __shfl_xor(ss, 1); ss += __shfl_xor(ss, 2);
      const float sc = (1.0f / sqrtf(ss + EPS)) * (part == 0 ? 0.125f : 1.0f);
#pragma unroll
      for (int i = 0; i < 4; ++i) { v[i] = v[i] * sc; *(LAS f32x4*)(src + 4 * i) = v[i]; }
      LAS unsigned char* bdst = (LAS unsigned char*)(lf + (part ? L_KB : L_QB)) + t * 144 + 32 * qt;
      v4u o; o.x = pk2(v[0].x, v[0].y); o.y = pk2(v[0].z, v[0].w); o.z = pk2(v[1].x, v[1].y); o.w = pk2(v[1].z, v[1].w); *(LAS v4u*)bdst = o;
      o.x = pk2(v[2].x, v[2].y); o.y = pk2(v[2].z, v[2].w); o.z = pk2(v[3].x, v[3].y); o.w = pk2(v[3].z, v[3].w); *(LAS v4u*)(bdst + 16) = o; }
    __syncthreads();
    { const int mat = wave >> 2, it = wave & 3, li = lane & 15, g4 = lane >> 4;
      const LAS unsigned char* Ab = (const LAS unsigned char*)(lf + (mat ? L_QB : L_KB)); const LAS unsigned char* Kb = (const LAS unsigned char*)(lf + L_KB);
      bf16x8 af[2];
#pragma unroll
      for (int s2 = 0; s2 < 2; ++s2) af[s2] = *(const LAS bf16x8*)(Ab + (16 * it + li) * 144 + (32 * s2 + 8 * g4) * 2);
      LAS float* G = lf + (mat ? L_GQK : L_GKK);
#pragma unroll
      for (int jt = 0; jt < 4; ++jt) { f32x4 acc = {0.f, 0.f, 0.f, 0.f};
#pragma unroll
          for (int s2 = 0; s2 < 2; ++s2) { const bf16x8 bq = *(const LAS bf16x8*)(Kb + (16 * jt + li) * 144 + (32 * s2 + 8 * g4) * 2); acc = __builtin_amdgcn_mfma_f32_16x16x32_bf16(af[s2], bq, acc, 0, 0, 0); }
#pragma unroll
          for (int r = 0; r < 4; ++r) G[(16 * it + 4 * g4 + r) * GS + 16 * jt + li] = acc[r]; } }
    __syncthreads();
    const int dir = tid >> 8, td = tid & 255;
    const LAS float* sm = lf + L_SM + dir * SMD;
    unsigned char* rec = p.ws + WS_REC + (size_t)(item * 2 + dir) * REC_BYTES;
    { const int i = td >> 2, jq = td & 3, ti = dir ? 63 - i : i; const float gi = sm[i], bi = sm[64 + i];
      const LAS float* grow = lf + L_GKK + ti * GS + (dir ? 48 - 16 * jq : 16 * jq);
      float gv[16], gc[16];
#pragma unroll
      for (int k = 0; k < 4; ++k) { const f32x4 a = *(const LAS f32x4*)(grow + 4 * k), c = *(const LAS f32x4*)(sm + 16 * jq + 4 * k);
          gv[4 * k] = a.x; gv[4 * k + 1] = a.y; gv[4 * k + 2] = a.z; gv[4 * k + 3] = a.w; gc[4 * k] = c.x; gc[4 * k + 1] = c.y; gc[4 * k + 2] = c.z; gc[4 * k + 3] = c.w; }
      float val[16];
#pragma unroll
      for (int jj = 0; jj < 16; ++jj) { const int j = 16 * jq + jj; const float G = dir ? gv[15 - jj] : gv[jj];
          const float v = bi * G * fexp(fminf(gi - gc[jj], 0.f)); val[jj] = (i > j) ? v : 0.f; }
      { const bool below = jq < (i >> 4);
        v4u o0, o1; o0.x = below ? pk2(-val[0], -val[1]) : 0u; o0.y = below ? pk2(-val[2], -val[3]) : 0u; o0.z = below ? pk2(-val[4], -val[5]) : 0u; o0.w = below ? pk2(-val[6], -val[7]) : 0u;
        o1.x = below ? pk2(-val[8], -val[9]) : 0u; o1.y = below ? pk2(-val[10], -val[11]) : 0u; o1.z = below ? pk2(-val[12], -val[13]) : 0u; o1.w = below ? pk2(-val[14], -val[15]) : 0u;
        LAS unsigned char* ao = (LAS unsigned char*)(lf + L_AO) + dir * 9216 + i * 144 + 32 * jq; *(LAS v4u*)ao = o0; *(LAS v4u*)(ao + 16) = o1; }
      if (jq == (i >> 4)) { LAS float* ad = lf + L_AD + dir * 1280 + (i >> 4) * 320 + (i & 15) * 20;
#pragma unroll
          for (int k = 0; k < 4; ++k) *(LAS f32x4*)(ad + 4 * k) = (f32x4){val[4 * k], val[4 * k + 1], val[4 * k + 2], val[4 * k + 3]}; } }
#pragma unroll
    for (int k = 0; k < 2; ++k) { const int f = td + 256 * k, ms = f >> 6, ll = f & 63, m = ms >> 1, s = ms & 1, rr = 16 * m + (ll & 15), cb = 32 * s + 4 * (ll >> 4);
        float va[8], vq[8], vk[8];
        const int ti = dir ? 63 - rr : rr; const float gi = sm[rr];
#pragma unroll
        for (int hh = 0; hh < 2; ++hh) { const int c0 = cb + 16 * hh;
            const f32x4 g4 = *(const LAS f32x4*)(lf + L_GQK + ti * GS + (dir ? 60 - c0 : c0)), s4 = *(const LAS f32x4*)(sm + c0), q4 = *(const LAS f32x4*)(lf + L_Q + ti * 68 + c0);
            const float gq[4] = {dir ? g4.w : g4.x, dir ? g4.z : g4.y, dir ? g4.y : g4.z, dir ? g4.x : g4.w}, sc[4] = {s4.x, s4.y, s4.z, s4.w}, qq[4] = {q4.x, q4.y, q4.z, q4.w};
#pragma unroll
            for (int e = 0; e < 4; ++e) { const int c = c0 + e, tc = dir ? 63 - c : c;
                const float v = gq[e] * fexp(fminf(gi - sc[e], 0.f)); va[4 * hh + e] = (rr >= c) ? v : 0.f;
                vq[4 * hh + e] = qq[e];
                vk[4 * hh + e] = lf[L_K + tc * 68 + rr]; } }
        v4u o; o.x = pk2(va[0], va[1]); o.y = pk2(va[2], va[3]); o.z = pk2(va[4], va[5]); o.w = pk2(va[6], va[7]); *(GAS v4u*)(rec + R_ATTN + f * 16) = o;
        o.x = pk2(vq[0], vq[1]); o.y = pk2(vq[2], vq[3]); o.z = pk2(vq[4], vq[5]); o.w = pk2(vq[6], vq[7]); *(GAS v4u*)(rec + R_Q + f * 16) = o;
        o.x = pk2(vk[0], vk[1]); o.y = pk2(vk[2], vk[3]); o.z = pk2(vk[4], vk[5]); o.w = pk2(vk[6], vk[7]); *(GAS v4u*)(rec + R_KT + f * 16) = o; }
    if (td < 64) { float* vec = (float*)(rec + R_VEC); vec[td] = sm[128 + td]; vec[64 + td] = expf(sm[63] - sm[td]); if (td == 0) vec[128] = expf(sm[63]); }
    const int li = lane & 15, g4 = lane >> 4, nt0 = 2 * (wave & 3);
    f32x4 Rt[2][4];
#pragma unroll
    for (int t = 0; t < 2; ++t) { const int nt = nt0 + t; const LAS float* src = lf + (nt < 4 ? L_V + 16 * nt + li : L_K + 16 * (nt - 4) + li); const LAS float* scl = sm + (nt < 4 ? 64 : 192);
#pragma unroll
        for (int m = 0; m < 4; ++m) { const f32x4 sc = *(const LAS f32x4*)(scl + 16 * m + 4 * g4); const int i0 = 16 * m + 4 * g4;
            Rt[t][m] = (f32x4){src[(dir ? 63 - i0 : i0) * 68] * sc.x, src[(dir ? 62 - i0 : i0 + 1) * 68] * sc.y, src[(dir ? 61 - i0 : i0 + 2) * 68] * sc.z, src[(dir ? 60 - i0 : i0 + 3) * 68] * sc.w}; } }
    __syncthreads();
    if ((wave & 3) == 0) { const int blk = lane >> 4, c = lane & 15; const LAS float* Ad = lf + L_AD + dir * 1280 + blk * 320;
        float x[16];
#pragma unroll
        for (int r = 0; r < 16; ++r) x[r] = 0.f;
#pragma unroll
        for (int r = 0; r < 16; ++r) { float acc = (r == c) ? 1.f : 0.f;
#pragma unroll
            for (int q = 0; q < (r + 3) / 4; ++q) { const f32x4 a = *(const LAS f32x4*)(Ad + r * 20 + 4 * q); acc -= (a.x * x[4 * q] + a.y * x[4 * q + 1]) + (a.z * x[4 * q + 2] + a.w * x[4 * q + 3]); }
            x[r] = acc; }
        LAS bf16_t* DF = (LAS bf16_t*)(lf + L_DF) + dir * 1280 + blk * 320;
#pragma unroll
        for (int r = 0; r < 16; ++r) DF[r * 20 + c] = f2bf(x[r]); }
    __syncthreads();
    { const LAS unsigned char* ao = (const LAS unsigned char*)(lf + L_AO) + dir * 9216; const LAS unsigned char* df = (const LAS unsigned char*)(lf + L_DF) + dir * 2560;
      const f32x4 zero4 = {0.f, 0.f, 0.f, 0.f};
      f32x4 X[2][4];
#pragma unroll
      for (int t = 0; t < 2; ++t)
#pragma unroll
          for (int m = 0; m < 4; ++m) X[t][m] = zero4;
#pragma unroll
      for (int m = 0; m < 4; ++m) {
          const u32x2 dw = *(const LAS u32x2*)(df + m * 640 + li * 40 + g4 * 8);
          const bf16x8 dfrag = __builtin_bit_cast(bf16x8, (v4u){dw.x, dw.y, 0u, 0u});
          f32x4 acc[2] = {Rt[0][m], Rt[1][m]};
#pragma unroll
          for (int s2 = 0; s2 < (m + 1) / 2; ++s2) { const u32x2 lo = *(const LAS u32x2*)(ao + (16 * m + li) * 144 + (32 * s2 + 4 * g4) * 2), hi = *(const LAS u32x2*)(ao + (16 * m + li) * 144 + (32 * s2 + 16 + 4 * g4) * 2);
              const bf16x8 afrag = __builtin_bit_cast(bf16x8, (v4u){lo.x, lo.y, hi.x, hi.y});
#pragma unroll
              for (int t = 0; t < 2; ++t) acc[t] = __builtin_amdgcn_mfma_f32_16x16x32_bf16(afrag, pack8(X[t][2 * s2], X[t][2 * s2 + 1]), acc[t], 0, 0, 0); }
#pragma unroll
          for (int t = 0; t < 2; ++t) X[t][m] = __builtin_amdgcn_mfma_f32_16x16x32_bf16(dfrag, pack8(acc[t], zero4), zero4, 0, 0, 0); }
      LAS float* XS = lf + L_XS + dir * 8448;
#pragma unroll
      for (int t = 0; t < 2; ++t)
#pragma unroll
          for (int m = 0; m < 4; ++m)
#pragma unroll
              for (int r = 0; r < 4; ++r) XS[(16 * m + 4 * g4 + r) * 132 + 16 * (nt0 + t) + li] = X[t][m][r]; }
    __syncthreads();
    { const LAS float* XS = lf + L_XS + dir * 8448;
#pragma unroll
      for (int k = 0; k < 2; ++k) { const int f = td + 256 * k, ms = f >> 6, ll = f & 63, m = ms >> 1, s = ms & 1, rr = 16 * m + (ll & 15), cb = 32 * s + 4 * (ll >> 4);
          float v[8];
#pragma unroll
          for (int e = 0; e < 8; ++e) v[e] = -XS[rr * 132 + 64 + cb + 16 * (e >> 2) + (e & 3)];
          v4u o; o.x = pk2(v[0], v[1]); o.y = pk2(v[2], v[3]); o.z = pk2(v[4], v[5]); o.w = pk2(v[6], v[7]); *(GAS v4u*)(rec + R_NW + f * 16) = o; }
#pragma unroll
      for (int k = 0; k < 4; ++k) { const int u = td + 256 * k, w = u >> 8, m = (u >> 6) & 3, ll = u & 63, r0 = 16 * m + 4 * (ll >> 4), c = 16 * w + (ll & 15);
          const f32x4 o = {XS[r0 * 132 + c], XS[(r0 + 1) * 132 + c], XS[(r0 + 2) * 132 + c], XS[(r0 + 3) * 132 + c]};
          *(GAS f32x4*)(rec + R_U + u * 16) = o; } }
    __syncthreads();
}
__device__ __forceinline__ void phase_prep(Frame& F, int l) {
    v4u raw[6]; float abn[2] = {0.f, 0.f};
    F.refresh();
    if (F.vcu < NITEM) prep_load(F, l, F.vcu, raw, abn);
    for (int it = F.vcu; it < NITEM; it += F.G) { F.refresh(); prep_item(F, l, it, raw, abn, it + F.G < NITEM ? it + F.G : it); }
}

__device__ __forceinline__ void scan_rec(int b, int h, int dir, int step, int& cid, int& row0) {
    if (step < 4) { const int n = dir ? 3 - step : step; cid = 2048 + (b * 4 + h) * 4 + n; row0 = MLAT + b * CTXL + 64 * n; }
    else { const int n = dir ? 35 - step : step - 4; cid = (b * 4 + h) * 32 + n; row0 = b * SEQ + 64 * n; }
}
__device__ __forceinline__ void phase_scan(Frame& F, int l) {
    const Ptrs& p = F.p;
    if (F.vcu >= 128) { if (l + 1 < DEPTH) convert_weights(F, l + 1, (F.vcu - 128) * NWAVES + F.wave, (F.G - 128) * NWAVES); return; }
    const int s = F.vcu, b = s >> 3, h = (s >> 1) & 3, dir = s & 1, lane = F.lane;
    constexpr int NSTEP = 36, PIECES = REC_BYTES / 1024 / 4;
    if (F.wave >= 4) {
        const int lw = F.wave - 4;
#define SCAN_ISSUE(t_) do { int cid_, row0_; scan_rec(b, h, dir, (t_), cid_, row0_); const unsigned char* rec_ = p.ws + WS_REC + (size_t)(cid_ * 2 + dir) * REC_BYTES + lane * 16; \
            LAS unsigned char* slot_ = F.lds + ((t_) % 3) * REC_BYTES; \
            _Pragma("unroll") for (int k_ = 0; k_ < PIECES; ++k_) { const int pc_ = lw + 4 * k_; \
                __builtin_amdgcn_global_load_lds((const GAS unsigned*)(rec_ + pc_ * 1024), (LAS unsigned*)(slot_ + pc_ * 1024), 16, 0, 0); } } while (0)
        SCAN_ISSUE(0); SCAN_ISSUE(1);
        for (int t = 0; t < NSTEP; ++t) {
            if (t + 1 < NSTEP) asm volatile("s_waitcnt vmcnt(13)" ::: "memory"); else asm volatile("s_waitcnt vmcnt(0)" ::: "memory");
            asm volatile("" ::: "memory"); __builtin_amdgcn_s_barrier(); asm volatile("" ::: "memory");
            if (t + 2 < NSTEP) SCAN_ISSUE(t + 2);
        }
#undef SCAN_ISSUE
        return;
    }
    const int w = F.wave, li = lane & 15, g4 = lane >> 4;
    f32x4 S[4];
#pragma unroll
    for (int m = 0; m < 4; ++m) S[m] = (f32x4){0.f, 0.f, 0.f, 0.f};
    bf16_t* O = (bf16_t*)(p.ws + WS_OB16) + (size_t)dir * MTOT * 256;
    for (int step = 0; step < NSTEP; ++step) {
        int cid, row0; scan_rec(b, h, dir, step, cid, row0);
        asm volatile("s_waitcnt lgkmcnt(0)" ::: "memory"); __builtin_amdgcn_s_barrier(); asm volatile("" ::: "memory");
        const LAS unsigned char* rec = F.lds + (step % 3) * REC_BYTES;
        bf16x8 nw[4][2], qf[4][2], at[4][2], kt[4][2]; f32x4 av[4], ao[4], a2[4], egc4[4], edl4[4];
#pragma unroll
        for (int m = 0; m < 4; ++m) {
#pragma unroll
            for (int s2 = 0; s2 < 2; ++s2) { nw[m][s2] = *(const LAS bf16x8*)(rec + R_NW + ((m * 2 + s2) * 64 + lane) * 16); qf[m][s2] = *(const LAS bf16x8*)(rec + R_Q + ((m * 2 + s2) * 64 + lane) * 16); }
            av[m] = *(const LAS f32x4*)(rec + R_U + ((w * 4 + m) * 64 + lane) * 16); ao[m] = (f32x4){0.f, 0.f, 0.f, 0.f}; }
        const float gl = *(const LAS float*)(rec + R_VEC + 512);
        bf16x8 Bs[2] = {pack8(S[0], S[1]), pack8(S[2], S[3])};
#pragma unroll
        for (int m = 0; m < 4; ++m)
#pragma unroll
            for (int s2 = 0; s2 < 2; ++s2) { av[m] = __builtin_amdgcn_mfma_f32_16x16x32_bf16(nw[m][s2], Bs[s2], av[m], 0, 0, 0); ao[m] = __builtin_amdgcn_mfma_f32_16x16x32_bf16(qf[m][s2], Bs[s2], ao[m], 0, 0, 0); }
#pragma unroll
        for (int m = 0; m < 4; ++m) {
#pragma unroll
            for (int s2 = 0; s2 < 2; ++s2) { at[m][s2] = *(const LAS bf16x8*)(rec + R_ATTN + ((m * 2 + s2) * 64 + lane) * 16); kt[m][s2] = *(const LAS bf16x8*)(rec + R_KT + ((m * 2 + s2) * 64 + lane) * 16); }
            edl4[m] = *(const LAS f32x4*)(rec + R_VEC + 256 + (16 * m + 4 * g4) * 4); egc4[m] = *(const LAS f32x4*)(rec + R_VEC + (16 * m + 4 * g4) * 4); a2[m] = (f32x4){0.f, 0.f, 0.f, 0.f}; }
        bf16x8 Bv[2] = {pack8(av[0], av[1]), pack8(av[2], av[3])};
        bf16x8 Bvs[2] = {pack8(av[0] * edl4[0], av[1] * edl4[1]), pack8(av[2] * edl4[2], av[3] * edl4[3])};
#pragma unroll
        for (int m = 0; m < 4; ++m) S[m] = S[m] * gl;
#pragma unroll
        for (int m = 0; m < 4; ++m)
#pragma unroll
            for (int s2 = 0; s2 < 2; ++s2) { a2[m] = __builtin_amdgcn_mfma_f32_16x16x32_bf16(at[m][s2], Bv[s2], a2[m], 0, 0, 0); S[m] = __builtin_amdgcn_mfma_f32_16x16x32_bf16(kt[m][s2], Bvs[s2], S[m], 0, 0, 0); }
#pragma unroll
        for (int m = 0; m < 4; ++m) { const f32x4 o = egc4[m] * ao[m] + a2[m];
#pragma unroll
            for (int r = 0; r < 4; ++r) { const int i = 16 * m + 4 * g4 + r, tok = dir ? 63 - i : i;
                O[(size_t)(row0 + tok) * 256 + h * 64 + 16 * w + li] = f2bf(o[r]); } }
    }
}

__device__ __forceinline__ void phase_comb(Frame& F, int l) {
    const Ptrs& p = F.p; const int lane = F.lane;
    const int gw = F.vcu * NWAVES + F.wave, NGW = F.G * NWAVES;
    const bf16_t* OF = (const bf16_t*)(p.ws + WS_OB16); const bf16_t* OB = OF + (size_t)MTOT * 256; const bf16_t* GA = ptile_d(p, T_GA);
    const f32x4 ng = *(const f32x4*)(p.gdn_norm_g + l * 64 + 4 * (lane & 15));
    const int nrow = (l == DEPTH - 1) ? MLAT : MTOT;
    u32x2 an, cn, gn;
    if (gw < nrow) { an = *(const GAS u32x2*)(OF + (size_t)gw * 256 + 4 * lane); cn = *(const GAS u32x2*)(OB + (size_t)gw * 256 + 4 * lane); gn = *(const GAS u32x2*)(GA + (size_t)gw * 256 + 4 * lane); }
    for (int r = gw; r < nrow; r += NGW) {
        const u32x2 a = an, c = cn, gt = gn;
        if (r + NGW < nrow) { const size_t r2 = (size_t)(r + NGW); an = *(const GAS u32x2*)(OF + r2 * 256 + 4 * lane); cn = *(const GAS u32x2*)(OB + r2 * 256 + 4 * lane); gn = *(const GAS u32x2*)(GA + r2 * 256 + 4 * lane); }
        const f32x4 o = {bflo(a.x) + bflo(c.x), bfhi(a.x) + bfhi(c.x), bflo(a.y) + bflo(c.y), bfhi(a.y) + bfhi(c.y)};
        float ss = (o.x * o.x + o.y * o.y) + (o.z * o.z + o.w * o.w);
        ss = row16_sum(ss);
        const float rs = 1.0f / sqrtf(ss * (1.f / 64.f) + EPS);
        u32x2 y; y.x = pk2(o.x * rs * ng.x * fsilu(bflo(gt.x)), o.y * rs * ng.y * fsilu(bfhi(gt.x))); y.y = pk2(o.z * rs * ng.z * fsilu(bflo(gt.y)), o.w * rs * ng.w * fsilu(bfhi(gt.y)));
        *(GAS u32x2*)((bf16_t*)(p.ws + WS_HY) + (size_t)r * DM + 4 * lane) = y;
    }
}

constexpr int PH_FINAL = 1 + 7 * DEPTH, PH_END = PH_FINAL + 1;
struct Args { Ptrs p; int ph_lo, ph_hi; };
__global__ void __launch_bounds__(NWAVES * 64, 2) mega(Args args) {
    extern __shared__ __attribute__((aligned(16))) unsigned char lds[];
    Frame F;
    F.lds = (LAS unsigned char*)lds; F.MISC = (volatile LAS unsigned*)(F.lds + MISC_OFF);
    F.tid = threadIdx.x; F.lane = F.tid & 63; F.wave = __builtin_amdgcn_readfirstlane(F.tid >> 6);
    F.G = gridDim.x; { const int bx = blockIdx.x; F.vcu = (F.G % 8 == 0) ? (bx % 8) * (F.G / 8) + bx / 8 : bx; }
    F.p = args.p; F.ctl = (gu32*)(args.p.ws + WS_CTL);
    for (int u = F.tid; u < (LDS_BYTES - LDSCTL_OFF) / 4; u += NWAVES * 64) ((LAS unsigned*)(F.lds + LDSCTL_OFF))[u] = 0u;
    __syncthreads();
    const bool multi = args.ph_hi - args.ph_lo > 1;
    XcdBarrier bar; bar.bar = (unsigned*)(F.ctl + CW_BAR); bar.x = 0; bar.st = nullptr;
    if (multi) bar = xcd_barrier_post((unsigned*)(F.ctl + CW_BAR), F.MISC + 8);
    for (int ph = args.ph_lo; ph < args.ph_hi; ++ph) {
        F.refresh();
        if (ph == 0) phase_pre(F);
        else if (ph == PH_FINAL) phase_final(F);
        else { const int l = (ph - 1) / 7, s = (ph - 1) % 7;
            if (s == 0) phase_norm(F, l);
            else if (s == 1) phase_gemm1(F, l);
            else if (s == 2) phase_mix(F, l);
            else if (s == 3) phase_prep(F, l);
            else if (s == 4) phase_scan(F, l);
            else if (s == 5) phase_comb(F, l);
            else if (s == 6) phase_gemm2(F, l);
        }
        if (ph + 1 < args.ph_hi) xcd_barrier(bar);
    }
}

extern "C" void kernel_launch(void* const* d_in, const int* in_sizes, int n_in, void* d_out, int out_size, void* d_ws, size_t ws_size, hipStream_t stream) {
    static int grid = 0;
    if (grid == 0) {
        if (n_in != 23 || out_size != MLAT * DM || ws_size < WS_END) { fprintf(stderr, "kernel_launch: unexpected shapes (n_in %d out %d ws %zu)\n", n_in, out_size, ws_size); grid = -1; return; }
        int dev = 0, cus = 0;
        if (hipGetDevice(&dev) != hipSuccess || hipDeviceGetAttribute(&cus, hipDeviceAttributeMultiprocessorCount, dev) != hipSuccess) { grid = -1; return; }
        if (hipFuncSetAttribute((const void*)mega, hipFuncAttributeMaxDynamicSharedMemorySize, LDS_BYTES) != hipSuccess) { fprintf(stderr, "kernel_launch: hipFuncSetAttribute failed\n"); grid = -1; return; }
        grid = cus;
        if (grid != 256) fprintf(stderr, "kernel_launch: %d CUs (built for 256)\n", grid);
    }
    if (grid < 0) return;
    hipMemsetAsync((char*)d_ws + WS_CTL, 0, CTL_ZERO_BYTES, stream);
    Args a{};
    const float** f = (const float**)&a.p;
    for (int i = 0; i < 23; ++i) f[i] = (const float*)d_in[i];
    a.p.out = (float*)d_out; a.p.ws = (unsigned char*)d_ws;
    a.ph_lo = 0; a.ph_hi = PH_END;
    hipLaunchKernelGGL(mega, dim3(grid), dim3(NWAVES * 64), LDS_BYTES, stream, a);
}
```

```cpp
#include <hip/hip_runtime.h>
#ifndef PROBE_S
#define PROBE_S (-1)
#endif
#include <cstdio>
#include <cstdint>

typedef unsigned short bf16_t;
__device__ __forceinline__ float bf2f(bf16_t v) { return __uint_as_float(((unsigned)v) << 16); }
typedef __bf16 nbf16x2 __attribute__((ext_vector_type(2)));
typedef __bf16 nbf16x8 __attribute__((ext_vector_type(8)));
typedef float nf32x2 __attribute__((ext_vector_type(2)));
typedef float nf32x8 __attribute__((ext_vector_type(8)));
__device__ __forceinline__ bf16_t f2bf(float f) { return __builtin_bit_cast(bf16_t, (__bf16)f); }

constexpr int DM = 1024, NB = 16, SEQ = 2048, DEPTH = 4, CTXL = 256, HD = 64, BW = 256, HA = 4;
constexpr int INC = 3600, NPC = 3584, NTILE = 14;
constexpr int MLAT = NB * SEQ, MCTX = NB * CTXL, MTOT = MLAT + MCTX;
constexpr float EPS = 1e-6f;
__device__ __constant__ int c_tile_col[NTILE] = {0, 256, 512, 2576, 784, 1040, 1296, 1552, 1808, 2064, 2320, 2832, 3088, 3344};
enum { T_Q = 0, T_K = 1, T_V = 2, T_GA = 3, T_BG = 4, T_CG = 5, T_XI = 6, T_GLA = 7, T_GLB = 8, T_U = 9, T_VV = 10, T_GB = 11, T_GC = 12, T_GD = 13 };

constexpr size_t MiB = 1u << 20;
constexpr size_t WS_CTL = 0, WS_MOD = 1 * MiB, WS_AB = 2 * MiB, WS_GB = 5 * MiB, WS_STAT = 8 * MiB, WS_XC = 16 * MiB, WS_WIN = 32 * MiB, WS_WOUT = 60 * MiB,
                 WS_HY = 68 * MiB, WS_P = 140 * MiB, WS_OFB = 392 * MiB, WS_END = 512 * MiB;
constexpr size_t PTILE_ELEMS = (size_t)MTOT * 256;
constexpr size_t WS_QKV = WS_P + 4 * PTILE_ELEMS * 2;

struct Ptrs {
    const float *x, *c, *ctx, *c_ctx, *norm_g, *w_ada, *b_ada, *w_in, *qkv_conv_w, *a_log, *dt_bias, *gdn_norm_g, *short_conv_w, *conf_conv_w, *conf_conv_b,
        *conf_ln_g, *conf_ln_b, *smlp_ln_g, *smlp_ln_b, *smlp_w, *smlp_b, *w_out, *final_g;
    float* out; unsigned char* ws;
};

__device__ __forceinline__ float silu_f(float x) { return x / (1.f + expf(-x)); }
__device__ __forceinline__ float sigmoid_f(float x) { return 1.f / (1.f + expf(-x)); }
__device__ __forceinline__ float softplus_f(float x) { return x > 20.f ? x : log1pf(expf(x)); }
__device__ __forceinline__ float fexp(float x) { return __builtin_amdgcn_exp2f(x * 1.44269504089f); }
__device__ __forceinline__ float fsigmoid(float x) { return __builtin_amdgcn_rcpf(1.f + fexp(-x)); }
__device__ __forceinline__ float fsilu(float x) { return x * fsigmoid(x); }

__device__ __forceinline__ float block_sum256(float v, float* red) {
#pragma unroll
    for (int o = 32; o > 0; o >>= 1) v += __shfl_xor(v, o);
    __syncthreads();
    if ((threadIdx.x & 63) == 0) red[threadIdx.x >> 6] = v;
    __syncthreads();
    return red[0] + red[1] + red[2] + red[3];
}
template <int CTRL> __device__ __forceinline__ float dpp_f(float v) { return __int_as_float(__builtin_amdgcn_mov_dpp(__float_as_int(v), CTRL, 0xF, 0xF, true)); }
__device__ __forceinline__ float row16_sum(float v) {
    v += dpp_f<0xB1>(v); v += dpp_f<0x4E>(v); v += dpp_f<0x141>(v); v += dpp_f<0x140>(v); return v; }
__device__ __forceinline__ float wave_sum(float v) {
    v = row16_sum(v);
    { auto r = __builtin_amdgcn_permlane16_swap(__float_as_uint(v), __float_as_uint(v), false, false); v = __uint_as_float(r[0]) + __uint_as_float(r[1]); }
    { auto r = __builtin_amdgcn_permlane32_swap(__float_as_uint(v), __float_as_uint(v), false, false); v = __uint_as_float(r[0]) + __uint_as_float(r[1]); }
    return v; }

__device__ __forceinline__ void row_seq(int row, int& start, int& len) { if (row < MLAT) { start = row & ~(SEQ - 1); len = SEQ; } else { start = row & ~(CTXL - 1); len = CTXL; } }

namespace pg8 {
#define PG8_LAS __attribute__((address_space(3)))
typedef unsigned short bf16_t;
typedef short bf16x8 __attribute__((ext_vector_type(8)));
typedef float f32x4 __attribute__((ext_vector_type(4)));
typedef unsigned u32x4 __attribute__((ext_vector_type(4)));
constexpr int BM = 256, BK = 64, HALF = 128, HTB = HALF * BK * 2  , STAGE_BYTES = 8 * HTB, NXCD = 8, WGM = 8;

__host__ __device__ __forceinline__ int lds_byte(int r, int c) { const int st = (r >> 4) * 2 + (c >> 5), rr = r & 15, cc = c & 31, ob = rr * 64 + cc * 2; return st * 1024 + (ob ^ (((ob >> 9) & 1) << 5)); }
__host__ __device__ __forceinline__ void stage_rc(int b, int& R, int& C) { const int st = b / 1024, sb = b % 1024, swz = sb ^ (((sb >> 9) & 1) << 5); R = (st >> 1) * 16 + swz / 64; C = (st & 1) * 32 + (swz % 64) / 2; }
__host__ __device__ __forceinline__ int perm32(int rho) { const int n = rho >> 4, i = rho & 15; return 8 * (i >> 2) + 4 * n + (i & 3); }

struct Unit { int pm, pn; };
struct Gemm { const bf16_t* A; const bf16_t* Bt; int M, N, K; };

struct StaticOrder {
    int nM, nN, nwg, G, c;
    __host__ __device__ void init(int M, int N, int G_, int c_) { nM = M / BM; nN = N / BM; nwg = nM * nN; G = G_; c = c_; }
    __host__ __device__ bool next(int i, Unit& u) const {
        const long L = (long)i * G + c; if (L >= nwg) return false;
        int wgid = (int)L; { const int q = nwg / NXCD, r = nwg % NXCD, xcd = wgid % NXCD, off = wgid / NXCD; wgid = (xcd < r ? xcd * (q + 1) : r * (q + 1) + (xcd - r) * q) + off; }
        const int nig = WGM * nN, gid = wgid / nig, fm = gid * WGM, gsz = (nM - fm) < WGM ? (nM - fm) : WGM;
        u.pm = fm + ((wgid % nig) % gsz); u.pn = (wgid % nig) / gsz; return true;
    }
    __device__ __forceinline__ void a_ready(const Unit&) const {}
    __device__ __forceinline__ void done(const Unit&) const {}
};


__device__ __forceinline__ unsigned cvt_pk_bf16(float lo, float hi) { return __builtin_bit_cast(unsigned, __builtin_convertvector((nf32x2){lo, hi}, nbf16x2)); }
struct EpiP {
    static constexpr bool PERM = true, AFTER_DRAIN = false;
    bf16_t* P; size_t tile_elems;
    __device__ __forceinline__ void operator()(const f32x4 (&acc)[2][2][4][2], const Unit& u, int wr, int wc, int fr, int fq) const {
        const int row0 = u.pm * BM + wr * 64 + fr;
        bf16_t* base = P + (size_t)u.pn * tile_elems + wc * 32 + 8 * fq;
#pragma unroll
        for (int ai = 0; ai < 2; ++ai)
#pragma unroll
            for (int m = 0; m < 4; ++m) { bf16_t* rowp = base + (size_t)(row0 + ai * HALF + m * 16) * 256;
#pragma unroll
                for (int bj = 0; bj < 2; ++bj) { const f32x4 v0 = acc[ai][bj][m][0], v1 = acc[ai][bj][m][1];
                    u32x4 w; w.x = cvt_pk_bf16(v0[0], v0[1]); w.y = cvt_pk_bf16(v0[2], v0[3]); w.z = cvt_pk_bf16(v1[0], v1[1]); w.w = cvt_pk_bf16(v1[2], v1[3]);
                    *(u32x4*)(rowp + bj * HALF) = w; } }
    }
};
struct EpiResid {
    static constexpr bool PERM = true, AFTER_DRAIN = false;
    const float* x_old; float* x_new; const float* xc_old; float* xc_new; const float* mod_l; int odd, mlat, seq, dm;
    __device__ __forceinline__ void operator()(f32x4 (&acc)[2][2][4][2], const Unit& u, int wr, int wc, int fr, int fq) const {
        const int rbase = u.pm * BM; const bool lat = rbase < mlat; const int b = lat ? rbase / seq : 16;
        const int col = u.pn * BM + wc * 32 + 8 * fq;
        { const float* gate = mod_l + (size_t)b * 3072 + 2048 + col;
#pragma unroll
          for (int bj = 0; bj < 2; ++bj)
#pragma unroll
            for (int n = 0; n < 2; ++n) { const f32x4 g = *(const f32x4*)(gate + bj * HALF + 4 * n);
#pragma unroll
                for (int ai = 0; ai < 2; ++ai)
#pragma unroll
                    for (int m = 0; m < 4; ++m) acc[ai][bj][m][n] = acc[ai][bj][m][n] * g; } }
        const float* ob = lat ? x_old : xc_old; float* nb = lat ? x_new : xc_new;
#pragma unroll
        for (int ai = 0; ai < 2; ++ai)
#pragma unroll
          for (int mh = 0; mh < 2; ++mh) {
            f32x4 o[2][2][2]; unsigned offs[2];
#pragma unroll
            for (int mm = 0; mm < 2; ++mm) { const int r = rbase + ai * HALF + wr * 64 + (2 * mh + mm) * 16 + fr;
                if (lat) { const int tp = r % seq; const int t = odd ? ((tp & 31) * 64 + (tp >> 5)) : tp; offs[mm] = (unsigned)(((r / seq) * seq + t) * dm + col); }
                else offs[mm] = (unsigned)((r - mlat) * dm + col);
#pragma unroll
                for (int bj = 0; bj < 2; ++bj)
#pragma unroll
                    for (int n = 0; n < 2; ++n) o[mm][bj][n] = *(const f32x4*)(ob + offs[mm] + bj * HALF + 4 * n); }
#pragma unroll
            for (int mm = 0; mm < 2; ++mm)
#pragma unroll
                for (int bj = 0; bj < 2; ++bj)
#pragma unroll
                    for (int n = 0; n < 2; ++n) *(f32x4*)(nb + offs[mm] + bj * HALF + 4 * n) = o[mm][bj][n] + acc[ai][bj][2 * mh + mm][n];
            asm volatile("" ::: "memory");
          }
    }
};
template <class Epi, class Sched, bool ALIGN_EPI = false, bool SP2 = false>
__device__ __forceinline__ void gemm_phase(PG8_LAS unsigned char* lds, const Gemm g, const Sched& S, const Epi& E) {
    int tid_ = threadIdx.x; asm volatile("" : "+v"(tid_));
    const int tid = tid_, wid = __builtin_amdgcn_readfirstlane(tid >> 6), lane = tid & 63, wr = wid >> 2, wc = wid & 3, fr = lane & 15, fq = lane >> 4;
    const int K = g.K, nt = K / BK;
    unsigned voffA[2], voffB[2];
#pragma unroll
    for (int i = 0; i < 2; ++i) { int R, C; stage_rc(tid * 16 + i * 8192, R, C); const int Rb = Epi::PERM ? ((R & ~31) + perm32(R & 31)) : R;
        voffA[i] = (unsigned)(R * K + C) * 2u; voffB[i] = (unsigned)(Rb * K + C) * 2u; }
    const size_t kstep = (size_t)(BK * 2);
    const size_t hstep = (size_t)HALF * K * 2;
    const size_t tstep = 2 * hstep;
    const unsigned ldsw = (unsigned)wid * 1024u;
    const int aoff = lds_byte(wr * 64 + fr, fq * 8), boff = lds_byte(wc * 32 + fr, fq * 8);
#define PG8_SA(b, h) (((b) * 2 + (h)) * HTB)
#define PG8_SB(b, h) ((4 + (b) * 2 + (h)) * HTB)
#define PG8_STAGE(bufoff, gbase, voff) do { _Pragma("unroll") for (int _i = 0; _i < 2; ++_i) \
        __builtin_amdgcn_global_load_lds((const unsigned*)((const char*)(gbase) + (voff)[_i]), (PG8_LAS unsigned*)(lds + (bufoff) + ldsw + _i * 8192), 16, 0, 0); } while (0)
#define PG8_LDA(dst, b, h) do { _Pragma("unroll") for (int m = 0; m < 4; ++m) _Pragma("unroll") for (int k = 0; k < 2; ++k) dst[m][k] = *(const PG8_LAS bf16x8*)(lds + PG8_SA(b, h) + aoff + m * 2048 + k * 1024); } while (0)
#define PG8_LDB(dst, b, h) do { _Pragma("unroll") for (int n = 0; n < 2; ++n) _Pragma("unroll") for (int k = 0; k < 2; ++k) dst[n][k] = *(const PG8_LAS bf16x8*)(lds + PG8_SB(b, h) + boff + n * 2048 + k * 1024); } while (0)
#define PG8_MMA(ai, bj, At, Bt) do { __builtin_amdgcn_s_setprio(1); _Pragma("unroll") for (int m = 0; m < 4; ++m) _Pragma("unroll") for (int n = 0; n < 2; ++n) _Pragma("unroll") for (int k = 0; k < 2; ++k) \
        acc[ai][bj][m][n] = __builtin_amdgcn_mfma_f32_16x16x32_bf16(Bt[n][k], At[m][k], acc[ai][bj][m][n], 0, 0, 0); __builtin_amdgcn_s_setprio(0); } while (0)
#define PG8_WAIT_V(n) asm volatile("s_waitcnt vmcnt(" #n ")" ::: "memory")
#define PG8_WAIT_L(n) asm volatile("s_waitcnt lgkmcnt(" #n ")" ::: "memory")
#define PG8_BAR __builtin_amdgcn_s_barrier()
#define PG8_SCHED __builtin_amdgcn_sched_barrier(0)
    Unit cur, nxt; int ui = 0;
    if (!S.next(0, cur)) return;
    f32x4 acc[2][2][4][2];
#pragma unroll
    for (int a = 0; a < 2; ++a)
#pragma unroll
        for (int b = 0; b < 2; ++b)
#pragma unroll
            for (int m = 0; m < 4; ++m)
#pragma unroll
                for (int n = 0; n < 2; ++n) acc[a][b][m][n] = (f32x4){0.f, 0.f, 0.f, 0.f};
    bf16x8 At[4][2], B0[2][2], B1[2][2];
    const char* cA = (const char*)g.A + (size_t)cur.pm * tstep; const char* cB = (const char*)g.Bt + (size_t)cur.pn * tstep;
    S.a_ready(cur);
    if constexpr (SP2) {
        PG8_STAGE(PG8_SB(0, 0), cB, voffB); PG8_STAGE(PG8_SB(0, 1), cB + hstep, voffB); PG8_STAGE(PG8_SA(0, 0), cA, voffA); PG8_STAGE(PG8_SA(0, 1), cA + hstep, voffA);
        if (wr == 1) PG8_BAR;
        PG8_WAIT_V(2); PG8_BAR;
        PG8_STAGE(PG8_SB(1, 0), cB + kstep, voffB); PG8_STAGE(PG8_SA(1, 0), cA + kstep, voffA); PG8_STAGE(PG8_SB(1, 1), cB + hstep + kstep, voffB);
        PG8_WAIT_V(6); PG8_BAR;
    } else {
        PG8_STAGE(PG8_SB(0, 0), cB, voffB); PG8_STAGE(PG8_SA(0, 0), cA, voffA); PG8_STAGE(PG8_SB(0, 1), cB + hstep, voffB); PG8_STAGE(PG8_SA(0, 1), cA + hstep, voffA);
        if (wr == 1) PG8_BAR;
        PG8_WAIT_V(4); PG8_BAR;
        PG8_STAGE(PG8_SB(1, 0), cB + kstep, voffB); PG8_STAGE(PG8_SA(1, 0), cA + kstep, voffA); PG8_STAGE(PG8_SB(1, 1), cB + hstep + kstep, voffB);
        PG8_WAIT_V(6); PG8_BAR;
    }
    for (;;) {
        const bool has_next = S.next(ui + 1, nxt);
        const char* nA = has_next ? (const char*)g.A + (size_t)nxt.pm * tstep : cA; const char* nB = has_next ? (const char*)g.Bt + (size_t)nxt.pn * tstep : cB;
        for (int t = 0; t < nt; t += 2) {
            const bool last = (t == nt - 2);
            const char* a1 = cA + (size_t)(t + 1) * kstep;
            const char* a2 = last ? nA : cA + (size_t)(t + 2) * kstep; const char* b2 = last ? nB : cB + (size_t)(t + 2) * kstep;
            const char* a3 = a2 + kstep; const char* b3 = b2 + kstep;
            if (last && has_next) S.a_ready(nxt);
            if constexpr (SP2) {
            PG8_LDB(B0, 0, 0); PG8_LDB(B1, 0, 1); PG8_SCHED; PG8_LDA(At, 0, 0); PG8_STAGE(PG8_SA(1, 1), a1 + hstep, voffA);
            PG8_WAIT_V(8); PG8_WAIT_L(0); PG8_BAR; PG8_MMA(0, 0, At, B0); PG8_MMA(0, 1, At, B1); PG8_BAR; PG8_SCHED;
            PG8_LDA(At, 0, 1); PG8_STAGE(PG8_SB(0, 0), b2, voffB); PG8_STAGE(PG8_SB(0, 1), b2 + hstep, voffB); PG8_STAGE(PG8_SA(0, 0), a2, voffA);
            PG8_WAIT_V(8); PG8_WAIT_L(0); PG8_BAR; PG8_MMA(1, 0, At, B0); PG8_MMA(1, 1, At, B1); PG8_BAR; PG8_SCHED;
            PG8_LDB(B0, 1, 0); PG8_LDB(B1, 1, 1); PG8_SCHED; PG8_LDA(At, 1, 0); PG8_STAGE(PG8_SA(0, 1), a2 + hstep, voffA);
            PG8_WAIT_V(8); PG8_WAIT_L(0); PG8_BAR; PG8_MMA(0, 0, At, B0); PG8_MMA(0, 1, At, B1); PG8_BAR; PG8_SCHED;
            PG8_LDA(At, 1, 1); PG8_STAGE(PG8_SB(1, 0), b3, voffB); PG8_STAGE(PG8_SB(1, 1), b3 + hstep, voffB); PG8_STAGE(PG8_SA(1, 0), a3, voffA);
            PG8_WAIT_V(8); PG8_WAIT_L(0); PG8_BAR; PG8_MMA(1, 0, At, B0); PG8_MMA(1, 1, At, B1); PG8_BAR; PG8_SCHED;
            } else {
            PG8_LDB(B0, 0, 0); PG8_SCHED; PG8_LDA(At, 0, 0); PG8_STAGE(PG8_SA(1, 1), a1 + hstep, voffA);
            PG8_WAIT_L(8); PG8_BAR; PG8_WAIT_L(0); PG8_MMA(0, 0, At, B0); PG8_BAR; PG8_SCHED;
            PG8_LDB(B1, 0, 1); PG8_STAGE(PG8_SB(0, 0), b2, voffB);
            PG8_BAR; PG8_WAIT_L(0); PG8_MMA(0, 1, At, B1); PG8_BAR;
            PG8_LDA(At, 0, 1); PG8_STAGE(PG8_SA(0, 0), a2, voffA);
            PG8_BAR; PG8_WAIT_L(0); PG8_MMA(1, 0, At, B0); PG8_BAR; PG8_SCHED;
            PG8_STAGE(PG8_SB(0, 1), b2 + hstep, voffB);
            PG8_WAIT_V(6); PG8_BAR; PG8_MMA(1, 1, At, B1); PG8_BAR;
            PG8_LDB(B0, 1, 0); PG8_SCHED; PG8_LDA(At, 1, 0); PG8_STAGE(PG8_SA(0, 1), a2 + hstep, voffA);
            PG8_WAIT_L(8); PG8_BAR; PG8_WAIT_L(0); PG8_MMA(0, 0, At, B0); PG8_BAR; PG8_SCHED;
            PG8_LDB(B1, 1, 1); PG8_STAGE(PG8_SB(1, 0), b3, voffB);
            PG8_BAR; PG8_WAIT_L(0); PG8_MMA(0, 1, At, B1); PG8_BAR;
            PG8_LDA(At, 1, 1); PG8_STAGE(PG8_SA(1, 0), a3, voffA);
            PG8_BAR; PG8_WAIT_L(0); PG8_MMA(1, 0, At, B0); PG8_BAR; PG8_SCHED;
            PG8_STAGE(PG8_SB(1, 1), b3 + hstep, voffB);
            PG8_WAIT_V(6); PG8_BAR; PG8_MMA(1, 1, At, B1); PG8_BAR;
            }
        }
        if constexpr (ALIGN_EPI) { if (wr == 0) PG8_BAR; }
        if constexpr (!Epi::AFTER_DRAIN) { E(acc, cur, wr, wc, fr, fq); S.done(cur); }
        if (!has_next) break;
#pragma unroll
        for (int a = 0; a < 2; ++a)
#pragma unroll
            for (int b = 0; b < 2; ++b)
#pragma unroll
                for (int m = 0; m < 4; ++m)
#pragma unroll
                    for (int n = 0; n < 2; ++n) acc[a][b][m][n] = (f32x4){0.f, 0.f, 0.f, 0.f};
        cur = nxt; cA = nA; cB = nB; ++ui;
        if constexpr (ALIGN_EPI) { if (wr == 1) PG8_BAR; }
    }
    PG8_WAIT_V(0);
    if constexpr (!ALIGN_EPI) { if (wr == 0) PG8_BAR; }
    PG8_BAR;
    if constexpr (Epi::AFTER_DRAIN) { E.fused(acc, cur, wr, wc, fr, fq, lds, wid, lane); S.done(cur); }
#undef PG8_SA
#undef PG8_SB
#undef PG8_STAGE
#undef PG8_LDA
#undef PG8_LDB
#undef PG8_MMA
#undef PG8_WAIT_V
#undef PG8_WAIT_L
#undef PG8_BAR
#undef PG8_SCHED
}
}

constexpr int NWAVES = 8;
constexpr int RING_BYTES = 159744, LDSCTL_OFF = RING_BYTES, MISC_OFF = LDSCTL_OFF + 320, LDS_BYTES = 163840;
constexpr int CW_BAR = 4096;
constexpr size_t CTL_ZERO_BYTES = 64 * 1024;
#define GAS __attribute__((address_space(1)))
#define LAS __attribute__((address_space(3)))
typedef unsigned v4u __attribute__((ext_vector_type(4)));
typedef float f32x4 __attribute__((ext_vector_type(4)));
typedef GAS unsigned gu32;
#define LDS_WAIT() asm volatile("s_waitcnt lgkmcnt(0)" ::: "memory")
#define LBAR() do { asm volatile("s_waitcnt lgkmcnt(0)" ::: "memory"); __builtin_amdgcn_s_barrier(); asm volatile("" ::: "memory"); } while (0)
#define VM_WAIT() asm volatile("s_waitcnt vmcnt(0)" ::: "memory")
__device__ __forceinline__ unsigned pk2(float lo, float hi) { return __builtin_bit_cast(unsigned, __builtin_convertvector((nf32x2){lo, hi}, nbf16x2)); }

#define XB_TMO      128
#define XB_XCNT(j)  (256  + 64 * (j))
#define XB_XSUB(j)  (1280 + 64 * (j))
#define XB_XGEN(j)  (2304 + 64 * (j))
#define XB_TOP      3328
#define XB_TOPGEN   3392
#define XCD_BAR_WORDS 3456
#define XB_SPIN_CAP (1u << 22)

__device__ __forceinline__ unsigned xb_ld(unsigned* p)              { return __hip_atomic_load(p, __ATOMIC_RELAXED, __HIP_MEMORY_SCOPE_AGENT); }
__device__ __forceinline__ unsigned xb_add(unsigned* p, unsigned v) { return __hip_atomic_fetch_add(p, v, __ATOMIC_RELAXED, __HIP_MEMORY_SCOPE_AGENT); }
__device__ __forceinline__ unsigned xb_xcc_id() { return (unsigned)__builtin_amdgcn_s_getreg((3 << 11) | 20) & 0xFu; }
#define XB_SPIN(cond, bar) do { unsigned _sp = 0; while (cond) { __builtin_amdgcn_s_sleep(1); \
    if ((++_sp & 255u) == 0u) { if (xb_ld(&(bar)[XB_TMO])) break; if (_sp > XB_SPIN_CAP) { atomicAdd(&(bar)[XB_TMO], 1u); break; } } } } while (0)

struct XcdBarrier {
    unsigned* bar; unsigned x;
    volatile LAS unsigned* st;
};

__device__ __forceinline__ XcdBarrier xcd_barrier_post(unsigned* bar, volatile LAS unsigned* st) {
    XcdBarrier b; b.bar = bar; b.x = xb_xcc_id(); b.st = st;
    if (threadIdx.x == 0) (void)xb_add(&bar[XB_XCNT(b.x)], 1u);
    return b;
}
__device__ __forceinline__ void xcd_barrier_complete(unsigned* bar, unsigned x, unsigned& nloc, unsigned& nx) {
    const unsigned G = gridDim.x * gridDim.y * gridDim.z;
    unsigned sum, cnt, mine, sp = 0u;
    for (;;) {
        sum = 0u; cnt = 0u; mine = 0u;
#pragma unroll
        for (unsigned j = 0; j < 16; ++j) { const unsigned c = xb_ld(&bar[XB_XCNT(j)]); sum += c; cnt += (c > 0u) ? 1u : 0u; mine = (j == x) ? c : mine; }
        if (sum == G) break;
        __builtin_amdgcn_s_sleep(1);
        if ((++sp & 255u) == 0u) { if (xb_ld(&bar[XB_TMO])) break; if (sp > XB_SPIN_CAP) { atomicAdd(&bar[XB_TMO], 1u); break; } }
    }
    nloc = mine > 0u ? mine : 1u; nx = cnt > 0u ? cnt : 1u;
}

__device__ __forceinline__ void xcd_barrier(const XcdBarrier& b) {
    asm volatile("s_waitcnt vmcnt(0)" ::: "memory");
    __syncthreads();
    if (threadIdx.x == 0) {
        unsigned* bar = b.bar;
        __builtin_amdgcn_s_waitcnt(0);
        unsigned nloc = b.st[0], nx = b.st[1];
        if (nloc == 0u) { xcd_barrier_complete(bar, b.x, nloc, nx); b.st[0] = nloc; b.st[1] = nx; }
        const unsigned old = xb_add(&bar[XB_XSUB(b.x)], 1u);
        const unsigned gen = old / nloc;
        if (old + 1u == (gen + 1u) * nloc) {
            __builtin_amdgcn_fence(__ATOMIC_RELEASE, "agent");
            asm volatile("s_waitcnt vmcnt(0)" ::: "memory");
            const unsigned og = xb_add(&bar[XB_TOP], 1u);
            const unsigned tg = og / nx;
            if (og + 1u == (tg + 1u) * nx) xb_add(&bar[XB_TOPGEN], 1u);
            else XB_SPIN(xb_ld(&bar[XB_TOPGEN]) == tg, bar);
            __builtin_amdgcn_fence(__ATOMIC_ACQUIRE, "agent");
            xb_add(&bar[XB_XGEN(b.x)], 1u);
            asm volatile("s_waitcnt vmcnt(0)" ::: "memory");
        } else {
            XB_SPIN(xb_ld(&bar[XB_XGEN(b.x)]) == gen, bar);
            __builtin_amdgcn_fence(__ATOMIC_ACQUIRE, "agent");
            asm volatile("s_waitcnt vmcnt(0)" ::: "memory");
        }
    }
    __syncthreads();
}


struct Frame {
    LAS unsigned char* lds; volatile LAS unsigned* MISC; gu32* ctl;
    int tid, lane, wave, vcu, G;
    Ptrs p;
    __device__ __forceinline__ void refresh() { int t = threadIdx.x; asm volatile("" : "+v"(t)); tid = t; lane = t & 63; wave = __builtin_amdgcn_readfirstlane(t >> 6); }
};

__device__ __forceinline__ void transpose_item(const float* W, int ld, bf16_t* WT, LAS float* scr, int k0, int lane) {
    float tv[32];
#pragma unroll
    for (int i = 0; i < 32; ++i) tv[i] = W[(size_t)(k0 + 2 * i + (lane >> 5)) * ld + (lane & 31)];
#pragma unroll
    for (int i = 0; i < 32; ++i) scr[(2 * i + (lane >> 5)) * 33 + (lane & 31)] = tv[i];
    LDS_WAIT(); asm volatile("" ::: "memory");
    const int c = lane & 7;
#pragma unroll
    for (int j = 0; j < 4; ++j) { const int n = (lane >> 3) + 8 * j; const LAS float* s = scr + (8 * c) * 33 + n;
        v4u o; o.x = pk2(s[0 * 33], s[1 * 33]); o.y = pk2(s[2 * 33], s[3 * 33]); o.z = pk2(s[4 * 33], s[5 * 33]); o.w = pk2(s[6 * 33], s[7 * 33]);
        *(GAS v4u*)(WT + (size_t)n * DM + k0 + 8 * c) = o; }
    LDS_WAIT(); asm volatile("" ::: "memory");
}
__device__ __forceinline__ void convert_weights(Frame& F, int l, int gw, int NGW) {
    const Ptrs& p = F.p;
    LAS float* scr = (LAS float*)(F.lds + F.wave * 16384);
    constexpr int I_IN = 16 * (NPC / 32), I_OUT = 16 * (DM / 32), I_L = I_IN + I_OUT;
    for (int it = gw; it < I_L; it += NGW) { int r = it;
        if (r < I_IN) { const int kb = r / (NPC / 32), nb = r % (NPC / 32), n0 = 32 * nb;
            transpose_item(p.w_in + (size_t)l * DM * INC + c_tile_col[n0 >> 8] + (n0 & 255), INC, (bf16_t*)(p.ws + WS_WIN) + ((size_t)l * NPC + n0) * DM, scr, 64 * kb, F.lane); }
        else { r -= I_IN; const int kb = r / (DM / 32), nb = r % (DM / 32), n0 = 32 * nb;
            transpose_item(p.w_out + (size_t)l * DM * DM + n0, DM, (bf16_t*)(p.ws + WS_WOUT) + ((size_t)l * DM + n0) * DM, scr, 64 * kb, F.lane); }
    }
}
__device__ __forceinline__ void mod_item(Frame& F, int l, int slab) {
    const Ptrs& p = F.p; const int n0 = slab * 64;
    LAS float* s = (LAS float*)F.lds;
    LAS float* red = s + 17 * DM;
    { float cv[34];
#pragma unroll
      for (int j = 0; j < 34; ++j) { const int i = F.tid + j * NWAVES * 64, b = i >> 10, k = i & 1023; cv[j] = b < 16 ? p.c[b * DM + k] : p.c_ctx[k]; }
#pragma unroll
      for (int j = 0; j < 34; ++j) s[F.tid + j * NWAVES * 64] = fsilu(cv[j]); }
    __syncthreads();
    const int kg = F.tid >> 6, col = F.tid & 63;
    float acc[17];
#pragma unroll
    for (int b = 0; b < 17; ++b) acc[b] = 0.f;
    const float* w = p.w_ada + (size_t)l * DM * 3072 + n0 + col;
    for (int k0 = kg * 128; k0 < kg * 128 + 128; k0 += 32) { float wv[32];
#pragma unroll
        for (int kk = 0; kk < 32; ++kk) wv[kk] = w[(size_t)(k0 + kk) * 3072];
#pragma unroll
        for (int kk = 0; kk < 32; ++kk)
#pragma unroll
            for (int b = 0; b < 17; ++b) acc[b] += s[b * DM + k0 + kk] * wv[kk]; }
#pragma unroll
    for (int b = 0; b < 17; ++b) red[(kg * 17 + b) * 64 + col] = acc[b];
    __syncthreads();
    float* mod = (float*)(p.ws + WS_MOD);
    for (int o = F.tid; o < 17 * 64; o += NWAVES * 64) { const int b = o >> 6, cc = o & 63; float sum = p.b_ada[l * 3072 + n0 + cc];
#pragma unroll
        for (int g = 0; g < 8; ++g) sum += red[(g * 17 + b) * 64 + cc];
        mod[(size_t)(l * 17 + b) * 3072 + n0 + cc] = sum; }
    __syncthreads();
}
__device__ __forceinline__ void phase_pre(Frame& F) {
    const Ptrs& p = F.p;
    if (blockIdx.x < 48) mod_item(F, 0, (int)blockIdx.x);
    convert_weights(F, 0, F.vcu * NWAVES + F.wave, F.G * NWAVES);
    { bf16_t* wsb = (bf16_t*)(p.ws + (9u << 20));
      for (int i = F.vcu * NWAVES * 64 + F.tid; i < DEPTH * 4 * 128 * 128 / 4; i += F.G * NWAVES * 64) { const f32x4 v = *(const f32x4*)(p.smlp_w + 4 * (size_t)i);
          unsigned long long o = (unsigned long long)pk2(v.x, v.y) | ((unsigned long long)pk2(v.z, v.w) << 32); *(GAS unsigned long long*)(wsb + 4 * (size_t)i) = o; } }
}

__device__ __forceinline__ void phase_norm(Frame& F, int l) {
    const Ptrs& p = F.p;
    LAS float* wab = (LAS float*)F.lds;
    for (int i = F.tid; i < 16 * DM; i += NWAVES * 64) { const int k = i >> 4, j = i & 15; wab[j * DM + k] = p.w_in[(size_t)l * DM * INC + (size_t)k * INC + 768 + j]; }
    __syncthreads();
    const int gw = F.vcu * NWAVES + F.wave, lane = F.lane;
    constexpr int RPW = MTOT / (256 * NWAVES);
    int curb = -1; f32x4 gs[4], sh[4];
    const int rbeg = gw * RPW, rend = (gw + 1) * RPW < MTOT ? (gw + 1) * RPW : MTOT;
    f32x4 vn[2][4]; int bn[2] = {0, 0};
#define NORM_SRC(r_, b_, src_) do { if ((r_) < MLAT) { b_ = (r_) >> 11; const int tp_ = (r_) & 2047; const int t_ = (l & 1) ? ((tp_ & 31) * 64 + (tp_ >> 5)) : tp_; src_ = (l == 0 ? p.x : p.out) + ((size_t)b_ * SEQ + t_) * DM; } \
        else { b_ = 16; src_ = (l == 0 ? p.ctx : (const float*)(p.ws + WS_XC)) + (size_t)((r_) - MLAT) * DM; } } while (0)
#define NORM_LOAD(r_, slot_) do { if ((r_) < rend) { const float* src_; NORM_SRC(r_, bn[slot_], src_); const GAS f32x4* xr_ = (const GAS f32x4*)src_ + lane; \
        _Pragma("unroll") for (int j = 0; j < 4; ++j) vn[slot_][j] = xr_[64 * j]; } } while (0)
    NORM_LOAD(rbeg, 0); NORM_LOAD(rbeg + 1, 1);
    for (int r0 = rbeg; r0 < rend; r0 += 2) {
#pragma unroll
      for (int u = 0; u < 2; ++u) { const int r = r0 + u; if (r < rend) {
        const int b = bn[u]; f32x4 v[4]; float ss = 0.f;
#pragma unroll
        for (int j = 0; j < 4; ++j) v[j] = vn[u][j];
        NORM_LOAD(r + 2, u);
        if (b != curb) { curb = b; const float* mod = (const float*)(p.ws + WS_MOD) + (size_t)(l * 17 + b) * 3072;
#pragma unroll
            for (int j = 0; j < 4; ++j) { const f32x4 g = *(const f32x4*)(p.norm_g + l * DM + 256 * j + 4 * lane), sc = *(const f32x4*)(mod + 1024 + 256 * j + 4 * lane);
                gs[j] = g * (sc + 1.0f); sh[j] = *(const f32x4*)(mod + 256 * j + 4 * lane); } }
#pragma unroll
        for (int j = 0; j < 4; ++j) { ss += (v[j].x * v[j].x + v[j].y * v[j].y) + (v[j].z * v[j].z + v[j].w * v[j].w); }
        ss = wave_sum(ss);
        const float rstd = 1.0f / sqrtf(ss * (1.0f / DM) + EPS);
        GAS unsigned long long* o8 = (GAS unsigned long long*)((bf16_t*)(p.ws + WS_HY) + (size_t)r * DM) + lane;
#pragma unroll
        for (int j = 0; j < 4; ++j) { v[j] = v[j] * rstd * gs[j] + sh[j]; o8[64 * j] = (unsigned long long)pk2(v[j].x, v[j].y) | ((unsigned long long)pk2(v[j].z, v[j].w) << 32); }
        float acc[16];
#pragma unroll
        for (int n = 0; n < 16; ++n) { float a = 0.f;
#pragma unroll
            for (int j = 0; j < 4; ++j) { const f32x4 w4 = *(const LAS f32x4*)(wab + n * DM + 256 * j + 4 * lane); a += (v[j].x * w4.x + v[j].y * w4.y) + (v[j].z * w4.z + v[j].w * w4.w); }
            acc[n] = a; if ((n & 3) == 3) asm volatile("" ::: "memory"); }
        float r8[8], r4[4], r2[2], r1;
#pragma unroll
        for (int i = 0; i < 8; ++i) { auto q = __builtin_amdgcn_permlane32_swap(__float_as_uint(acc[i]), __float_as_uint(acc[i + 8]), false, false); r8[i] = __uint_as_float(q[0]) + __uint_as_float(q[1]); }
#pragma unroll
        for (int i = 0; i < 4; ++i) { auto q = __builtin_amdgcn_permlane16_swap(__float_as_uint(r8[i]), __float_as_uint(r8[i + 4]), false, false); r4[i] = __uint_as_float(q[0]) + __uint_as_float(q[1]); }
        { const bool up = lane & 8;
#pragma unroll
          for (int i = 0; i < 2; ++i) { const float keep = up ? r4[i + 2] : r4[i], send = up ? r4[i] : r4[i + 2]; r2[i] = keep + dpp_f<0x128>(send); } }
        { const bool up = lane & 4; const float keep = up ? r2[1] : r2[0], send = up ? r2[0] : r2[1]; r1 = keep + __shfl_xor(send, 4); }
        r1 += dpp_f<0x4E>(r1); r1 += dpp_f<0xB1>(r1);
        if ((lane & 3) == 0) ((float*)(p.ws + WS_AB))[(size_t)r * 16 + (lane >> 2)] = r1;
      } }
    }
    __syncthreads();
}

__device__ __forceinline__ void phase_final(Frame& F) {
    const Ptrs& p = F.p; const int lane = F.lane;
    const int gw = F.vcu * NWAVES + F.wave, NGW = F.G * NWAVES;
    f32x4 g[4];
#pragma unroll
    for (int j = 0; j < 4; ++j) g[j] = *(const f32x4*)(p.final_g + 256 * j + 4 * lane);
    f32x4 vn[4];
    if (gw < MLAT) { const GAS f32x4* xr = (const GAS f32x4*)(p.out + (size_t)gw * DM) + lane;
#pragma unroll
        for (int j = 0; j < 4; ++j) vn[j] = xr[64 * j]; }
    for (int r = gw; r < MLAT; r += NGW) {
        GAS f32x4* xr = (GAS f32x4*)(p.out + (size_t)r * DM) + lane;
        f32x4 v[4]; float ss = 0.f;
#pragma unroll
        for (int j = 0; j < 4; ++j) { v[j] = vn[j]; ss += (v[j].x * v[j].x + v[j].y * v[j].y) + (v[j].z * v[j].z + v[j].w * v[j].w); }
        if (r + NGW < MLAT) { const GAS f32x4* xn = (const GAS f32x4*)(p.out + (size_t)(r + NGW) * DM) + lane;
#pragma unroll
            for (int j = 0; j < 4; ++j) vn[j] = xn[64 * j]; }
        ss = wave_sum(ss);
        const float rstd = 1.0f / sqrtf(ss * (1.0f / DM) + EPS);
#pragma unroll
        for (int j = 0; j < 4; ++j) xr[64 * j] = v[j] * rstd * g[j];
    }
}

__device__ __forceinline__ void phase_gemm1(Frame& F, int l) {
    const Ptrs& p = F.p;
    pg8::Gemm g{(const bf16_t*)(p.ws + WS_HY), (const bf16_t*)(p.ws + WS_WIN) + (size_t)l * NPC * DM, MTOT, NPC, DM};
    pg8::StaticOrder S; S.init(MTOT, NPC, F.G, (int)blockIdx.x);
    pg8::EpiP E{(bf16_t*)(p.ws + WS_P), PTILE_ELEMS};
    pg8::gemm_phase<pg8::EpiP, pg8::StaticOrder, true, true>(F.lds, g, S, E);
}
__device__ __forceinline__ void phase_gemm2(Frame& F, int l) {
    const Ptrs& p = F.p;
    const int M = (l == DEPTH - 1) ? MLAT : MTOT;
    pg8::Gemm g{(const bf16_t*)(p.ws + WS_HY), (const bf16_t*)(p.ws + WS_WOUT) + (size_t)l * DM * DM, M, DM, DM};
    pg8::StaticOrder S; S.init(M, DM, F.G, (int)blockIdx.x);
    pg8::EpiResid E{l == 0 ? p.x : p.out, p.out, l == 0 ? p.ctx : (const float*)(p.ws + WS_XC), (float*)(p.ws + WS_XC), (const float*)(p.ws + WS_MOD) + (size_t)l * 17 * 3072, l & 1, MLAT, SEQ, DM};
    pg8::gemm_phase<pg8::EpiResid, pg8::StaticOrder, true, true>(F.lds, g, S, E);
}


typedef short bf16x8 __attribute__((ext_vector_type(8)));
typedef short s16x4 __attribute__((ext_vector_type(4)));
typedef unsigned u32x2 __attribute__((ext_vector_type(2)));
__device__ __forceinline__ float bflo(unsigned w) { return __uint_as_float(w << 16); }
__device__ __forceinline__ float bfhi(unsigned w) { return __uint_as_float(w & 0xffff0000u); }
__device__ __forceinline__ void unpack8(const v4u& w, float (&f)[8]) { f[0] = bflo(w.x); f[1] = bfhi(w.x); f[2] = bflo(w.y); f[3] = bfhi(w.y); f[4] = bflo(w.z); f[5] = bfhi(w.z); f[6] = bflo(w.w); f[7] = bfhi(w.w); }
__device__ __forceinline__ const bf16_t* ptile_d(const Ptrs& p, int t) { return (const bf16_t*)(p.ws + WS_P) + (size_t)t * PTILE_ELEMS; }
constexpr size_t WS_WSB = 9 * MiB;

__device__ __forceinline__ void mix_unit_B(Frame& F, int l, int row0) {
    const Ptrs& p = F.p; const int oct = F.tid & 31, tg = F.tid >> 5;
    int start, len; row_seq(row0, start, len);
    const bf16_t *CG = ptile_d(p, T_CG), *XI = ptile_d(p, T_XI), *BG = ptile_d(p, T_BG), *GB = ptile_d(p, T_GB);
    float w[3][8];
#pragma unroll
    for (int j = 0; j < 3; ++j) { const f32x4 a = *(const f32x4*)(p.short_conv_w + (size_t)(l * 3 + j) * BW + 8 * oct), b = *(const f32x4*)(p.short_conv_w + (size_t)(l * 3 + j) * BW + 8 * oct + 4);
        w[j][0] = a.x; w[j][1] = a.y; w[j][2] = a.z; w[j][3] = a.w; w[j][4] = b.x; w[j][5] = b.y; w[j][6] = b.z; w[j][7] = b.w; }
    const int r0 = row0 + tg * 8;
    float cx[10][8];
    { v4u ca[10], xa[10];
#pragma unroll
      for (int i = 0; i < 10; ++i) { int r = r0 + i - 1; r = r < start ? start : (r >= start + len ? start + len - 1 : r); ca[i] = *(const GAS v4u*)(CG + (size_t)r * 256 + 8 * oct); xa[i] = *(const GAS v4u*)(XI + (size_t)r * 256 + 8 * oct); }
#pragma unroll
      for (int i = 0; i < 10; ++i) { float fa[8], fb[8]; unpack8(ca[i], fa); unpack8(xa[i], fb);
#pragma unroll
          for (int e = 0; e < 8; ++e) cx[i][e] = fa[e] * fb[e]; }
      const bool lo_ok = r0 - 1 >= start, hi_ok = r0 + 8 < start + len;
#pragma unroll
      for (int e = 0; e < 8; ++e) { cx[0][e] = lo_ok ? cx[0][e] : 0.f; cx[9][e] = hi_ok ? cx[9][e] : 0.f; } }
#pragma unroll
    for (int i = 0; i < 8; ++i) { const int r = r0 + i;
        const v4u bgw = *(const GAS v4u*)(BG + (size_t)r * 256 + 8 * oct), gw = *(const GAS v4u*)(GB + (size_t)r * 256 + 8 * oct); float bg[8], gt[8], y[8]; unpack8(bgw, bg); unpack8(gw, gt);
#pragma unroll
        for (int e = 0; e < 8; ++e) y[e] = bg[e] * (w[0][e] * cx[i][e] + w[1][e] * cx[i + 1][e] + w[2][e] * cx[i + 2][e]) * fsilu(gt[e]);
        v4u o; o.x = pk2(y[0], y[1]); o.y = pk2(y[2], y[3]); o.z = pk2(y[4], y[5]); o.w = pk2(y[6], y[7]);
        *(GAS v4u*)((bf16_t*)(p.ws + WS_HY) + (size_t)r * DM + 256 + 8 * oct) = o; }
}

constexpr int MIX_ND = MTOT / 128, MIX_NC = MTOT / 64, MIX_NB = MTOT / 128, MIX_NU = MIX_ND + MIX_NC + MIX_NB, CW_MIXQ = 8192, NPF = 12;
__device__ __forceinline__ void mix_prefetch(Frame& F, int l, int u, v4u (&pf)[NPF]) {
    const Ptrs& p = F.p; const int tid = F.tid, lane = F.lane, wave = F.wave;
    if (u < MIX_ND) {
        const bf16_t* VV = ptile_d(p, T_VV) + (size_t)(u * 128 + wave * 16) * 256 + 4 * lane;
#pragma unroll
        for (int k = 0; k < 8; ++k) { const u32x2 a = *(const GAS u32x2*)(VV + (size_t)(2 * k) * 256), b = *(const GAS u32x2*)(VV + (size_t)(2 * k + 1) * 256); pf[k] = (v4u){a.x, a.y, b.x, b.y}; }
        pf[10] = *(const GAS v4u*)(p.smlp_ln_g + l * BW + 4 * lane); pf[11] = *(const GAS v4u*)(p.smlp_ln_b + l * BW + 4 * lane);
        asm volatile("; PF_D" ::: "memory");
    } else if (u < MIX_ND + MIX_NC) {
        const int row0 = (u - MIX_ND) * 64; int start, len; row_seq(row0, start, len);
        const bf16_t *GA = ptile_d(p, T_GLA), *GLB = ptile_d(p, T_GLB);
#pragma unroll
        for (int k = 0; k < 6; ++k) { const int idx = tid + k * NWAVES * 64, i = idx >> 5, oct = idx & 31; int r = row0 - 15 + i; r = r < start ? start : (r >= start + len ? start + len - 1 : r);
            pf[2 * k] = *(const GAS v4u*)(GA + (size_t)r * 256 + 8 * oct); pf[2 * k + 1] = *(const GAS v4u*)(GLB + (size_t)r * 256 + 8 * oct); }
        asm volatile("; PF_C" ::: "memory");
    }
}
__device__ __forceinline__ f32x4 asf4(const v4u& w) { return __builtin_bit_cast(f32x4, w); }

__device__ __forceinline__ void mix_unit_C(Frame& F, int l, int row0, v4u (&pf)[NPF], int nxt) {
    const Ptrs& p = F.p; const int tid = F.tid, lane = F.lane, wave = F.wave;
    int start, len; row_seq(row0, start, len);
    LAS float* glu = (LAS float*)F.lds;
#pragma unroll
    for (int k = 0; k < 6; ++k) { const int idx = tid + k * NWAVES * 64, i = idx >> 5, oct = idx & 31, r = row0 - 15 + i;
        if (i < 94) { const bool ok = r >= start && r < start + len; float fa[8], fb[8]; unpack8(pf[2 * k], fa); unpack8(pf[2 * k + 1], fb);
            const f32x4 o0 = {ok ? fa[0] * fsigmoid(fb[0]) : 0.f, ok ? fa[1] * fsigmoid(fb[1]) : 0.f, ok ? fa[2] * fsigmoid(fb[2]) : 0.f, ok ? fa[3] * fsigmoid(fb[3]) : 0.f};
            const f32x4 o1 = {ok ? fa[4] * fsigmoid(fb[4]) : 0.f, ok ? fa[5] * fsigmoid(fb[5]) : 0.f, ok ? fa[6] * fsigmoid(fb[6]) : 0.f, ok ? fa[7] * fsigmoid(fb[7]) : 0.f};
            *(LAS f32x4*)(glu + i * 256 + 8 * oct) = o0; *(LAS f32x4*)(glu + i * 256 + 8 * oct + 4) = o1; } }
    float wt[32]; u32x2 gate[8];
#pragma unroll
    for (int j = 0; j < 32; ++j) wt[j] = j < 31 ? p.conf_conv_w[(size_t)(l * 31 + j) * BW + (tid & 255)] : p.conf_conv_b[l * BW + (tid & 255)];
    { const bf16_t* GC = ptile_d(p, T_GC);
#pragma unroll
      for (int i = 0; i < 8; ++i) gate[i] = *(const GAS u32x2*)(GC + (size_t)(row0 + wave * 8 + i) * 256 + 4 * lane); }
    const f32x4 lg = *(const f32x4*)(p.conf_ln_g + l * BW + 4 * lane), lb = *(const f32x4*)(p.conf_ln_b + l * BW + 4 * lane);
    mix_prefetch(F, l, nxt, pf);
    LBAR();
    const int c = tid & 255, th = tid >> 8;
    float z[32];
#pragma unroll
    for (int hb = 0; hb < 2; ++hb) {
        float win[46];
#pragma unroll
        for (int i = 0; i < 46; ++i) win[i] = glu[(th * 32 + hb * 16 + i) * 256 + c];
#pragma unroll
        for (int i = 0; i < 16; ++i) z[hb * 16 + i] = wt[31];
#pragma unroll
        for (int j = 0; j < 31; ++j)
#pragma unroll
            for (int i = 0; i < 16; ++i) z[hb * 16 + i] += wt[j] * win[i + j];
    }
    LBAR();
#pragma unroll
    for (int i = 0; i < 32; ++i) glu[(th * 32 + i) * 256 + c] = z[i];
    LBAR();
#pragma unroll
    for (int i = 0; i < 8; ++i) { const int t = wave * 8 + i, r = row0 + t;
        const f32x4 zz = *(const LAS f32x4*)(glu + t * 256 + 4 * lane);
        const float mean = wave_sum((zz.x + zz.y) + (zz.z + zz.w)) * (1.f / 256.f);
        const f32x4 d = zz - mean;
        const float var = wave_sum((d.x * d.x + d.y * d.y) + (d.z * d.z + d.w * d.w)) * (1.f / 256.f);
        const float rstd = 1.0f / sqrtf(var + EPS);
        const f32x4 ln = d * rstd * lg + lb;
        const u32x2 gw = gate[i];
        u32x2 o; o.x = pk2(fsilu(ln.x) * fsilu(bflo(gw.x)), fsilu(ln.y) * fsilu(bfhi(gw.x))); o.y = pk2(fsilu(ln.z) * fsilu(bflo(gw.y)), fsilu(ln.w) * fsilu(bfhi(gw.y)));
        *(GAS u32x2*)((bf16_t*)(p.ws + WS_HY) + (size_t)r * DM + 512 + 4 * lane) = o; }
    LBAR();
}

__device__ __forceinline__ void mix_unit_D(Frame& F, int l, int row0, v4u (&pf)[NPF], int nxt) {
    const Ptrs& p = F.p; const int lane = F.lane, wave = F.wave;
    constexpr int VS = 528;
    LAS unsigned char* vl = F.lds;
    const bf16_t *U = ptile_d(p, T_U), *GD = ptile_d(p, T_GD);
    const int g = wave >> 1, ph = wave & 1, li = lane & 15, lg4 = lane >> 4;
    bf16x8 wf[4][4];
    { const bf16_t* W = (const bf16_t*)(p.ws + WS_WSB) + (size_t)(l * 4 + g) * 128 * 128;
#pragma unroll
      for (int ks = 0; ks < 4; ++ks)
#pragma unroll
          for (int pt = 0; pt < 4; ++pt) wf[ks][pt] = *(const GAS bf16x8*)(W + (size_t)(64 * ph + 16 * pt + li) * 128 + 32 * ks + 8 * lg4); }
    { const f32x4 lg = asf4(pf[10]), lb = asf4(pf[11]);
#pragma unroll
      for (int i = 0; i < 16; ++i) { const int q = wave * 16 + i; const u32x2 raw = (i & 1) ? (u32x2){pf[i >> 1].z, pf[i >> 1].w} : (u32x2){pf[i >> 1].x, pf[i >> 1].y};
        const f32x4 v = {bflo(raw.x), bfhi(raw.x), bflo(raw.y), bfhi(raw.y)};
        const float mean = wave_sum((v.x + v.y) + (v.z + v.w)) * (1.f / 256.f);
        const f32x4 d = v - mean;
        const float var = wave_sum((d.x * d.x + d.y * d.y) + (d.z * d.z + d.w * d.w)) * (1.f / 256.f);
        const float rstd = 1.0f / sqrtf(var + EPS);
        const f32x4 y = d * rstd * lg + lb;
        u32x2 o; o.x = pk2(y.x, y.y); o.y = pk2(y.z, y.w);
        *(LAS u32x2*)(vl + q * VS + 8 * lane) = o; } }
    LBAR();
    f32x4 acc[4][4];
#pragma unroll
    for (int a = 0; a < 4; ++a)
#pragma unroll
        for (int b = 0; b < 4; ++b) acc[a][b] = (f32x4){0.f, 0.f, 0.f, 0.f};
#pragma unroll
    for (int ks = 0; ks < 4; ++ks) {
        bf16x8 af[4];
#pragma unroll
        for (int ct = 0; ct < 4; ++ct) { LAS unsigned char* a = vl + (32 * ks + 8 * lg4 + (li >> 2)) * VS + (64 * g + 16 * ct + 4 * (li & 3)) * 2;
            const s16x4 lo = __builtin_amdgcn_ds_read_tr16_b64_v4i16((LAS s16x4*)a), hi = __builtin_amdgcn_ds_read_tr16_b64_v4i16((LAS s16x4*)(a + 4 * VS));
            af[ct] = (bf16x8){lo[0], lo[1], lo[2], lo[3], hi[0], hi[1], hi[2], hi[3]}; }
#pragma unroll
        for (int ct = 0; ct < 4; ++ct)
#pragma unroll
            for (int pt = 0; pt < 4; ++pt) acc[ct][pt] = __builtin_amdgcn_mfma_f32_16x16x32_bf16(af[ct], wf[ks][pt], acc[ct][pt], 0, 0, 0);
    }
    u32x2 uw[4][4], gw[4][4]; float bs[4];
#pragma unroll
    for (int pt = 0; pt < 4; ++pt) { const int prow = 64 * ph + 16 * pt + li; const size_t r = (size_t)row0 + prow; bs[pt] = p.smlp_b[(l * 4 + g) * 128 + prow];
#pragma unroll
        for (int ct = 0; ct < 4; ++ct) { const int c = 64 * g + 16 * ct + 4 * lg4; uw[pt][ct] = *(const GAS u32x2*)(U + r * 256 + c); gw[pt][ct] = *(const GAS u32x2*)(GD + r * 256 + c); } }
    mix_prefetch(F, l, nxt, pf);
#pragma unroll
    for (int pt = 0; pt < 4; ++pt) { const int prow = 64 * ph + 16 * pt + li; const size_t r = (size_t)row0 + prow;
#pragma unroll
        for (int ct = 0; ct < 4; ++ct) { const int c = 64 * g + 16 * ct + 4 * lg4;
            const f32x4 m = acc[ct][pt] + bs[pt]; const u32x2 u2 = uw[pt][ct], g2 = gw[pt][ct];
            u32x2 o; o.x = pk2(bflo(u2.x) * m.x * fsilu(bflo(g2.x)), bfhi(u2.x) * m.y * fsilu(bfhi(g2.x))); o.y = pk2(bflo(u2.y) * m.z * fsilu(bflo(g2.y)), bfhi(u2.y) * m.w * fsilu(bfhi(g2.y)));
            *(GAS u32x2*)((bf16_t*)(p.ws + WS_HY) + r * DM + 768 + c) = o; } }
    LBAR();
}

__device__ __forceinline__ void phase_mix(Frame& F, int l) {
    gu32* ctr = F.ctl + CW_MIXQ + 64 * l;
    volatile LAS unsigned* Q = F.MISC;
    unsigned fetched = 0;
    if (F.tid == 0) { Q[0] = __hip_atomic_fetch_add(ctr, 1u, __ATOMIC_RELAXED, __HIP_MEMORY_SCOPE_AGENT); Q[1] = __hip_atomic_fetch_add(ctr, 1u, __ATOMIC_RELAXED, __HIP_MEMORY_SCOPE_AGENT); }
    LBAR();
    int cur = (int)Q[0], nxt = (int)Q[1];
    v4u pf[NPF];
    F.refresh();
    if (cur < MIX_NU) mix_prefetch(F, l, cur, pf);
#define MIX_ROUND(CALL) do { LBAR();   \
        if (F.tid == 0) fetched = __hip_atomic_fetch_add(ctr, 1u, __ATOMIC_RELAXED, __HIP_MEMORY_SCOPE_AGENT);   \
        F.refresh(); CALL; if (F.tid == 0) Q[0] = fetched; LBAR(); cur = nxt; nxt = (int)Q[0]; } while (0)
    while (cur < MIX_ND) MIX_ROUND(mix_unit_D(F, l, cur * 128, pf, nxt));
    while (cur < MIX_ND + MIX_NC) MIX_ROUND(mix_unit_C(F, l, (cur - MIX_ND) * 64, pf, nxt));
    while (cur < MIX_NU) MIX_ROUND(mix_unit_B(F, l, (cur - MIX_ND - MIX_NC) * 128));
#undef MIX_ROUND
}

constexpr size_t WS_REC = 212 * MiB, WS_OB16 = 476 * MiB;
constexpr int REC_BYTES = 53248, R_NW = 0, R_Q = 8192, R_U = 16384, R_VEC = 32768, R_ATTN = 33792, R_KT = 41984;
constexpr int NITEM = 2304;
constexpr int L_Q = 0, L_K = 4352, L_V = 8704, L_GKK = 13056, L_GQK = 17408, L_QB = 21760, L_KB = 24064, L_AO = 21760, L_AD = 26368, L_DF = 28928, L_SM = 30208, L_XS = 0, GS = 68, SMD = 256;

__device__ __forceinline__ float dpp_xor1(float v) { return __int_as_float(__builtin_amdgcn_mov_dpp(__float_as_int(v), 0xB1, 0xF, 0xF, true)); }
__device__ __forceinline__ bf16x8 pack8(const f32x4& a, const f32x4& b) {
    return __builtin_bit_cast(bf16x8, __builtin_convertvector((nf32x8){a.x, a.y, a.z, a.w, b.x, b.y, b.z, b.w}, nbf16x8)); }

__device__ __forceinline__ void prep_decode(int item, int& b, int& h, int& row0) {
    if (item < 2048) { b = item >> 7; h = (item >> 5) & 3; const int n = item & 31; row0 = b * SEQ + 64 * n; }
    else { const int it = item - 2048; b = it >> 4; h = (it >> 2) & 3; const int n = it & 3; row0 = MLAT + b * CTXL + 64 * n; }
}
__device__ __forceinline__ void prep_load(Frame& F, int l, int item, v4u (&raw)[6], float (&abn)[2]) {
    const Ptrs& p = F.p; int b, h, row0; prep_decode(item, b, h, row0); int start, len; row_seq(row0, start, len);
    const int tq = F.tid < 384 ? F.tid : 383, tg = tq / 24, o = tq % 24, part = o >> 3, oo = o & 7;
    const bf16_t* T = ptile_d(p, part) + h * 64 + 8 * oo;
#pragma unroll
    for (int i = 0; i < 6; ++i) { int r = row0 + 4 * tg - 1 + i; r = r < start ? start : (r >= start + len ? start + len - 1 : r); raw[i] = *(const GAS v4u*)(T + (size_t)r * 256); }
    if ((F.wave & 3) == 0) { const int dir = F.wave >> 2, tok = dir ? 63 - F.lane : F.lane; const float* AB = (const float*)(p.ws + WS_AB) + ((size_t)row0 + tok) * 16;
        abn[0] = AB[dir * 4 + h]; abn[1] = AB[8 + dir * 4 + h]; }
}
__device__ __forceinline__ void prep_item(Frame& F, int l, int item, v4u (&raw)[6], float (&abn)[2], int next_item) {
    const Ptrs& p = F.p; const int tid = F.tid, lane = F.lane, wave = F.wave;
    int b, h, row0; prep_decode(item, b, h, row0);
    int start, len; row_seq(row0, start, len);
    LAS float* lf = (LAS float*)F.lds;
    if (tid < 384) { const int tg = tid / 24, o = tid % 24, part = o >> 3, oo = o & 7;
        const float* wc = p.qkv_conv_w + (size_t)l * 3 * 768 + part * 256 + h * 64 + 8 * oo;
        float w[3][8], x[6][8];
#pragma unroll
        for (int j = 0; j < 3; ++j) { const f32x4 w0 = *(const f32x4*)(wc + j * 768), w1 = *(const f32x4*)(wc + j * 768 + 4);
            w[j][0] = w0.x; w[j][1] = w0.y; w[j][2] = w0.z; w[j][3] = w0.w; w[j][4] = w1.x; w[j][5] = w1.y; w[j][6] = w1.z; w[j][7] = w1.w; }
#pragma unroll
        for (int i = 0; i < 6; ++i) unpack8(raw[i], x[i]);
        const bool lo_ok = row0 + 4 * tg - 1 >= start, hi_ok = row0 + 4 * tg + 4 < start + len;
#pragma unroll
        for (int e = 0; e < 8; ++e) { x[0][e] = lo_ok ? x[0][e] : 0.f; x[5][e] = hi_ok ? x[5][e] : 0.f; }
#pragma unroll
        for (int t = 0; t < 4; ++t) { float a[8];
#pragma unroll
            for (int e = 0; e < 8; ++e) a[e] = fsilu(w[0][e] * x[t][e] + w[1][e] * x[t + 1][e] + w[2][e] * x[t + 2][e]);
            LAS float* dst = lf + part * 4352 + (4 * tg + t) * 68 + 8 * oo;
            *(LAS f32x4*)dst = (f32x4){a[0], a[1], a[2], a[3]}; *(LAS f32x4*)(dst + 4) = (f32x4){a[4], a[5], a[6], a[7]}; } }
    if ((wave & 3) == 0) { const int dir = wave >> 2, i = lane;
        const float g = -expf(p.a_log[(l * 2 + dir) * 4 + h]) * softplus_f(abn[0] + p.dt_bias[(l * 2 + dir) * 4 + h]);
        const float beta = sigmoid_f(abn[1]);
        float gc = g;
#pragma unroll
        for (int o = 1; o < 64; o <<= 1) { const float t = __shfl_up(gc, o); if (lane >= o) gc += t; }
        LAS float* sm = lf + L_SM + dir * SMD; const float eg = expf(gc); sm[i] = gc; sm[64 + i] = beta; sm[128 + i] = eg; sm[192 + i] = beta * eg; }
    prep_load(F, l, next_item, raw, abn);
    LBAR();
    { const int row = tid >> 2, part = row >> 6, t = row & 63, qt = tid & 3; LAS float* src = lf + part * 4352 + t * 68 + 16 * qt;
      f32x4 v[4]; float ss = 0.f;
#pragma unroll
      for (int i = 0; i < 4; ++i) { v[i] = *(LAS f32x4*)(src + 4 * i); ss += (v[i].x * v[i].x + v[i].y * v[i].y) + (v[i].z * v[i].z + v[i].w * v[i].w); }
      ss += __shfl_xor(ss, 1); ss += __shfl_xor(ss, 2);
      const float sc = (1.0f / sqrtf(ss + EPS)) * (part == 0 ? 0.125f : 1.0f);
#pragma unroll
      for (int i = 0; i < 4; ++i) { v[i] = v[i] * sc; *(LAS f32x4*)(src + 4 * i) = v[i]; }
      LAS unsigned char* bdst = (LAS unsigned char*)(lf + (part ? L_KB : L_QB)) + t * 144 + 32 * qt;
      v4u o; o.x = pk2(v[0].x, v[0].y); o.y = pk2(v[0].z, v[0].w); o.z = pk2(v[1].x, v[1].y); o.w = pk2(v[1].z, v[1].w); *(LAS v4u*)bdst = o;
      o.x = pk2(v[2].x, v[2].y); o.y = pk2(v[2].z, v[2].w); o.z = pk2(v[3].x, v[3].y); o.w = pk2(v[3].z, v[3].w); *(LAS v4u*)(bdst + 16) = o; }
    LBAR();
    { const int mat = wave >> 2, it = wave & 3, li = lane & 15, g4 = lane >> 4;
      const LAS unsigned char* Ab = (const LAS unsigned char*)(lf + (mat ? L_QB : L_KB)); const LAS unsigned char* Kb = (const LAS unsigned char*)(lf + L_KB);
      bf16x8 af[2];
#pragma unroll
      for (int s2 = 0; s2 < 2; ++s2) af[s2] = *(const LAS bf16x8*)(Ab + (16 * it + li) * 144 + (32 * s2 + 8 * g4) * 2);
      LAS float* G = lf + (mat ? L_GQK : L_GKK);
#pragma unroll
      for (int jt = 0; jt < 4; ++jt) { f32x4 acc = {0.f, 0.f, 0.f, 0.f};
#pragma unroll
          for (int s2 = 0; s2 < 2; ++s2) { const bf16x8 bq = *(const LAS bf16x8*)(Kb + (16 * jt + li) * 144 + (32 * s2 + 8 * g4) * 2); acc = __builtin_amdgcn_mfma_f32_16x16x32_bf16(af[s2], bq, acc, 0, 0, 0); }
#pragma unroll
          for (int r = 0; r < 4; ++r) G[(16 * it + 4 * g4 + r) * GS + 16 * jt + li] = acc[r]; } }
    LBAR();
    const int dir = tid >> 8, td = tid & 255;
    const LAS float* sm = lf + L_SM + dir * SMD;
    unsigned char* rec = p.ws + WS_REC + (size_t)(item * 2 + dir) * REC_BYTES;
    { const int i = td >> 2, jq = td & 3, ti = dir ? 63 - i : i; const float gi = sm[i], bi = sm[64 + i];
      const LAS float* grow = lf + L_GKK + ti * GS + (dir ? 48 - 16 * jq : 16 * jq);
      float gv[16], gc[16];
#pragma unroll
      for (int k = 0; k < 4; ++k) { const f32x4 a = *(const LAS f32x4*)(grow + 4 * k), c = *(const LAS f32x4*)(sm + 16 * jq + 4 * k);
          gv[4 * k] = a.x; gv[4 * k + 1] = a.y; gv[4 * k + 2] = a.z; gv[4 * k + 3] = a.w; gc[4 * k] = c.x; gc[4 * k + 1] = c.y; gc[4 * k + 2] = c.z; gc[4 * k + 3] = c.w; }
      float val[16];
#pragma unroll
      for (int jj = 0; jj < 16; ++jj) { const int j = 16 * jq + jj; const float G = dir ? gv[15 - jj] : gv[jj];
          const float v = bi * G * fexp(fminf(gi - gc[jj], 0.f)); val[jj] = (i > j) ? v : 0.f; }
      { const bool below = jq < (i >> 4);
        v4u o0, o1; o0.x = below ? pk2(-val[0], -val[1]) : 0u; o0.y = below ? pk2(-val[2], -val[3]) : 0u; o0.z = below ? pk2(-val[4], -val[5]) : 0u; o0.w = below ? pk2(-val[6], -val[7]) : 0u;
        o1.x = below ? pk2(-val[8], -val[9]) : 0u; o1.y = below ? pk2(-val[10], -val[11]) : 0u; o1.z = below ? pk2(-val[12], -val[13]) : 0u; o1.w = below ? pk2(-val[14], -val[15]) : 0u;
        LAS unsigned char* ao = (LAS unsigned char*)(lf + L_AO) + dir * 9216 + i * 144 + 32 * jq; *(LAS v4u*)ao = o0; *(LAS v4u*)(ao + 16) = o1; }
      if (jq == (i >> 4)) { LAS float* ad = lf + L_AD + dir * 1280 + (i >> 4) * 320 + (i & 15) * 20;
#pragma unroll
          for (int k = 0; k < 4; ++k) *(LAS f32x4*)(ad + 4 * k) = (f32x4){val[4 * k], val[4 * k + 1], val[4 * k + 2], val[4 * k + 3]}; } }
#pragma unroll
    for (int k = 0; k < 2; ++k) { const int f = td + 256 * k, ms = f >> 6, ll = f & 63, m = ms >> 1, s = ms & 1, rr = 16 * m + (ll & 15), cb = 32 * s + 4 * (ll >> 4);
        float va[8], vq[8], vk[8];
        const int ti = dir ? 63 - rr : rr; const float gi = sm[rr];
#pragma unroll
        for (int hh = 0; hh < 2; ++hh) { const int c0 = cb + 16 * hh;
            const f32x4 g4 = *(const LAS f32x4*)(lf + L_GQK + ti * GS + (dir ? 60 - c0 : c0)), s4 = *(const LAS f32x4*)(sm + c0), q4 = *(const LAS f32x4*)(lf + L_Q + ti * 68 + c0);
            const float gq[4] = {dir ? g4.w : g4.x, dir ? g4.z : g4.y, dir ? g4.y : g4.z, dir ? g4.x : g4.w}, sc[4] = {s4.x, s4.y, s4.z, s4.w}, qq[4] = {q4.x, q4.y, q4.z, q4.w};
#pragma unroll
            for (int e = 0; e < 4; ++e) { const int c = c0 + e, tc = dir ? 63 - c : c;
                const float v = gq[e] * fexp(fminf(gi - sc[e], 0.f)); va[4 * hh + e] = (rr >= c) ? v : 0.f;
                vq[4 * hh + e] = qq[e];
                vk[4 * hh + e] = lf[L_K + tc * 68 + rr]; } }
        v4u o; o.x = pk2(va[0], va[1]); o.y = pk2(va[2], va[3]); o.z = pk2(va[4], va[5]); o.w = pk2(va[6], va[7]); *(GAS v4u*)(rec + R_ATTN + f * 16) = o;
        o.x = pk2(vq[0], vq[1]); o.y = pk2(vq[2], vq[3]); o.z = pk2(vq[4], vq[5]); o.w = pk2(vq[6], vq[7]); *(GAS v4u*)(rec + R_Q + f * 16) = o;
        o.x = pk2(vk[0], vk[1]); o.y = pk2(vk[2], vk[3]); o.z = pk2(vk[4], vk[5]); o.w = pk2(vk[6], vk[7]); *(GAS v4u*)(rec + R_KT + f * 16) = o; }
    if (td < 64) { float* vec = (float*)(rec + R_VEC); vec[td] = sm[128 + td]; vec[64 + td] = expf(sm[63] - sm[td]); if (td == 0) vec[128] = expf(sm[63]); }
    const int li = lane & 15, g4 = lane >> 4, nt0 = 2 * (wave & 3);
    f32x4 Rt[2][4];
#pragma unroll
    for (int t = 0; t < 2; ++t) { const int nt = nt0 + t; const LAS float* src = lf + (nt < 4 ? L_V + 16 * nt + li : L_K + 16 * (nt - 4) + li); const LAS float* scl = sm + (nt < 4 ? 64 : 192);
#pragma unroll
        for (int m = 0; m < 4; ++m) { const f32x4 sc = *(const LAS f32x4*)(scl + 16 * m + 4 * g4); const int i0 = 16 * m + 4 * g4;
            Rt[t][m] = (f32x4){src[(dir ? 63 - i0 : i0) * 68] * sc.x, src[(dir ? 62 - i0 : i0 + 1) * 68] * sc.y, src[(dir ? 61 - i0 : i0 + 2) * 68] * sc.z, src[(dir ? 60 - i0 : i0 + 3) * 68] * sc.w}; } }
    LBAR();
    if ((wave & 3) == 0) { const int blk = lane >> 4, c = lane & 15; const LAS float* Ad = lf + L_AD + dir * 1280 + blk * 320;
        float x[16];
#pragma unroll
        for (int r = 0; r < 16; ++r) x[r] = 0.f;
#pragma unroll
        for (int r = 0; r < 16; ++r) { float acc = (r == c) ? 1.f : 0.f;
#pragma unroll
            for (int q = 0; q < (r + 3) / 4; ++q) { const f32x4 a = *(const LAS f32x4*)(Ad + r * 20 + 4 * q); acc -= (a.x * x[4 * q] + a.y * x[4 * q + 1]) + (a.z * x[4 * q + 2] + a.w * x[4 * q + 3]); }
            x[r] = acc; }
        LAS bf16_t* DF = (LAS bf16_t*)(lf + L_DF) + dir * 1280 + blk * 320;
#pragma unroll
        for (int r = 0; r < 16; ++r) DF[r * 20 + c] = f2bf(x[r]); }
    LBAR();
    { const LAS unsigned char* ao = (const LAS unsigned char*)(lf + L_AO) + dir * 9216; const LAS unsigned char* df = (const LAS unsigned char*)(lf + L_DF) + dir * 2560;
      const f32x4 zero4 = {0.f, 0.f, 0.f, 0.f};
      f32x4 X[2][4];
#pragma unroll
      for (int t = 0; t < 2; ++t)
#pragma unroll
          for (int m = 0; m < 4; ++m) X[t][m] = zero4;
#pragma unroll
      for (int m = 0; m < 4; ++m) {
          const u32x2 dw = *(const LAS u32x2*)(df + m * 640 + li * 40 + g4 * 8);
          const bf16x8 dfrag = __builtin_bit_cast(bf16x8, (v4u){dw.x, dw.y, 0u, 0u});
          f32x4 acc[2] = {Rt[0][m], Rt[1][m]};
#pragma unroll
          for (int s2 = 0; s2 < (m + 1) / 2; ++s2) { const u32x2 lo = *(const LAS u32x2*)(ao + (16 * m + li) * 144 + (32 * s2 + 4 * g4) * 2), hi = *(const LAS u32x2*)(ao + (16 * m + li) * 144 + (32 * s2 + 16 + 4 * g4) * 2);
              const bf16x8 afrag = __builtin_bit_cast(bf16x8, (v4u){lo.x, lo.y, hi.x, hi.y});
#pragma unroll
              for (int t = 0; t < 2; ++t) acc[t] = __builtin_amdgcn_mfma_f32_16x16x32_bf16(afrag, pack8(X[t][2 * s2], X[t][2 * s2 + 1]), acc[t], 0, 0, 0); }
#pragma unroll
          for (int t = 0; t < 2; ++t) X[t][m] = __builtin_amdgcn_mfma_f32_16x16x32_bf16(dfrag, pack8(acc[t], zero4), zero4, 0, 0, 0); }
      LAS float* XS = lf + L_XS + dir * 8448;
#pragma unroll
      for (int t = 0; t < 2; ++t)
#pragma unroll
          for (int m = 0; m < 4; ++m)
#pragma unroll
              for (int r = 0; r < 4; ++r) XS[(16 * m + 4 * g4 + r) * 132 + 16 * (nt0 + t) + li] = X[t][m][r]; }
    LBAR();
    { const LAS float* XS = lf + L_XS + dir * 8448;
#pragma unroll
      for (int k = 0; k < 2; ++k) { const int f = td + 256 * k, ms = f >> 6, ll = f & 63, m = ms >> 1, s = ms & 1, rr = 16 * m + (ll & 15), cb = 32 * s + 4 * (ll >> 4);
          float v[8];
#pragma unroll
          for (int e = 0; e < 8; ++e) v[e] = -XS[rr * 132 + 64 + cb + 16 * (e >> 2) + (e & 3)];
          v4u o; o.x = pk2(v[0], v[1]); o.y = pk2(v[2], v[3]); o.z = pk2(v[4], v[5]); o.w = pk2(v[6], v[7]); *(GAS v4u*)(rec + R_NW + f * 16) = o; }
#pragma unroll
      for (int k = 0; k < 4; ++k) { const int u = td + 256 * k, w = u >> 8, m = (u >> 6) & 3, ll = u & 63, r0 = 16 * m + 4 * (ll >> 4), c = 16 * w + (ll & 15);
          const f32x4 o = {XS[r0 * 132 + c], XS[(r0 + 1) * 132 + c], XS[(r0 + 2) * 132 + c], XS[(r0 + 3) * 132 + c]};
          *(GAS f32x4*)(rec + R_U + u * 16) = o; } }
    LBAR();
}
__device__ __forceinline__ void phase_prep(Frame& F, int l) {
    v4u raw[6]; float abn[2] = {0.f, 0.f};
    F.refresh();
    if (F.vcu < NITEM) prep_load(F, l, F.vcu, raw, abn);
    for (int it = F.vcu; it < NITEM; it += F.G) { F.refresh(); prep_item(F, l, it, raw, abn, it + F.G < NITEM ? it + F.G : it); }
}

__device__ __forceinline__ void scan_rec(int b, int h, int dir, int step, int& cid, int& row0) {
    if (step < 4) { const int n = dir ? 3 - step : step; cid = 2048 + (b * 4 + h) * 4 + n; row0 = MLAT + b * CTXL + 64 * n; }
    else { const int n = dir ? 35 - step : step - 4; cid = (b * 4 + h) * 32 + n; row0 = b * SEQ + 64 * n; }
}
__device__ __forceinline__ void phase_scan(Frame& F, int l) {
    const Ptrs& p = F.p;
    const int bx = (int)blockIdx.x;
    if (bx >= 128) { if (l + 1 < DEPTH) { if (bx < 128 + 48) mod_item(F, l + 1, bx - 128); convert_weights(F, l + 1, (bx - 128) * NWAVES + F.wave, (F.G - 128) * NWAVES); } return; }
    const int s = bx, b = s >> 3, h = (s >> 1) & 3, dir = s & 1, lane = F.lane;
    constexpr int NSTEP = 36, PIECES = REC_BYTES / 1024 / 4;
    if (F.wave >= 4) {
        const int lw = F.wave - 4;
#define SCAN_ISSUE(t_) do { int cid_, row0_; scan_rec(b, h, dir, (t_), cid_, row0_); const unsigned char* rec_ = p.ws + WS_REC + (size_t)(cid_ * 2 + dir) * REC_BYTES + lane * 16; \
            LAS unsigned char* slot_ = F.lds + ((t_) % 3) * REC_BYTES; \
            _Pragma("unroll") for (int k_ = 0; k_ < PIECES; ++k_) { const int pc_ = lw + 4 * k_; \
                __builtin_amdgcn_global_load_lds((const GAS unsigned*)(rec_ + pc_ * 1024), (LAS unsigned*)(slot_ + pc_ * 1024), 16, 0, 0); } } while (0)
        SCAN_ISSUE(0); SCAN_ISSUE(1);
        for (int t = 0; t < NSTEP; ++t) {
            if (t + 1 < NSTEP) asm volatile("s_waitcnt vmcnt(13)" ::: "memory"); else asm volatile("s_waitcnt vmcnt(0)" ::: "memory");
            asm volatile("" ::: "memory"); __builtin_amdgcn_s_barrier(); asm volatile("" ::: "memory");
            if (t + 2 < NSTEP) SCAN_ISSUE(t + 2);
        }
#undef SCAN_ISSUE
        return;
    }
    const int w = F.wave, li = lane & 15, g4 = lane >> 4;
    f32x4 S[4];
#pragma unroll
    for (int m = 0; m < 4; ++m) S[m] = (f32x4){0.f, 0.f, 0.f, 0.f};
    bf16_t* O = (bf16_t*)(p.ws + WS_OB16) + (size_t)dir * MTOT * 256;
    for (int step = 0; step < NSTEP; ++step) {
        int cid, row0; scan_rec(b, h, dir, step, cid, row0);
        asm volatile("s_waitcnt lgkmcnt(0)" ::: "memory"); __builtin_amdgcn_s_barrier(); asm volatile("" ::: "memory");
        const LAS unsigned char* rec = F.lds + (step % 3) * REC_BYTES;
        bf16x8 nw[4][2], qf[4][2], at[4][2], kt[4][2]; f32x4 av[4], ao[4], a2[4], egc4[4], edl4[4];
#pragma unroll
        for (int m = 0; m < 4; ++m) {
#pragma unroll
            for (int s2 = 0; s2 < 2; ++s2) { nw[m][s2] = *(const LAS bf16x8*)(rec + R_NW + ((m * 2 + s2) * 64 + lane) * 16); qf[m][s2] = *(const LAS bf16x8*)(rec + R_Q + ((m * 2 + s2) * 64 + lane) * 16); }
            av[m] = *(const LAS f32x4*)(rec + R_U + ((w * 4 + m) * 64 + lane) * 16); ao[m] = (f32x4){0.f, 0.f, 0.f, 0.f}; }
        const float gl = *(const LAS float*)(rec + R_VEC + 512);
        bf16x8 Bs[2] = {pack8(S[0], S[1]), pack8(S[2], S[3])};
#pragma unroll
        for (int m = 0; m < 4; ++m)
#pragma unroll
            for (int s2 = 0; s2 < 2; ++s2) { av[m] = __builtin_amdgcn_mfma_f32_16x16x32_bf16(nw[m][s2], Bs[s2], av[m], 0, 0, 0); ao[m] = __builtin_amdgcn_mfma_f32_16x16x32_bf16(qf[m][s2], Bs[s2], ao[m], 0, 0, 0); }
#pragma unroll
        for (int m = 0; m < 4; ++m) {
#pragma unroll
            for (int s2 = 0; s2 < 2; ++s2) { at[m][s2] = *(const LAS bf16x8*)(rec + R_ATTN + ((m * 2 + s2) * 64 + lane) * 16); kt[m][s2] = *(const LAS bf16x8*)(rec + R_KT + ((m * 2 + s2) * 64 + lane) * 16); }
            edl4[m] = *(const LAS f32x4*)(rec + R_VEC + 256 + (16 * m + 4 * g4) * 4); egc4[m] = *(const LAS f32x4*)(rec + R_VEC + (16 * m + 4 * g4) * 4); a2[m] = (f32x4){0.f, 0.f, 0.f, 0.f}; }
        bf16x8 Bv[2] = {pack8(av[0], av[1]), pack8(av[2], av[3])};
        bf16x8 Bvs[2] = {pack8(av[0] * edl4[0], av[1] * edl4[1]), pack8(av[2] * edl4[2], av[3] * edl4[3])};
#pragma unroll
        for (int m = 0; m < 4; ++m) S[m] = S[m] * gl;
#pragma unroll
        for (int m = 0; m < 4; ++m)
#pragma unroll
            for (int s2 = 0; s2 < 2; ++s2) { a2[m] = __builtin_amdgcn_mfma_f32_16x16x32_bf16(at[m][s2], Bv[s2], a2[m], 0, 0, 0); S[m] = __builtin_amdgcn_mfma_f32_16x16x32_bf16(kt[m][s2], Bvs[s2], S[m], 0, 0, 0); }
#pragma unroll
        for (int m = 0; m < 4; ++m) { const f32x4 o = egc4[m] * ao[m] + a2[m];
#pragma unroll
            for (int r = 0; r < 4; ++r) { const int i = 16 * m + 4 * g4 + r, tok = dir ? 63 - i : i;
                O[(size_t)(row0 + tok) * 256 + h * 64 + 16 * w + li] = f2bf(o[r]); } }
    }
}

__device__ __forceinline__ void phase_comb(Frame& F, int l) {
    const Ptrs& p = F.p; const int lane = F.lane;
    const int gw = F.vcu * NWAVES + F.wave, NGW = F.G * NWAVES;
    const bf16_t* OF = (const bf16_t*)(p.ws + WS_OB16); const bf16_t* OB = OF + (size_t)MTOT * 256; const bf16_t* GA = ptile_d(p, T_GA);
    const f32x4 ng = *(const f32x4*)(p.gdn_norm_g + l * 64 + 4 * (lane & 15));
    const int nrow = (l == DEPTH - 1) ? MLAT : MTOT;
    u32x2 an, cn, gn;
    if (gw < nrow) { an = *(const GAS u32x2*)(OF + (size_t)gw * 256 + 4 * lane); cn = *(const GAS u32x2*)(OB + (size_t)gw * 256 + 4 * lane); gn = *(const GAS u32x2*)(GA + (size_t)gw * 256 + 4 * lane); }
    for (int r = gw; r < nrow; r += NGW) {
        const u32x2 a = an, c = cn, gt = gn;
        if (r + NGW < nrow) { const size_t r2 = (size_t)(r + NGW); an = *(const GAS u32x2*)(OF + r2 * 256 + 4 * lane); cn = *(const GAS u32x2*)(OB + r2 * 256 + 4 * lane); gn = *(const GAS u32x2*)(GA + r2 * 256 + 4 * lane); }
        const f32x4 o = {bflo(a.x) + bflo(c.x), bfhi(a.x) + bfhi(c.x), bflo(a.y) + bflo(c.y), bfhi(a.y) + bfhi(c.y)};
        float ss = (o.x * o.x + o.y * o.y) + (o.z * o.z + o.w * o.w);
        ss = row16_sum(ss);
        const float rs = 1.0f / sqrtf(ss * (1.f / 64.f) + EPS);
        u32x2 y; y.x = pk2(o.x * rs * ng.x * fsilu(bflo(gt.x)), o.y * rs * ng.y * fsilu(bfhi(gt.x))); y.y = pk2(o.z * rs * ng.z * fsilu(bflo(gt.y)), o.w * rs * ng.w * fsilu(bfhi(gt.y)));
        *(GAS u32x2*)((bf16_t*)(p.ws + WS_HY) + (size_t)r * DM + 4 * lane) = y;
    }
}

constexpr int PH_FINAL = 1 + 7 * DEPTH, PH_END = PH_FINAL + 1;
struct Args { Ptrs p; int ph_lo, ph_hi; };
__global__ void __launch_bounds__(NWAVES * 64, 2) mega(Args args) {
    extern __shared__ __attribute__((aligned(16))) unsigned char lds[];
    Frame F;
    F.lds = (LAS unsigned char*)lds; F.MISC = (volatile LAS unsigned*)(F.lds + MISC_OFF);
    F.tid = threadIdx.x; F.lane = F.tid & 63; F.wave = __builtin_amdgcn_readfirstlane(F.tid >> 6);
    F.G = gridDim.x; { const int bx = blockIdx.x; F.vcu = (F.G % 8 == 0) ? (bx % 8) * (F.G / 8) + bx / 8 : bx; }
    F.p = args.p; F.ctl = (gu32*)(args.p.ws + WS_CTL);
    for (int u = F.tid; u < (LDS_BYTES - LDSCTL_OFF) / 4; u += NWAVES * 64) ((LAS unsigned*)(F.lds + LDSCTL_OFF))[u] = 0u;
    __syncthreads();
    const bool multi = args.ph_hi - args.ph_lo > 1;
    XcdBarrier bar; bar.bar = (unsigned*)(F.ctl + CW_BAR); bar.x = 0; bar.st = nullptr;
    if (multi) bar = xcd_barrier_post((unsigned*)(F.ctl + CW_BAR), F.MISC + 8);
    for (int ph = args.ph_lo; ph < args.ph_hi; ++ph) {
        F.refresh();
#if PROBE_S >= 0
        const bool amp = (PROBE_S == 7) ? (ph == 0) : (PROBE_S == 8) ? (ph == PH_FINAL) : (ph > 0 && ph < PH_FINAL && (ph - 1) % 7 == PROBE_S);
        const unsigned long long t0 = __builtin_amdgcn_s_memrealtime();
#endif
        if (ph == 0) phase_pre(F);
        else if (ph == PH_FINAL) phase_final(F);
        else { const int l = (ph - 1) / 7, s = (ph - 1) % 7;
            if (s == 0) phase_norm(F, l);
            else if (s == 1) phase_gemm1(F, l);
            else if (s == 2) phase_mix(F, l);
            else if (s == 3) phase_prep(F, l);
            else if (s == 4) phase_scan(F, l);
            else if (s == 5) phase_comb(F, l);
            else if (s == 6) phase_gemm2(F, l);
        }
        if (ph + 1 < args.ph_hi) xcd_barrier(bar);
#if PROBE_S >= 0
        if (amp) { const unsigned long long dt = __builtin_amdgcn_s_memrealtime() - t0; while (__builtin_amdgcn_s_memrealtime() - t0 < 2 * dt) __builtin_amdgcn_s_sleep(4); }
#endif
    }
}

extern "C" void kernel_launch(void* const* d_in, const int* in_sizes, int n_in, void* d_out, int out_size, void* d_ws, size_t ws_size, hipStream_t stream) {
    static int grid = 0;
    if (grid == 0) {
        if (n_in != 23 || out_size != MLAT * DM || ws_size < WS_END) { fprintf(stderr, "kernel_launch: unexpected shapes (n_in %d out %d ws %zu)\n", n_in, out_size, ws_size); grid = -1; return; }
        int dev = 0, cus = 0;
        if (hipGetDevice(&dev) != hipSuccess || hipDeviceGetAttribute(&cus, hipDeviceAttributeMultiprocessorCount, dev) != hipSuccess) { grid = -1; return; }
        if (hipFuncSetAttribute((const void*)mega, hipFuncAttributeMaxDynamicSharedMemorySize, LDS_BYTES) != hipSuccess) { fprintf(stderr, "kernel_launch: hipFuncSetAttribute failed\n"); grid = -1; return; }
        grid = cus;
        if (grid != 256) fprintf(stderr, "kernel_launch: %d CUs (built for 256)\n", grid);
    }
    if (grid < 0) return;
    hipMemsetAsync((char*)d_ws + WS_CTL, 0, CTL_ZERO_BYTES, stream);
    Args a{};
    const float** f = (const float**)&a.p;
    for (int i = 0; i < 23; ++i) f[i] = (const float*)d_in[i];
    a.p.out = (float*)d_out; a.p.ws = (unsigned char*)d_ws;
    a.ph_lo = 0; a.ph_hi = PH_END;
    hipLaunchKernelGGL(mega, dim3(grid), dim3(NWAVES * 64), LDS_BYTES, stream, a);
}
```

```cpp
#include <hip/hip_runtime.h>
#ifndef PROBE_S
#define PROBE_S (-1)
#endif
#include <cstdio>
#include <cstdint>

typedef unsigned short bf16_t;
__device__ __forceinline__ float bf2f(bf16_t v) { return __uint_as_float(((unsigned)v) << 16); }
typedef __bf16 nbf16x2 __attribute__((ext_vector_type(2)));
typedef __bf16 nbf16x8 __attribute__((ext_vector_type(8)));
typedef float nf32x2 __attribute__((ext_vector_type(2)));
typedef float nf32x8 __attribute__((ext_vector_type(8)));
__device__ __forceinline__ bf16_t f2bf(float f) { return __builtin_bit_cast(bf16_t, (__bf16)f); }

constexpr int DM = 1024, NB = 16, SEQ = 2048, DEPTH = 4, CTXL = 256, HD = 64, BW = 256, HA = 4;
constexpr int INC = 3600, NPC = 3584, NTILE = 14;
constexpr int MLAT = NB * SEQ, MCTX = NB * CTXL, MTOT = MLAT + MCTX;
constexpr float EPS = 1e-6f;
__device__ __constant__ int c_tile_col[NTILE] = {0, 256, 512, 2576, 784, 1040, 1296, 1552, 1808, 2064, 2320, 2832, 3088, 3344};
enum { T_Q = 0, T_K = 1, T_V = 2, T_GA = 3, T_BG = 4, T_CG = 5, T_XI = 6, T_GLA = 7, T_GLB = 8, T_U = 9, T_VV = 10, T_GB = 11, T_GC = 12, T_GD = 13 };

constexpr size_t MiB = 1u << 20;
constexpr size_t WS_CTL = 0, WS_MOD = 1 * MiB, WS_AB = 2 * MiB, WS_GB = 5 * MiB, WS_STAT = 8 * MiB, WS_XC = 16 * MiB, WS_WIN = 32 * MiB, WS_WOUT = 60 * MiB,
                 WS_HY = 68 * MiB, WS_P = 140 * MiB, WS_OFB = 392 * MiB, WS_END = 512 * MiB;
constexpr size_t PTILE_ELEMS = (size_t)MTOT * 256;
constexpr size_t WS_QKV = WS_P + 4 * PTILE_ELEMS * 2;

struct Ptrs {
    const float *x, *c, *ctx, *c_ctx, *norm_g, *w_ada, *b_ada, *w_in, *qkv_conv_w, *a_log, *dt_bias, *gdn_norm_g, *short_conv_w, *conf_conv_w, *conf_conv_b,
        *conf_ln_g, *conf_ln_b, *smlp_ln_g, *smlp_ln_b, *smlp_w, *smlp_b, *w_out, *final_g;
    float* out; unsigned char* ws;
};

__device__ __forceinline__ float silu_f(float x) { return x / (1.f + expf(-x)); }
__device__ __forceinline__ float sigmoid_f(float x) { return 1.f / (1.f + expf(-x)); }
__device__ __forceinline__ float softplus_f(float x) { return x > 20.f ? x : log1pf(expf(x)); }
__device__ __forceinline__ float fexp(float x) { return __builtin_amdgcn_exp2f(x * 1.44269504089f); }
__device__ __forceinline__ float fsigmoid(float x) { return __builtin_amdgcn_rcpf(1.f + fexp(-x)); }
__device__ __forceinline__ float fsilu(float x) { return x * fsigmoid(x); }

__device__ __forceinline__ float block_sum256(float v, float* red) {
#pragma unroll
    for (int o = 32; o > 0; o >>= 1) v += __shfl_xor(v, o);
    __syncthreads();
    if ((threadIdx.x & 63) == 0) red[threadIdx.x >> 6] = v;
    __syncthreads();
    return red[0] + red[1] + red[2] + red[3];
}
template <int CTRL> __device__ __forceinline__ float dpp_f(float v) { return __int_as_float(__builtin_amdgcn_mov_dpp(__float_as_int(v), CTRL, 0xF, 0xF, true)); }
__device__ __forceinline__ float row16_sum(float v) {
    v += dpp_f<0xB1>(v); v += dpp_f<0x4E>(v); v += dpp_f<0x141>(v); v += dpp_f<0x140>(v); return v; }
__device__ __forceinline__ float wave_sum(float v) {
    v = row16_sum(v);
    { auto r = __builtin_amdgcn_permlane16_swap(__float_as_uint(v), __float_as_uint(v), false, false); v = __uint_as_float(r[0]) + __uint_as_float(r[1]); }
    { auto r = __builtin_amdgcn_permlane32_swap(__float_as_uint(v), __float_as_uint(v), false, false); v = __uint_as_float(r[0]) + __uint_as_float(r[1]); }
    return v; }

__device__ __forceinline__ void row_seq(int row, int& start, int& len) { if (row < MLAT) { start = row & ~(SEQ - 1); len = SEQ; } else { start = row & ~(CTXL - 1); len = CTXL; } }

namespace pg8 {
#define PG8_LAS __attribute__((address_space(3)))
typedef unsigned short bf16_t;
typedef short bf16x8 __attribute__((ext_vector_type(8)));
typedef float f32x4 __attribute__((ext_vector_type(4)));
typedef unsigned u32x4 __attribute__((ext_vector_type(4)));
constexpr int BM = 256, BK = 64, HALF = 128, HTB = HALF * BK * 2  , STAGE_BYTES = 8 * HTB, NXCD = 8, WGM = 8;

__host__ __device__ __forceinline__ int lds_byte(int r, int c) { const int st = (r >> 4) * 2 + (c >> 5), rr = r & 15, cc = c & 31, ob = rr * 64 + cc * 2; return st * 1024 + (ob ^ (((ob >> 9) & 1) << 5)); }
__host__ __device__ __forceinline__ void stage_rc(int b, int& R, int& C) { const int st = b / 1024, sb = b % 1024, swz = sb ^ (((sb >> 9) & 1) << 5); R = (st >> 1) * 16 + swz / 64; C = (st & 1) * 32 + (swz % 64) / 2; }
__host__ __device__ __forceinline__ int perm32(int rho) { const int n = rho >> 4, i = rho & 15; return 8 * (i >> 2) + 4 * n + (i & 3); }

struct Unit { int pm, pn; };
struct Gemm { const bf16_t* A; const bf16_t* Bt; int M, N, K; };

struct StaticOrder {
    int nM, nN, nwg, G, c;
    __host__ __device__ void init(int M, int N, int G_, int c_) { nM = M / BM; nN = N / BM; nwg = nM * nN; G = G_; c = c_; }
    __host__ __device__ bool next(int i, Unit& u) const {
        const long L = (long)i * G + c; if (L >= nwg) return false;
        int wgid = (int)L; { const int q = nwg / NXCD, r = nwg % NXCD, xcd = wgid % NXCD, off = wgid / NXCD; wgid = (xcd < r ? xcd * (q + 1) : r * (q + 1) + (xcd - r) * q) + off; }
        const int nig = WGM * nN, gid = wgid / nig, fm = gid * WGM, gsz = (nM - fm) < WGM ? (nM - fm) : WGM;
        u.pm = fm + ((wgid % nig) % gsz); u.pn = (wgid % nig) / gsz; return true;
    }
    __device__ __forceinline__ void a_ready(const Unit&) const {}
    __device__ __forceinline__ void done(const Unit&) const {}
};


__device__ __forceinline__ unsigned cvt_pk_bf16(float lo, float hi) { return __builtin_bit_cast(unsigned, __builtin_convertvector((nf32x2){lo, hi}, nbf16x2)); }
struct EpiP {
    static constexpr bool PERM = true, AFTER_DRAIN = false;
    bf16_t* P; size_t tile_elems;
    __device__ __forceinline__ void operator()(const f32x4 (&acc)[2][2][4][2], const Unit& u, int wr, int wc, int fr, int fq) const {
        const int row0 = u.pm * BM + wr * 64 + fr;
        bf16_t* base = P + (size_t)u.pn * tile_elems + wc * 32 + 8 * fq;
#pragma unroll
        for (int ai = 0; ai < 2; ++ai)
#pragma unroll
            for (int m = 0; m < 4; ++m) { bf16_t* rowp = base + (size_t)(row0 + ai * HALF + m * 16) * 256;
#pragma unroll
                for (int bj = 0; bj < 2; ++bj) { const f32x4 v0 = acc[ai][bj][m][0], v1 = acc[ai][bj][m][1];
                    u32x4 w; w.x = cvt_pk_bf16(v0[0], v0[1]); w.y = cvt_pk_bf16(v0[2], v0[3]); w.z = cvt_pk_bf16(v1[0], v1[1]); w.w = cvt_pk_bf16(v1[2], v1[3]);
                    *(u32x4*)(rowp + bj * HALF) = w; } }
    }
};
struct OneUnit {
    Unit u0;
    __device__ __forceinline__ bool next(int i, Unit& u) const { if (i != 0) return false; u = u0; return true; }
    __device__ __forceinline__ void a_ready(const Unit&) const {}
    __device__ __forceinline__ void done(const Unit&) const {}
};
struct EpiResid {
    static constexpr bool PERM = true, AFTER_DRAIN = false;
    const void* x_old; bf16_t* x_new; const void* xc_old; bf16_t* xc_new; const float* mod_l; int odd, mlat, seq, dm, f32in, row_off;
    __device__ __forceinline__ void operator()(f32x4 (&acc)[2][2][4][2], const Unit& u, int wr, int wc, int fr, int fq) const {
        const int rbase = row_off + u.pm * BM; const bool lat = rbase < mlat; const int b = lat ? rbase / seq : 16;
        const int col = u.pn * BM + wc * 32 + 8 * fq;
        { const float* gate = mod_l + (size_t)b * 3072 + 2048 + col;
#pragma unroll
          for (int bj = 0; bj < 2; ++bj)
#pragma unroll
            for (int n = 0; n < 2; ++n) { const f32x4 g = *(const f32x4*)(gate + bj * HALF + 4 * n);
#pragma unroll
                for (int ai = 0; ai < 2; ++ai)
#pragma unroll
                    for (int m = 0; m < 4; ++m) acc[ai][bj][m][n] = acc[ai][bj][m][n] * g; } }
        const void* ob = lat ? x_old : xc_old; bf16_t* nb = lat ? x_new : xc_new;
#pragma unroll
        for (int ai = 0; ai < 2; ++ai)
#pragma unroll
          for (int mh = 0; mh < 2; ++mh) {
            f32x4 o[2][2][2]; unsigned offs[2];
#pragma unroll
            for (int mm = 0; mm < 2; ++mm) { const int r = rbase + ai * HALF + wr * 64 + (2 * mh + mm) * 16 + fr;
                if (lat) { const int tp = r % seq; const int t = odd ? ((tp & 31) * 64 + (tp >> 5)) : tp; offs[mm] = (unsigned)(((r / seq) * seq + t) * dm + col); }
                else offs[mm] = (unsigned)((r - mlat) * dm + col); }
            if (f32in) {
#pragma unroll
                for (int mm = 0; mm < 2; ++mm)
#pragma unroll
                    for (int bj = 0; bj < 2; ++bj)
#pragma unroll
                        for (int n = 0; n < 2; ++n) o[mm][bj][n] = *(const f32x4*)((const float*)ob + offs[mm] + bj * HALF + 4 * n);
            } else {
#pragma unroll
                for (int mm = 0; mm < 2; ++mm)
#pragma unroll
                    for (int bj = 0; bj < 2; ++bj) { const u32x4 w = *(const u32x4*)((const bf16_t*)ob + offs[mm] + bj * HALF);
                        o[mm][bj][0] = (f32x4){__uint_as_float(w.x << 16), __uint_as_float(w.x & 0xffff0000u), __uint_as_float(w.y << 16), __uint_as_float(w.y & 0xffff0000u)};
                        o[mm][bj][1] = (f32x4){__uint_as_float(w.z << 16), __uint_as_float(w.z & 0xffff0000u), __uint_as_float(w.w << 16), __uint_as_float(w.w & 0xffff0000u)}; }
            }
#pragma unroll
            for (int mm = 0; mm < 2; ++mm)
#pragma unroll
                for (int bj = 0; bj < 2; ++bj) { const f32x4 v0 = o[mm][bj][0] + acc[ai][bj][2 * mh + mm][0], v1 = o[mm][bj][1] + acc[ai][bj][2 * mh + mm][1];
                    u32x4 w; w.x = cvt_pk_bf16(v0[0], v0[1]); w.y = cvt_pk_bf16(v0[2], v0[3]); w.z = cvt_pk_bf16(v1[0], v1[1]); w.w = cvt_pk_bf16(v1[2], v1[3]);
                    *(u32x4*)(nb + offs[mm] + bj * HALF) = w; }
            asm volatile("" ::: "memory");
          }
    }
};
template <class Epi, class Sched, bool ALIGN_EPI = false, bool SP2 = false>
__device__ __forceinline__ void gemm_phase(PG8_LAS unsigned char* lds, const Gemm g, const Sched& S, const Epi& E) {
    int tid_ = threadIdx.x; asm volatile("" : "+v"(tid_));
    const int tid = tid_, wid = __builtin_amdgcn_readfirstlane(tid >> 6), lane = tid & 63, wr = wid >> 2, wc = wid & 3, fr = lane & 15, fq = lane >> 4;
    const int K = g.K, nt = K / BK;
    unsigned voffA[2], voffB[2];
#pragma unroll
    for (int i = 0; i < 2; ++i) { int R, C; stage_rc(tid * 16 + i * 8192, R, C); const int Rb = Epi::PERM ? ((R & ~31) + perm32(R & 31)) : R;
        voffA[i] = (unsigned)(R * K + C) * 2u; voffB[i] = (unsigned)(Rb * K + C) * 2u; }
    const size_t kstep = (size_t)(BK * 2);
    const size_t hstep = (size_t)HALF * K * 2;
    const size_t tstep = 2 * hstep;
    const unsigned ldsw = (unsigned)wid * 1024u;
    const int aoff = lds_byte(wr * 64 + fr, fq * 8), boff = lds_byte(wc * 32 + fr, fq * 8);
#define PG8_SA(b, h) (((b) * 2 + (h)) * HTB)
#define PG8_SB(b, h) ((4 + (b) * 2 + (h)) * HTB)
#define PG8_STAGE(bufoff, gbase, voff) do { _Pragma("unroll") for (int _i = 0; _i < 2; ++_i) \
        __builtin_amdgcn_global_load_lds((const unsigned*)((const char*)(gbase) + (voff)[_i]), (PG8_LAS unsigned*)(lds + (bufoff) + ldsw + _i * 8192), 16, 0, 0); } while (0)
#define PG8_LDA(dst, b, h) do { _Pragma("unroll") for (int m = 0; m < 4; ++m) _Pragma("unroll") for (int k = 0; k < 2; ++k) dst[m][k] = *(const PG8_LAS bf16x8*)(lds + PG8_SA(b, h) + aoff + m * 2048 + k * 1024); } while (0)
#define PG8_LDB(dst, b, h) do { _Pragma("unroll") for (int n = 0; n < 2; ++n) _Pragma("unroll") for (int k = 0; k < 2; ++k) dst[n][k] = *(const PG8_LAS bf16x8*)(lds + PG8_SB(b, h) + boff + n * 2048 + k * 1024); } while (0)
#define PG8_MMA(ai, bj, At, Bt) do { __builtin_amdgcn_s_setprio(1); _Pragma("unroll") for (int m = 0; m < 4; ++m) _Pragma("unroll") for (int n = 0; n < 2; ++n) _Pragma("unroll") for (int k = 0; k < 2; ++k) \
        acc[ai][bj][m][n] = __builtin_amdgcn_mfma_f32_16x16x32_bf16(Bt[n][k], At[m][k], acc[ai][bj][m][n], 0, 0, 0); __builtin_amdgcn_s_setprio(0); } while (0)
#define PG8_WAIT_V(n) asm volatile("s_waitcnt vmcnt(" #n ")" ::: "memory")
#define PG8_WAIT_L(n) asm volatile("s_waitcnt lgkmcnt(" #n ")" ::: "memory")
#define PG8_BAR __builtin_amdgcn_s_barrier()
#define PG8_SCHED __builtin_amdgcn_sched_barrier(0)
    Unit cur, nxt; int ui = 0;
    if (!S.next(0, cur)) return;
    f32x4 acc[2][2][4][2];
#pragma unroll
    for (int a = 0; a < 2; ++a)
#pragma unroll
        for (int b = 0; b < 2; ++b)
#pragma unroll
            for (int m = 0; m < 4; ++m)
#pragma unroll
                for (int n = 0; n < 2; ++n) acc[a][b][m][n] = (f32x4){0.f, 0.f, 0.f, 0.f};
    bf16x8 At[4][2], B0[2][2], B1[2][2];
    const char* cA = (const char*)g.A + (size_t)cur.pm * tstep; const char* cB = (const char*)g.Bt + (size_t)cur.pn * tstep;
    S.a_ready(cur);
    if constexpr (SP2) {
        PG8_STAGE(PG8_SB(0, 0), cB, voffB); PG8_STAGE(PG8_SB(0, 1), cB + hstep, voffB); PG8_STAGE(PG8_SA(0, 0), cA, voffA); PG8_STAGE(PG8_SA(0, 1), cA + hstep, voffA);
        if (wr == 1) PG8_BAR;
        PG8_WAIT_V(2); PG8_BAR;
        PG8_STAGE(PG8_SB(1, 0), cB + kstep, voffB); PG8_STAGE(PG8_SA(1, 0), cA + kstep, voffA); PG8_STAGE(PG8_SB(1, 1), cB + hstep + kstep, voffB);
        PG8_WAIT_V(6); PG8_BAR;
    } else {
        PG8_STAGE(PG8_SB(0, 0), cB, voffB); PG8_STAGE(PG8_SA(0, 0), cA, voffA); PG8_STAGE(PG8_SB(0, 1), cB + hstep, voffB); PG8_STAGE(PG8_SA(0, 1), cA + hstep, voffA);
        if (wr == 1) PG8_BAR;
        PG8_WAIT_V(4); PG8_BAR;
        PG8_STAGE(PG8_SB(1, 0), cB + kstep, voffB); PG8_STAGE(PG8_SA(1, 0), cA + kstep, voffA); PG8_STAGE(PG8_SB(1, 1), cB + hstep + kstep, voffB);
        PG8_WAIT_V(6); PG8_BAR;
    }
    for (;;) {
        const bool has_next = S.next(ui + 1, nxt);
        const char* nA = has_next ? (const char*)g.A + (size_t)nxt.pm * tstep : cA; const char* nB = has_next ? (const char*)g.Bt + (size_t)nxt.pn * tstep : cB;
        for (int t = 0; t < nt; t += 2) {
            const bool last = (t == nt - 2);
            const char* a1 = cA + (size_t)(t + 1) * kstep;
            const char* a2 = last ? nA : cA + (size_t)(t + 2) * kstep; const char* b2 = last ? nB : cB + (size_t)(t + 2) * kstep;
            const char* a3 = a2 + kstep; const char* b3 = b2 + kstep;
            if (last && has_next) S.a_ready(nxt);
            if constexpr (SP2) {
            PG8_LDB(B0, 0, 0); PG8_LDB(B1, 0, 1); PG8_SCHED; PG8_LDA(At, 0, 0); PG8_STAGE(PG8_SA(1, 1), a1 + hstep, voffA);
            PG8_WAIT_V(8); PG8_WAIT_L(0); PG8_BAR; PG8_MMA(0, 0, At, B0); PG8_MMA(0, 1, At, B1); PG8_BAR; PG8_SCHED;
            PG8_LDA(At, 0, 1); PG8_STAGE(PG8_SB(0, 0), b2, voffB); PG8_STAGE(PG8_SB(0, 1), b2 + hstep, voffB); PG8_STAGE(PG8_SA(0, 0), a2, voffA);
            PG8_WAIT_V(8); PG8_WAIT_L(0); PG8_BAR; PG8_MMA(1, 0, At, B0); PG8_MMA(1, 1, At, B1); PG8_BAR; PG8_SCHED;
            PG8_LDB(B0, 1, 0); PG8_LDB(B1, 1, 1); PG8_SCHED; PG8_LDA(At, 1, 0); PG8_STAGE(PG8_SA(0, 1), a2 + hstep, voffA);
            PG8_WAIT_V(8); PG8_WAIT_L(0); PG8_BAR; PG8_MMA(0, 0, At, B0); PG8_MMA(0, 1, At, B1); PG8_BAR; PG8_SCHED;
            PG8_LDA(At, 1, 1); PG8_STAGE(PG8_SB(1, 0), b3, voffB); PG8_STAGE(PG8_SB(1, 1), b3 + hstep, voffB); PG8_STAGE(PG8_SA(1, 0), a3, voffA);
            PG8_WAIT_V(8); PG8_WAIT_L(0); PG8_BAR; PG8_MMA(1, 0, At, B0); PG8_MMA(1, 1, At, B1); PG8_BAR; PG8_SCHED;
            } else {
            PG8_LDB(B0, 0, 0); PG8_SCHED; PG8_LDA(At, 0, 0); PG8_STAGE(PG8_SA(1, 1), a1 + hstep, voffA);
            PG8_WAIT_L(8); PG8_BAR; PG8_WAIT_L(0); PG8_MMA(0, 0, At, B0); PG8_BAR; PG8_SCHED;
            PG8_LDB(B1, 0, 1); PG8_STAGE(PG8_SB(0, 0), b2, voffB);
            PG8_BAR; PG8_WAIT_L(0); PG8_MMA(0, 1, At, B1); PG8_BAR;
            PG8_LDA(At, 0, 1); PG8_STAGE(PG8_SA(0, 0), a2, voffA);
            PG8_BAR; PG8_WAIT_L(0); PG8_MMA(1, 0, At, B0); PG8_BAR; PG8_SCHED;
            PG8_STAGE(PG8_SB(0, 1), b2 + hstep, voffB);
            PG8_WAIT_V(6); PG8_BAR; PG8_MMA(1, 1, At, B1); PG8_BAR;
            PG8_LDB(B0, 1, 0); PG8_SCHED; PG8_LDA(At, 1, 0); PG8_STAGE(PG8_SA(0, 1), a2 + hstep, voffA);
            PG8_WAIT_L(8); PG8_BAR; PG8_WAIT_L(0); PG8_MMA(0, 0, At, B0); PG8_BAR; PG8_SCHED;
            PG8_LDB(B1, 1, 1); PG8_STAGE(PG8_SB(1, 0), b3, voffB);
            PG8_BAR; PG8_WAIT_L(0); PG8_MMA(0, 1, At, B1); PG8_BAR;
            PG8_LDA(At, 1, 1); PG8_STAGE(PG8_SA(1, 0), a3, voffA);
            PG8_BAR; PG8_WAIT_L(0); PG8_MMA(1, 0, At, B0); PG8_BAR; PG8_SCHED;
            PG8_STAGE(PG8_SB(1, 1), b3 + hstep, voffB);
            PG8_WAIT_V(6); PG8_BAR; PG8_MMA(1, 1, At, B1); PG8_BAR;
            }
        }
        if constexpr (ALIGN_EPI) { if (wr == 0) PG8_BAR; }
        if constexpr (!Epi::AFTER_DRAIN) { E(acc, cur, wr, wc, fr, fq); S.done(cur); }
        if (!has_next) break;
#pragma unroll
        for (int a = 0; a < 2; ++a)
#pragma unroll
            for (int b = 0; b < 2; ++b)
#pragma unroll
                for (int m = 0; m < 4; ++m)
#pragma unroll
                    for (int n = 0; n < 2; ++n) acc[a][b][m][n] = (f32x4){0.f, 0.f, 0.f, 0.f};
        cur = nxt; cA = nA; cB = nB; ++ui;
        if constexpr (ALIGN_EPI) { if (wr == 1) PG8_BAR; }
    }
    PG8_WAIT_V(0);
    if constexpr (!ALIGN_EPI) { if (wr == 0) PG8_BAR; }
    PG8_BAR;
    if constexpr (Epi::AFTER_DRAIN) { E.fused(acc, cur, wr, wc, fr, fq, lds, wid, lane); S.done(cur); }
#undef PG8_SA
#undef PG8_SB
#undef PG8_STAGE
#undef PG8_LDA
#undef PG8_LDB
#undef PG8_MMA
#undef PG8_WAIT_V
#undef PG8_WAIT_L
#undef PG8_BAR
#undef PG8_SCHED
}
}

constexpr int NWAVES = 8;
constexpr int RING_BYTES = 159744, LDSCTL_OFF = RING_BYTES, MISC_OFF = LDSCTL_OFF + 320, LDS_BYTES = 163840;
constexpr int CW_BAR = 4096;
constexpr size_t CTL_ZERO_BYTES = 64 * 1024;
#define GAS __attribute__((address_space(1)))
#define LAS __attribute__((address_space(3)))
typedef float f32x4 __attribute__((ext_vector_type(4)));
typedef unsigned v4u __attribute__((ext_vector_type(4)));
typedef unsigned u32x2 __attribute__((ext_vector_type(2)));
__device__ __forceinline__ float bflo(unsigned w) { return __uint_as_float(w << 16); }
__device__ __forceinline__ float bfhi(unsigned w) { return __uint_as_float(w & 0xffff0000u); }
typedef short bf16x8 __attribute__((ext_vector_type(8)));
__device__ __forceinline__ void unpack8(const v4u& w, float (&f)[8]) { f[0] = bflo(w.x); f[1] = bfhi(w.x); f[2] = bflo(w.y); f[3] = bfhi(w.y); f[4] = bflo(w.z); f[5] = bfhi(w.z); f[6] = bflo(w.w); f[7] = bfhi(w.w); }
__device__ __forceinline__ bf16x8 pack8(const f32x4& a, const f32x4& b) {
    return __builtin_bit_cast(bf16x8, __builtin_convertvector((nf32x8){a.x, a.y, a.z, a.w, b.x, b.y, b.z, b.w}, nbf16x8)); }
typedef GAS unsigned gu32;
#define LDS_WAIT() asm volatile("s_waitcnt lgkmcnt(0)" ::: "memory")
#define LBAR() do { asm volatile("s_waitcnt lgkmcnt(0)" ::: "memory"); __builtin_amdgcn_s_barrier(); asm volatile("" ::: "memory"); } while (0)
#define VM_WAIT() asm volatile("s_waitcnt vmcnt(0)" ::: "memory")
__device__ __forceinline__ unsigned pk2(float lo, float hi) { return __builtin_bit_cast(unsigned, __builtin_convertvector((nf32x2){lo, hi}, nbf16x2)); }

#define XB_TMO      128
#define XB_XCNT(j)  (256  + 64 * (j))
#define XB_XSUB(j)  (1280 + 64 * (j))
#define XB_XGEN(j)  (2304 + 64 * (j))
#define XB_TOP      3328
#define XB_TOPGEN   3392
#define XCD_BAR_WORDS 3456
#define XB_SPIN_CAP (1u << 22)

__device__ __forceinline__ unsigned xb_ld(unsigned* p)              { return __hip_atomic_load(p, __ATOMIC_RELAXED, __HIP_MEMORY_SCOPE_AGENT); }
__device__ __forceinline__ unsigned xb_add(unsigned* p, unsigned v) { return __hip_atomic_fetch_add(p, v, __ATOMIC_RELAXED, __HIP_MEMORY_SCOPE_AGENT); }
__device__ __forceinline__ unsigned xb_xcc_id() { return (unsigned)__builtin_amdgcn_s_getreg((3 << 11) | 20) & 0xFu; }
#define XB_SPIN(cond, bar) do { unsigned _sp = 0; while (cond) { __builtin_amdgcn_s_sleep(1); \
    if ((++_sp & 255u) == 0u) { if (xb_ld(&(bar)[XB_TMO])) break; if (_sp > XB_SPIN_CAP) { atomicAdd(&(bar)[XB_TMO], 1u); break; } } } } while (0)

struct XcdBarrier {
    unsigned* bar; unsigned x;
    volatile LAS unsigned* st;
};

__device__ __forceinline__ XcdBarrier xcd_barrier_post(unsigned* bar, volatile LAS unsigned* st) {
    XcdBarrier b; b.bar = bar; b.x = xb_xcc_id(); b.st = st;
    if (threadIdx.x == 0) (void)xb_add(&bar[XB_XCNT(b.x)], 1u);
    return b;
}
__device__ __forceinline__ void xcd_barrier_complete(unsigned* bar, unsigned x, unsigned& nloc, unsigned& nx) {
    const unsigned G = gridDim.x * gridDim.y * gridDim.z;
    unsigned sum, cnt, mine, sp = 0u;
    for (;;) {
        sum = 0u; cnt = 0u; mine = 0u;
#pragma unroll
        for (unsigned j = 0; j < 16; ++j) { const unsigned c = xb_ld(&bar[XB_XCNT(j)]); sum += c; cnt += (c > 0u) ? 1u : 0u; mine = (j == x) ? c : mine; }
        if (sum == G) break;
        __builtin_amdgcn_s_sleep(1);
        if ((++sp & 255u) == 0u) { if (xb_ld(&bar[XB_TMO])) break; if (sp > XB_SPIN_CAP) { atomicAdd(&bar[XB_TMO], 1u); break; } }
    }
    nloc = mine > 0u ? mine : 1u; nx = cnt > 0u ? cnt : 1u;
}

__device__ __forceinline__ void xcd_barrier(const XcdBarrier& b) {
    asm volatile("s_waitcnt vmcnt(0)" ::: "memory");
    __syncthreads();
    if (threadIdx.x == 0) {
        unsigned* bar = b.bar;
        __builtin_amdgcn_s_waitcnt(0);
        unsigned nloc = b.st[0], nx = b.st[1];
        if (nloc == 0u) { xcd_barrier_complete(bar, b.x, nloc, nx); b.st[0] = nloc; b.st[1] = nx; }
        const unsigned old = xb_add(&bar[XB_XSUB(b.x)], 1u);
        const unsigned gen = old / nloc;
        if (old + 1u == (gen + 1u) * nloc) {
            __builtin_amdgcn_fence(__ATOMIC_RELEASE, "agent");
            asm volatile("s_waitcnt vmcnt(0)" ::: "memory");
            const unsigned og = xb_add(&bar[XB_TOP], 1u);
            const unsigned tg = og / nx;
            if (og + 1u == (tg + 1u) * nx) xb_add(&bar[XB_TOPGEN], 1u);
            else XB_SPIN(xb_ld(&bar[XB_TOPGEN]) == tg, bar);
            __builtin_amdgcn_fence(__ATOMIC_ACQUIRE, "agent");
            xb_add(&bar[XB_XGEN(b.x)], 1u);
            asm volatile("s_waitcnt vmcnt(0)" ::: "memory");
        } else {
            XB_SPIN(xb_ld(&bar[XB_XGEN(b.x)]) == gen, bar);
            __builtin_amdgcn_fence(__ATOMIC_ACQUIRE, "agent");
            asm volatile("s_waitcnt vmcnt(0)" ::: "memory");
        }
    }
    __syncthreads();
}


struct Frame {
    LAS unsigned char* lds; volatile LAS unsigned* MISC; gu32* ctl;
    int tid, lane, wave, vcu, G;
    Ptrs p;
    __device__ __forceinline__ void refresh() { int t = threadIdx.x; asm volatile("" : "+v"(t)); tid = t; lane = t & 63; wave = __builtin_amdgcn_readfirstlane(t >> 6); }
};

__device__ __forceinline__ void transpose_item(const float* W, int ld, bf16_t* WT, LAS float* scr, int k0, int lane) {
    float tv[32];
#pragma unroll
    for (int i = 0; i < 32; ++i) tv[i] = W[(size_t)(k0 + 2 * i + (lane >> 5)) * ld + (lane & 31)];
#pragma unroll
    for (int i = 0; i < 32; ++i) scr[(2 * i + (lane >> 5)) * 33 + (lane & 31)] = tv[i];
    LDS_WAIT(); asm volatile("" ::: "memory");
    const int c = lane & 7;
#pragma unroll
    for (int j = 0; j < 4; ++j) { const int n = (lane >> 3) + 8 * j; const LAS float* s = scr + (8 * c) * 33 + n;
        v4u o; o.x = pk2(s[0 * 33], s[1 * 33]); o.y = pk2(s[2 * 33], s[3 * 33]); o.z = pk2(s[4 * 33], s[5 * 33]); o.w = pk2(s[6 * 33], s[7 * 33]);
        *(GAS v4u*)(WT + (size_t)n * DM + k0 + 8 * c) = o; }
    LDS_WAIT(); asm volatile("" ::: "memory");
}
__device__ __forceinline__ void convert_weights(Frame& F, int l, int gw, int NGW) {
    const Ptrs& p = F.p;
    LAS float* scr = (LAS float*)(F.lds + F.wave * 16384);
    constexpr int I_IN = 16 * (NPC / 32), I_OUT = 16 * (DM / 32), I_L = I_IN + I_OUT;
    for (int it = gw; it < I_L; it += NGW) { int r = it;
        if (r < I_IN) { const int kb = r / (NPC / 32), nb = r % (NPC / 32), n0 = 32 * nb;
            transpose_item(p.w_in + (size_t)l * DM * INC + c_tile_col[n0 >> 8] + (n0 & 255), INC, (bf16_t*)(p.ws + WS_WIN) + ((size_t)l * NPC + n0) * DM, scr, 64 * kb, F.lane); }
        else { r -= I_IN; const int kb = r / (DM / 32), nb = r % (DM / 32), n0 = 32 * nb;
            transpose_item(p.w_out + (size_t)l * DM * DM + n0, DM, (bf16_t*)(p.ws + WS_WOUT) + ((size_t)l * DM + n0) * DM, scr, 64 * kb, F.lane); }
    }
}
__device__ __forceinline__ void mod_item(Frame& F, int l, int slab) {
    const Ptrs& p = F.p; const int n0 = slab * 128;
    LAS float* s = (LAS float*)F.lds;
    LAS float* red = s + 17 * DM;
    { float cv[34];
#pragma unroll
      for (int j = 0; j < 34; ++j) { const int i = F.tid + j * NWAVES * 64, b = i >> 10, k = i & 1023; cv[j] = b < 16 ? p.c[b * DM + k] : p.c_ctx[k]; }
#pragma unroll
      for (int j = 0; j < 34; ++j) s[F.tid + j * NWAVES * 64] = fsilu(cv[j]); }
    __syncthreads();
    const int cq = F.tid & 31, kg = F.tid >> 5;
    f32x4 acc[17];
#pragma unroll
    for (int b = 0; b < 17; ++b) acc[b] = (f32x4){0.f, 0.f, 0.f, 0.f};
    const float* w = p.w_ada + (size_t)l * DM * 3072 + n0 + 4 * cq;
#pragma unroll 1
    for (int k0 = kg * 64; k0 < kg * 64 + 64; k0 += 16) { f32x4 wv[16];
#pragma unroll
        for (int kk = 0; kk < 16; ++kk) wv[kk] = *(const f32x4*)(w + (size_t)(k0 + kk) * 3072);
#pragma unroll
        for (int q = 0; q < 4; ++q) {
#pragma unroll
            for (int b = 0; b < 17; ++b) { const f32x4 s4 = *(const LAS f32x4*)(s + b * DM + k0 + 4 * q);
                acc[b] += wv[4 * q] * s4.x + wv[4 * q + 1] * s4.y + wv[4 * q + 2] * s4.z + wv[4 * q + 3] * s4.w; }
            asm volatile("" ::: "memory"); } }
#pragma unroll
    for (int b = 0; b < 17; ++b) {
        float v[4] = {acc[b].x, acc[b].y, acc[b].z, acc[b].w};
#pragma unroll
        for (int e = 0; e < 4; ++e) { auto r = __builtin_amdgcn_permlane32_swap(__float_as_uint(v[e]), __float_as_uint(v[e]), false, false); v[e] = __uint_as_float(r[0]) + __uint_as_float(r[1]); }
        if (F.lane < 32) *(LAS f32x4*)(red + (F.wave * 17 + b) * 128 + 4 * cq) = (f32x4){v[0], v[1], v[2], v[3]}; }
    __syncthreads();
    float* mod = (float*)(p.ws + WS_MOD);
    for (int o = F.tid; o < 17 * 128; o += NWAVES * 64) { const int b = o >> 7, cc = o & 127; float sum = p.b_ada[l * 3072 + n0 + cc];
#pragma unroll
        for (int g = 0; g < 8; ++g) sum += red[(g * 17 + b) * 128 + cc];
        mod[(size_t)(l * 17 + b) * 3072 + n0 + cc] = sum; }
    __syncthreads();
}
__device__ __forceinline__ void phase_pre(Frame& F) {
    const Ptrs& p = F.p;
    if (blockIdx.x < 96) mod_item(F, (int)blockIdx.x / 24, (int)blockIdx.x % 24);
    for (int ll = 0; ll < DEPTH; ++ll) convert_weights(F, ll, F.vcu * NWAVES + F.wave, F.G * NWAVES);
    { bf16_t* wsb = (bf16_t*)(p.ws + (9u << 20));
      for (int i = F.vcu * NWAVES * 64 + F.tid; i < DEPTH * 4 * 128 * 128 / 4; i += F.G * NWAVES * 64) { const f32x4 v = *(const f32x4*)(p.smlp_w + 4 * (size_t)i);
          unsigned long long o = (unsigned long long)pk2(v.x, v.y) | ((unsigned long long)pk2(v.z, v.w) << 32); *(GAS unsigned long long*)(wsb + 4 * (size_t)i) = o; } }
}

__device__ __forceinline__ void norm_wave_rows(Frame& F, int l, const LAS float* wab, int rbeg, int rend) {
    const Ptrs& p = F.p;
    const int lane = F.lane;
    int curb = -1; f32x4 gs[4], sh[4];
    f32x4 vn[2][4]; int bn[2] = {0, 0};
    const bf16_t* const XB = (const bf16_t*)((const char*)p.out + (64u << 20)); const bf16_t* const XCB = (const bf16_t*)(p.ws + WS_XC);
#define NORM_OFF(r_, b_, off_, lat_) do { if ((r_) < MLAT) { b_ = (r_) >> 11; const int tp_ = (r_) & 2047; const int t_ = (l & 1) ? ((tp_ & 31) * 64 + (tp_ >> 5)) : tp_; off_ = ((size_t)b_ * SEQ + t_) * DM; lat_ = true; } \
        else { b_ = 16; off_ = (size_t)((r_) - MLAT) * DM; lat_ = false; } } while (0)
#define NORM_LOAD(r_, slot_) do { if ((r_) < rend) { size_t off_; bool lat_; NORM_OFF(r_, bn[slot_], off_, lat_); \
        if (l == 0) { const GAS f32x4* xr_ = (const GAS f32x4*)((lat_ ? p.x : p.ctx) + off_) + lane; _Pragma("unroll") for (int j = 0; j < 4; ++j) vn[slot_][j] = xr_[64 * j]; } \
        else { const GAS u32x2* xr_ = (const GAS u32x2*)((lat_ ? XB : XCB) + off_) + lane; _Pragma("unroll") for (int j = 0; j < 4; ++j) { const u32x2 w_ = xr_[64 * j]; vn[slot_][j] = (f32x4){bflo(w_.x), bfhi(w_.x), bflo(w_.y), bfhi(w_.y)}; } } } } while (0)
    NORM_LOAD(rbeg, 0); NORM_LOAD(rbeg + 1, 1);
    for (int r0 = rbeg; r0 < rend; r0 += 2) {
#pragma unroll
      for (int u = 0; u < 2; ++u) { const int r = r0 + u; if (r < rend) {
        const int b = bn[u]; f32x4 v[4]; float ss = 0.f;
#pragma unroll
        for (int j = 0; j < 4; ++j) v[j] = vn[u][j];
        NORM_LOAD(r + 2, u);
        if (b != curb) { curb = b; const float* mod = (const float*)(p.ws + WS_MOD) + (size_t)(l * 17 + b) * 3072;
#pragma unroll
            for (int j = 0; j < 4; ++j) { const f32x4 g = *(const f32x4*)(p.norm_g + l * DM + 256 * j + 4 * lane), sc = *(const f32x4*)(mod + 1024 + 256 * j + 4 * lane);
                gs[j] = g * (sc + 1.0f); sh[j] = *(const f32x4*)(mod + 256 * j + 4 * lane); } }
#pragma unroll
        for (int j = 0; j < 4; ++j) { ss += (v[j].x * v[j].x + v[j].y * v[j].y) + (v[j].z * v[j].z + v[j].w * v[j].w); }
        ss = wave_sum(ss);
        const float rstd = 1.0f / sqrtf(ss * (1.0f / DM) + EPS);
        GAS unsigned long long* o8 = (GAS unsigned long long*)((bf16_t*)(p.ws + WS_HY) + (size_t)r * DM) + lane;
#pragma unroll
        for (int j = 0; j < 4; ++j) { v[j] = v[j] * rstd * gs[j] + sh[j]; o8[64 * j] = (unsigned long long)pk2(v[j].x, v[j].y) | ((unsigned long long)pk2(v[j].z, v[j].w) << 32); }
        float acc[16];
#pragma unroll
        for (int n = 0; n < 16; ++n) { float a = 0.f;
#pragma unroll
            for (int j = 0; j < 4; ++j) { const f32x4 w4 = *(const LAS f32x4*)(wab + n * DM + 256 * j + 4 * lane); a += (v[j].x * w4.x + v[j].y * w4.y) + (v[j].z * w4.z + v[j].w * w4.w); }
            acc[n] = a; if ((n & 3) == 3) asm volatile("" ::: "memory"); }
        float r8[8], r4[4], r2[2], r1;
#pragma unroll
        for (int i = 0; i < 8; ++i) { auto q = __builtin_amdgcn_permlane32_swap(__float_as_uint(acc[i]), __float_as_uint(acc[i + 8]), false, false); r8[i] = __uint_as_float(q[0]) + __uint_as_float(q[1]); }
#pragma unroll
        for (int i = 0; i < 4; ++i) { auto q = __builtin_amdgcn_permlane16_swap(__float_as_uint(r8[i]), __float_as_uint(r8[i + 4]), false, false); r4[i] = __uint_as_float(q[0]) + __uint_as_float(q[1]); }
        { const bool up = lane & 8;
#pragma unroll
          for (int i = 0; i < 2; ++i) { const float keep = up ? r4[i + 2] : r4[i], send = up ? r4[i] : r4[i + 2]; r2[i] = keep + dpp_f<0x128>(send); } }
        { const bool up = lane & 4; const float keep = up ? r2[1] : r2[0], send = up ? r2[0] : r2[1]; r1 = keep + __shfl_xor(send, 4); }
        r1 += dpp_f<0x4E>(r1); r1 += dpp_f<0xB1>(r1);
        if ((lane & 3) == 0) ((float*)(p.ws + WS_AB))[(size_t)r * 16 + (lane >> 2)] = r1;
      } }
    }
}
__device__ __forceinline__ void norm_tile16(Frame& F, int l, const LAS bf16_t* wabT, LAS float* tab, int r0, int& curb) {
    const Ptrs& p = F.p; const int lane = F.lane, li = lane & 15, g4 = lane >> 4;
    const bf16_t* const XB = (const bf16_t*)((const char*)p.out + (64u << 20)); const bf16_t* const XCB = (const bf16_t*)(p.ws + WS_XC);
    const int r = r0 + li; int b; const bf16_t* src;
    if (r < MLAT) { b = r >> 11; const int tp = r & 2047; const int t = (l & 1) ? ((tp & 31) * 64 + (tp >> 5)) : tp; src = XB + ((size_t)b * SEQ + t) * DM; }
    else { b = 16; src = XCB + (size_t)(r - MLAT) * DM; }
    v4u xr[32];
#pragma unroll
    for (int s2 = 0; s2 < 32; ++s2) xr[s2] = *(const GAS v4u*)(src + 32 * s2 + 8 * g4);
    const int bt = __builtin_amdgcn_readfirstlane(b);
    if (bt != curb) { curb = bt; const float* mod = (const float*)(p.ws + WS_MOD) + (size_t)(l * 17 + bt) * 3072;
#pragma unroll
        for (int j = 0; j < 4; ++j) { const f32x4 g = *(const f32x4*)(p.norm_g + l * DM + 256 * j + 4 * lane), sc = *(const f32x4*)(mod + 1024 + 256 * j + 4 * lane), sh = *(const f32x4*)(mod + 256 * j + 4 * lane);
            *(LAS f32x4*)(tab + 256 * j + 4 * lane) = g * (sc + 1.0f); *(LAS f32x4*)(tab + 1024 + 256 * j + 4 * lane) = sh; }
        asm volatile("s_waitcnt lgkmcnt(0)" ::: "memory"); }
    float ss = 0.f;
#pragma unroll
    for (int s2 = 0; s2 < 32; ++s2) { float f[8]; unpack8(xr[s2], f);
#pragma unroll
        for (int e = 0; e < 8; ++e) ss += f[e] * f[e]; }
    { auto q = __builtin_amdgcn_permlane16_swap(__float_as_uint(ss), __float_as_uint(ss), false, false); ss = __uint_as_float(q[0]) + __uint_as_float(q[1]); }
    { auto q = __builtin_amdgcn_permlane32_swap(__float_as_uint(ss), __float_as_uint(ss), false, false); ss = __uint_as_float(q[0]) + __uint_as_float(q[1]); }
    const float rstd = 1.0f / sqrtf(ss * (1.0f / DM) + EPS);
#pragma unroll
    for (int s2 = 0; s2 < 32; ++s2) asm volatile("" : "+v"(xr[s2]));
    f32x4 acc = {0.f, 0.f, 0.f, 0.f};
    bf16_t* hrow = (bf16_t*)(p.ws + WS_HY) + (size_t)r * DM + 8 * g4;
#pragma unroll
    for (int s2 = 0; s2 < 32; ++s2) { float f[8]; unpack8(xr[s2], f);
        const f32x4 ga = *(const LAS f32x4*)(tab + 32 * s2 + 8 * g4), gb = *(const LAS f32x4*)(tab + 32 * s2 + 8 * g4 + 4), sa = *(const LAS f32x4*)(tab + 1024 + 32 * s2 + 8 * g4), sb = *(const LAS f32x4*)(tab + 1024 + 32 * s2 + 8 * g4 + 4);
        const f32x4 ha = (f32x4){f[0], f[1], f[2], f[3]} * rstd * ga + sa, hb = (f32x4){f[4], f[5], f[6], f[7]} * rstd * gb + sb;
        const bf16x8 hf = pack8(ha, hb);
        *(GAS bf16x8*)(hrow + 32 * s2) = hf;
        const bf16x8 wf = *(const LAS bf16x8*)(wabT + li * DM + 32 * s2 + 8 * g4);
        acc = __builtin_amdgcn_mfma_f32_16x16x32_bf16(hf, wf, acc, 0, 0, 0);
        if ((s2 & 1) == 1) asm volatile("" ::: "memory"); }
    float* AB = (float*)(p.ws + WS_AB) + (size_t)(r0 + 4 * g4) * 16 + li;
#pragma unroll
    for (int rr = 0; rr < 4; ++rr) AB[rr * 16] = acc[rr];
}
constexpr int CW_CTXC = 9216, CW_NORMQ = 13312;
__device__ __forceinline__ void norm_stage_wab(Frame& F, int l, LAS float* wab) {
    const Ptrs& p = F.p;
    for (int i = F.tid; i < 16 * DM; i += NWAVES * 64) { const int k = i >> 4, j = i & 15; wab[j * DM + k] = p.w_in[(size_t)l * DM * INC + (size_t)k * INC + 768 + j]; }
    __syncthreads();
}
__device__ __forceinline__ void phase_norm(Frame& F, int l) {
    const Ptrs& p = F.p;
    LAS float* wab = (LAS float*)F.lds;
    if (l == 0) {
        norm_stage_wab(F, l, wab);
        constexpr int RPW = MTOT / (256 * NWAVES);
        const int gw = F.vcu * NWAVES + F.wave;
        norm_wave_rows(F, l, wab, gw * RPW, (gw + 1) * RPW < MTOT ? (gw + 1) * RPW : MTOT);
        __syncthreads();
        return;
    }
    const LAS bf16_t* wabT = (const LAS bf16_t*)F.lds; LAS float* tab = (LAS float*)(F.lds + 32768 + F.wave * 8192); int curb = -1;
#define NORM_STAGE_WAB() do { for (int i = F.tid; i < 16 * DM; i += NWAVES * 64) { const int k = i >> 4, j = i & 15; ((LAS bf16_t*)F.lds)[j * DM + k] = f2bf(p.w_in[(size_t)l * DM * INC + (size_t)k * INC + 768 + j]); } __syncthreads(); } while (0)
    if (blockIdx.x < 64) {
        const int pmc = (int)blockIdx.x >> 2, pn = (int)blockIdx.x & 3, lp = l - 1;
        pg8::Gemm g{(const bf16_t*)(p.ws + WS_HY) + (size_t)MLAT * DM, (const bf16_t*)(p.ws + WS_WOUT) + (size_t)lp * DM * DM, MCTX, DM, DM};
        pg8::OneUnit S{{pmc, pn}};
        bf16_t* const XCB = (bf16_t*)(p.ws + WS_XC);
        pg8::EpiResid E{nullptr, nullptr, lp == 0 ? (const void*)p.ctx : (const void*)XCB, XCB, (const float*)(p.ws + WS_MOD) + (size_t)lp * 17 * 3072, 0, MLAT, SEQ, DM, lp == 0 ? 1 : 0, MLAT};
        pg8::gemm_phase<pg8::EpiResid, pg8::OneUnit, false, true>(F.lds, g, S, E);
        F.refresh();
        asm volatile("s_waitcnt vmcnt(0)" ::: "memory");
        __syncthreads();
        if (F.tid == 0) { __builtin_amdgcn_fence(__ATOMIC_RELEASE, "agent"); asm volatile("s_waitcnt vmcnt(0)" ::: "memory");
            gu32* cnt = F.ctl + CW_CTXC + (l * 16 + pmc) * 64;
            (void)__hip_atomic_fetch_add(cnt, 1u, __ATOMIC_RELAXED, __HIP_MEMORY_SCOPE_AGENT);
            unsigned spins = 0;
            while (__hip_atomic_load(cnt, __ATOMIC_RELAXED, __HIP_MEMORY_SCOPE_AGENT) < 4u && ++spins < (1u << 22)) __builtin_amdgcn_s_sleep(2);
            __builtin_amdgcn_fence(__ATOMIC_ACQUIRE, "agent"); asm volatile("s_waitcnt vmcnt(0)" ::: "memory"); }
        __syncthreads();
        NORM_STAGE_WAB();
        if (F.wave < 4) norm_tile16(F, l, wabT, tab, MLAT + 256 * pmc + 64 * pn + 16 * F.wave, curb);
    } else {
        NORM_STAGE_WAB();
        const int wi = ((int)blockIdx.x - 64) * NWAVES + F.wave;
        for (int t = wi; t < MLAT / 16; t += 1536) norm_tile16(F, l, wabT, tab, 16 * t, curb);
    }
#undef NORM_STAGE_WAB
    __syncthreads();
}

__device__ __forceinline__ void phase_final(Frame& F) {
    const Ptrs& p = F.p; const int lane = F.lane;
    const int gw = F.vcu * NWAVES + F.wave, NGW = F.G * NWAVES;
    const bf16_t* X = (const bf16_t*)(p.ws + WS_P);
    f32x4 g[4];
#pragma unroll
    for (int j = 0; j < 4; ++j) g[j] = *(const f32x4*)(p.final_g + 256 * j + 4 * lane);
    for (int r0 = gw; r0 < MLAT; r0 += 4 * NGW) {
        u32x2 raw[4][4];
#pragma unroll
        for (int u = 0; u < 4; ++u) { const int r = r0 + u * NGW; if (r < MLAT) { const GAS u32x2* xr = (const GAS u32x2*)(X + (size_t)r * DM) + lane;
#pragma unroll
            for (int j = 0; j < 4; ++j) raw[u][j] = xr[64 * j]; } }
#pragma unroll
        for (int u = 0; u < 4; ++u) { const int r = r0 + u * NGW; if (r < MLAT) {
            f32x4 v[4]; float ss = 0.f;
#pragma unroll
            for (int j = 0; j < 4; ++j) { v[j] = (f32x4){bflo(raw[u][j].x), bfhi(raw[u][j].x), bflo(raw[u][j].y), bfhi(raw[u][j].y)}; ss += (v[j].x * v[j].x + v[j].y * v[j].y) + (v[j].z * v[j].z + v[j].w * v[j].w); }
            ss = wave_sum(ss);
            const float rstd = 1.0f / sqrtf(ss * (1.0f / DM) + EPS);
            GAS f32x4* xo = (GAS f32x4*)(p.out + (size_t)r * DM) + lane;
#pragma unroll
            for (int j = 0; j < 4; ++j) xo[64 * j] = v[j] * rstd * g[j]; } }
    }
}

__device__ __forceinline__ void phase_gemm1(Frame& F, int l) {
    const Ptrs& p = F.p;
    pg8::Gemm g{(const bf16_t*)(p.ws + WS_HY), (const bf16_t*)(p.ws + WS_WIN) + (size_t)l * NPC * DM, MTOT, NPC, DM};
    pg8::StaticOrder S; S.init(MTOT, NPC, F.G, (int)blockIdx.x);
    pg8::EpiP E{(bf16_t*)(p.ws + WS_P), PTILE_ELEMS};
    pg8::gemm_phase<pg8::EpiP, pg8::StaticOrder, true, true>(F.lds, g, S, E);
}
__device__ __forceinline__ void phase_gemm2(Frame& F, int l) {
    const Ptrs& p = F.p;
    const int M = MLAT;
    pg8::Gemm g{(const bf16_t*)(p.ws + WS_HY), (const bf16_t*)(p.ws + WS_WOUT) + (size_t)l * DM * DM, M, DM, DM};
    pg8::StaticOrder S; S.init(M, DM, F.G, (int)blockIdx.x);
    bf16_t* const XB = (bf16_t*)((char*)p.out + (64u << 20));
    bf16_t* const XCB = (bf16_t*)(p.ws + WS_XC);
    pg8::EpiResid E{l == 0 ? (const void*)p.x : (const void*)XB, l == DEPTH - 1 ? (bf16_t*)(p.ws + WS_P) : XB, l == 0 ? (const void*)p.ctx : (const void*)XCB, XCB,
                    (const float*)(p.ws + WS_MOD) + (size_t)l * 17 * 3072, l & 1, MLAT, SEQ, DM, l == 0 ? 1 : 0, 0};
    pg8::gemm_phase<pg8::EpiResid, pg8::StaticOrder, true, true>(F.lds, g, S, E);
}


typedef short s16x4 __attribute__((ext_vector_type(4)));
__device__ __forceinline__ const bf16_t* ptile_d(const Ptrs& p, int t) { return (const bf16_t*)(p.ws + WS_P) + (size_t)t * PTILE_ELEMS; }
constexpr size_t WS_WSB = 9 * MiB;

__device__ __forceinline__ void mix_unit_B(Frame& F, int l, int row0) {
    const Ptrs& p = F.p; const int oct = F.tid & 31, tg = F.tid >> 5;
    int start, len; row_seq(row0, start, len);
    const bf16_t *CG = ptile_d(p, T_CG), *XI = ptile_d(p, T_XI), *BG = ptile_d(p, T_BG), *GB = ptile_d(p, T_GB);
    float w[3][8];
#pragma unroll
    for (int j = 0; j < 3; ++j) { const f32x4 a = *(const f32x4*)(p.short_conv_w + (size_t)(l * 3 + j) * BW + 8 * oct), b = *(const f32x4*)(p.short_conv_w + (size_t)(l * 3 + j) * BW + 8 * oct + 4);
        w[j][0] = a.x; w[j][1] = a.y; w[j][2] = a.z; w[j][3] = a.w; w[j][4] = b.x; w[j][5] = b.y; w[j][6] = b.z; w[j][7] = b.w; }
    const int r0 = row0 + tg * 8;
    float cx[10][8];
    { v4u ca[10], xa[10];
#pragma unroll
      for (int i = 0; i < 10; ++i) { int r = r0 + i - 1; r = r < start ? start : (r >= start + len ? start + len - 1 : r); ca[i] = *(const GAS v4u*)(CG + (size_t)r * 256 + 8 * oct); xa[i] = *(const GAS v4u*)(XI + (size_t)r * 256 + 8 * oct); }
#pragma unroll
      for (int i = 0; i < 10; ++i) { float fa[8], fb[8]; unpack8(ca[i], fa); unpack8(xa[i], fb);
#pragma unroll
          for (int e = 0; e < 8; ++e) cx[i][e] = fa[e] * fb[e]; }
      const bool lo_ok = r0 - 1 >= start, hi_ok = r0 + 8 < start + len;
#pragma unroll
      for (int e = 0; e < 8; ++e) { cx[0][e] = lo_ok ? cx[0][e] : 0.f; cx[9][e] = hi_ok ? cx[9][e] : 0.f; } }
#pragma unroll
    for (int i = 0; i < 8; ++i) { const int r = r0 + i;
        const v4u bgw = *(const GAS v4u*)(BG + (size_t)r * 256 + 8 * oct), gw = *(const GAS v4u*)(GB + (size_t)r * 256 + 8 * oct); float bg[8], gt[8], y[8]; unpack8(bgw, bg); unpack8(gw, gt);
#pragma unroll
        for (int e = 0; e < 8; ++e) y[e] = bg[e] * (w[0][e] * cx[i][e] + w[1][e] * cx[i + 1][e] + w[2][e] * cx[i + 2][e]) * fsilu(gt[e]);
        v4u o; o.x = pk2(y[0], y[1]); o.y = pk2(y[2], y[3]); o.z = pk2(y[4], y[5]); o.w = pk2(y[6], y[7]);
        *(GAS v4u*)((bf16_t*)(p.ws + WS_HY) + (size_t)r * DM + 256 + 8 * oct) = o; }
}

constexpr int MIX_ND = MTOT / 128, MIX_NC = MTOT / 64, MIX_NB = MTOT / 128, MIX_NU = MIX_ND + MIX_NC + MIX_NB, CW_MIXQ = 8192, NPF = 12;
__device__ __forceinline__ void mix_prefetch(Frame& F, int l, int u, v4u (&pf)[NPF]) {
    const Ptrs& p = F.p; const int tid = F.tid, lane = F.lane, wave = F.wave;
    if (u < MIX_ND) {
        const bf16_t* VV = ptile_d(p, T_VV) + (size_t)(u * 128 + wave * 16) * 256 + 4 * lane;
#pragma unroll
        for (int k = 0; k < 8; ++k) { const u32x2 a = *(const GAS u32x2*)(VV + (size_t)(2 * k) * 256), b = *(const GAS u32x2*)(VV + (size_t)(2 * k + 1) * 256); pf[k] = (v4u){a.x, a.y, b.x, b.y}; }
        pf[10] = *(const GAS v4u*)(p.smlp_ln_g + l * BW + 4 * lane); pf[11] = *(const GAS v4u*)(p.smlp_ln_b + l * BW + 4 * lane);
        asm volatile("; PF_D" ::: "memory");
    } else if (u < MIX_ND + MIX_NC) {
        const int row0 = (u - MIX_ND) * 64; int start, len; row_seq(row0, start, len);
        const bf16_t *GA = ptile_d(p, T_GLA), *GLB = ptile_d(p, T_GLB);
#pragma unroll
        for (int k = 0; k < 6; ++k) { const int idx = tid + k * NWAVES * 64, i = idx >> 5, oct = idx & 31; int r = row0 - 15 + i; r = r < start ? start : (r >= start + len ? start + len - 1 : r);
            pf[2 * k] = *(const GAS v4u*)(GA + (size_t)r * 256 + 8 * oct); pf[2 * k + 1] = *(const GAS v4u*)(GLB + (size_t)r * 256 + 8 * oct); }
        asm volatile("; PF_C" ::: "memory");
    }
}
__device__ __forceinline__ f32x4 asf4(const v4u& w) { return __builtin_bit_cast(f32x4, w); }

__device__ __forceinline__ void mix_unit_C(Frame& F, int l, int row0, v4u (&pf)[NPF], int nxt) {
    const Ptrs& p = F.p; const int tid = F.tid, lane = F.lane, wave = F.wave;
    int start, len; row_seq(row0, start, len);
    LAS float* glu = (LAS float*)F.lds;
#pragma unroll
    for (int k = 0; k < 6; ++k) { const int idx = tid + k * NWAVES * 64, i = idx >> 5, oct = idx & 31, r = row0 - 15 + i;
        if (i < 94) { const bool ok = r >= start && r < start + len; float fa[8], fb[8]; unpack8(pf[2 * k], fa); unpack8(pf[2 * k + 1], fb);
            const f32x4 o0 = {ok ? fa[0] * fsigmoid(fb[0]) : 0.f, ok ? fa[1] * fsigmoid(fb[1]) : 0.f, ok ? fa[2] * fsigmoid(fb[2]) : 0.f, ok ? fa[3] * fsigmoid(fb[3]) : 0.f};
            const f32x4 o1 = {ok ? fa[4] * fsigmoid(fb[4]) : 0.f, ok ? fa[5] * fsigmoid(fb[5]) : 0.f, ok ? fa[6] * fsigmoid(fb[6]) : 0.f, ok ? fa[7] * fsigmoid(fb[7]) : 0.f};
            *(LAS f32x4*)(glu + i * 256 + 8 * oct) = o0; *(LAS f32x4*)(glu + i * 256 + 8 * oct + 4) = o1; } }
    float wt[32]; u32x2 gate[8];
#pragma unroll
    for (int j = 0; j < 32; ++j) wt[j] = j < 31 ? p.conf_conv_w[(size_t)(l * 31 + j) * BW + (tid & 255)] : p.conf_conv_b[l * BW + (tid & 255)];
    { const bf16_t* GC = ptile_d(p, T_GC);
#pragma unroll
      for (int i = 0; i < 8; ++i) gate[i] = *(const GAS u32x2*)(GC + (size_t)(row0 + wave * 8 + i) * 256 + 4 * lane); }
    const f32x4 lg = *(const f32x4*)(p.conf_ln_g + l * BW + 4 * lane), lb = *(const f32x4*)(p.conf_ln_b + l * BW + 4 * lane);
    mix_prefetch(F, l, nxt, pf);
    LBAR();
    const int c = tid & 255, th = tid >> 8;
    float z[32];
#pragma unroll
    for (int hb = 0; hb < 2; ++hb) {
        float win[46];
#pragma unroll
        for (int i = 0; i < 46; ++i) win[i] = glu[(th * 32 + hb * 16 + i) * 256 + c];
#pragma unroll
        for (int i = 0; i < 16; ++i) z[hb * 16 + i] = wt[31];
#pragma unroll
        for (int j = 0; j < 31; ++j)
#pragma unroll
            for (int i = 0; i < 16; ++i) z[hb * 16 + i] += wt[j] * win[i + j];
    }
    LBAR();
#pragma unroll
    for (int i = 0; i < 32; ++i) glu[(th * 32 + i) * 256 + c] = z[i];
    LBAR();
#pragma unroll
    for (int i = 0; i < 8; ++i) { const int t = wave * 8 + i, r = row0 + t;
        const f32x4 zz = *(const LAS f32x4*)(glu + t * 256 + 4 * lane);
        const float mean = wave_sum((zz.x + zz.y) + (zz.z + zz.w)) * (1.f / 256.f);
        const f32x4 d = zz - mean;
        const float var = wave_sum((d.x * d.x + d.y * d.y) + (d.z * d.z + d.w * d.w)) * (1.f / 256.f);
        const float rstd = 1.0f / sqrtf(var + EPS);
        const f32x4 ln = d * rstd * lg + lb;
        const u32x2 gw = gate[i];
        u32x2 o; o.x = pk2(fsilu(ln.x) * fsilu(bflo(gw.x)), fsilu(ln.y) * fsilu(bfhi(gw.x))); o.y = pk2(fsilu(ln.z) * fsilu(bflo(gw.y)), fsilu(ln.w) * fsilu(bfhi(gw.y)));
        *(GAS u32x2*)((bf16_t*)(p.ws + WS_HY) + (size_t)r * DM + 512 + 4 * lane) = o; }
    LBAR();
}

__device__ __forceinline__ void mix_unit_D(Frame& F, int l, int row0, v4u (&pf)[NPF], int nxt) {
    const Ptrs& p = F.p; const int lane = F.lane, wave = F.wave;
    constexpr int VS = 528;
    LAS unsigned char* vl = F.lds;
    const bf16_t *U = ptile_d(p, T_U), *GD = ptile_d(p, T_GD);
    const int g = wave >> 1, ph = wave & 1, li = lane & 15, lg4 = lane >> 4;
    bf16x8 wf[4][4];
    { const bf16_t* W = (const bf16_t*)(p.ws + WS_WSB) + (size_t)(l * 4 + g) * 128 * 128;
#pragma unroll
      for (int ks = 0; ks < 4; ++ks)
#pragma unroll
          for (int pt = 0; pt < 4; ++pt) wf[ks][pt] = *(const GAS bf16x8*)(W + (size_t)(64 * ph + 16 * pt + li) * 128 + 32 * ks + 8 * lg4); }
    { const f32x4 lg = asf4(pf[10]), lb = asf4(pf[11]);
#pragma unroll
      for (int i = 0; i < 16; ++i) { const int q = wave * 16 + i; const u32x2 raw = (i & 1) ? (u32x2){pf[i >> 1].z, pf[i >> 1].w} : (u32x2){pf[i >> 1].x, pf[i >> 1].y};
        const f32x4 v = {bflo(raw.x), bfhi(raw.x), bflo(raw.y), bfhi(raw.y)};
        const float mean = wave_sum((v.x + v.y) + (v.z + v.w)) * (1.f / 256.f);
        const f32x4 d = v - mean;
        const float var = wave_sum((d.x * d.x + d.y * d.y) + (d.z * d.z + d.w * d.w)) * (1.f / 256.f);
        const float rstd = 1.0f / sqrtf(var + EPS);
        const f32x4 y = d * rstd * lg + lb;
        u32x2 o; o.x = pk2(y.x, y.y); o.y = pk2(y.z, y.w);
        *(LAS u32x2*)(vl + q * VS + 8 * lane) = o; } }
    LBAR();
    f32x4 acc[4][4];
#pragma unroll
    for (int a = 0; a < 4; ++a)
#pragma unroll
        for (int b = 0; b < 4; ++b) acc[a][b] = (f32x4){0.f, 0.f, 0.f, 0.f};
#pragma unroll
    for (int ks = 0; ks < 4; ++ks) {
        bf16x8 af[4];
#pragma unroll
        for (int ct = 0; ct < 4; ++ct) { LAS unsigned char* a = vl + (32 * ks + 8 * lg4 + (li >> 2)) * VS + (64 * g + 16 * ct + 4 * (li & 3)) * 2;
            const s16x4 lo = __builtin_amdgcn_ds_read_tr16_b64_v4i16((LAS s16x4*)a), hi = __builtin_amdgcn_ds_read_tr16_b64_v4i16((LAS s16x4*)(a + 4 * VS));
            af[ct] = (bf16x8){lo[0], lo[1], lo[2], lo[3], hi[0], hi[1], hi[2], hi[3]}; }
#pragma unroll
        for (int ct = 0; ct < 4; ++ct)
#pragma unroll
            for (int pt = 0; pt < 4; ++pt) acc[ct][pt] = __builtin_amdgcn_mfma_f32_16x16x32_bf16(af[ct], wf[ks][pt], acc[ct][pt], 0, 0, 0);
    }
    u32x2 uw[4][4], gw[4][4]; float bs[4];
#pragma unroll
    for (int pt = 0; pt < 4; ++pt) { const int prow = 64 * ph + 16 * pt + li; const size_t r = (size_t)row0 + prow; bs[pt] = p.smlp_b[(l * 4 + g) * 128 + prow];
#pragma unroll
        for (int ct = 0; ct < 4; ++ct) { const int c = 64 * g + 16 * ct + 4 * lg4; uw[pt][ct] = *(const GAS u32x2*)(U + r * 256 + c); gw[pt][ct] = *(const GAS u32x2*)(GD + r * 256 + c); } }
    mix_prefetch(F, l, nxt, pf);
#pragma unroll
    for (int pt = 0; pt < 4; ++pt) { const int prow = 64 * ph + 16 * pt + li; const size_t r = (size_t)row0 + prow;
#pragma unroll
        for (int ct = 0; ct < 4; ++ct) { const int c = 64 * g + 16 * ct + 4 * lg4;
            const f32x4 m = acc[ct][pt] + bs[pt]; const u32x2 u2 = uw[pt][ct], g2 = gw[pt][ct];
            u32x2 o; o.x = pk2(bflo(u2.x) * m.x * fsilu(bflo(g2.x)), bfhi(u2.x) * m.y * fsilu(bfhi(g2.x))); o.y = pk2(bflo(u2.y) * m.z * fsilu(bflo(g2.y)), bfhi(u2.y) * m.w * fsilu(bfhi(g2.y)));
            *(GAS u32x2*)((bf16_t*)(p.ws + WS_HY) + r * DM + 768 + c) = o; } }
    LBAR();
}

__device__ __forceinline__ void phase_mix(Frame& F, int l) {
    gu32* ctr = F.ctl + CW_MIXQ + 64 * l;
    volatile LAS unsigned* Q = F.MISC;
    unsigned fetched = 0;
    if (F.tid == 0) { Q[0] = __hip_atomic_fetch_add(ctr, 1u, __ATOMIC_RELAXED, __HIP_MEMORY_SCOPE_AGENT); Q[1] = __hip_atomic_fetch_add(ctr, 1u, __ATOMIC_RELAXED, __HIP_MEMORY_SCOPE_AGENT); }
    LBAR();
    int cur = (int)Q[0], nxt = (int)Q[1];
    v4u pf[NPF];
    F.refresh();
    if (cur < MIX_NU) mix_prefetch(F, l, cur, pf);
#define MIX_ROUND(CALL) do { LBAR();   \
        if (F.tid == 0) fetched = __hip_atomic_fetch_add(ctr, 1u, __ATOMIC_RELAXED, __HIP_MEMORY_SCOPE_AGENT);   \
        F.refresh(); CALL; if (F.tid == 0) Q[0] = fetched; LBAR(); cur = nxt; nxt = (int)Q[0]; } while (0)
    while (cur < MIX_ND) MIX_ROUND(mix_unit_D(F, l, cur * 128, pf, nxt));
    while (cur < MIX_ND + MIX_NC) MIX_ROUND(mix_unit_C(F, l, (cur - MIX_ND) * 64, pf, nxt));
    while (cur < MIX_NU) MIX_ROUND(mix_unit_B(F, l, (cur - MIX_ND - MIX_NC) * 128));
#undef MIX_ROUND
}

constexpr size_t WS_REC = 212 * MiB, WS_OB16 = 476 * MiB;
constexpr int REC_BYTES = 53248, R_NW = 0, R_Q = 8192, R_U = 16384, R_VEC = 32768, R_ATTN = 33792, R_KT = 41984;
constexpr int NITEM = 2304;
constexpr int L_Q = 0, L_K = 4352, L_V = 8704, L_GKK = 13056, L_GQK = 17408, L_QB = 21760, L_KB = 24064, L_AO = 21760, L_AD = 26368, L_DF = 28928, L_SM = 30208, L_XS = 0, GS = 68, SMD = 256;

__device__ __forceinline__ float dpp_xor1(float v) { return __int_as_float(__builtin_amdgcn_mov_dpp(__float_as_int(v), 0xB1, 0xF, 0xF, true)); }

__device__ __forceinline__ void prep_decode(int item, int& b, int& h, int& row0) {
    if (item < 2048) { b = item >> 7; h = (item >> 5) & 3; const int n = item & 31; row0 = b * SEQ + 64 * n; }
    else { const int it = item - 2048; b = it >> 4; h = (it >> 2) & 3; const int n = it & 3; row0 = MLAT + b * CTXL + 64 * n; }
}
__device__ __forceinline__ void prep_load(Frame& F, int l, int item, v4u (&raw)[6], float (&abn)[4], v4u (&wq)[6]) {
    const Ptrs& p = F.p; int b, h, row0; prep_decode(item, b, h, row0); int start, len; row_seq(row0, start, len);
    const int tq = F.tid < 384 ? F.tid : 383, tg = tq / 24, o = tq % 24, part = o >> 3, oo = o & 7;
    const bf16_t* T = ptile_d(p, part) + h * 64 + 8 * oo;
#pragma unroll
    for (int i = 0; i < 6; ++i) { int r = row0 + 4 * tg - 1 + i; r = r < start ? start : (r >= start + len ? start + len - 1 : r); raw[i] = *(const GAS v4u*)(T + (size_t)r * 256); }
    if ((F.wave & 3) == 0) { const int dir = F.wave >> 2, tok = dir ? 63 - F.lane : F.lane; const float* AB = (const float*)(p.ws + WS_AB) + ((size_t)row0 + tok) * 16;
        abn[0] = AB[dir * 4 + h]; abn[1] = AB[8 + dir * 4 + h]; abn[2] = p.a_log[(l * 2 + dir) * 4 + h]; abn[3] = p.dt_bias[(l * 2 + dir) * 4 + h]; }
    { const float* wc = p.qkv_conv_w + (size_t)l * 3 * 768 + part * 256 + h * 64 + 8 * oo;
#pragma unroll
      for (int j = 0; j < 3; ++j) { wq[2 * j] = *(const GAS v4u*)(wc + j * 768); wq[2 * j + 1] = *(const GAS v4u*)(wc + j * 768 + 4); } }
}
__device__ __forceinline__ void prep_item(Frame& F, int l, int item, v4u (&raw)[6], float (&abn)[4], v4u (&wq)[6], int next_item) {
    const Ptrs& p = F.p; const int tid = F.tid, lane = F.lane, wave = F.wave;
    int b, h, row0; prep_decode(item, b, h, row0);
    int start, len; row_seq(row0, start, len);
    LAS float* lf = (LAS float*)F.lds;
    if (tid < 384) { const int tg = tid / 24, o = tid % 24, part = o >> 3, oo = o & 7;
        float w[3][8], x[6][8];
#pragma unroll
        for (int j = 0; j < 3; ++j) { const f32x4 w0 = __builtin_bit_cast(f32x4, wq[2 * j]), w1 = __builtin_bit_cast(f32x4, wq[2 * j + 1]);
            w[j][0] = w0.x; w[j][1] = w0.y; w[j][2] = w0.z; w[j][3] = w0.w; w[j][4] = w1.x; w[j][5] = w1.y; w[j][6] = w1.z; w[j][7] = w1.w; }
#pragma unroll
        for (int i = 0; i < 6; ++i) unpack8(raw[i], x[i]);
        const bool lo_ok = row0 + 4 * tg - 1 >= start, hi_ok = row0 + 4 * tg + 4 < start + len;
#pragma unroll
        for (int e = 0; e < 8; ++e) { x[0][e] = lo_ok ? x[0][e] : 0.f; x[5][e] = hi_ok ? x[5][e] : 0.f; }
#pragma unroll
        for (int t = 0; t < 4; ++t) { float a[8];
#pragma unroll
            for (int e = 0; e < 8; ++e) a[e] = fsilu(w[0][e] * x[t][e] + w[1][e] * x[t + 1][e] + w[2][e] * x[t + 2][e]);
            LAS float* dst = lf + part * 4352 + (4 * tg + t) * 68 + 8 * oo;
            *(LAS f32x4*)dst = (f32x4){a[0], a[1], a[2], a[3]}; *(LAS f32x4*)(dst + 4) = (f32x4){a[4], a[5], a[6], a[7]}; } }
    if ((wave & 3) == 0) { const int dir = wave >> 2, i = lane;
        const float sx = abn[0] + abn[3];
        const float sp = sx > 15.f ? sx : __builtin_amdgcn_logf(1.f + fexp(sx)) * 0.69314718056f;
        const float g = -fexp(abn[2]) * sp;
        const float beta = fsigmoid(abn[1]);
        float gc = g;
        gc += dpp_f<0x111>(gc); gc += dpp_f<0x112>(gc); gc += dpp_f<0x114>(gc); gc += dpp_f<0x118>(gc);
        gc += __int_as_float(__builtin_amdgcn_update_dpp(0, __float_as_int(gc), 0x142, 0xA, 0xF, false));
        gc += __int_as_float(__builtin_amdgcn_update_dpp(0, __float_as_int(gc), 0x143, 0xC, 0xF, false));
        LAS float* sm = lf + L_SM + dir * SMD; const float eg = fexp(gc); sm[i] = gc; sm[64 + i] = beta; sm[128 + i] = eg; sm[192 + i] = beta * eg; }
    prep_load(F, l, next_item, raw, abn, wq);
    LBAR();
    { const int row = tid >> 2, part = row >> 6, t = row & 63, qt = tid & 3; LAS float* src = lf + part * 4352 + t * 68 + 16 * qt;
      f32x4 v[4]; float ss = 0.f;
#pragma unroll
      for (int i = 0; i < 4; ++i) { v[i] = *(LAS f32x4*)(src + 4 * i); ss += (v[i].x * v[i].x + v[i].y * v[i].y) + (v[i].z * v[i].z + v[i].w * v[i].w); }
      ss += __shfl_xor(ss, 1); ss += __shfl_xor(ss, 2);
      const float sc = (1.0f / sqrtf(ss + EPS)) * (part == 0 ? 0.125f : 1.0f);
#pragma unroll
      for (int i = 0; i < 4; ++i) { v[i] = v[i] * sc; *(LAS f32x4*)(src + 4 * i) = v[i]; }
      LAS unsigned char* bdst = (LAS unsigned char*)(lf + (part ? L_KB : L_QB)) + t * 144 + 32 * qt;
      v4u o; o.x = pk2(v[0].x, v[0].y); o.y = pk2(v[0].z, v[0].w); o.z = pk2(v[1].x, v[1].y); o.w = pk2(v[1].z, v[1].w); *(LAS v4u*)bdst = o;
      o.x = pk2(v[2].x, v[2].y); o.y = pk2(v[2].z, v[2].w); o.z = pk2(v[3].x, v[3].y); o.w = pk2(v[3].z, v[3].w); *(LAS v4u*)(bdst + 16) = o; }
    LBAR();
    { const int mat = wave >> 2, it = wave & 3, li = lane & 15, g4 = lane >> 4;
      const LAS unsigned char* Ab = (const LAS unsigned char*)(lf + (mat ? L_QB : L_KB)); const LAS unsigned char* Kb = (const LAS unsigned char*)(lf + L_KB);
      bf16x8 af[2];
#pragma unroll
      for (int s2 = 0; s2 < 2; ++s2) af[s2] = *(const LAS bf16x8*)(Ab + (16 * it + li) * 144 + (32 * s2 + 8 * g4) * 2);
      LAS float* G = lf + (mat ? L_GQK : L_GKK);
#pragma unroll
      for (int jt = 0; jt < 4; ++jt) { f32x4 acc = {0.f, 0.f, 0.f, 0.f};
#pragma unroll
          for (int s2 = 0; s2 < 2; ++s2) { const bf16x8 bq = *(const LAS bf16x8*)(Kb + (16 * jt + li) * 144 + (32 * s2 + 8 * g4) * 2); acc = __builtin_amdgcn_mfma_f32_16x16x32_bf16(af[s2], bq, acc, 0, 0, 0); }
#pragma unroll
          for (int r = 0; r < 4; ++r) G[(16 * it + 4 * g4 + r) * GS + 16 * jt + li] = acc[r]; } }
    LBAR();
    const int dir = tid >> 8, td = tid & 255;
    const LAS float* sm = lf + L_SM + dir * SMD;
    unsigned char* rec = p.ws + WS_REC + (size_t)(item * 2 + dir) * REC_BYTES;
    { const int i = td >> 2, jq = td & 3, ti = dir ? 63 - i : i; const float gi = sm[i], bi = sm[64 + i];
      const LAS float* grow = lf + L_GKK + ti * GS + (dir ? 48 - 16 * jq : 16 * jq);
      float gv[16], gc[16];
#pragma unroll
      for (int k = 0; k < 4; ++k) { const f32x4 a = *(const LAS f32x4*)(grow + 4 * k), c = *(const LAS f32x4*)(sm + 16 * jq + 4 * k);
          gv[4 * k] = a.x; gv[4 * k + 1] = a.y; gv[4 * k + 2] = a.z; gv[4 * k + 3] = a.w; gc[4 * k] = c.x; gc[4 * k + 1] = c.y; gc[4 * k + 2] = c.z; gc[4 * k + 3] = c.w; }
      float val[16];
#pragma unroll
      for (int jj = 0; jj < 16; ++jj) { const int j = 16 * jq + jj; const float G = dir ? gv[15 - jj] : gv[jj];
          const float v = bi * G * fexp(fminf(gi - gc[jj], 0.f)); val[jj] = (i > j) ? v : 0.f; }
      { const bool below = jq < (i >> 4);
        v4u o0, o1; o0.x = below ? pk2(-val[0], -val[1]) : 0u; o0.y = below ? pk2(-val[2], -val[3]) : 0u; o0.z = below ? pk2(-val[4], -val[5]) : 0u; o0.w = below ? pk2(-val[6], -val[7]) : 0u;
        o1.x = below ? pk2(-val[8], -val[9]) : 0u; o1.y = below ? pk2(-val[10], -val[11]) : 0u; o1.z = below ? pk2(-val[12], -val[13]) : 0u; o1.w = below ? pk2(-val[14], -val[15]) : 0u;
        LAS unsigned char* ao = (LAS unsigned char*)(lf + L_AO) + dir * 9216 + i * 144 + 32 * jq; *(LAS v4u*)ao = o0; *(LAS v4u*)(ao + 16) = o1; }
      if (jq == (i >> 4)) { LAS float* ad = lf + L_AD + dir * 1280 + (i >> 4) * 320 + (i & 15) * 20;
#pragma unroll
          for (int k = 0; k < 4; ++k) *(LAS f32x4*)(ad + 4 * k) = (f32x4){val[4 * k], val[4 * k + 1], val[4 * k + 2], val[4 * k + 3]}; } }
#pragma unroll
    for (int k = 0; k < 2; ++k) { const int f = td + 256 * k, ms = f >> 6, ll = f & 63, m = ms >> 1, s = ms & 1, rr = 16 * m + (ll & 15), cb = 32 * s + 4 * (ll >> 4);
        float va[8], vq[8], vk[8];
        const int ti = dir ? 63 - rr : rr; const float gi = sm[rr];
#pragma unroll
        for (int hh = 0; hh < 2; ++hh) { const int c0 = cb + 16 * hh;
            const f32x4 g4 = *(const LAS f32x4*)(lf + L_GQK + ti * GS + (dir ? 60 - c0 : c0)), s4 = *(const LAS f32x4*)(sm + c0), q4 = *(const LAS f32x4*)(lf + L_Q + ti * 68 + c0);
            const float gq[4] = {dir ? g4.w : g4.x, dir ? g4.z : g4.y, dir ? g4.y : g4.z, dir ? g4.x : g4.w}, sc[4] = {s4.x, s4.y, s4.z, s4.w}, qq[4] = {q4.x, q4.y, q4.z, q4.w};
#pragma unroll
            for (int e = 0; e < 4; ++e) { const int c = c0 + e, tc = dir ? 63 - c : c;
                const float v = gq[e] * fexp(fminf(gi - sc[e], 0.f)); va[4 * hh + e] = (rr >= c) ? v : 0.f;
                vq[4 * hh + e] = qq[e];
                vk[4 * hh + e] = lf[L_K + tc * 68 + rr]; } }
        v4u o; o.x = pk2(va[0], va[1]); o.y = pk2(va[2], va[3]); o.z = pk2(va[4], va[5]); o.w = pk2(va[6], va[7]); *(GAS v4u*)(rec + R_ATTN + f * 16) = o;
        o.x = pk2(vq[0], vq[1]); o.y = pk2(vq[2], vq[3]); o.z = pk2(vq[4], vq[5]); o.w = pk2(vq[6], vq[7]); *(GAS v4u*)(rec + R_Q + f * 16) = o;
        o.x = pk2(vk[0], vk[1]); o.y = pk2(vk[2], vk[3]); o.z = pk2(vk[4], vk[5]); o.w = pk2(vk[6], vk[7]); *(GAS v4u*)(rec + R_KT + f * 16) = o; }
    if (td < 64) { float* vec = (float*)(rec + R_VEC); vec[td] = sm[128 + td]; vec[64 + td] = expf(sm[63] - sm[td]); if (td == 0) vec[128] = expf(sm[63]); }
    const int li = lane & 15, g4 = lane >> 4, nt0 = 2 * (wave & 3);
    f32x4 Rt[2][4];
#pragma unroll
    for (int t = 0; t < 2; ++t) { const int nt = nt0 + t; const LAS float* src = lf + (nt < 4 ? L_V + 16 * nt + li : L_K + 16 * (nt - 4) + li); const LAS float* scl = sm + (nt < 4 ? 64 : 192);
#pragma unroll
        for (int m = 0; m < 4; ++m) { const f32x4 sc = *(const LAS f32x4*)(scl + 16 * m + 4 * g4); const int i0 = 16 * m + 4 * g4;
            Rt[t][m] = (f32x4){src[(dir ? 63 - i0 : i0) * 68] * sc.x, src[(dir ? 62 - i0 : i0 + 1) * 68] * sc.y, src[(dir ? 61 - i0 : i0 + 2) * 68] * sc.z, src[(dir ? 60 - i0 : i0 + 3) * 68] * sc.w}; } }
    LBAR();
    if ((wave & 3) == 0) { const int blk = lane >> 4, c = lane & 15; const LAS float* Ad = lf + L_AD + dir * 1280 + blk * 320;
        float x[16];
#pragma unroll
        for (int r = 0; r < 16; ++r) x[r] = 0.f;
#pragma unroll
        for (int hb = 0; hb < 2; ++hb) {
            f32x4 arow[8][4];
#pragma unroll
            for (int rr = 0; rr < 8; ++rr)
#pragma unroll
                for (int q = 0; q < (8 * hb + rr + 3) / 4; ++q) arow[rr][q] = *(const LAS f32x4*)(Ad + (8 * hb + rr) * 20 + 4 * q);
#pragma unroll
            for (int rr = 0; rr < 8; ++rr) { const int r = 8 * hb + rr; float acc = (r == c) ? 1.f : 0.f;
#pragma unroll
                for (int q = 0; q < (r + 3) / 4; ++q) { const f32x4 a = arow[rr][q]; acc -= (a.x * x[4 * q] + a.y * x[4 * q + 1]) + (a.z * x[4 * q + 2] + a.w * x[4 * q + 3]); }
                x[r] = acc; } }
        LAS bf16_t* DF = (LAS bf16_t*)(lf + L_DF) + dir * 1280 + blk * 320;
#pragma unroll
        for (int r = 0; r < 16; ++r) DF[r * 20 + c] = f2bf(x[r]); }
    LBAR();
    { const LAS unsigned char* ao = (const LAS unsigned char*)(lf + L_AO) + dir * 9216; const LAS unsigned char* df = (const LAS unsigned char*)(lf + L_DF) + dir * 2560;
      const f32x4 zero4 = {0.f, 0.f, 0.f, 0.f};
      f32x4 X[2][4];
#pragma unroll
      for (int t = 0; t < 2; ++t)
#pragma unroll
          for (int m = 0; m < 4; ++m) X[t][m] = zero4;
#pragma unroll
      for (int m = 0; m < 4; ++m) {
          const u32x2 dw = *(const LAS u32x2*)(df + m * 640 + li * 40 + g4 * 8);
          const bf16x8 dfrag = __builtin_bit_cast(bf16x8, (v4u){dw.x, dw.y, 0u, 0u});
          f32x4 acc[2] = {Rt[0][m], Rt[1][m]};
#pragma unroll
          for (int s2 = 0; s2 < (m + 1) / 2; ++s2) { const u32x2 lo = *(const LAS u32x2*)(ao + (16 * m + li) * 144 + (32 * s2 + 4 * g4) * 2), hi = *(const LAS u32x2*)(ao + (16 * m + li) * 144 + (32 * s2 + 16 + 4 * g4) * 2);
              const bf16x8 afrag = __builtin_bit_cast(bf16x8, (v4u){lo.x, lo.y, hi.x, hi.y});
#pragma unroll
              for (int t = 0; t < 2; ++t) acc[t] = __builtin_amdgcn_mfma_f32_16x16x32_bf16(afrag, pack8(X[t][2 * s2], X[t][2 * s2 + 1]), acc[t], 0, 0, 0); }
#pragma unroll
          for (int t = 0; t < 2; ++t) X[t][m] = __builtin_amdgcn_mfma_f32_16x16x32_bf16(dfrag, pack8(acc[t], zero4), zero4, 0, 0, 0); }
      LAS float* XS = lf + L_XS + dir * 8448;
#pragma unroll
      for (int t = 0; t < 2; ++t)
#pragma unroll
          for (int m = 0; m < 4; ++m)
#pragma unroll
              for (int r = 0; r < 4; ++r) XS[(16 * m + 4 * g4 + r) * 132 + 16 * (nt0 + t) + li] = X[t][m][r]; }
    LBAR();
    { const LAS float* XS = lf + L_XS + dir * 8448;
#pragma unroll
      for (int k = 0; k < 2; ++k) { const int f = td + 256 * k, ms = f >> 6, ll = f & 63, m = ms >> 1, s = ms & 1, rr = 16 * m + (ll & 15), cb = 32 * s + 4 * (ll >> 4);
          float v[8];
#pragma unroll
          for (int e = 0; e < 8; ++e) v[e] = -XS[rr * 132 + 64 + cb + 16 * (e >> 2) + (e & 3)];
          v4u o; o.x = pk2(v[0], v[1]); o.y = pk2(v[2], v[3]); o.z = pk2(v[4], v[5]); o.w = pk2(v[6], v[7]); *(GAS v4u*)(rec + R_NW + f * 16) = o; }
#pragma unroll
      for (int k = 0; k < 4; ++k) { const int u = td + 256 * k, w = u >> 8, m = (u >> 6) & 3, ll = u & 63, r0 = 16 * m + 4 * (ll >> 4), c = 16 * w + (ll & 15);
          const f32x4 o = {XS[r0 * 132 + c], XS[(r0 + 1) * 132 + c], XS[(r0 + 2) * 132 + c], XS[(r0 + 3) * 132 + c]};
          *(GAS f32x4*)(rec + R_U + u * 16) = o; } }
    LBAR();
}
__device__ __forceinline__ void phase_prep(Frame& F, int l) {
    v4u raw[6], wq[6]; float abn[4] = {0.f, 0.f, 0.f, 0.f};
    F.refresh();
    if (F.vcu < NITEM) prep_load(F, l, F.vcu, raw, abn, wq);
    for (int it = F.vcu; it < NITEM; it += F.G) { F.refresh(); prep_item(F, l, it, raw, abn, wq, it + F.G < NITEM ? it + F.G : it); }
}

__device__ __forceinline__ void scan_rec(int b, int h, int dir, int step, int& cid, int& row0) {
    if (step < 4) { const int n = dir ? 3 - step : step; cid = 2048 + (b * 4 + h) * 4 + n; row0 = MLAT + b * CTXL + 64 * n; }
    else { const int n = dir ? 35 - step : step - 4; cid = (b * 4 + h) * 32 + n; row0 = b * SEQ + 64 * n; }
}
__device__ __forceinline__ void phase_scan(Frame& F, int l) {
    const Ptrs& p = F.p;
    const int bx = (int)blockIdx.x, xq = bx >> 3, half = xq & 1, s = (bx & 7) * 16 + (xq >> 1), b = s >> 3, h = (s >> 1) & 3, dir = s & 1, lane = F.lane;
    constexpr int NSTEP = 36, PIECES = 7;
    if (F.wave >= 2) {
        const int lw = F.wave - 2;
#define SCAN_ISSUE(t_) do { int cid_, row0_; scan_rec(b, h, dir, (t_), cid_, row0_); const unsigned char* rec_ = p.ws + WS_REC + (size_t)(cid_ * 2 + dir) * REC_BYTES + lane * 16; \
            LAS unsigned char* slot_ = F.lds + ((t_) % 3) * REC_BYTES; \
            _Pragma("unroll") for (int k_ = 0; k_ < PIECES; ++k_) { int j_ = lw + 6 * k_; j_ = j_ > 40 ? 40 : j_; \
                const int pc_ = j_ < 16 ? j_ : j_ < 24 ? 8 * half + j_ : j_ == 24 ? 32 : j_ + 8; \
                __builtin_amdgcn_global_load_lds((const GAS unsigned*)(rec_ + pc_ * 1024), (LAS unsigned*)(slot_ + pc_ * 1024), 16, 0, 0); } } while (0)
        SCAN_ISSUE(0); SCAN_ISSUE(1);
        for (int t = 0; t < NSTEP; ++t) {
            if (t + 1 < NSTEP) asm volatile("s_waitcnt vmcnt(7)" ::: "memory"); else asm volatile("s_waitcnt vmcnt(0)" ::: "memory");
            asm volatile("" ::: "memory"); __builtin_amdgcn_s_barrier(); asm volatile("" ::: "memory");
            if (t + 2 < NSTEP) SCAN_ISSUE(t + 2);
        }
#undef SCAN_ISSUE
        return;
    }
    const int w = 2 * half + F.wave, li = lane & 15, g4 = lane >> 4;
    f32x4 S[4];
#pragma unroll
    for (int m = 0; m < 4; ++m) S[m] = (f32x4){0.f, 0.f, 0.f, 0.f};
    bf16_t* O = (bf16_t*)(p.ws + WS_OB16) + (size_t)dir * MTOT * 256;
    for (int step = 0; step < NSTEP; ++step) {
        int cid, row0; scan_rec(b, h, dir, step, cid, row0);
        asm volatile("s_waitcnt lgkmcnt(0)" ::: "memory"); __builtin_amdgcn_s_barrier(); asm volatile("" ::: "memory");
        const LAS unsigned char* rec = F.lds + (step % 3) * REC_BYTES;
        bf16x8 nw[4][2], qf[4][2], at[4][2], kt[4][2]; f32x4 av[4], ao[4], a2[4], egc4[4], edl4[4];
#pragma unroll
        for (int m = 0; m < 4; ++m) {
#pragma unroll
            for (int s2 = 0; s2 < 2; ++s2) { nw[m][s2] = *(const LAS bf16x8*)(rec + R_NW + ((m * 2 + s2) * 64 + lane) * 16); qf[m][s2] = *(const LAS bf16x8*)(rec + R_Q + ((m * 2 + s2) * 64 + lane) * 16); }
            av[m] = *(const LAS f32x4*)(rec + R_U + ((w * 4 + m) * 64 + lane) * 16); ao[m] = (f32x4){0.f, 0.f, 0.f, 0.f}; }
        const float gl = *(const LAS float*)(rec + R_VEC + 512);
        bf16x8 Bs[2] = {pack8(S[0], S[1]), pack8(S[2], S[3])};
#pragma unroll
        for (int m = 0; m < 4; ++m)
#pragma unroll
            for (int s2 = 0; s2 < 2; ++s2) { av[m] = __builtin_amdgcn_mfma_f32_16x16x32_bf16(nw[m][s2], Bs[s2], av[m], 0, 0, 0); ao[m] = __builtin_amdgcn_mfma_f32_16x16x32_bf16(qf[m][s2], Bs[s2], ao[m], 0, 0, 0); }
#pragma unroll
        for (int m = 0; m < 4; ++m) {
#pragma unroll
            for (int s2 = 0; s2 < 2; ++s2) { at[m][s2] = *(const LAS bf16x8*)(rec + R_ATTN + ((m * 2 + s2) * 64 + lane) * 16); kt[m][s2] = *(const LAS bf16x8*)(rec + R_KT + ((m * 2 + s2) * 64 + lane) * 16); }
            edl4[m] = *(const LAS f32x4*)(rec + R_VEC + 256 + (16 * m + 4 * g4) * 4); egc4[m] = *(const LAS f32x4*)(rec + R_VEC + (16 * m + 4 * g4) * 4); a2[m] = (f32x4){0.f, 0.f, 0.f, 0.f}; }
        bf16x8 Bv[2] = {pack8(av[0], av[1]), pack8(av[2], av[3])};
        bf16x8 Bvs[2] = {pack8(av[0] * edl4[0], av[1] * edl4[1]), pack8(av[2] * edl4[2], av[3] * edl4[3])};
#pragma unroll
        for (int m = 0; m < 4; ++m) S[m] = S[m] * gl;
#pragma unroll
        for (int m = 0; m < 4; ++m)
#pragma unroll
            for (int s2 = 0; s2 < 2; ++s2) { a2[m] = __builtin_amdgcn_mfma_f32_16x16x32_bf16(at[m][s2], Bv[s2], a2[m], 0, 0, 0); S[m] = __builtin_amdgcn_mfma_f32_16x16x32_bf16(kt[m][s2], Bvs[s2], S[m], 0, 0, 0); }
#pragma unroll
        for (int m = 0; m < 4; ++m) { const f32x4 o = egc4[m] * ao[m] + a2[m];
#pragma unroll
            for (int r = 0; r < 4; ++r) { const int i = 16 * m + 4 * g4 + r, tok = dir ? 63 - i : i;
                O[(size_t)(row0 + tok) * 256 + h * 64 + 16 * w + li] = f2bf(o[r]); } }
    }
}

__device__ __forceinline__ void phase_comb(Frame& F, int l) {
    const Ptrs& p = F.p; const int lane = F.lane;
    const int gw = F.vcu * NWAVES + F.wave, NGW = F.G * NWAVES;
    const bf16_t* OF = (const bf16_t*)(p.ws + WS_OB16); const bf16_t* OB = OF + (size_t)MTOT * 256; const bf16_t* GA = ptile_d(p, T_GA);
    const f32x4 ng = *(const f32x4*)(p.gdn_norm_g + l * 64 + 4 * (lane & 15));
    const int nrow = (l == DEPTH - 1) ? MLAT : MTOT;
    u32x2 an, cn, gn;
    if (gw < nrow) { an = *(const GAS u32x2*)(OF + (size_t)gw * 256 + 4 * lane); cn = *(const GAS u32x2*)(OB + (size_t)gw * 256 + 4 * lane); gn = *(const GAS u32x2*)(GA + (size_t)gw * 256 + 4 * lane); }
    for (int r = gw; r < nrow; r += NGW) {
        const u32x2 a = an, c = cn, gt = gn;
        if (r + NGW < nrow) { const size_t r2 = (size_t)(r + NGW); an = *(const GAS u32x2*)(OF + r2 * 256 + 4 * lane); cn = *(const GAS u32x2*)(OB + r2 * 256 + 4 * lane); gn = *(const GAS u32x2*)(GA + r2 * 256 + 4 * lane); }
        const f32x4 o = {bflo(a.x) + bflo(c.x), bfhi(a.x) + bfhi(c.x), bflo(a.y) + bflo(c.y), bfhi(a.y) + bfhi(c.y)};
        float ss = (o.x * o.x + o.y * o.y) + (o.z * o.z + o.w * o.w);
        ss = row16_sum(ss);
        const float rs = 1.0f / sqrtf(ss * (1.f / 64.f) + EPS);
        u32x2 y; y.x = pk2(o.x * rs * ng.x * fsilu(bflo(gt.x)), o.y * rs * ng.y * fsilu(bfhi(gt.x))); y.y = pk2(o.z * rs * ng.z * fsilu(bflo(gt.y)), o.w * rs * ng.w * fsilu(bfhi(gt.y)));
        *(GAS u32x2*)((bf16_t*)(p.ws + WS_HY) + (size_t)r * DM + 4 * lane) = y;
    }
}

constexpr int PH_FINAL = 1 + 7 * DEPTH, PH_END = PH_FINAL + 1;
struct Args { Ptrs p; int ph_lo, ph_hi; };
__global__ void __launch_bounds__(NWAVES * 64, 2) mega(Args args) {
    extern __shared__ __attribute__((aligned(16))) unsigned char lds[];
    Frame F;
    F.lds = (LAS unsigned char*)lds; F.MISC = (volatile LAS unsigned*)(F.lds + MISC_OFF);
    F.tid = threadIdx.x; F.lane = F.tid & 63; F.wave = __builtin_amdgcn_readfirstlane(F.tid >> 6);
    F.G = gridDim.x; { const int bx = blockIdx.x; F.vcu = (F.G % 8 == 0) ? (bx % 8) * (F.G / 8) + bx / 8 : bx; }
    F.p = args.p; F.ctl = (gu32*)(args.p.ws + WS_CTL);
    for (int u = F.tid; u < (LDS_BYTES - LDSCTL_OFF) / 4; u += NWAVES * 64) ((LAS unsigned*)(F.lds + LDSCTL_OFF))[u] = 0u;
    __syncthreads();
    const bool multi = args.ph_hi - args.ph_lo > 1;
    XcdBarrier bar; bar.bar = (unsigned*)(F.ctl + CW_BAR); bar.x = 0; bar.st = nullptr;
    if (multi) bar = xcd_barrier_post((unsigned*)(F.ctl + CW_BAR), F.MISC + 8);
    for (int ph = args.ph_lo; ph < args.ph_hi; ++ph) {
        F.refresh();
#if PROBE_S >= 0
        const bool amp = (PROBE_S == 7) ? (ph == 0) : (PROBE_S == 8) ? (ph == PH_FINAL) : (ph > 0 && ph < PH_FINAL && (ph - 1) % 7 == PROBE_S);
        const unsigned long long t0 = __builtin_amdgcn_s_memrealtime();
#endif
        if (ph == 0) phase_pre(F);
        else if (ph == PH_FINAL) phase_final(F);
        else { const int l = (ph - 1) / 7, s = (ph - 1) % 7;
            if (s == 0) phase_norm(F, l);
            else if (s == 1) phase_gemm1(F, l);
            else if (s == 2) phase_mix(F, l);
            else if (s == 3) phase_prep(F, l);
            else if (s == 4) phase_scan(F, l);
            else if (s == 5) phase_comb(F, l);
            else if (s == 6) phase_gemm2(F, l);
        }
        if (ph + 1 < args.ph_hi) xcd_barrier(bar);
#if PROBE_S >= 0
        if (amp) { const unsigned long long dt = __builtin_amdgcn_s_memrealtime() - t0; while (__builtin_amdgcn_s_memrealtime() - t0 < 2 * dt) __builtin_amdgcn_s_sleep(4); }
#endif
    }
}

extern "C" void kernel_launch(void* const* d_in, const int* in_sizes, int n_in, void* d_out, int out_size, void* d_ws, size_t ws_size, hipStream_t stream) {
    static int grid = 0;
    if (grid == 0) {
        if (n_in != 23 || out_size != MLAT * DM || ws_size < WS_END) { fprintf(stderr, "kernel_launch: unexpected shapes (n_in %d out %d ws %zu)\n", n_in, out_size, ws_size); grid = -1; return; }
        int dev = 0, cus = 0;
        if (hipGetDevice(&dev) != hipSuccess || hipDeviceGetAttribute(&cus, hipDeviceAttributeMultiprocessorCount, dev) != hipSuccess) { grid = -1; return; }
        if (hipFuncSetAttribute((const void*)mega, hipFuncAttributeMaxDynamicSharedMemorySize, LDS_BYTES) != hipSuccess) { fprintf(stderr, "kernel_launch: hipFuncSetAttribute failed\n"); grid = -1; return; }
        grid = cus;
        if (grid != 256) fprintf(stderr, "kernel_launch: %d CUs (built for 256)\n", grid);
    }
    if (grid < 0) return;
    hipMemsetAsync((char*)d_ws + WS_CTL, 0, CTL_ZERO_BYTES, stream);
    Args a{};
    const float** f = (const float**)&a.p;
    for (int i = 0; i < 23; ++i) f[i] = (const float*)d_in[i];
    a.p.out = (float*)d_out; a.p.ws = (unsigned char*)d_ws;
    a.ph_lo = 0; a.ph_hi = PH_END;
    hipLaunchKernelGGL(mega, dim3(grid), dim3(NWAVES * 64), LDS_BYTES, stream, a);
}
```

```cpp
#include <hip/hip_runtime.h>
#ifndef PROBE_S
#define PROBE_S (-1)
#endif
#include <cstdio>
#include <cstdint>

typedef unsigned short bf16_t;
__device__ __forceinline__ float bf2f(bf16_t v) { return __uint_as_float(((unsigned)v) << 16); }
typedef __bf16 nbf16x2 __attribute__((ext_vector_type(2)));
typedef __bf16 nbf16x8 __attribute__((ext_vector_type(8)));
typedef float nf32x2 __attribute__((ext_vector_type(2)));
typedef float nf32x8 __attribute__((ext_vector_type(8)));
__device__ __forceinline__ bf16_t f2bf(float f) { return __builtin_bit_cast(bf16_t, (__bf16)f); }

constexpr int DM = 1024, NB = 16, SEQ = 2048, DEPTH = 4, CTXL = 256, HD = 64, BW = 256, HA = 4;
constexpr int INC = 3600, NPC = 3584, NTILE = 10;
constexpr int MLAT = NB * SEQ, MCTX = NB * CTXL, MTOT = MLAT + MCTX;
constexpr float EPS = 1e-6f;
__device__ __constant__ int c_gt_col[14]   = {0, 256, 512, 2576,   784, 784 + 128,    1040, 1040 + 128,  1552, 1552 + 128,  2064, 2064 + 128,  2320, 3088};
__device__ __constant__ int c_gt_delta[14] = {0, 0,   0,   0,      2048, 2048,        256, 256,          256, 256,          1280, 1280,        0,    0};
enum { T_Q = 0, T_K = 1, T_V = 2, T_GA = 3, T_BGS = 4, T_CX = 5, T_GLU = 6, T_UG = 7, T_VV = 8, T_GC = 9 };

constexpr size_t MiB = 1u << 20;
constexpr size_t WS_CTL = 0, WS_MOD = 1 * MiB, WS_AB = 2 * MiB, WS_GB = 5 * MiB, WS_STAT = 8 * MiB, WS_XC = 16 * MiB, WS_WIN = 32 * MiB, WS_WOUT = 60 * MiB,
                 WS_HY = 68 * MiB, WS_P = 140 * MiB, WS_OFB = 392 * MiB, WS_END = 512 * MiB;
constexpr size_t PTILE_ELEMS = (size_t)MTOT * 256;
constexpr size_t WS_QKV = WS_P + 4 * PTILE_ELEMS * 2;

struct Ptrs {
    const float *x, *c, *ctx, *c_ctx, *norm_g, *w_ada, *b_ada, *w_in, *qkv_conv_w, *a_log, *dt_bias, *gdn_norm_g, *short_conv_w, *conf_conv_w, *conf_conv_b,
        *conf_ln_g, *conf_ln_b, *smlp_ln_g, *smlp_ln_b, *smlp_w, *smlp_b, *w_out, *final_g;
    float* out; unsigned char* ws;
};

__device__ __forceinline__ float silu_f(float x) { return x / (1.f + expf(-x)); }
__device__ __forceinline__ float sigmoid_f(float x) { return 1.f / (1.f + expf(-x)); }
__device__ __forceinline__ float softplus_f(float x) { return x > 20.f ? x : log1pf(expf(x)); }
__device__ __forceinline__ float fexp(float x) { return __builtin_amdgcn_exp2f(x * 1.44269504089f); }
__device__ __forceinline__ float fsigmoid(float x) { return __builtin_amdgcn_rcpf(1.f + fexp(-x)); }
__device__ __forceinline__ float fsilu(float x) { return x * fsigmoid(x); }

__device__ __forceinline__ float block_sum256(float v, float* red) {
#pragma unroll
    for (int o = 32; o > 0; o >>= 1) v += __shfl_xor(v, o);
    __syncthreads();
    if ((threadIdx.x & 63) == 0) red[threadIdx.x >> 6] = v;
    __syncthreads();
    return red[0] + red[1] + red[2] + red[3];
}
template <int CTRL> __device__ __forceinline__ float dpp_f(float v) { return __int_as_float(__builtin_amdgcn_mov_dpp(__float_as_int(v), CTRL, 0xF, 0xF, true)); }
__device__ __forceinline__ float row16_sum(float v) {
    v += dpp_f<0xB1>(v); v += dpp_f<0x4E>(v); v += dpp_f<0x141>(v); v += dpp_f<0x140>(v); return v; }
__device__ __forceinline__ float wave_sum(float v) {
    v = row16_sum(v);
    { auto r = __builtin_amdgcn_permlane16_swap(__float_as_uint(v), __float_as_uint(v), false, false); v = __uint_as_float(r[0]) + __uint_as_float(r[1]); }
    { auto r = __builtin_amdgcn_permlane32_swap(__float_as_uint(v), __float_as_uint(v), false, false); v = __uint_as_float(r[0]) + __uint_as_float(r[1]); }
    return v; }

__device__ __forceinline__ void row_seq(int row, int& start, int& len) { if (row < MLAT) { start = row & ~(SEQ - 1); len = SEQ; } else { start = row & ~(CTXL - 1); len = CTXL; } }

namespace pg8 {
#define PG8_LAS __attribute__((address_space(3)))
typedef unsigned short bf16_t;
typedef short bf16x8 __attribute__((ext_vector_type(8)));
typedef float f32x4 __attribute__((ext_vector_type(4)));
typedef unsigned u32x4 __attribute__((ext_vector_type(4)));
constexpr int BM = 256, BK = 64, HALF = 128, HTB = HALF * BK * 2  , STAGE_BYTES = 8 * HTB, NXCD = 8, WGM = 8;

__host__ __device__ __forceinline__ int lds_byte(int r, int c) { const int st = (r >> 4) * 2 + (c >> 5), rr = r & 15, cc = c & 31, ob = rr * 64 + cc * 2; return st * 1024 + (ob ^ (((ob >> 9) & 1) << 5)); }
__host__ __device__ __forceinline__ void stage_rc(int b, int& R, int& C) { const int st = b / 1024, sb = b % 1024, swz = sb ^ (((sb >> 9) & 1) << 5); R = (st >> 1) * 16 + swz / 64; C = (st & 1) * 32 + (swz % 64) / 2; }
__host__ __device__ __forceinline__ int perm32(int rho) { const int n = rho >> 4, i = rho & 15; return 8 * (i >> 2) + 4 * n + (i & 3); }

struct Unit { int pm, pn; };
struct Gemm { const bf16_t* A; const bf16_t* Bt; int M, N, K; };

struct StaticOrder {
    int nM, nN, nwg, G, c;
    __host__ __device__ void init(int M, int N, int G_, int c_) { nM = M / BM; nN = N / BM; nwg = nM * nN; G = G_; c = c_; }
    __host__ __device__ bool next(int i, Unit& u) const {
        const long L = (long)i * G + c; if (L >= nwg) return false;
        int wgid = (int)L; { const int q = nwg / NXCD, r = nwg % NXCD, xcd = wgid % NXCD, off = wgid / NXCD; wgid = (xcd < r ? xcd * (q + 1) : r * (q + 1) + (xcd - r) * q) + off; }
        const int nig = WGM * nN, gid = wgid / nig, fm = gid * WGM, gsz = (nM - fm) < WGM ? (nM - fm) : WGM;
        u.pm = fm + ((wgid % nig) % gsz); u.pn = (wgid % nig) / gsz; return true;
    }
    __device__ __forceinline__ void a_ready(const Unit&) const {}
    __device__ __forceinline__ void done(const Unit&) const {}
};


__device__ __forceinline__ unsigned cvt_pk_bf16(float lo, float hi) { return __builtin_bit_cast(unsigned, __builtin_convertvector((nf32x2){lo, hi}, nbf16x2)); }
struct EpiP {
    static constexpr bool PERM = true, AFTER_DRAIN = false;
    bf16_t* P; size_t tile_elems;
    __device__ __forceinline__ void operator()(const f32x4 (&acc)[2][2][4][2], const Unit& u, int wr, int wc, int fr, int fq) const {
        const int row0 = u.pm * BM + wr * 64 + fr, g = u.pn;
        if (g < 4 || g > 11) {
            bf16_t* base = P + (size_t)(g < 4 ? g : g - 4) * tile_elems + wc * 32 + 8 * fq;
            const bool gate = g == 3 || g == 13;
#pragma unroll
            for (int ai = 0; ai < 2; ++ai)
#pragma unroll
                for (int m = 0; m < 4; ++m) { bf16_t* rowp = base + (size_t)(row0 + ai * HALF + m * 16) * 256;
#pragma unroll
                    for (int bj = 0; bj < 2; ++bj) { f32x4 v0 = acc[ai][bj][m][0], v1 = acc[ai][bj][m][1];
                        if (gate) {
#pragma unroll
                            for (int e = 0; e < 4; ++e) { v0[e] = v0[e] * __builtin_amdgcn_rcpf(1.f + __builtin_amdgcn_exp2f(-1.44269504089f * v0[e])); v1[e] = v1[e] * __builtin_amdgcn_rcpf(1.f + __builtin_amdgcn_exp2f(-1.44269504089f * v1[e])); } }
                        u32x4 w; w.x = cvt_pk_bf16(v0[0], v0[1]); w.y = cvt_pk_bf16(v0[2], v0[3]); w.z = cvt_pk_bf16(v1[0], v1[1]); w.w = cvt_pk_bf16(v1[2], v1[3]);
                        *(u32x4*)(rowp + bj * HALF) = w; } }
        } else {
            const int pr = (g - 4) >> 1;
            bf16_t* base = P + (size_t)(4 + pr) * tile_elems + 128 * (g & 1) + wc * 16 + 4 * fq;
#pragma unroll
            for (int ai = 0; ai < 2; ++ai)
#pragma unroll
                for (int m = 0; m < 4; ++m) { bf16_t* rowp = base + (size_t)(row0 + ai * HALF + m * 16) * 256;
#pragma unroll
                    for (int bj = 0; bj < 2; ++bj) { const f32x4 v0 = acc[ai][bj][m][0], v1 = acc[ai][bj][m][1];
                        const float a4[4] = {v0[0], v0[2], v1[0], v1[2]}, b4[4] = {v0[1], v0[3], v1[1], v1[3]}; float o[4];
#pragma unroll
                        for (int e = 0; e < 4; ++e) { const float sg = __builtin_amdgcn_rcpf(1.f + __builtin_amdgcn_exp2f(-1.44269504089f * b4[e]));
                            o[e] = pr == 1 ? a4[e] * b4[e] : pr == 2 ? a4[e] * sg : a4[e] * (b4[e] * sg); }
                        typedef unsigned u32x2v __attribute__((ext_vector_type(2)));
                        u32x2v w; w.x = cvt_pk_bf16(o[0], o[1]); w.y = cvt_pk_bf16(o[2], o[3]);
                        *(u32x2v*)(rowp + bj * 64) = w; } }
        }
    }
};
struct OneUnit {
    Unit u0;
    __device__ __forceinline__ bool next(int i, Unit& u) const { if (i != 0) return false; u = u0; return true; }
    __device__ __forceinline__ void a_ready(const Unit&) const {}
    __device__ __forceinline__ void done(const Unit&) const {}
};
struct EpiResid {
    static constexpr bool PERM = true, AFTER_DRAIN = false;
    const void* x_old; bf16_t* x_new; const void* xc_old; bf16_t* xc_new; const float* mod_l; int odd, mlat, seq, dm, f32in, row_off;
    __device__ __forceinline__ void operator()(f32x4 (&acc)[2][2][4][2], const Unit& u, int wr, int wc, int fr, int fq) const {
        const int rbase = row_off + u.pm * BM; const bool lat = rbase < mlat; const int b = lat ? rbase / seq : 16;
        const int col = u.pn * BM + wc * 32 + 8 * fq;
        { const float* gate = mod_l + (size_t)b * 3072 + 2048 + col;
#pragma unroll
          for (int bj = 0; bj < 2; ++bj)
#pragma unroll
            for (int n = 0; n < 2; ++n) { const f32x4 g = *(const f32x4*)(gate + bj * HALF + 4 * n);
#pragma unroll
                for (int ai = 0; ai < 2; ++ai)
#pragma unroll
                    for (int m = 0; m < 4; ++m) acc[ai][bj][m][n] = acc[ai][bj][m][n] * g; } }
        const void* ob = lat ? x_old : xc_old; bf16_t* nb = lat ? x_new : xc_new;
#pragma unroll
        for (int ai = 0; ai < 2; ++ai)
#pragma unroll
          for (int mh = 0; mh < 2; ++mh) {
            f32x4 o[2][2][2]; unsigned offs[2];
#pragma unroll
            for (int mm = 0; mm < 2; ++mm) { const int r = rbase + ai * HALF + wr * 64 + (2 * mh + mm) * 16 + fr;
                if (lat) { const int tp = r % seq; const int t = odd ? ((tp & 31) * 64 + (tp >> 5)) : tp; offs[mm] = (unsigned)(((r / seq) * seq + t) * dm + col); }
                else offs[mm] = (unsigned)((r - mlat) * dm + col); }
            if (f32in) {
#pragma unroll
                for (int mm = 0; mm < 2; ++mm)
#pragma unroll
                    for (int bj = 0; bj < 2; ++bj)
#pragma unroll
                        for (int n = 0; n < 2; ++n) o[mm][bj][n] = *(const f32x4*)((const float*)ob + offs[mm] + bj * HALF + 4 * n);
            } else {
#pragma unroll
                for (int mm = 0; mm < 2; ++mm)
#pragma unroll
                    for (int bj = 0; bj < 2; ++bj) { const u32x4 w = *(const u32x4*)((const bf16_t*)ob + offs[mm] + bj * HALF);
                        o[mm][bj][0] = (f32x4){__uint_as_float(w.x << 16), __uint_as_float(w.x & 0xffff0000u), __uint_as_float(w.y << 16), __uint_as_float(w.y & 0xffff0000u)};
                        o[mm][bj][1] = (f32x4){__uint_as_float(w.z << 16), __uint_as_float(w.z & 0xffff0000u), __uint_as_float(w.w << 16), __uint_as_float(w.w & 0xffff0000u)}; }
            }
#pragma unroll
            for (int mm = 0; mm < 2; ++mm)
#pragma unroll
                for (int bj = 0; bj < 2; ++bj) { const f32x4 v0 = o[mm][bj][0] + acc[ai][bj][2 * mh + mm][0], v1 = o[mm][bj][1] + acc[ai][bj][2 * mh + mm][1];
                    u32x4 w; w.x = cvt_pk_bf16(v0[0], v0[1]); w.y = cvt_pk_bf16(v0[2], v0[3]); w.z = cvt_pk_bf16(v1[0], v1[1]); w.w = cvt_pk_bf16(v1[2], v1[3]);
                    *(u32x4*)(nb + offs[mm] + bj * HALF) = w; }
            asm volatile("" ::: "memory");
          }
    }
};
template <class Epi, class Sched, bool ALIGN_EPI = false, bool SP2 = false>
__device__ __forceinline__ void gemm_phase(PG8_LAS unsigned char* lds, const Gemm g, const Sched& S, const Epi& E) {
    int tid_ = threadIdx.x; asm volatile("" : "+v"(tid_));
    const int tid = tid_, wid = __builtin_amdgcn_readfirstlane(tid >> 6), lane = tid & 63, wr = wid >> 2, wc = wid & 3, fr = lane & 15, fq = lane >> 4;
    const int K = g.K, nt = K / BK;
    unsigned voffA[2], voffB[2];
#pragma unroll
    for (int i = 0; i < 2; ++i) { int R, C; stage_rc(tid * 16 + i * 8192, R, C); const int Rb = Epi::PERM ? ((R & ~31) + perm32(R & 31)) : R;
        voffA[i] = (unsigned)(R * K + C) * 2u; voffB[i] = (unsigned)(Rb * K + C) * 2u; }
    const size_t kstep = (size_t)(BK * 2);
    const size_t hstep = (size_t)HALF * K * 2;
    const size_t tstep = 2 * hstep;
    const unsigned ldsw = (unsigned)wid * 1024u;
    const int aoff = lds_byte(wr * 64 + fr, fq * 8), boff = lds_byte(wc * 32 + fr, fq * 8);
#define PG8_SA(b, h) (((b) * 2 + (h)) * HTB)
#define PG8_SB(b, h) ((4 + (b) * 2 + (h)) * HTB)
#define PG8_STAGE(bufoff, gbase, voff) do { _Pragma("unroll") for (int _i = 0; _i < 2; ++_i) \
        __builtin_amdgcn_global_load_lds((const unsigned*)((const char*)(gbase) + (voff)[_i]), (PG8_LAS unsigned*)(lds + (bufoff) + ldsw + _i * 8192), 16, 0, 0); } while (0)
#define PG8_LDA(dst, b, h) do { _Pragma("unroll") for (int m = 0; m < 4; ++m) _Pragma("unroll") for (int k = 0; k < 2; ++k) dst[m][k] = *(const PG8_LAS bf16x8*)(lds + PG8_SA(b, h) + aoff + m * 2048 + k * 1024); } while (0)
#define PG8_LDB(dst, b, h) do { _Pragma("unroll") for (int n = 0; n < 2; ++n) _Pragma("unroll") for (int k = 0; k < 2; ++k) dst[n][k] = *(const PG8_LAS bf16x8*)(lds + PG8_SB(b, h) + boff + n * 2048 + k * 1024); } while (0)
#define PG8_MMA(ai, bj, At, Bt) do { __builtin_amdgcn_s_setprio(1); _Pragma("unroll") for (int m = 0; m < 4; ++m) _Pragma("unroll") for (int n = 0; n < 2; ++n) _Pragma("unroll") for (int k = 0; k < 2; ++k) \
        acc[ai][bj][m][n] = __builtin_amdgcn_mfma_f32_16x16x32_bf16(Bt[n][k], At[m][k], acc[ai][bj][m][n], 0, 0, 0); __builtin_amdgcn_s_setprio(0); } while (0)
#define PG8_WAIT_V(n) asm volatile("s_waitcnt vmcnt(" #n ")" ::: "memory")
#define PG8_WAIT_L(n) asm volatile("s_waitcnt lgkmcnt(" #n ")" ::: "memory")
#define PG8_BAR __builtin_amdgcn_s_barrier()
#define PG8_SCHED __builtin_amdgcn_sched_barrier(0)
    Unit cur, nxt; int ui = 0;
    if (!S.next(0, cur)) return;
    f32x4 acc[2][2][4][2];
#pragma unroll
    for (int a = 0; a < 2; ++a)
#pragma unroll
        for (int b = 0; b < 2; ++b)
#pragma unroll
            for (int m = 0; m < 4; ++m)
#pragma unroll
                for (int n = 0; n < 2; ++n) acc[a][b][m][n] = (f32x4){0.f, 0.f, 0.f, 0.f};
    bf16x8 At[4][2], B0[2][2], B1[2][2];
    const char* cA = (const char*)g.A + (size_t)cur.pm * tstep; const char* cB = (const char*)g.Bt + (size_t)cur.pn * tstep;
    S.a_ready(cur);
    if constexpr (SP2) {
        PG8_STAGE(PG8_SB(0, 0), cB, voffB); PG8_STAGE(PG8_SB(0, 1), cB + hstep, voffB); PG8_STAGE(PG8_SA(0, 0), cA, voffA); PG8_STAGE(PG8_SA(0, 1), cA + hstep, voffA);
        if (wr == 1) PG8_BAR;
        PG8_WAIT_V(2); PG8_BAR;
        PG8_STAGE(PG8_SB(1, 0), cB + kstep, voffB); PG8_STAGE(PG8_SA(1, 0), cA + kstep, voffA); PG8_STAGE(PG8_SB(1, 1), cB + hstep + kstep, voffB);
        PG8_WAIT_V(6); PG8_BAR;
    } else {
        PG8_STAGE(PG8_SB(0, 0), cB, voffB); PG8_STAGE(PG8_SA(0, 0), cA, voffA); PG8_STAGE(PG8_SB(0, 1), cB + hstep, voffB); PG8_STAGE(PG8_SA(0, 1), cA + hstep, voffA);
        if (wr == 1) PG8_BAR;
        PG8_WAIT_V(4); PG8_BAR;
        PG8_STAGE(PG8_SB(1, 0), cB + kstep, voffB); PG8_STAGE(PG8_SA(1, 0), cA + kstep, voffA); PG8_STAGE(PG8_SB(1, 1), cB + hstep + kstep, voffB);
        PG8_WAIT_V(6); PG8_BAR;
    }
    for (;;) {
        const bool has_next = S.next(ui + 1, nxt);
        const char* nA = has_next ? (const char*)g.A + (size_t)nxt.pm * tstep : cA; const char* nB = has_next ? (const char*)g.Bt + (size_t)nxt.pn * tstep : cB;
        for (int t = 0; t < nt; t += 2) {
            const bool last = (t == nt - 2);
            const char* a1 = cA + (size_t)(t + 1) * kstep;
            const char* a2 = last ? nA : cA + (size_t)(t + 2) * kstep; const char* b2 = last ? nB : cB + (size_t)(t + 2) * kstep;
            const char* a3 = a2 + kstep; const char* b3 = b2 + kstep;
            if (last && has_next) S.a_ready(nxt);
            if constexpr (SP2) {
            PG8_LDB(B0, 0, 0); PG8_LDB(B1, 0, 1); PG8_SCHED; PG8_LDA(At, 0, 0); PG8_STAGE(PG8_SA(1, 1), a1 + hstep, voffA);
            PG8_WAIT_V(8); PG8_WAIT_L(0); PG8_BAR; PG8_MMA(0, 0, At, B0); PG8_MMA(0, 1, At, B1); PG8_BAR; PG8_SCHED;
            PG8_LDA(At, 0, 1); PG8_STAGE(PG8_SB(0, 0), b2, voffB); PG8_STAGE(PG8_SB(0, 1), b2 + hstep, voffB); PG8_STAGE(PG8_SA(0, 0), a2, voffA);
            PG8_WAIT_V(8); PG8_WAIT_L(0); PG8_BAR; PG8_MMA(1, 0, At, B0); PG8_MMA(1, 1, At, B1); PG8_BAR; PG8_SCHED;
            PG8_LDB(B0, 1, 0); PG8_LDB(B1, 1, 1); PG8_SCHED; PG8_LDA(At, 1, 0); PG8_STAGE(PG8_SA(0, 1), a2 + hstep, voffA);
            PG8_WAIT_V(8); PG8_WAIT_L(0); PG8_BAR; PG8_MMA(0, 0, At, B0); PG8_MMA(0, 1, At, B1); PG8_BAR; PG8_SCHED;
            PG8_LDA(At, 1, 1); PG8_STAGE(PG8_SB(1, 0), b3, voffB); PG8_STAGE(PG8_SB(1, 1), b3 + hstep, voffB); PG8_STAGE(PG8_SA(1, 0), a3, voffA);
            PG8_WAIT_V(8); PG8_WAIT_L(0); PG8_BAR; PG8_MMA(1, 0, At, B0); PG8_MMA(1, 1, At, B1); PG8_BAR; PG8_SCHED;
            } else {
            PG8_LDB(B0, 0, 0); PG8_SCHED; PG8_LDA(At, 0, 0); PG8_STAGE(PG8_SA(1, 1), a1 + hstep, voffA);
            PG8_WAIT_L(8); PG8_BAR; PG8_WAIT_L(0); PG8_MMA(0, 0, At, B0); PG8_BAR; PG8_SCHED;
            PG8_LDB(B1, 0, 1); PG8_STAGE(PG8_SB(0, 0), b2, voffB);
            PG8_BAR; PG8_WAIT_L(0); PG8_MMA(0, 1, At, B1); PG8_BAR;
            PG8_LDA(At, 0, 1); PG8_STAGE(PG8_SA(0, 0), a2, voffA);
            PG8_BAR; PG8_WAIT_L(0); PG8_MMA(1, 0, At, B0); PG8_BAR; PG8_SCHED;
            PG8_STAGE(PG8_SB(0, 1), b2 + hstep, voffB);
            PG8_WAIT_V(6); PG8_BAR; PG8_MMA(1, 1, At, B1); PG8_BAR;
            PG8_LDB(B0, 1, 0); PG8_SCHED; PG8_LDA(At, 1, 0); PG8_STAGE(PG8_SA(0, 1), a2 + hstep, voffA);
            PG8_WAIT_L(8); PG8_BAR; PG8_WAIT_L(0); PG8_MMA(0, 0, At, B0); PG8_BAR; PG8_SCHED;
            PG8_LDB(B1, 1, 1); PG8_STAGE(PG8_SB(1, 0), b3, voffB);
            PG8_BAR; PG8_WAIT_L(0); PG8_MMA(0, 1, At, B1); PG8_BAR;
            PG8_LDA(At, 1, 1); PG8_STAGE(PG8_SA(1, 0), a3, voffA);
            PG8_BAR; PG8_WAIT_L(0); PG8_MMA(1, 0, At, B0); PG8_BAR; PG8_SCHED;
            PG8_STAGE(PG8_SB(1, 1), b3 + hstep, voffB);
            PG8_WAIT_V(6); PG8_BAR; PG8_MMA(1, 1, At, B1); PG8_BAR;
            }
        }
        if constexpr (ALIGN_EPI) { if (wr == 0) PG8_BAR; }
        if constexpr (!Epi::AFTER_DRAIN) { E(acc, cur, wr, wc, fr, fq); S.done(cur); }
        if (!has_next) break;
#pragma unroll
        for (int a = 0; a < 2; ++a)
#pragma unroll
            for (int b = 0; b < 2; ++b)
#pragma unroll
                for (int m = 0; m < 4; ++m)
#pragma unroll
                    for (int n = 0; n < 2; ++n) acc[a][b][m][n] = (f32x4){0.f, 0.f, 0.f, 0.f};
        cur = nxt; cA = nA; cB = nB; ++ui;
        if constexpr (ALIGN_EPI) { if (wr == 1) PG8_BAR; }
    }
    PG8_WAIT_V(0);
    if constexpr (!ALIGN_EPI) { if (wr == 0) PG8_BAR; }
    PG8_BAR;
    if constexpr (Epi::AFTER_DRAIN) { E.fused(acc, cur, wr, wc, fr, fq, lds, wid, lane); S.done(cur); }
#undef PG8_SA
#undef PG8_SB
#undef PG8_STAGE
#undef PG8_LDA
#undef PG8_LDB
#undef PG8_MMA
#undef PG8_WAIT_V
#undef PG8_WAIT_L
#undef PG8_BAR
#undef PG8_SCHED
}
}

constexpr int NWAVES = 8;
constexpr int RING_BYTES = 159744, LDSCTL_OFF = RING_BYTES, MISC_OFF = LDSCTL_OFF + 320, LDS_BYTES = 163840;
constexpr int CW_BAR = 4096;
constexpr size_t CTL_ZERO_BYTES = 64 * 1024;
#define GAS __attribute__((address_space(1)))
#define LAS __attribute__((address_space(3)))
typedef float f32x4 __attribute__((ext_vector_type(4)));
typedef unsigned v4u __attribute__((ext_vector_type(4)));
typedef unsigned u32x2 __attribute__((ext_vector_type(2)));
__device__ __forceinline__ float bflo(unsigned w) { return __uint_as_float(w << 16); }
__device__ __forceinline__ float bfhi(unsigned w) { return __uint_as_float(w & 0xffff0000u); }
typedef short bf16x8 __attribute__((ext_vector_type(8)));
__device__ __forceinline__ void unpack8(const v4u& w, float (&f)[8]) { f[0] = bflo(w.x); f[1] = bfhi(w.x); f[2] = bflo(w.y); f[3] = bfhi(w.y); f[4] = bflo(w.z); f[5] = bfhi(w.z); f[6] = bflo(w.w); f[7] = bfhi(w.w); }
__device__ __forceinline__ bf16x8 pack8(const f32x4& a, const f32x4& b) {
    return __builtin_bit_cast(bf16x8, __builtin_convertvector((nf32x8){a.x, a.y, a.z, a.w, b.x, b.y, b.z, b.w}, nbf16x8)); }
typedef GAS unsigned gu32;
#define LDS_WAIT() asm volatile("s_waitcnt lgkmcnt(0)" ::: "memory")
#define LBAR() do { asm volatile("s_waitcnt lgkmcnt(0)" ::: "memory"); __builtin_amdgcn_s_barrier(); asm volatile("" ::: "memory"); } while (0)
#define VM_WAIT() asm volatile("s_waitcnt vmcnt(0)" ::: "memory")
__device__ __forceinline__ unsigned pk2(float lo, float hi) { return __builtin_bit_cast(unsigned, __builtin_convertvector((nf32x2){lo, hi}, nbf16x2)); }

#define XB_TMO      128
#define XB_XCNT(j)  (256  + 64 * (j))
#define XB_XSUB(j)  (1280 + 64 * (j))
#define XB_XGEN(j)  (2304 + 64 * (j))
#define XB_TOP      3328
#define XB_TOPGEN   3392
#define XCD_BAR_WORDS 3456
#define XB_SPIN_CAP (1u << 22)

__device__ __forceinline__ unsigned xb_ld(unsigned* p)              { return __hip_atomic_load(p, __ATOMIC_RELAXED, __HIP_MEMORY_SCOPE_AGENT); }
__device__ __forceinline__ unsigned xb_add(unsigned* p, unsigned v) { return __hip_atomic_fetch_add(p, v, __ATOMIC_RELAXED, __HIP_MEMORY_SCOPE_AGENT); }
__device__ __forceinline__ unsigned xb_xcc_id() { return (unsigned)__builtin_amdgcn_s_getreg((3 << 11) | 20) & 0xFu; }
#define XB_SPIN(cond, bar) do { unsigned _sp = 0; while (cond) { __builtin_amdgcn_s_sleep(1); \
    if ((++_sp & 255u) == 0u) { if (xb_ld(&(bar)[XB_TMO])) break; if (_sp > XB_SPIN_CAP) { atomicAdd(&(bar)[XB_TMO], 1u); break; } } } } while (0)

struct XcdBarrier {
    unsigned* bar; unsigned x;
    volatile LAS unsigned* st;
};

__device__ __forceinline__ XcdBarrier xcd_barrier_post(unsigned* bar, volatile LAS unsigned* st) {
    XcdBarrier b; b.bar = bar; b.x = xb_xcc_id(); b.st = st;
    if (threadIdx.x == 0) (void)xb_add(&bar[XB_XCNT(b.x)], 1u);
    return b;
}
__device__ __forceinline__ void xcd_barrier_complete(unsigned* bar, unsigned x, unsigned& nloc, unsigned& nx) {
    const unsigned G = gridDim.x * gridDim.y * gridDim.z;
    unsigned sum, cnt, mine, sp = 0u;
    for (;;) {
        sum = 0u; cnt = 0u; mine = 0u;
#pragma unroll
        for (unsigned j = 0; j < 16; ++j) { const unsigned c = xb_ld(&bar[XB_XCNT(j)]); sum += c; cnt += (c > 0u) ? 1u : 0u; mine = (j == x) ? c : mine; }
        if (sum == G) break;
        __builtin_amdgcn_s_sleep(1);
        if ((++sp & 255u) == 0u) { if (xb_ld(&bar[XB_TMO])) break; if (sp > XB_SPIN_CAP) { atomicAdd(&bar[XB_TMO], 1u); break; } }
    }
    nloc = mine > 0u ? mine : 1u; nx = cnt > 0u ? cnt : 1u;
}

__device__ __forceinline__ void xcd_barrier(const XcdBarrier& b) {
    asm volatile("s_waitcnt vmcnt(0)" ::: "memory");
    __syncthreads();
    if (threadIdx.x == 0) {
        unsigned* bar = b.bar;
        __builtin_amdgcn_s_waitcnt(0);
        unsigned nloc = b.st[0], nx = b.st[1];
        if (nloc == 0u) { xcd_barrier_complete(bar, b.x, nloc, nx); b.st[0] = nloc; b.st[1] = nx; }
        const unsigned old = xb_add(&bar[XB_XSUB(b.x)], 1u);
        const unsigned gen = old / nloc;
        if (old + 1u == (gen + 1u) * nloc) {
            __builtin_amdgcn_fence(__ATOMIC_RELEASE, "agent");
            asm volatile("s_waitcnt vmcnt(0)" ::: "memory");
            const unsigned og = xb_add(&bar[XB_TOP], 1u);
            const unsigned tg = og / nx;
            if (og + 1u == (tg + 1u) * nx) xb_add(&bar[XB_TOPGEN], 1u);
            else XB_SPIN(xb_ld(&bar[XB_TOPGEN]) == tg, bar);
            __builtin_amdgcn_fence(__ATOMIC_ACQUIRE, "agent");
            xb_add(&bar[XB_XGEN(b.x)], 1u);
            asm volatile("s_waitcnt vmcnt(0)" ::: "memory");
        } else {
            XB_SPIN(xb_ld(&bar[XB_XGEN(b.x)]) == gen, bar);
            __builtin_amdgcn_fence(__ATOMIC_ACQUIRE, "agent");
            asm volatile("s_waitcnt vmcnt(0)" ::: "memory");
        }
    }
    __syncthreads();
}


#define CAS __attribute__((address_space(4)))
typedef const CAS Ptrs KPtrs;
struct Frame {
    LAS unsigned char* lds; volatile LAS unsigned* MISC; gu32* ctl;
    int tid, lane, wave, vcu, G;
    __device__ __forceinline__ KPtrs& P() const { const CAS char* kp = (const CAS char*)__builtin_amdgcn_kernarg_segment_ptr(); asm volatile("" : "+s"(kp)); return *(KPtrs*)kp; }
    __device__ __forceinline__ void refresh() { int t = threadIdx.x; asm volatile("" : "+v"(t)); tid = t; lane = t & 63; wave = __builtin_amdgcn_readfirstlane(t >> 6); }
};

__device__ __forceinline__ void transpose_item(const float* W, int coff, int ld, bf16_t* WT, LAS float* scr, int k0, int lane) {
    float tv[32];
#pragma unroll
    for (int i = 0; i < 32; ++i) tv[i] = W[(size_t)(k0 + 2 * i + (lane >> 5)) * ld + coff];
#pragma unroll
    for (int i = 0; i < 32; ++i) scr[(2 * i + (lane >> 5)) * 33 + (lane & 31)] = tv[i];
    LDS_WAIT(); asm volatile("" ::: "memory");
    const int c = lane & 7;
#pragma unroll
    for (int j = 0; j < 4; ++j) { const int n = (lane >> 3) + 8 * j; const LAS float* s = scr + (8 * c) * 33 + n;
        v4u o; o.x = pk2(s[0 * 33], s[1 * 33]); o.y = pk2(s[2 * 33], s[3 * 33]); o.z = pk2(s[4 * 33], s[5 * 33]); o.w = pk2(s[6 * 33], s[7 * 33]);
        *(GAS v4u*)(WT + (size_t)n * DM + k0 + 8 * c) = o; }
    LDS_WAIT(); asm volatile("" ::: "memory");
}
__device__ __forceinline__ void convert_weights(Frame& F, int l, int gw, int NGW) {
    KPtrs& p = F.P();
    LAS float* scr = (LAS float*)(F.lds + F.wave * 16384);
    constexpr int I_IN = 16 * (NPC / 32), I_OUT = 16 * (DM / 32), I_L = I_IN + I_OUT;
    for (int it = gw; it < I_L; it += NGW) { int r = it;
        if (r < I_IN) { const int kb = r / (NPC / 32), nb = r % (NPC / 32), n0 = 32 * nb;
            const int g = n0 >> 8, i0 = n0 & 255, li = F.lane & 31, dl = c_gt_delta[g];
            const int coff = c_gt_col[g] + (dl ? (i0 >> 1) + (li >> 1) + ((li & 1) ? dl : 0) : i0 + li);
            transpose_item(p.w_in + (size_t)l * DM * INC, coff, INC, (bf16_t*)(p.ws + WS_WIN) + ((size_t)l * NPC + n0) * DM, scr, 64 * kb, F.lane); }
        else { r -= I_IN; const int kb = r / (DM / 32), nb = r % (DM / 32), n0 = 32 * nb;
            transpose_item(p.w_out + (size_t)l * DM * DM, n0 + (F.lane & 31), DM, (bf16_t*)(p.ws + WS_WOUT) + ((size_t)l * DM + n0) * DM, scr, 64 * kb, F.lane); }
    }
}
__device__ __forceinline__ void mod_item(Frame& F, int l, int slab) {
    KPtrs& p = F.P(); const int n0 = slab * 128;
    LAS float* s = (LAS float*)F.lds;
    LAS float* red = s + 17 * DM;
    { float cv[34];
#pragma unroll
      for (int j = 0; j < 34; ++j) { const int i = F.tid + j * NWAVES * 64, b = i >> 10, k = i & 1023; cv[j] = b < 16 ? p.c[b * DM + k] : p.c_ctx[k]; }
#pragma unroll
      for (int j = 0; j < 34; ++j) s[F.tid + j * NWAVES * 64] = fsilu(cv[j]); }
    __syncthreads();
    const int cq = F.tid & 31, kg = F.tid >> 5;
    f32x4 acc[17];
#pragma unroll
    for (int b = 0; b < 17; ++b) acc[b] = (f32x4){0.f, 0.f, 0.f, 0.f};
    const float* w = p.w_ada + (size_t)l * DM * 3072 + n0 + 4 * cq;
#pragma unroll 1
    for (int k0 = kg * 64; k0 < kg * 64 + 64; k0 += 16) { f32x4 wv[16];
#pragma unroll
        for (int kk = 0; kk < 16; ++kk) wv[kk] = *(const f32x4*)(w + (size_t)(k0 + kk) * 3072);
#pragma unroll
        for (int q = 0; q < 4; ++q) {
#pragma unroll
            for (int b = 0; b < 17; ++b) { const f32x4 s4 = *(const LAS f32x4*)(s + b * DM + k0 + 4 * q);
                acc[b] += wv[4 * q] * s4.x + wv[4 * q + 1] * s4.y + wv[4 * q + 2] * s4.z + wv[4 * q + 3] * s4.w; }
            asm volatile("" ::: "memory"); } }
#pragma unroll
    for (int b = 0; b < 17; ++b) {
        float v[4] = {acc[b].x, acc[b].y, acc[b].z, acc[b].w};
#pragma unroll
        for (int e = 0; e < 4; ++e) { auto r = __builtin_amdgcn_permlane32_swap(__float_as_uint(v[e]), __float_as_uint(v[e]), false, false); v[e] = __uint_as_float(r[0]) + __uint_as_float(r[1]); }
        if (F.lane < 32) *(LAS f32x4*)(red + (F.wave * 17 + b) * 128 + 4 * cq) = (f32x4){v[0], v[1], v[2], v[3]}; }
    __syncthreads();
    float* mod = (float*)(p.ws + WS_MOD);
    for (int o = F.tid; o < 17 * 128; o += NWAVES * 64) { const int b = o >> 7, cc = o & 127; float sum = p.b_ada[l * 3072 + n0 + cc];
#pragma unroll
        for (int g = 0; g < 8; ++g) sum += red[(g * 17 + b) * 128 + cc];
        mod[(size_t)(l * 17 + b) * 3072 + n0 + cc] = sum; }
    __syncthreads();
}
__device__ __forceinline__ void phase_pre(Frame& F) {
    KPtrs& p = F.P();
    if (blockIdx.x < 96) mod_item(F, (int)blockIdx.x / 24, (int)blockIdx.x % 24);
    convert_weights(F, 0, F.vcu * NWAVES + F.wave, F.G * NWAVES);
    { bf16_t* wsb = (bf16_t*)(p.ws + (9u << 20));
      for (int i = F.vcu * NWAVES * 64 + F.tid; i < DEPTH * 4 * 128 * 128 / 4; i += F.G * NWAVES * 64) { const f32x4 v = *(const f32x4*)(p.smlp_w + 4 * (size_t)i);
          unsigned long long o = (unsigned long long)pk2(v.x, v.y) | ((unsigned long long)pk2(v.z, v.w) << 32); *(GAS unsigned long long*)(wsb + 4 * (size_t)i) = o; } }
}

__device__ __forceinline__ void norm_wave_rows(Frame& F, int l, const LAS float* wab, int rbeg, int rend) {
    KPtrs& p = F.P();
    const int lane = F.lane;
    int curb = -1; f32x4 gs[4], sh[4];
    f32x4 vn[2][4]; int bn[2] = {0, 0};
    const bf16_t* const XB = (const bf16_t*)((const char*)p.out + (64u << 20)); const bf16_t* const XCB = (const bf16_t*)(p.ws + WS_XC);
#define NORM_OFF(r_, b_, off_, lat_) do { if ((r_) < MLAT) { b_ = (r_) >> 11; const int tp_ = (r_) & 2047; const int t_ = (l & 1) ? ((tp_ & 31) * 64 + (tp_ >> 5)) : tp_; off_ = ((size_t)b_ * SEQ + t_) * DM; lat_ = true; } \
        else { b_ = 16; off_ = (size_t)((r_) - MLAT) * DM; lat_ = false; } } while (0)
#define NORM_LOAD(r_, slot_) do { if ((r_) < rend) { size_t off_; bool lat_; NORM_OFF(r_, bn[slot_], off_, lat_); \
        if (l == 0) { const GAS f32x4* xr_ = (const GAS f32x4*)((lat_ ? p.x : p.ctx) + off_) + lane; _Pragma("unroll") for (int j = 0; j < 4; ++j) vn[slot_][j] = xr_[64 * j]; } \
        else { const GAS u32x2* xr_ = (const GAS u32x2*)((lat_ ? XB : XCB) + off_) + lane; _Pragma("unroll") for (int j = 0; j < 4; ++j) { const u32x2 w_ = xr_[64 * j]; vn[slot_][j] = (f32x4){bflo(w_.x), bfhi(w_.x), bflo(w_.y), bfhi(w_.y)}; } } } } while (0)
    NORM_LOAD(rbeg, 0); NORM_LOAD(rbeg + 1, 1);
    for (int r0 = rbeg; r0 < rend; r0 += 2) {
#pragma unroll
      for (int u = 0; u < 2; ++u) { const int r = r0 + u; if (r < rend) {
        const int b = bn[u]; f32x4 v[4]; float ss = 0.f;
#pragma unroll
        for (int j = 0; j < 4; ++j) v[j] = vn[u][j];
        NORM_LOAD(r + 2, u);
        if (b != curb) { curb = b; const float* mod = (const float*)(p.ws + WS_MOD) + (size_t)(l * 17 + b) * 3072;
#pragma unroll
            for (int j = 0; j < 4; ++j) { const f32x4 g = *(const f32x4*)(p.norm_g + l * DM + 256 * j + 4 * lane), sc = *(const f32x4*)(mod + 1024 + 256 * j + 4 * lane);
                gs[j] = g * (sc + 1.0f); sh[j] = *(const f32x4*)(mod + 256 * j + 4 * lane); } }
#pragma unroll
        for (int j = 0; j < 4; ++j) { ss += (v[j].x * v[j].x + v[j].y * v[j].y) + (v[j].z * v[j].z + v[j].w * v[j].w); }
        ss = wave_sum(ss);
        const float rstd = 1.0f / sqrtf(ss * (1.0f / DM) + EPS);
        GAS unsigned long long* o8 = (GAS unsigned long long*)((bf16_t*)(p.ws + WS_HY) + (size_t)r * DM) + lane;
#pragma unroll
        for (int j = 0; j < 4; ++j) { v[j] = v[j] * rstd * gs[j] + sh[j]; o8[64 * j] = (unsigned long long)pk2(v[j].x, v[j].y) | ((unsigned long long)pk2(v[j].z, v[j].w) << 32); }
        float acc[16];
#pragma unroll
        for (int n = 0; n < 16; ++n) { float a = 0.f;
#pragma unroll
            for (int j = 0; j < 4; ++j) { const f32x4 w4 = *(const LAS f32x4*)(wab + n * DM + 256 * j + 4 * lane); a += (v[j].x * w4.x + v[j].y * w4.y) + (v[j].z * w4.z + v[j].w * w4.w); }
            acc[n] = a; if ((n & 3) == 3) asm volatile("" ::: "memory"); }
        float r8[8], r4[4], r2[2], r1;
#pragma unroll
        for (int i = 0; i < 8; ++i) { auto q = __builtin_amdgcn_permlane32_swap(__float_as_uint(acc[i]), __float_as_uint(acc[i + 8]), false, false); r8[i] = __uint_as_float(q[0]) + __uint_as_float(q[1]); }
#pragma unroll
        for (int i = 0; i < 4; ++i) { auto q = __builtin_amdgcn_permlane16_swap(__float_as_uint(r8[i]), __float_as_uint(r8[i + 4]), false, false); r4[i] = __uint_as_float(q[0]) + __uint_as_float(q[1]); }
        { const bool up = lane & 8;
#pragma unroll
          for (int i = 0; i < 2; ++i) { const float keep = up ? r4[i + 2] : r4[i], send = up ? r4[i] : r4[i + 2]; r2[i] = keep + dpp_f<0x128>(send); } }
        { const bool up = lane & 4; const float keep = up ? r2[1] : r2[0], send = up ? r2[0] : r2[1]; r1 = keep + __shfl_xor(send, 4); }
        r1 += dpp_f<0x4E>(r1); r1 += dpp_f<0xB1>(r1);
        if ((lane & 3) == 0) ((float*)(p.ws + WS_AB))[(size_t)r * 16 + (lane >> 2)] = r1;
      } }
    }
}
__device__ __forceinline__ void norm_tile16(Frame& F, int l, const LAS bf16_t* wabT, LAS float* tab, int r0, int& curb) {
    KPtrs& p = F.P(); const int lane = F.lane, li = lane & 15, g4 = lane >> 4;
    const bf16_t* const XB = (const bf16_t*)((const char*)p.out + (64u << 20)); const bf16_t* const XCB = (const bf16_t*)(p.ws + WS_XC);
    const int r = r0 + li; int b; const bf16_t* src;
    if (r < MLAT) { b = r >> 11; const int tp = r & 2047; const int t = (l & 1) ? ((tp & 31) * 64 + (tp >> 5)) : tp; src = XB + ((size_t)b * SEQ + t) * DM; }
    else { b = 16; src = XCB + (size_t)(r - MLAT) * DM; }
    v4u xr[32];
#pragma unroll
    for (int s2 = 0; s2 < 32; ++s2) xr[s2] = *(const GAS v4u*)(src + 32 * s2 + 8 * g4);
    const int bt = __builtin_amdgcn_readfirstlane(b);
    if (bt != curb) { curb = bt; const float* mod = (const float*)(p.ws + WS_MOD) + (size_t)(l * 17 + bt) * 3072;
#pragma unroll
        for (int j = 0; j < 4; ++j) { const f32x4 g = *(const f32x4*)(p.norm_g + l * DM + 256 * j + 4 * lane), sc = *(const f32x4*)(mod + 1024 + 256 * j + 4 * lane), sh = *(const f32x4*)(mod + 256 * j + 4 * lane);
            *(LAS f32x4*)(tab + 256 * j + 4 * lane) = g * (sc + 1.0f); *(LAS f32x4*)(tab + 1024 + 256 * j + 4 * lane) = sh; }
        asm volatile("s_waitcnt lgkmcnt(0)" ::: "memory"); }
    float ss = 0.f;
#pragma unroll
    for (int s2 = 0; s2 < 32; ++s2) { float f[8]; unpack8(xr[s2], f);
#pragma unroll
        for (int e = 0; e < 8; ++e) ss += f[e] * f[e]; }
    { auto q = __builtin_amdgcn_permlane16_swap(__float_as_uint(ss), __float_as_uint(ss), false, false); ss = __uint_as_float(q[0]) + __uint_as_float(q[1]); }
    { auto q = __builtin_amdgcn_permlane32_swap(__float_as_uint(ss), __float_as_uint(ss), false, false); ss = __uint_as_float(q[0]) + __uint_as_float(q[1]); }
    const float rstd = 1.0f / sqrtf(ss * (1.0f / DM) + EPS);
#pragma unroll
    for (int s2 = 0; s2 < 32; ++s2) asm volatile("" : "+v"(xr[s2]));
    f32x4 acc = {0.f, 0.f, 0.f, 0.f};
    bf16_t* hrow = (bf16_t*)(p.ws + WS_HY) + (size_t)r * DM + 8 * g4;
#pragma unroll
    for (int s2 = 0; s2 < 32; ++s2) { float f[8]; unpack8(xr[s2], f);
        const f32x4 ga = *(const LAS f32x4*)(tab + 32 * s2 + 8 * g4), gb = *(const LAS f32x4*)(tab + 32 * s2 + 8 * g4 + 4), sa = *(const LAS f32x4*)(tab + 1024 + 32 * s2 + 8 * g4), sb = *(const LAS f32x4*)(tab + 1024 + 32 * s2 + 8 * g4 + 4);
        const f32x4 ha = (f32x4){f[0], f[1], f[2], f[3]} * rstd * ga + sa, hb = (f32x4){f[4], f[5], f[6], f[7]} * rstd * gb + sb;
        const bf16x8 hf = pack8(ha, hb);
        *(GAS bf16x8*)(hrow + 32 * s2) = hf;
        const bf16x8 wf = *(const LAS bf16x8*)(wabT + li * DM + 32 * s2 + 8 * g4);
        acc = __builtin_amdgcn_mfma_f32_16x16x32_bf16(hf, wf, acc, 0, 0, 0);
        if ((s2 & 1) == 1) asm volatile("" ::: "memory"); }
    float* AB = (float*)(p.ws + WS_AB) + (size_t)(r0 + 4 * g4) * 16 + li;
#pragma unroll
    for (int rr = 0; rr < 4; ++rr) AB[rr * 16] = acc[rr];
}
constexpr int CW_CTXC = 9216, CW_NORMQ = 13312;
__device__ __forceinline__ void norm_stage_wab(Frame& F, int l, LAS float* wab) {
    KPtrs& p = F.P();
    float wv[32];
#pragma unroll
    for (int q = 0; q < 32; ++q) { const int i = F.tid + q * NWAVES * 64; wv[q] = p.w_in[(size_t)l * DM * INC + (size_t)(i >> 4) * INC + 768 + (i & 15)]; }
#pragma unroll
    for (int q = 0; q < 32; ++q) { const int i = F.tid + q * NWAVES * 64; wab[(i & 15) * DM + (i >> 4)] = wv[q]; }
    __syncthreads();
}
__device__ __forceinline__ void phase_norm(Frame& F, int l) {
    KPtrs& p = F.P();
    LAS float* wab = (LAS float*)F.lds;
    if (l == 0) {
        norm_stage_wab(F, l, wab);
        constexpr int RPW = MTOT / (256 * NWAVES);
        const int gw = F.vcu * NWAVES + F.wave;
        norm_wave_rows(F, l, wab, gw * RPW, (gw + 1) * RPW < MTOT ? (gw + 1) * RPW : MTOT);
        __syncthreads();
        return;
    }
    const LAS bf16_t* wabT = (const LAS bf16_t*)F.lds; LAS float* tab = (LAS float*)(F.lds + 32768 + F.wave * 8192); int curb = -1;
#define NORM_STAGE_WAB() do { float wv_[32];   \
        _Pragma("unroll") for (int q_ = 0; q_ < 32; ++q_) { const int i_ = F.tid + q_ * NWAVES * 64; wv_[q_] = p.w_in[(size_t)l * DM * INC + (size_t)(i_ >> 4) * INC + 768 + (i_ & 15)]; } \
        _Pragma("unroll") for (int q_ = 0; q_ < 32; ++q_) { const int i_ = F.tid + q_ * NWAVES * 64; ((LAS bf16_t*)F.lds)[(i_ & 15) * DM + (i_ >> 4)] = f2bf(wv_[q_]); } \
        __syncthreads(); } while (0)
    if (blockIdx.x < 64) {
        const int pmc = (int)blockIdx.x >> 2, pn = (int)blockIdx.x & 3, lp = l - 1;
        pg8::Gemm g{(const bf16_t*)(p.ws + WS_HY) + (size_t)MLAT * DM, (const bf16_t*)(p.ws + WS_WOUT) + (size_t)lp * DM * DM, MCTX, DM, DM};
        pg8::OneUnit S{{pmc, pn}};
        bf16_t* const XCB = (bf16_t*)(p.ws + WS_XC);
        pg8::EpiResid E{nullptr, nullptr, lp == 0 ? (const void*)p.ctx : (const void*)XCB, XCB, (const float*)(p.ws + WS_MOD) + (size_t)lp * 17 * 3072, 0, MLAT, SEQ, DM, lp == 0 ? 1 : 0, MLAT};
        pg8::gemm_phase<pg8::EpiResid, pg8::OneUnit, false, true>(F.lds, g, S, E);
        F.refresh();
        asm volatile("s_waitcnt vmcnt(0)" ::: "memory");
        __syncthreads();
        if (F.tid == 0) { __builtin_amdgcn_fence(__ATOMIC_RELEASE, "agent"); asm volatile("s_waitcnt vmcnt(0)" ::: "memory");
            gu32* cnt = F.ctl + CW_CTXC + (l * 16 + pmc) * 64;
            (void)__hip_atomic_fetch_add(cnt, 1u, __ATOMIC_RELAXED, __HIP_MEMORY_SCOPE_AGENT);
            unsigned spins = 0;
            while (__hip_atomic_load(cnt, __ATOMIC_RELAXED, __HIP_MEMORY_SCOPE_AGENT) < 4u && ++spins < (1u << 22)) __builtin_amdgcn_s_sleep(2);
            __builtin_amdgcn_fence(__ATOMIC_ACQUIRE, "agent"); asm volatile("s_waitcnt vmcnt(0)" ::: "memory"); }
        __syncthreads();
        NORM_STAGE_WAB();
        if (F.wave < 4) norm_tile16(F, l, wabT, tab, MLAT + 256 * pmc + 64 * pn + 16 * F.wave, curb);
    } else {
        NORM_STAGE_WAB();
        const int wi = ((int)blockIdx.x - 64) * NWAVES + F.wave;
        for (int t = wi; t < MLAT / 16; t += 1536) norm_tile16(F, l, wabT, tab, 16 * t, curb);
        __syncthreads();
        convert_weights(F, l, wi, 1536);
    }
#undef NORM_STAGE_WAB
    __syncthreads();
}

__device__ __forceinline__ void phase_final(Frame& F) {
    KPtrs& p = F.P(); const int lane = F.lane;
    const int gw = F.vcu * NWAVES + F.wave, NGW = F.G * NWAVES;
    const bf16_t* X = (const bf16_t*)(p.ws + WS_P);
    f32x4 g[4];
#pragma unroll
    for (int j = 0; j < 4; ++j) g[j] = *(const f32x4*)(p.final_g + 256 * j + 4 * lane);
    for (int r0 = gw; r0 < MLAT; r0 += 4 * NGW) {
        u32x2 raw[4][4];
#pragma unroll
        for (int u = 0; u < 4; ++u) { const int r = r0 + u * NGW; if (r < MLAT) { const GAS u32x2* xr = (const GAS u32x2*)(X + (size_t)r * DM) + lane;
#pragma unroll
            for (int j = 0; j < 4; ++j) raw[u][j] = xr[64 * j]; } }
#pragma unroll
        for (int u = 0; u < 4; ++u) { const int r = r0 + u * NGW; if (r < MLAT) {
            f32x4 v[4]; float ss = 0.f;
#pragma unroll
            for (int j = 0; j < 4; ++j) { v[j] = (f32x4){bflo(raw[u][j].x), bfhi(raw[u][j].x), bflo(raw[u][j].y), bfhi(raw[u][j].y)}; ss += (v[j].x * v[j].x + v[j].y * v[j].y) + (v[j].z * v[j].z + v[j].w * v[j].w); }
            ss = wave_sum(ss);
            const float rstd = 1.0f / sqrtf(ss * (1.0f / DM) + EPS);
            GAS f32x4* xo = (GAS f32x4*)(p.out + (size_t)r * DM) + lane;
#pragma unroll
            for (int j = 0; j < 4; ++j) xo[64 * j] = v[j] * rstd * g[j]; } }
    }
}

__device__ __forceinline__ void phase_gemm1(Frame& F, int l) {
    KPtrs& p = F.P();
    pg8::Gemm g{(const bf16_t*)(p.ws + WS_HY), (const bf16_t*)(p.ws + WS_WIN) + (size_t)l * NPC * DM, MTOT, NPC, DM};
    pg8::StaticOrder S; S.init(MTOT, NPC, F.G, (int)blockIdx.x);
    pg8::EpiP E{(bf16_t*)(p.ws + WS_P), PTILE_ELEMS};
    pg8::gemm_phase<pg8::EpiP, pg8::StaticOrder, true, true>(F.lds, g, S, E);
}
__device__ __forceinline__ void phase_gemm2(Frame& F, int l) {
    KPtrs& p = F.P();
    const int M = MLAT;
    pg8::Gemm g{(const bf16_t*)(p.ws + WS_HY), (const bf16_t*)(p.ws + WS_WOUT) + (size_t)l * DM * DM, M, DM, DM};
    pg8::StaticOrder S; S.init(M, DM, F.G, (int)blockIdx.x);
    bf16_t* const XB = (bf16_t*)((char*)p.out + (64u << 20));
    bf16_t* const XCB = (bf16_t*)(p.ws + WS_XC);
    pg8::EpiResid E{l == 0 ? (const void*)p.x : (const void*)XB, l == DEPTH - 1 ? (bf16_t*)(p.ws + WS_P) : XB, l == 0 ? (const void*)p.ctx : (const void*)XCB, XCB,
                    (const float*)(p.ws + WS_MOD) + (size_t)l * 17 * 3072, l & 1, MLAT, SEQ, DM, l == 0 ? 1 : 0, 0};
    pg8::gemm_phase<pg8::EpiResid, pg8::StaticOrder, true, true>(F.lds, g, S, E);
}


typedef short s16x4 __attribute__((ext_vector_type(4)));
__device__ __forceinline__ const bf16_t* ptile_d(KPtrs& p, int t) { return (const bf16_t*)(p.ws + WS_P) + (size_t)t * PTILE_ELEMS; }
constexpr size_t WS_WSB = 9 * MiB;

__device__ __forceinline__ void mix_unit_B(Frame& F, int l, int row0) {
    KPtrs& p = F.P(); const int oct = F.tid & 31, tg = F.tid >> 5;
    int start, len; row_seq(row0, start, len);
    const bf16_t *CX = ptile_d(p, T_CX), *BGS = ptile_d(p, T_BGS);
    float w[3][8];
#pragma unroll
    for (int j = 0; j < 3; ++j) { const f32x4 a = *(const f32x4*)(p.short_conv_w + (size_t)(l * 3 + j) * BW + 8 * oct), b = *(const f32x4*)(p.short_conv_w + (size_t)(l * 3 + j) * BW + 8 * oct + 4);
        w[j][0] = a.x; w[j][1] = a.y; w[j][2] = a.z; w[j][3] = a.w; w[j][4] = b.x; w[j][5] = b.y; w[j][6] = b.z; w[j][7] = b.w; }
    const int r0 = row0 + tg * 8;
    float cx[10][8];
    { v4u ca[10];
#pragma unroll
      for (int i = 0; i < 10; ++i) { int r = r0 + i - 1; r = r < start ? start : (r >= start + len ? start + len - 1 : r); ca[i] = *(const GAS v4u*)(CX + (size_t)r * 256 + 8 * oct); }
#pragma unroll
      for (int i = 0; i < 10; ++i) unpack8(ca[i], cx[i]);
      const bool lo_ok = r0 - 1 >= start, hi_ok = r0 + 8 < start + len;
#pragma unroll
      for (int e = 0; e < 8; ++e) { cx[0][e] = lo_ok ? cx[0][e] : 0.f; cx[9][e] = hi_ok ? cx[9][e] : 0.f; } }
#pragma unroll
    for (int i = 0; i < 8; ++i) { const int r = r0 + i;
        const v4u bgw = *(const GAS v4u*)(BGS + (size_t)r * 256 + 8 * oct); float bg[8], y[8]; unpack8(bgw, bg);
#pragma unroll
        for (int e = 0; e < 8; ++e) y[e] = bg[e] * (w[0][e] * cx[i][e] + w[1][e] * cx[i + 1][e] + w[2][e] * cx[i + 2][e]);
        v4u o; o.x = pk2(y[0], y[1]); o.y = pk2(y[2], y[3]); o.z = pk2(y[4], y[5]); o.w = pk2(y[6], y[7]);
        *(GAS v4u*)((bf16_t*)(p.ws + WS_HY) + (size_t)r * DM + 256 + 8 * oct) = o; }
}

constexpr int MIX_ND = MTOT / 128, MIX_NC = MTOT / 64, MIX_NB = MTOT / 128, MIX_NU = MIX_ND + MIX_NC + MIX_NB, CW_MIXQ = 8192, NPF = 12;
__device__ __forceinline__ void mix_prefetch(Frame& F, int l, int u, v4u (&pf)[NPF]) {
    KPtrs& p = F.P(); const int tid = F.tid, lane = F.lane, wave = F.wave;
    if (u < MIX_ND) {
        const bf16_t* VV = ptile_d(p, T_VV) + (size_t)(u * 128 + wave * 16) * 256 + 4 * lane;
#pragma unroll
        for (int k = 0; k < 8; ++k) { const u32x2 a = *(const GAS u32x2*)(VV + (size_t)(2 * k) * 256), b = *(const GAS u32x2*)(VV + (size_t)(2 * k + 1) * 256); pf[k] = (v4u){a.x, a.y, b.x, b.y}; }
        pf[10] = *(const GAS v4u*)(p.smlp_ln_g + l * BW + 4 * lane); pf[11] = *(const GAS v4u*)(p.smlp_ln_b + l * BW + 4 * lane);
        asm volatile("; PF_D" ::: "memory");
    } else if (u < MIX_ND + MIX_NC) {
        const int row0 = (u - MIX_ND) * 64; int start, len; row_seq(row0, start, len);
        const bf16_t* GL = ptile_d(p, T_GLU);
#pragma unroll
        for (int k = 0; k < 6; ++k) { const int idx = tid + k * NWAVES * 64, i = idx >> 5, oct = idx & 31; int r = row0 - 15 + i; r = r < start ? start : (r >= start + len ? start + len - 1 : r);
            pf[k] = *(const GAS v4u*)(GL + (size_t)r * 256 + 8 * oct); }
        asm volatile("; PF_C" ::: "memory");
    }
}
__device__ __forceinline__ f32x4 asf4(const v4u& w) { return __builtin_bit_cast(f32x4, w); }

__device__ __forceinline__ void mix_unit_C(Frame& F, int l, int row0, v4u (&pf)[NPF], int nxt) {
    KPtrs& p = F.P(); const int tid = F.tid, lane = F.lane, wave = F.wave;
    int start, len; row_seq(row0, start, len);
    LAS float* glu = (LAS float*)F.lds;
#pragma unroll
    for (int k = 0; k < 6; ++k) { const int idx = tid + k * NWAVES * 64, i = idx >> 5, oct = idx & 31, r = row0 - 15 + i;
        if (i < 94) { const bool ok = r >= start && r < start + len; float fa[8]; unpack8(pf[k], fa);
            const f32x4 o0 = {ok ? fa[0] : 0.f, ok ? fa[1] : 0.f, ok ? fa[2] : 0.f, ok ? fa[3] : 0.f}, o1 = {ok ? fa[4] : 0.f, ok ? fa[5] : 0.f, ok ? fa[6] : 0.f, ok ? fa[7] : 0.f};
            *(LAS f32x4*)(glu + i * 256 + 8 * oct) = o0; *(LAS f32x4*)(glu + i * 256 + 8 * oct + 4) = o1; } }
    float wt[32]; u32x2 gate[8];
#pragma unroll
    for (int j = 0; j < 32; ++j) wt[j] = j < 31 ? p.conf_conv_w[(size_t)(l * 31 + j) * BW + (tid & 255)] : p.conf_conv_b[l * BW + (tid & 255)];
    { const bf16_t* GC = ptile_d(p, T_GC);
#pragma unroll
      for (int i = 0; i < 8; ++i) gate[i] = *(const GAS u32x2*)(GC + (size_t)(row0 + wave * 8 + i) * 256 + 4 * lane); }
    const f32x4 lg = *(const f32x4*)(p.conf_ln_g + l * BW + 4 * lane), lb = *(const f32x4*)(p.conf_ln_b + l * BW + 4 * lane);
    mix_prefetch(F, l, nxt, pf);
    LBAR();
    const int c = tid & 255, th = tid >> 8;
    float z[32];
#pragma unroll
    for (int hb = 0; hb < 2; ++hb) {
        float win[46];
#pragma unroll
        for (int i = 0; i < 46; ++i) win[i] = glu[(th * 32 + hb * 16 + i) * 256 + c];
#pragma unroll
        for (int i = 0; i < 16; ++i) z[hb * 16 + i] = wt[31];
#pragma unroll
        for (int j = 0; j < 31; ++j)
#pragma unroll
            for (int i = 0; i < 16; ++i) z[hb * 16 + i] += wt[j] * win[i + j];
    }
    LBAR();
#pragma unroll
    for (int i = 0; i < 32; ++i) glu[(th * 32 + i) * 256 + c] = z[i];
    LBAR();
#pragma unroll
    for (int i = 0; i < 8; ++i) { const int t = wave * 8 + i, r = row0 + t;
        const f32x4 zz = *(const LAS f32x4*)(glu + t * 256 + 4 * lane);
        const float mean = wave_sum((zz.x + zz.y) + (zz.z + zz.w)) * (1.f / 256.f);
        const f32x4 d = zz - mean;
        const float var = wave_sum((d.x * d.x + d.y * d.y) + (d.z * d.z + d.w * d.w)) * (1.f / 256.f);
        const float rstd = 1.0f / sqrtf(var + EPS);
        const f32x4 ln = d * rstd * lg + lb;
        const u32x2 gw = gate[i];
        u32x2 o; o.x = pk2(fsilu(ln.x) * bflo(gw.x), fsilu(ln.y) * bfhi(gw.x)); o.y = pk2(fsilu(ln.z) * bflo(gw.y), fsilu(ln.w) * bfhi(gw.y));
        *(GAS u32x2*)((bf16_t*)(p.ws + WS_HY) + (size_t)r * DM + 512 + 4 * lane) = o; }
    LBAR();
}

__device__ __forceinline__ void mix_unit_D(Frame& F, int l, int row0, v4u (&pf)[NPF], int nxt) {
    KPtrs& p = F.P(); const int lane = F.lane, wave = F.wave;
    constexpr int VS = 528;
    LAS unsigned char* vl = F.lds;
    const bf16_t* UG = ptile_d(p, T_UG);
    const int g = wave >> 1, ph = wave & 1, li = lane & 15, lg4 = lane >> 4;
    bf16x8 wf[4][4];
    { const bf16_t* W = (const bf16_t*)(p.ws + WS_WSB) + (size_t)(l * 4 + g) * 128 * 128;
#pragma unroll
      for (int ks = 0; ks < 4; ++ks)
#pragma unroll
          for (int pt = 0; pt < 4; ++pt) wf[ks][pt] = *(const GAS bf16x8*)(W + (size_t)(64 * ph + 16 * pt + li) * 128 + 32 * ks + 8 * lg4); }
    { const f32x4 lg = asf4(pf[10]), lb = asf4(pf[11]);
#pragma unroll
      for (int i = 0; i < 16; ++i) { const int q = wave * 16 + i; const u32x2 raw = (i & 1) ? (u32x2){pf[i >> 1].z, pf[i >> 1].w} : (u32x2){pf[i >> 1].x, pf[i >> 1].y};
        const f32x4 v = {bflo(raw.x), bfhi(raw.x), bflo(raw.y), bfhi(raw.y)};
        const float mean = wave_sum((v.x + v.y) + (v.z + v.w)) * (1.f / 256.f);
        const f32x4 d = v - mean;
        const float var = wave_sum((d.x * d.x + d.y * d.y) + (d.z * d.z + d.w * d.w)) * (1.f / 256.f);
        const float rstd = 1.0f / sqrtf(var + EPS);
        const f32x4 y = d * rstd * lg + lb;
        u32x2 o; o.x = pk2(y.x, y.y); o.y = pk2(y.z, y.w);
        *(LAS u32x2*)(vl + q * VS + 8 * lane) = o; } }
    LBAR();
    f32x4 acc[4][4];
#pragma unroll
    for (int a = 0; a < 4; ++a)
#pragma unroll
        for (int b = 0; b < 4; ++b) acc[a][b] = (f32x4){0.f, 0.f, 0.f, 0.f};
#pragma unroll
    for (int ks = 0; ks < 4; ++ks) {
        bf16x8 af[4];
#pragma unroll
        for (int ct = 0; ct < 4; ++ct) { LAS unsigned char* a = vl + (32 * ks + 8 * lg4 + (li >> 2)) * VS + (64 * g + 16 * ct + 4 * (li & 3)) * 2;
            const s16x4 lo = __builtin_amdgcn_ds_read_tr16_b64_v4i16((LAS s16x4*)a), hi = __builtin_amdgcn_ds_read_tr16_b64_v4i16((LAS s16x4*)(a + 4 * VS));
            af[ct] = (bf16x8){lo[0], lo[1], lo[2], lo[3], hi[0], hi[1], hi[2], hi[3]}; }
#pragma unroll
        for (int ct = 0; ct < 4; ++ct)
#pragma unroll
            for (int pt = 0; pt < 4; ++pt) acc[ct][pt] = __builtin_amdgcn_mfma_f32_16x16x32_bf16(af[ct], wf[ks][pt], acc[ct][pt], 0, 0, 0);
    }
    u32x2 uw[4][4]; float bs[4];
#pragma unroll
    for (int pt = 0; pt < 4; ++pt) { const int prow = 64 * ph + 16 * pt + li; const size_t r = (size_t)row0 + prow; bs[pt] = p.smlp_b[(l * 4 + g) * 128 + prow];
#pragma unroll
        for (int ct = 0; ct < 4; ++ct) { const int c = 64 * g + 16 * ct + 4 * lg4; uw[pt][ct] = *(const GAS u32x2*)(UG + r * 256 + c); } }
    mix_prefetch(F, l, nxt, pf);
#pragma unroll
    for (int pt = 0; pt < 4; ++pt) { const int prow = 64 * ph + 16 * pt + li; const size_t r = (size_t)row0 + prow;
#pragma unroll
        for (int ct = 0; ct < 4; ++ct) { const int c = 64 * g + 16 * ct + 4 * lg4;
            const f32x4 m = acc[ct][pt] + bs[pt]; const u32x2 u2 = uw[pt][ct];
            u32x2 o; o.x = pk2(bflo(u2.x) * m.x, bfhi(u2.x) * m.y); o.y = pk2(bflo(u2.y) * m.z, bfhi(u2.y) * m.w);
            *(GAS u32x2*)((bf16_t*)(p.ws + WS_HY) + r * DM + 768 + c) = o; } }
    LBAR();
}

__device__ __forceinline__ void phase_mix(Frame& F, int l) {
    gu32* ctr = F.ctl + CW_MIXQ + 64 * l;
    volatile LAS unsigned* Q = F.MISC;
    unsigned fetched = 0;
    if (F.tid == 0) { Q[0] = __hip_atomic_fetch_add(ctr, 1u, __ATOMIC_RELAXED, __HIP_MEMORY_SCOPE_AGENT); Q[1] = __hip_atomic_fetch_add(ctr, 1u, __ATOMIC_RELAXED, __HIP_MEMORY_SCOPE_AGENT); }
    LBAR();
    int cur = (int)Q[0], nxt = (int)Q[1];
    v4u pf[NPF];
    F.refresh();
    if (cur < MIX_NU) mix_prefetch(F, l, cur, pf);
#define MIX_ROUND(CALL) do { LBAR();   \
        if (F.tid == 0) fetched = __hip_atomic_fetch_add(ctr, 1u, __ATOMIC_RELAXED, __HIP_MEMORY_SCOPE_AGENT);   \
        F.refresh(); CALL; if (F.tid == 0) Q[0] = fetched; LBAR(); cur = nxt; nxt = (int)Q[0]; } while (0)
    while (cur < MIX_ND) MIX_ROUND(mix_unit_D(F, l, cur * 128, pf, nxt));
    while (cur < MIX_ND + MIX_NC) MIX_ROUND(mix_unit_C(F, l, (cur - MIX_ND) * 64, pf, nxt));
    while (cur < MIX_NU) MIX_ROUND(mix_unit_B(F, l, (cur - MIX_ND - MIX_NC) * 128));
#undef MIX_ROUND
}

constexpr size_t WS_REC = 212 * MiB, WS_OB16 = 476 * MiB;
constexpr int REC_BYTES = 53248, R_NW = 0, R_Q = 8192, R_U = 16384, R_VEC = 32768, R_ATTN = 33792, R_KT = 41984;
constexpr int NITEM = 2304;
constexpr int L_Q = 0, L_K = 4352, L_V = 8704, L_GKK = 13056, L_GQK = 17408, L_QB = 21760, L_KB = 24064, L_AO = 21760, L_AD = 26368, L_DF = 28928, L_SM = 30208, L_XS = 0, GS = 68, SMD = 256;

__device__ __forceinline__ float dpp_xor1(float v) { return __int_as_float(__builtin_amdgcn_mov_dpp(__float_as_int(v), 0xB1, 0xF, 0xF, true)); }

__device__ __forceinline__ void prep_decode(int item, int& b, int& h, int& row0) {
    if (item < 2048) { b = item >> 7; h = (item >> 5) & 3; const int n = item & 31; row0 = b * SEQ + 64 * n; }
    else { const int it = item - 2048; b = it >> 4; h = (it >> 2) & 3; const int n = it & 3; row0 = MLAT + b * CTXL + 64 * n; }
}
__device__ __forceinline__ void prep_load(Frame& F, int l, int item, v4u (&raw)[6], float (&abn)[4], v4u (&wq)[6]) {
    KPtrs& p = F.P(); int b, h, row0; prep_decode(item, b, h, row0); int start, len; row_seq(row0, start, len);
    const int tq = F.tid < 384 ? F.tid : 383, tg = tq / 24, o = tq % 24, part = o >> 3, oo = o & 7;
    const bf16_t* T = ptile_d(p, part) + h * 64 + 8 * oo;
#pragma unroll
    for (int i = 0; i < 6; ++i) { int r = row0 + 4 * tg - 1 + i; r = r < start ? start : (r >= start + len ? start + len - 1 : r); raw[i] = *(const GAS v4u*)(T + (size_t)r * 256); }
    if ((F.wave & 3) == 0) { const int dir = F.wave >> 2, tok = dir ? 63 - F.lane : F.lane; const float* AB = (const float*)(p.ws + WS_AB) + ((size_t)row0 + tok) * 16;
        abn[0] = AB[dir * 4 + h]; abn[1] = AB[8 + dir * 4 + h]; abn[2] = p.a_log[(l * 2 + dir) * 4 + h]; abn[3] = p.dt_bias[(l * 2 + dir) * 4 + h]; }
    { const float* wc = p.qkv_conv_w + (size_t)l * 3 * 768 + part * 256 + h * 64 + 8 * oo;
#pragma unroll
      for (int j = 0; j < 3; ++j) { wq[2 * j] = *(const GAS v4u*)(wc + j * 768); wq[2 * j + 1] = *(const GAS v4u*)(wc + j * 768 + 4); } }
}
__device__ __forceinline__ void prep_item(Frame& F, int l, int item, v4u (&raw)[6], float (&abn)[4], v4u (&wq)[6], int next_item) {
    KPtrs& p = F.P(); const int tid = F.tid, lane = F.lane, wave = F.wave;
    int b, h, row0; prep_decode(item, b, h, row0);
    int start, len; row_seq(row0, start, len);
    LAS float* lf = (LAS float*)F.lds;
    if (tid < 384) { const int tg = tid / 24, o = tid % 24, part = o >> 3, oo = o & 7;
        float w[3][8], x[6][8];
#pragma unroll
        for (int j = 0; j < 3; ++j) { const f32x4 w0 = __builtin_bit_cast(f32x4, wq[2 * j]), w1 = __builtin_bit_cast(f32x4, wq[2 * j + 1]);
            w[j][0] = w0.x; w[j][1] = w0.y; w[j][2] = w0.z; w[j][3] = w0.w; w[j][4] = w1.x; w[j][5] = w1.y; w[j][6] = w1.z; w[j][7] = w1.w; }
#pragma unroll
        for (int i = 0; i < 6; ++i) unpack8(raw[i], x[i]);
        const bool lo_ok = row0 + 4 * tg - 1 >= start, hi_ok = row0 + 4 * tg + 4 < start + len;
#pragma unroll
        for (int e = 0; e < 8; ++e) { x[0][e] = lo_ok ? x[0][e] : 0.f; x[5][e] = hi_ok ? x[5][e] : 0.f; }
#pragma unroll
        for (int t = 0; t < 4; ++t) { float a[8];
#pragma unroll
            for (int e = 0; e < 8; ++e) a[e] = fsilu(w[0][e] * x[t][e] + w[1][e] * x[t + 1][e] + w[2][e] * x[t + 2][e]);
            LAS float* dst = lf + part * 4352 + (4 * tg + t) * 68 + 8 * oo;
            *(LAS f32x4*)dst = (f32x4){a[0], a[1], a[2], a[3]}; *(LAS f32x4*)(dst + 4) = (f32x4){a[4], a[5], a[6], a[7]}; } }
    if ((wave & 3) == 0) { const int dir = wave >> 2, i = lane;
        const float sx = abn[0] + abn[3];
        const float sp = sx > 15.f ? sx : __builtin_amdgcn_logf(1.f + fexp(sx)) * 0.69314718056f;
        const float g = -fexp(abn[2]) * sp;
        const float beta = fsigmoid(abn[1]);
        float gc = g;
        gc += dpp_f<0x111>(gc); gc += dpp_f<0x112>(gc); gc += dpp_f<0x114>(gc); gc += dpp_f<0x118>(gc);
        gc += __int_as_float(__builtin_amdgcn_update_dpp(0, __float_as_int(gc), 0x142, 0xA, 0xF, false));
        gc += __int_as_float(__builtin_amdgcn_update_dpp(0, __float_as_int(gc), 0x143, 0xC, 0xF, false));
        LAS float* sm = lf + L_SM + dir * SMD; const float eg = fexp(gc); sm[i] = gc; sm[64 + i] = beta; sm[128 + i] = eg; sm[192 + i] = beta * eg; }
    prep_load(F, l, next_item, raw, abn, wq);
    LBAR();
    { const int row = tid >> 2, part = row >> 6, t = row & 63, qt = tid & 3; LAS float* src = lf + part * 4352 + t * 68 + 16 * qt;
      f32x4 v[4]; float ss = 0.f;
#pragma unroll
      for (int i = 0; i < 4; ++i) { v[i] = *(LAS f32x4*)(src + 4 * i); ss += (v[i].x * v[i].x + v[i].y * v[i].y) + (v[i].z * v[i].z + v[i].w * v[i].w); }
      ss += __shfl_xor(ss, 1); ss += __shfl_xor(ss, 2);
      const float sc = (1.0f / sqrtf(ss + EPS)) * (part == 0 ? 0.125f : 1.0f);
#pragma unroll
      for (int i = 0; i < 4; ++i) { v[i] = v[i] * sc; *(LAS f32x4*)(src + 4 * i) = v[i]; }
      LAS unsigned char* bdst = (LAS unsigned char*)(lf + (part ? L_KB : L_QB)) + t * 144 + 32 * qt;
      v4u o; o.x = pk2(v[0].x, v[0].y); o.y = pk2(v[0].z, v[0].w); o.z = pk2(v[1].x, v[1].y); o.w = pk2(v[1].z, v[1].w); *(LAS v4u*)bdst = o;
      o.x = pk2(v[2].x, v[2].y); o.y = pk2(v[2].z, v[2].w); o.z = pk2(v[3].x, v[3].y); o.w = pk2(v[3].z, v[3].w); *(LAS v4u*)(bdst + 16) = o; }
    LBAR();
    { const int mat = wave >> 2, it = wave & 3, li = lane & 15, g4 = lane >> 4;
      const LAS unsigned char* Ab = (const LAS unsigned char*)(lf + (mat ? L_QB : L_KB)); const LAS unsigned char* Kb = (const LAS unsigned char*)(lf + L_KB);
      bf16x8 af[2];
#pragma unroll
      for (int s2 = 0; s2 < 2; ++s2) af[s2] = *(const LAS bf16x8*)(Ab + (16 * it + li) * 144 + (32 * s2 + 8 * g4) * 2);
      LAS float* G = lf + (mat ? L_GQK : L_GKK);
#pragma unroll
      for (int jt = 0; jt < 4; ++jt) { f32x4 acc = {0.f, 0.f, 0.f, 0.f};
#pragma unroll
          for (int s2 = 0; s2 < 2; ++s2) { const bf16x8 bq = *(const LAS bf16x8*)(Kb + (16 * jt + li) * 144 + (32 * s2 + 8 * g4) * 2); acc = __builtin_amdgcn_mfma_f32_16x16x32_bf16(af[s2], bq, acc, 0, 0, 0); }
#pragma unroll
          for (int r = 0; r < 4; ++r) G[(16 * it + 4 * g4 + r) * GS + 16 * jt + li] = acc[r]; } }
    LBAR();
    const int dir = tid >> 8, td = tid & 255;
    const LAS float* sm = lf + L_SM + dir * SMD;
    unsigned char* rec = p.ws + WS_REC + (size_t)(item * 2 + dir) * REC_BYTES;
    { const int i = td >> 2, jq = td & 3, ti = dir ? 63 - i : i; const float gi = sm[i], bi = sm[64 + i];
      const LAS float* grow = lf + L_GKK + ti * GS + (dir ? 48 - 16 * jq : 16 * jq);
      float gv[16], gc[16];
#pragma unroll
      for (int k = 0; k < 4; ++k) { const f32x4 a = *(const LAS f32x4*)(grow + 4 * k), c = *(const LAS f32x4*)(sm + 16 * jq + 4 * k);
          gv[4 * k] = a.x; gv[4 * k + 1] = a.y; gv[4 * k + 2] = a.z; gv[4 * k + 3] = a.w; gc[4 * k] = c.x; gc[4 * k + 1] = c.y; gc[4 * k + 2] = c.z; gc[4 * k + 3] = c.w; }
      float val[16];
#pragma unroll
      for (int jj = 0; jj < 16; ++jj) { const int j = 16 * jq + jj; const float G = dir ? gv[15 - jj] : gv[jj];
          const float v = bi * G * fexp(fminf(gi - gc[jj], 0.f)); val[jj] = (i > j) ? v : 0.f; }
      { const bool below = jq < (i >> 4);
        v4u o0, o1; o0.x = below ? pk2(-val[0], -val[1]) : 0u; o0.y = below ? pk2(-val[2], -val[3]) : 0u; o0.z = below ? pk2(-val[4], -val[5]) : 0u; o0.w = below ? pk2(-val[6], -val[7]) : 0u;
        o1.x = below ? pk2(-val[8], -val[9]) : 0u; o1.y = below ? pk2(-val[10], -val[11]) : 0u; o1.z = below ? pk2(-val[12], -val[13]) : 0u; o1.w = below ? pk2(-val[14], -val[15]) : 0u;
        LAS unsigned char* ao = (LAS unsigned char*)(lf + L_AO) + dir * 9216 + i * 144 + 32 * jq; *(LAS v4u*)ao = o0; *(LAS v4u*)(ao + 16) = o1; }
      if (jq == (i >> 4)) { LAS float* ad = lf + L_AD + dir * 1280 + (i >> 4) * 320 + (i & 15) * 20;
#pragma unroll
          for (int k = 0; k < 4; ++k) *(LAS f32x4*)(ad + 4 * k) = (f32x4){val[4 * k], val[4 * k + 1], val[4 * k + 2], val[4 * k + 3]}; } }
#pragma unroll
    for (int k = 0; k < 2; ++k) { const int f = td + 256 * k, ms = f >> 6, ll = f & 63, m = ms >> 1, s = ms & 1, rr = 16 * m + (ll & 15), cb = 32 * s + 4 * (ll >> 4);
        float va[8], vq[8], vk[8];
        const int ti = dir ? 63 - rr : rr; const float gi = sm[rr];
#pragma unroll
        for (int hh = 0; hh < 2; ++hh) { const int c0 = cb + 16 * hh;
            const f32x4 g4 = *(const LAS f32x4*)(lf + L_GQK + ti * GS + (dir ? 60 - c0 : c0)), s4 = *(const LAS f32x4*)(sm + c0), q4 = *(const LAS f32x4*)(lf + L_Q + ti * 68 + c0);
            const float gq[4] = {dir ? g4.w : g4.x, dir ? g4.z : g4.y, dir ? g4.y : g4.z, dir ? g4.x : g4.w}, sc[4] = {s4.x, s4.y, s4.z, s4.w}, qq[4] = {q4.x, q4.y, q4.z, q4.w};
#pragma unroll
            for (int e = 0; e < 4; ++e) { const int c = c0 + e, tc = dir ? 63 - c : c;
                const float v = gq[e] * fexp(fminf(gi - sc[e], 0.f)); va[4 * hh + e] = (rr >= c) ? v : 0.f;
                vq[4 * hh + e] = qq[e];
                vk[4 * hh + e] = lf[L_K + tc * 68 + rr]; } }
        v4u o; o.x = pk2(va[0], va[1]); o.y = pk2(va[2], va[3]); o.z = pk2(va[4], va[5]); o.w = pk2(va[6], va[7]); *(GAS v4u*)(rec + R_ATTN + f * 16) = o;
        o.x = pk2(vq[0], vq[1]); o.y = pk2(vq[2], vq[3]); o.z = pk2(vq[4], vq[5]); o.w = pk2(vq[6], vq[7]); *(GAS v4u*)(rec + R_Q + f * 16) = o;
        o.x = pk2(vk[0], vk[1]); o.y = pk2(vk[2], vk[3]); o.z = pk2(vk[4], vk[5]); o.w = pk2(vk[6], vk[7]); *(GAS v4u*)(rec + R_KT + f * 16) = o; }
    if (td < 64) { float* vec = (float*)(rec + R_VEC); vec[td] = sm[128 + td]; vec[64 + td] = expf(sm[63] - sm[td]); if (td == 0) vec[128] = expf(sm[63]); }
    const int li = lane & 15, g4 = lane >> 4, nt0 = 2 * (wave & 3);
    f32x4 Rt[2][4];
#pragma unroll
    for (int t = 0; t < 2; ++t) { const int nt = nt0 + t; const LAS float* src = lf + (nt < 4 ? L_V + 16 * nt + li : L_K + 16 * (nt - 4) + li); const LAS float* scl = sm + (nt < 4 ? 64 : 192);
#pragma unroll
        for (int m = 0; m < 4; ++m) { const f32x4 sc = *(const LAS f32x4*)(scl + 16 * m + 4 * g4); const int i0 = 16 * m + 4 * g4;
            Rt[t][m] = (f32x4){src[(dir ? 63 - i0 : i0) * 68] * sc.x, src[(dir ? 62 - i0 : i0 + 1) * 68] * sc.y, src[(dir ? 61 - i0 : i0 + 2) * 68] * sc.z, src[(dir ? 60 - i0 : i0 + 3) * 68] * sc.w}; } }
    LBAR();
    if ((wave & 3) == 0) { const int blk = lane >> 4, c = lane & 15; const LAS float* Ad = lf + L_AD + dir * 1280 + blk * 320;
        float x[16];
#pragma unroll
        for (int r = 0; r < 16; ++r) x[r] = 0.f;
#pragma unroll
        for (int hb = 0; hb < 4; ++hb) {
            f32x4 arow[4][4];
#pragma unroll
            for (int rr = 0; rr < 4; ++rr)
#pragma unroll
                for (int q = 0; q < (4 * hb + rr + 3) / 4; ++q) arow[rr][q] = *(const LAS f32x4*)(Ad + (4 * hb + rr) * 20 + 4 * q);
#pragma unroll
            for (int rr = 0; rr < 4; ++rr) { const int r = 4 * hb + rr; float acc = (r == c) ? 1.f : 0.f;
#pragma unroll
                for (int q = 0; q < (r + 3) / 4; ++q) { const f32x4 a = arow[rr][q]; acc -= (a.x * x[4 * q] + a.y * x[4 * q + 1]) + (a.z * x[4 * q + 2] + a.w * x[4 * q + 3]); }
                x[r] = acc; } }
        LAS bf16_t* DF = (LAS bf16_t*)(lf + L_DF) + dir * 1280 + blk * 320;
#pragma unroll
        for (int r = 0; r < 16; ++r) DF[r * 20 + c] = f2bf(x[r]); }
    LBAR();
    { const LAS unsigned char* ao = (const LAS unsigned char*)(lf + L_AO) + dir * 9216; const LAS unsigned char* df = (const LAS unsigned char*)(lf + L_DF) + dir * 2560;
      const f32x4 zero4 = {0.f, 0.f, 0.f, 0.f};
      f32x4 X[2][4];
#pragma unroll
      for (int t = 0; t < 2; ++t)
#pragma unroll
          for (int m = 0; m < 4; ++m) X[t][m] = zero4;
#pragma unroll
      for (int m = 0; m < 4; ++m) {
          const u32x2 dw = *(const LAS u32x2*)(df + m * 640 + li * 40 + g4 * 8);
          const bf16x8 dfrag = __builtin_bit_cast(bf16x8, (v4u){dw.x, dw.y, 0u, 0u});
          f32x4 acc[2] = {Rt[0][m], Rt[1][m]};
#pragma unroll
          for (int s2 = 0; s2 < (m + 1) / 2; ++s2) { const u32x2 lo = *(const LAS u32x2*)(ao + (16 * m + li) * 144 + (32 * s2 + 4 * g4) * 2), hi = *(const LAS u32x2*)(ao + (16 * m + li) * 144 + (32 * s2 + 16 + 4 * g4) * 2);
              const bf16x8 afrag = __builtin_bit_cast(bf16x8, (v4u){lo.x, lo.y, hi.x, hi.y});
#pragma unroll
              for (int t = 0; t < 2; ++t) acc[t] = __builtin_amdgcn_mfma_f32_16x16x32_bf16(afrag, pack8(X[t][2 * s2], X[t][2 * s2 + 1]), acc[t], 0, 0, 0); }
#pragma unroll
          for (int t = 0; t < 2; ++t) X[t][m] = __builtin_amdgcn_mfma_f32_16x16x32_bf16(dfrag, pack8(acc[t], zero4), zero4, 0, 0, 0); }
      LAS float* XS = lf + L_XS + dir * 8448;
#pragma unroll
      for (int t = 0; t < 2; ++t)
#pragma unroll
          for (int m = 0; m < 4; ++m)
#pragma unroll
              for (int r = 0; r < 4; ++r) XS[(16 * m + 4 * g4 + r) * 132 + 16 * (nt0 + t) + li] = X[t][m][r]; }
    LBAR();
    { const LAS float* XS = lf + L_XS + dir * 8448;
#pragma unroll
      for (int k = 0; k < 2; ++k) { const int f = td + 256 * k, ms = f >> 6, ll = f & 63, m = ms >> 1, s = ms & 1, rr = 16 * m + (ll & 15), cb = 32 * s + 4 * (ll >> 4);
          float v[8];
#pragma unroll
          for (int e = 0; e < 8; ++e) v[e] = -XS[rr * 132 + 64 + cb + 16 * (e >> 2) + (e & 3)];
          v4u o; o.x = pk2(v[0], v[1]); o.y = pk2(v[2], v[3]); o.z = pk2(v[4], v[5]); o.w = pk2(v[6], v[7]); *(GAS v4u*)(rec + R_NW + f * 16) = o; }
#pragma unroll
      for (int k = 0; k < 4; ++k) { const int u = td + 256 * k, w = u >> 8, m = (u >> 6) & 3, ll = u & 63, r0 = 16 * m + 4 * (ll >> 4), c = 16 * w + (ll & 15);
          const f32x4 o = {XS[r0 * 132 + c], XS[(r0 + 1) * 132 + c], XS[(r0 + 2) * 132 + c], XS[(r0 + 3) * 132 + c]};
          *(GAS f32x4*)(rec + R_U + u * 16) = o; } }
    LBAR();
}
__device__ __forceinline__ void phase_prep(Frame& F, int l) {
    v4u raw[6], wq[6]; float abn[4] = {0.f, 0.f, 0.f, 0.f};
    F.refresh();
    if (F.vcu < NITEM) prep_load(F, l, F.vcu, raw, abn, wq);
    for (int it = F.vcu; it < NITEM; it += F.G) { F.refresh(); prep_item(F, l, it, raw, abn, wq, it + F.G < NITEM ? it + F.G : it); }
}

__device__ __forceinline__ void scan_rec(int b, int h, int dir, int step, int& cid, int& row0) {
    if (step < 4) { const int n = dir ? 3 - step : step; cid = 2048 + (b * 4 + h) * 4 + n; row0 = MLAT + b * CTXL + 64 * n; }
    else { const int n = dir ? 35 - step : step - 4; cid = (b * 4 + h) * 32 + n; row0 = b * SEQ + 64 * n; }
}
__device__ __forceinline__ void phase_scan(Frame& F, int l) {
    KPtrs& p = F.P();
    const int bx = (int)blockIdx.x, xq = bx >> 3, half = xq & 1, s = (bx & 7) * 16 + (xq >> 1), b = s >> 3, h = (s >> 1) & 3, dir = s & 1, lane = F.lane;
    constexpr int NSTEP = 36, PIECES = 7;
    if (F.wave >= 2) {
        const int lw = F.wave - 2;
#define SCAN_ISSUE(t_) do { int cid_, row0_; scan_rec(b, h, dir, (t_), cid_, row0_); const unsigned char* rec_ = p.ws + WS_REC + (size_t)(cid_ * 2 + dir) * REC_BYTES + lane * 16; \
            LAS unsigned char* slot_ = F.lds + ((t_) % 3) * REC_BYTES; \
            _Pragma("unroll") for (int k_ = 0; k_ < PIECES; ++k_) { int j_ = lw + 6 * k_; j_ = j_ > 40 ? 40 : j_; \
                const int pc_ = j_ < 16 ? j_ : j_ < 24 ? 8 * half + j_ : j_ == 24 ? 32 : j_ + 8; \
                __builtin_amdgcn_global_load_lds((const GAS unsigned*)(rec_ + pc_ * 1024), (LAS unsigned*)(slot_ + pc_ * 1024), 16, 0, 0); } } while (0)
        SCAN_ISSUE(0); SCAN_ISSUE(1);
        for (int t = 0; t < NSTEP; ++t) {
            if (t + 1 < NSTEP) asm volatile("s_waitcnt vmcnt(7)" ::: "memory"); else asm volatile("s_waitcnt vmcnt(0)" ::: "memory");
            asm volatile("" ::: "memory"); __builtin_amdgcn_s_barrier(); asm volatile("" ::: "memory");
            if (t + 2 < NSTEP) SCAN_ISSUE(t + 2);
        }
#undef SCAN_ISSUE
        return;
    }
    const int w = 2 * half + F.wave, li = lane & 15, g4 = lane >> 4;
    f32x4 S[4];
#pragma unroll
    for (int m = 0; m < 4; ++m) S[m] = (f32x4){0.f, 0.f, 0.f, 0.f};
    bf16_t* O = (bf16_t*)(p.ws + WS_OB16) + (size_t)dir * MTOT * 256;
    for (int step = 0; step < NSTEP; ++step) {
        int cid, row0; scan_rec(b, h, dir, step, cid, row0);
        asm volatile("s_waitcnt lgkmcnt(0)" ::: "memory"); __builtin_amdgcn_s_barrier(); asm volatile("" ::: "memory");
        const LAS unsigned char* rec = F.lds + (step % 3) * REC_BYTES;
        bf16x8 nw[4][2], qf[4][2], at[4][2], kt[4][2]; f32x4 av[4], ao[4], a2[4], egc4[4], edl4[4];
#pragma unroll
        for (int m = 0; m < 4; ++m) {
#pragma unroll
            for (int s2 = 0; s2 < 2; ++s2) { nw[m][s2] = *(const LAS bf16x8*)(rec + R_NW + ((m * 2 + s2) * 64 + lane) * 16); qf[m][s2] = *(const LAS bf16x8*)(rec + R_Q + ((m * 2 + s2) * 64 + lane) * 16); }
            av[m] = *(const LAS f32x4*)(rec + R_U + ((w * 4 + m) * 64 + lane) * 16); ao[m] = (f32x4){0.f, 0.f, 0.f, 0.f}; }
        const float gl = *(const LAS float*)(rec + R_VEC + 512);
        bf16x8 Bs[2] = {pack8(S[0], S[1]), pack8(S[2], S[3])};
#pragma unroll
        for (int m = 0; m < 4; ++m)
#pragma unroll
            for (int s2 = 0; s2 < 2; ++s2) { av[m] = __builtin_amdgcn_mfma_f32_16x16x32_bf16(nw[m][s2], Bs[s2], av[m], 0, 0, 0); ao[m] = __builtin_amdgcn_mfma_f32_16x16x32_bf16(qf[m][s2], Bs[s2], ao[m], 0, 0, 0); }
#pragma unroll
        for (int m = 0; m < 4; ++m) {
#pragma unroll
            for (int s2 = 0; s2 < 2; ++s2) { at[m][s2] = *(const LAS bf16x8*)(rec + R_ATTN + ((m * 2 + s2) * 64 + lane) * 16); kt[m][s2] = *(const LAS bf16x8*)(rec + R_KT + ((m * 2 + s2) * 64 + lane) * 16); }
            edl4[m] = *(const LAS f32x4*)(rec + R_VEC + 256 + (16 * m + 4 * g4) * 4); egc4[m] = *(const LAS f32x4*)(rec + R_VEC + (16 * m + 4 * g4) * 4); a2[m] = (f32x4){0.f, 0.f, 0.f, 0.f}; }
        bf16x8 Bv[2] = {pack8(av[0], av[1]), pack8(av[2], av[3])};
        bf16x8 Bvs[2] = {pack8(av[0] * edl4[0], av[1] * edl4[1]), pack8(av[2] * edl4[2], av[3] * edl4[3])};
#pragma unroll
        for (int m = 0; m < 4; ++m) S[m] = S[m] * gl;
#pragma unroll
        for (int m = 0; m < 4; ++m)
#pragma unroll
            for (int s2 = 0; s2 < 2; ++s2) { a2[m] = __builtin_amdgcn_mfma_f32_16x16x32_bf16(at[m][s2], Bv[s2], a2[m], 0, 0, 0); S[m] = __builtin_amdgcn_mfma_f32_16x16x32_bf16(kt[m][s2], Bvs[s2], S[m], 0, 0, 0); }
#pragma unroll
        for (int m = 0; m < 4; ++m) { const f32x4 o = egc4[m] * ao[m] + a2[m];
#pragma unroll
            for (int r = 0; r < 4; ++r) { const int i = 16 * m + 4 * g4 + r, tok = dir ? 63 - i : i;
                O[(size_t)(row0 + tok) * 256 + h * 64 + 16 * w + li] = f2bf(o[r]); } }
    }
}

__device__ __forceinline__ void phase_comb(Frame& F, int l) {
    KPtrs& p = F.P(); const int lane = F.lane;
    const int gw = F.vcu * NWAVES + F.wave, NGW = F.G * NWAVES;
    const bf16_t* OF = (const bf16_t*)(p.ws + WS_OB16); const bf16_t* OB = OF + (size_t)MTOT * 256; const bf16_t* GA = ptile_d(p, T_GA);
    const f32x4 ng = *(const f32x4*)(p.gdn_norm_g + l * 64 + 4 * (lane & 15));
    const int nrow = (l == DEPTH - 1) ? MLAT : MTOT;
    u32x2 an, cn, gn;
    if (gw < nrow) { an = *(const GAS u32x2*)(OF + (size_t)gw * 256 + 4 * lane); cn = *(const GAS u32x2*)(OB + (size_t)gw * 256 + 4 * lane); gn = *(const GAS u32x2*)(GA + (size_t)gw * 256 + 4 * lane); }
    for (int r = gw; r < nrow; r += NGW) {
        const u32x2 a = an, c = cn, gt = gn;
        if (r + NGW < nrow) { const size_t r2 = (size_t)(r + NGW); an = *(const GAS u32x2*)(OF + r2 * 256 + 4 * lane); cn = *(const GAS u32x2*)(OB + r2 * 256 + 4 * lane); gn = *(const GAS u32x2*)(GA + r2 * 256 + 4 * lane); }
        const f32x4 o = {bflo(a.x) + bflo(c.x), bfhi(a.x) + bfhi(c.x), bflo(a.y) + bflo(c.y), bfhi(a.y) + bfhi(c.y)};
        float ss = (o.x * o.x + o.y * o.y) + (o.z * o.z + o.w * o.w);
        ss = row16_sum(ss);
        const float rs = 1.0f / sqrtf(ss * (1.f / 64.f) + EPS);
        u32x2 y; y.x = pk2(o.x * rs * ng.x * bflo(gt.x), o.y * rs * ng.y * bfhi(gt.x)); y.y = pk2(o.z * rs * ng.z * bflo(gt.y), o.w * rs * ng.w * bfhi(gt.y));
        *(GAS u32x2*)((bf16_t*)(p.ws + WS_HY) + (size_t)r * DM + 4 * lane) = y;
    }
}

constexpr int PH_FINAL = 1 + 7 * DEPTH, PH_END = PH_FINAL + 1;
struct Args { Ptrs p; int ph_lo, ph_hi; };
__global__ void __launch_bounds__(NWAVES * 64, 2) mega(Args args) {
    extern __shared__ __attribute__((aligned(16))) unsigned char lds[];
    Frame F;
    F.lds = (LAS unsigned char*)lds; F.MISC = (volatile LAS unsigned*)(F.lds + MISC_OFF);
    F.tid = threadIdx.x; F.lane = F.tid & 63; F.wave = __builtin_amdgcn_readfirstlane(F.tid >> 6);
    F.G = gridDim.x; { const int bx = blockIdx.x; F.vcu = (F.G % 8 == 0) ? (bx % 8) * (F.G / 8) + bx / 8 : bx; }
    F.ctl = (gu32*)(args.p.ws + WS_CTL);
    for (int u = F.tid; u < (LDS_BYTES - LDSCTL_OFF) / 4; u += NWAVES * 64) ((LAS unsigned*)(F.lds + LDSCTL_OFF))[u] = 0u;
    __syncthreads();
    const bool multi = args.ph_hi - args.ph_lo > 1;
    XcdBarrier bar; bar.bar = (unsigned*)(F.ctl + CW_BAR); bar.x = 0; bar.st = nullptr;
    if (multi) bar = xcd_barrier_post((unsigned*)(F.ctl + CW_BAR), F.MISC + 8);
    for (int ph = args.ph_lo; ph < args.ph_hi; ++ph) {
        F.refresh();
#if PROBE_S >= 0
        const bool amp = (PROBE_S == 7) ? (ph == 0) : (PROBE_S == 8) ? (ph == PH_FINAL) : (ph > 0 && ph < PH_FINAL && (ph - 1) % 7 == PROBE_S);
        const unsigned long long t0 = __builtin_amdgcn_s_memrealtime();
#endif
        if (ph == 0) phase_pre(F);
        else if (ph == PH_FINAL) phase_final(F);
        else { const int l = (ph - 1) / 7, s = (ph - 1) % 7;
            if (s == 0) phase_norm(F, l);
            else if (s == 1) phase_gemm1(F, l);
            else if (s == 2) phase_mix(F, l);
            else if (s == 3) phase_prep(F, l);
            else if (s == 4) phase_scan(F, l);
            else if (s == 5) phase_comb(F, l);
            else if (s == 6) phase_gemm2(F, l);
        }
        if (ph + 1 < args.ph_hi) xcd_barrier(bar);
#if PROBE_S >= 0
        if (amp) { const unsigned long long dt = __builtin_amdgcn_s_memrealtime() - t0; while (__builtin_amdgcn_s_memrealtime() - t0 < 2 * dt) __builtin_amdgcn_s_sleep(4); }
#endif
    }
}

extern "C" void kernel_launch(void* const* d_in, const int* in_sizes, int n_in, void* d_out, int out_size, void* d_ws, size_t ws_size, hipStream_t stream) {
    static int grid = 0;
    if (grid == 0) {
        if (n_in != 23 || out_size != MLAT * DM || ws_size < WS_END) { fprintf(stderr, "kernel_launch: unexpected shapes (n_in %d out %d ws %zu)\n", n_in, out_size, ws_size); grid = -1; return; }
        int dev = 0, cus = 0;
        if (hipGetDevice(&dev) != hipSuccess || hipDeviceGetAttribute(&cus, hipDeviceAttributeMultiprocessorCount, dev) != hipSuccess) { grid = -1; return; }
        if (hipFuncSetAttribute((const void*)mega, hipFuncAttributeMaxDynamicSharedMemorySize, LDS_BYTES) != hipSuccess) { fprintf(stderr, "kernel_launch: hipFuncSetAttribute failed\n"); grid = -1; return; }
        grid = cus;
        if (grid != 256) fprintf(stderr, "kernel_launch: %d CUs (built for 256)\n", grid);
    }
    if (grid < 0) return;
    hipMemsetAsync((char*)d_ws + WS_CTL, 0, CTL_ZERO_BYTES, stream);
    Args a{};
    const float** f = (const float**)&a.p;
    for (int i = 0; i < 23; ++i) f[i] = (const float*)d_in[i];
    a.p.out = (float*)d_out; a.p.ws = (unsigned char*)d_ws;
    a.ph_lo = 0; a.ph_hi = PH_END;
    hipLaunchKernelGGL(mega, dim3(grid), dim3(NWAVES * 64), LDS_BYTES, stream, a);
}
```

```cpp
#include <hip/hip_runtime.h>
#ifndef PROBE_S
#define PROBE_S (-1)
#endif
#include <cstdio>
#include <cstdint>

typedef unsigned short bf16_t;
__device__ __forceinline__ float bf2f(bf16_t v) { return __uint_as_float(((unsigned)v) << 16); }
typedef __bf16 nbf16x2 __attribute__((ext_vector_type(2)));
typedef __bf16 nbf16x8 __attribute__((ext_vector_type(8)));
typedef float nf32x2 __attribute__((ext_vector_type(2)));
typedef float nf32x8 __attribute__((ext_vector_type(8)));
__device__ __forceinline__ bf16_t f2bf(float f) { return __builtin_bit_cast(bf16_t, (__bf16)f); }

constexpr int DM = 1024, NB = 16, SEQ = 2048, DEPTH = 4, CTXL = 256, HD = 64, BW = 256, HA = 4;
constexpr int INC = 3600, NPC = 3584, NTILE = 10;
constexpr int MLAT = NB * SEQ, MCTX = NB * CTXL, MTOT = MLAT + MCTX;
constexpr float EPS = 1e-6f;
__device__ __constant__ int c_gt_col[14]   = {0, 256, 512, 2576,   784, 784 + 128,    1040, 1040 + 128,  1552, 1552 + 128,  2064, 2064 + 128,  2320, 3088};
__device__ __constant__ int c_gt_delta[14] = {0, 0,   0,   0,      2048, 2048,        256, 256,          256, 256,          1280, 1280,        0,    0};
enum { T_Q = 0, T_K = 1, T_V = 2, T_GA = 3, T_BGS = 4, T_CX = 5, T_GLU = 6, T_UG = 7, T_VV = 8, T_GC = 9 };

constexpr size_t MiB = 1u << 20;
constexpr size_t WS_CTL = 0, WS_MOD = 1 * MiB, WS_AB = 2 * MiB, WS_GB = 5 * MiB, WS_STAT = 8 * MiB, WS_XC = 16 * MiB, WS_WIN = 32 * MiB, WS_WOUT = 60 * MiB,
                 WS_HY = 68 * MiB, WS_P = 140 * MiB, WS_OFB = 392 * MiB, WS_END = 512 * MiB;
constexpr size_t PTILE_ELEMS = (size_t)MTOT * 256;
constexpr size_t WS_QKV = WS_P + 4 * PTILE_ELEMS * 2;

struct Ptrs {
    const float *x, *c, *ctx, *c_ctx, *norm_g, *w_ada, *b_ada, *w_in, *qkv_conv_w, *a_log, *dt_bias, *gdn_norm_g, *short_conv_w, *conf_conv_w, *conf_conv_b,
        *conf_ln_g, *conf_ln_b, *smlp_ln_g, *smlp_ln_b, *smlp_w, *smlp_b, *w_out, *final_g;
    float* out; unsigned char* ws;
};

__device__ __forceinline__ float silu_f(float x) { return x / (1.f + expf(-x)); }
__device__ __forceinline__ float sigmoid_f(float x) { return 1.f / (1.f + expf(-x)); }
__device__ __forceinline__ float softplus_f(float x) { return x > 20.f ? x : log1pf(expf(x)); }
__device__ __forceinline__ float fexp(float x) { return __builtin_amdgcn_exp2f(x * 1.44269504089f); }
__device__ __forceinline__ float fsigmoid(float x) { return __builtin_amdgcn_rcpf(1.f + fexp(-x)); }
__device__ __forceinline__ float fsilu(float x) { return x * fsigmoid(x); }

__device__ __forceinline__ float block_sum256(float v, float* red) {
#pragma unroll
    for (int o = 32; o > 0; o >>= 1) v += __shfl_xor(v, o);
    __syncthreads();
    if ((threadIdx.x & 63) == 0) red[threadIdx.x >> 6] = v;
    __syncthreads();
    return red[0] + red[1] + red[2] + red[3];
}
template <int CTRL> __device__ __forceinline__ float dpp_f(float v) { return __int_as_float(__builtin_amdgcn_mov_dpp(__float_as_int(v), CTRL, 0xF, 0xF, true)); }
__device__ __forceinline__ float row16_sum(float v) {
    v += dpp_f<0xB1>(v); v += dpp_f<0x4E>(v); v += dpp_f<0x141>(v); v += dpp_f<0x140>(v); return v; }
__device__ __forceinline__ float wave_sum(float v) {
    v = row16_sum(v);
    { auto r = __builtin_amdgcn_permlane16_swap(__float_as_uint(v), __float_as_uint(v), false, false); v = __uint_as_float(r[0]) + __uint_as_float(r[1]); }
    { auto r = __builtin_amdgcn_permlane32_swap(__float_as_uint(v), __float_as_uint(v), false, false); v = __uint_as_float(r[0]) + __uint_as_float(r[1]); }
    return v; }

__device__ __forceinline__ void row_seq(int row, int& start, int& len) { if (row < MLAT) { start = row & ~(SEQ - 1); len = SEQ; } else { start = row & ~(CTXL - 1); len = CTXL; } }

namespace pg8 {
#define PG8_LAS __attribute__((address_space(3)))
typedef unsigned short bf16_t;
typedef short bf16x8 __attribute__((ext_vector_type(8)));
typedef float f32x4 __attribute__((ext_vector_type(4)));
typedef unsigned u32x4 __attribute__((ext_vector_type(4)));
constexpr int BM = 256, BK = 64, HALF = 128, HTB = HALF * BK * 2  , STAGE_BYTES = 8 * HTB, NXCD = 8, WGM = 8;

__host__ __device__ __forceinline__ int lds_byte(int r, int c) { const int st = (r >> 4) * 2 + (c >> 5), rr = r & 15, cc = c & 31, ob = rr * 64 + cc * 2; return st * 1024 + (ob ^ (((ob >> 9) & 1) << 5)); }
__host__ __device__ __forceinline__ void stage_rc(int b, int& R, int& C) { const int st = b / 1024, sb = b % 1024, swz = sb ^ (((sb >> 9) & 1) << 5); R = (st >> 1) * 16 + swz / 64; C = (st & 1) * 32 + (swz % 64) / 2; }
__host__ __device__ __forceinline__ int perm32(int rho) { const int n = rho >> 4, i = rho & 15; return 8 * (i >> 2) + 4 * n + (i & 3); }

struct Unit { int pm, pn; };
struct Gemm { const bf16_t* A; const bf16_t* Bt; int M, N, K; };

struct StaticOrder {
    int nM, nN, nwg, G, c;
    __host__ __device__ void init(int M, int N, int G_, int c_) { nM = M / BM; nN = N / BM; nwg = nM * nN; G = G_; c = c_; }
    __host__ __device__ bool next(int i, Unit& u) const {
        const long L = (long)i * G + c; if (L >= nwg) return false;
        int wgid = (int)L; { const int q = nwg / NXCD, r = nwg % NXCD, xcd = wgid % NXCD, off = wgid / NXCD; wgid = (xcd < r ? xcd * (q + 1) : r * (q + 1) + (xcd - r) * q) + off; }
        const int nig = WGM * nN, gid = wgid / nig, fm = gid * WGM, gsz = (nM - fm) < WGM ? (nM - fm) : WGM;
        u.pm = fm + ((wgid % nig) % gsz); u.pn = (wgid % nig) / gsz; return true;
    }
    __device__ __forceinline__ void a_ready(const Unit&) const {}
    __device__ __forceinline__ void done(const Unit&) const {}
};


__device__ __forceinline__ unsigned cvt_pk_bf16(float lo, float hi) { return __builtin_bit_cast(unsigned, __builtin_convertvector((nf32x2){lo, hi}, nbf16x2)); }
struct EpiP {
    static constexpr bool PERM = true, AFTER_DRAIN = false;
    bf16_t* P; size_t tile_elems;
    __device__ __forceinline__ void operator()(const f32x4 (&acc)[2][2][4][2], const Unit& u, int wr, int wc, int fr, int fq) const {
        const int row0 = u.pm * BM + wr * 64 + fr, g = u.pn;
        if (g < 4 || g > 11) {
            bf16_t* base = P + (size_t)(g < 4 ? g : g - 4) * tile_elems + wc * 32 + 8 * fq;
            const bool gate = g == 3 || g == 13;
#pragma unroll
            for (int ai = 0; ai < 2; ++ai)
#pragma unroll
                for (int m = 0; m < 4; ++m) { bf16_t* rowp = base + (size_t)(row0 + ai * HALF + m * 16) * 256;
#pragma unroll
                    for (int bj = 0; bj < 2; ++bj) { f32x4 v0 = acc[ai][bj][m][0], v1 = acc[ai][bj][m][1];
                        if (gate) {
#pragma unroll
                            for (int e = 0; e < 4; ++e) { v0[e] = v0[e] * __builtin_amdgcn_rcpf(1.f + __builtin_amdgcn_exp2f(-1.44269504089f * v0[e])); v1[e] = v1[e] * __builtin_amdgcn_rcpf(1.f + __builtin_amdgcn_exp2f(-1.44269504089f * v1[e])); } }
                        u32x4 w; w.x = cvt_pk_bf16(v0[0], v0[1]); w.y = cvt_pk_bf16(v0[2], v0[3]); w.z = cvt_pk_bf16(v1[0], v1[1]); w.w = cvt_pk_bf16(v1[2], v1[3]);
                        *(u32x4*)(rowp + bj * HALF) = w; } }
        } else {
            const int pr = (g - 4) >> 1;
            bf16_t* base = P + (size_t)(4 + pr) * tile_elems + 128 * (g & 1) + wc * 16 + 4 * fq;
#pragma unroll
            for (int ai = 0; ai < 2; ++ai)
#pragma unroll
                for (int m = 0; m < 4; ++m) { bf16_t* rowp = base + (size_t)(row0 + ai * HALF + m * 16) * 256;
#pragma unroll
                    for (int bj = 0; bj < 2; ++bj) { const f32x4 v0 = acc[ai][bj][m][0], v1 = acc[ai][bj][m][1];
                        const float a4[4] = {v0[0], v0[2], v1[0], v1[2]}, b4[4] = {v0[1], v0[3], v1[1], v1[3]}; float o[4];
#pragma unroll
                        for (int e = 0; e < 4; ++e) { const float sg = __builtin_amdgcn_rcpf(1.f + __builtin_amdgcn_exp2f(-1.44269504089f * b4[e]));
                            o[e] = pr == 1 ? a4[e] * b4[e] : pr == 2 ? a4[e] * sg : a4[e] * (b4[e] * sg); }
                        typedef unsigned u32x2v __attribute__((ext_vector_type(2)));
                        u32x2v w; w.x = cvt_pk_bf16(o[0], o[1]); w.y = cvt_pk_bf16(o[2], o[3]);
                        *(u32x2v*)(rowp + bj * 64) = w; } }
        }
    }
};
struct OneUnit {
    Unit u0;
    __device__ __forceinline__ bool next(int i, Unit& u) const { if (i != 0) return false; u = u0; return true; }
    __device__ __forceinline__ void a_ready(const Unit&) const {}
    __device__ __forceinline__ void done(const Unit&) const {}
};
struct EpiResid {
    static constexpr bool PERM = true, AFTER_DRAIN = false;
    const void* x_old; bf16_t* x_new; const void* xc_old; bf16_t* xc_new; const float* mod_l; int odd, mlat, seq, dm, f32in, row_off;
    __device__ __forceinline__ void operator()(f32x4 (&acc)[2][2][4][2], const Unit& u, int wr, int wc, int fr, int fq) const {
        const int rbase = row_off + u.pm * BM; const bool lat = rbase < mlat; const int b = lat ? rbase / seq : 16;
        const int col = u.pn * BM + wc * 32 + 8 * fq;
        { const float* gate = mod_l + (size_t)b * 3072 + 2048 + col;
#pragma unroll
          for (int bj = 0; bj < 2; ++bj)
#pragma unroll
            for (int n = 0; n < 2; ++n) { const f32x4 g = *(const f32x4*)(gate + bj * HALF + 4 * n);
#pragma unroll
                for (int ai = 0; ai < 2; ++ai)
#pragma unroll
                    for (int m = 0; m < 4; ++m) acc[ai][bj][m][n] = acc[ai][bj][m][n] * g; } }
        const void* ob = lat ? x_old : xc_old; bf16_t* nb = lat ? x_new : xc_new;
#pragma unroll
        for (int ai = 0; ai < 2; ++ai)
#pragma unroll
          for (int mh = 0; mh < 2; ++mh) {
            f32x4 o[2][2][2]; unsigned offs[2];
#pragma unroll
            for (int mm = 0; mm < 2; ++mm) { const int r = rbase + ai * HALF + wr * 64 + (2 * mh + mm) * 16 + fr;
                if (lat) { const int tp = r % seq; const int t = odd ? ((tp & 31) * 64 + (tp >> 5)) : tp; offs[mm] = (unsigned)(((r / seq) * seq + t) * dm + col); }
                else offs[mm] = (unsigned)((r - mlat) * dm + col); }
            if (f32in) {
#pragma unroll
                for (int mm = 0; mm < 2; ++mm)
#pragma unroll
                    for (int bj = 0; bj < 2; ++bj)
#pragma unroll
                        for (int n = 0; n < 2; ++n) o[mm][bj][n] = *(const f32x4*)((const float*)ob + offs[mm] + bj * HALF + 4 * n);
            } else {
#pragma unroll
                for (int mm = 0; mm < 2; ++mm)
#pragma unroll
                    for (int bj = 0; bj < 2; ++bj) { const u32x4 w = *(const u32x4*)((const bf16_t*)ob + offs[mm] + bj * HALF);
                        o[mm][bj][0] = (f32x4){__uint_as_float(w.x << 16), __uint_as_float(w.x & 0xffff0000u), __uint_as_float(w.y << 16), __uint_as_float(w.y & 0xffff0000u)};
                        o[mm][bj][1] = (f32x4){__uint_as_float(w.z << 16), __uint_as_float(w.z & 0xffff0000u), __uint_as_float(w.w << 16), __uint_as_float(w.w & 0xffff0000u)}; }
            }
#pragma unroll
            for (int mm = 0; mm < 2; ++mm)
#pragma unroll
                for (int bj = 0; bj < 2; ++bj) { const f32x4 v0 = o[mm][bj][0] + acc[ai][bj][2 * mh + mm][0], v1 = o[mm][bj][1] + acc[ai][bj][2 * mh + mm][1];
                    u32x4 w; w.x = cvt_pk_bf16(v0[0], v0[1]); w.y = cvt_pk_bf16(v0[2], v0[3]); w.z = cvt_pk_bf16(v1[0], v1[1]); w.w = cvt_pk_bf16(v1[2], v1[3]);
                    *(u32x4*)(nb + offs[mm] + bj * HALF) = w; }
            asm volatile("" ::: "memory");
          }
    }
};
template <class Epi, class Sched, bool ALIGN_EPI = false, bool SP2 = false>
__device__ __forceinline__ void gemm_phase(PG8_LAS unsigned char* lds, const Gemm g, const Sched& S, const Epi& E) {
    int tid_ = threadIdx.x; asm volatile("" : "+v"(tid_));
    const int tid = tid_, wid = __builtin_amdgcn_readfirstlane(tid >> 6), lane = tid & 63, wr = wid >> 2, wc = wid & 3, fr = lane & 15, fq = lane >> 4;
    const int K = g.K, nt = K / BK;
    unsigned voffA[2], voffB[2];
#pragma unroll
    for (int i = 0; i < 2; ++i) { int R, C; stage_rc(tid * 16 + i * 8192, R, C); const int Rb = Epi::PERM ? ((R & ~31) + perm32(R & 31)) : R;
        voffA[i] = (unsigned)(R * K + C) * 2u; voffB[i] = (unsigned)(Rb * K + C) * 2u; }
    const size_t kstep = (size_t)(BK * 2);
    const size_t hstep = (size_t)HALF * K * 2;
    const size_t tstep = 2 * hstep;
    const unsigned ldsw = (unsigned)wid * 1024u;
    const int aoff = lds_byte(wr * 64 + fr, fq * 8), boff = lds_byte(wc * 32 + fr, fq * 8);
#define PG8_SA(b, h) (((b) * 2 + (h)) * HTB)
#define PG8_SB(b, h) ((4 + (b) * 2 + (h)) * HTB)
#define PG8_STAGE(bufoff, gbase, voff) do { _Pragma("unroll") for (int _i = 0; _i < 2; ++_i) \
        __builtin_amdgcn_global_load_lds((const unsigned*)((const char*)(gbase) + (voff)[_i]), (PG8_LAS unsigned*)(lds + (bufoff) + ldsw + _i * 8192), 16, 0, 0); } while (0)
#define PG8_LDA(dst, b, h) do { _Pragma("unroll") for (int m = 0; m < 4; ++m) _Pragma("unroll") for (int k = 0; k < 2; ++k) dst[m][k] = *(const PG8_LAS bf16x8*)(lds + PG8_SA(b, h) + aoff + m * 2048 + k * 1024); } while (0)
#define PG8_LDB(dst, b, h) do { _Pragma("unroll") for (int n = 0; n < 2; ++n) _Pragma("unroll") for (int k = 0; k < 2; ++k) dst[n][k] = *(const PG8_LAS bf16x8*)(lds + PG8_SB(b, h) + boff + n * 2048 + k * 1024); } while (0)
#define PG8_MMA(ai, bj, At, Bt) do { __builtin_amdgcn_s_setprio(1); _Pragma("unroll") for (int m = 0; m < 4; ++m) _Pragma("unroll") for (int n = 0; n < 2; ++n) _Pragma("unroll") for (int k = 0; k < 2; ++k) \
        acc[ai][bj][m][n] = __builtin_amdgcn_mfma_f32_16x16x32_bf16(Bt[n][k], At[m][k], acc[ai][bj][m][n], 0, 0, 0); __builtin_amdgcn_s_setprio(0); } while (0)
#define PG8_WAIT_V(n) asm volatile("s_waitcnt vmcnt(" #n ")" ::: "memory")
#define PG8_WAIT_L(n) asm volatile("s_waitcnt lgkmcnt(" #n ")" ::: "memory")
#define PG8_BAR __builtin_amdgcn_s_barrier()
#define PG8_SCHED __builtin_amdgcn_sched_barrier(0)
    Unit cur, nxt; int ui = 0;
    if (!S.next(0, cur)) return;
    f32x4 acc[2][2][4][2];
#pragma unroll
    for (int a = 0; a < 2; ++a)
#pragma unroll
        for (int b = 0; b < 2; ++b)
#pragma unroll
            for (int m = 0; m < 4; ++m)
#pragma unroll
                for (int n = 0; n < 2; ++n) acc[a][b][m][n] = (f32x4){0.f, 0.f, 0.f, 0.f};
    bf16x8 At[4][2], B0[2][2], B1[2][2];
    const char* cA = (const char*)g.A + (size_t)cur.pm * tstep; const char* cB = (const char*)g.Bt + (size_t)cur.pn * tstep;
    S.a_ready(cur);
    if constexpr (SP2) {
        PG8_STAGE(PG8_SB(0, 0), cB, voffB); PG8_STAGE(PG8_SB(0, 1), cB + hstep, voffB); PG8_STAGE(PG8_SA(0, 0), cA, voffA); PG8_STAGE(PG8_SA(0, 1), cA + hstep, voffA);
        if (wr == 1) PG8_BAR;
        PG8_WAIT_V(2); PG8_BAR;
        PG8_STAGE(PG8_SB(1, 0), cB + kstep, voffB); PG8_STAGE(PG8_SA(1, 0), cA + kstep, voffA); PG8_STAGE(PG8_SB(1, 1), cB + hstep + kstep, voffB);
        PG8_WAIT_V(6); PG8_BAR;
    } else {
        PG8_STAGE(PG8_SB(0, 0), cB, voffB); PG8_STAGE(PG8_SA(0, 0), cA, voffA); PG8_STAGE(PG8_SB(0, 1), cB + hstep, voffB); PG8_STAGE(PG8_SA(0, 1), cA + hstep, voffA);
        if (wr == 1) PG8_BAR;
        PG8_WAIT_V(4); PG8_BAR;
        PG8_STAGE(PG8_SB(1, 0), cB + kstep, voffB); PG8_STAGE(PG8_SA(1, 0), cA + kstep, voffA); PG8_STAGE(PG8_SB(1, 1), cB + hstep + kstep, voffB);
        PG8_WAIT_V(6); PG8_BAR;
    }
    for (;;) {
        const bool has_next = S.next(ui + 1, nxt);
        const char* nA = has_next ? (const char*)g.A + (size_t)nxt.pm * tstep : cA; const char* nB = has_next ? (const char*)g.Bt + (size_t)nxt.pn * tstep : cB;
        for (int t = 0; t < nt; t += 2) {
            const bool last = (t == nt - 2);
            const char* a1 = cA + (size_t)(t + 1) * kstep;
            const char* a2 = last ? nA : cA + (size_t)(t + 2) * kstep; const char* b2 = last ? nB : cB + (size_t)(t + 2) * kstep;
            const char* a3 = a2 + kstep; const char* b3 = b2 + kstep;
            if (last && has_next) S.a_ready(nxt);
            if constexpr (SP2) {
            PG8_LDB(B0, 0, 0); PG8_LDB(B1, 0, 1); PG8_SCHED; PG8_LDA(At, 0, 0); PG8_STAGE(PG8_SA(1, 1), a1 + hstep, voffA);
            PG8_WAIT_V(8); PG8_WAIT_L(0); PG8_BAR; PG8_MMA(0, 0, At, B0); PG8_MMA(0, 1, At, B1); PG8_BAR; PG8_SCHED;
            PG8_LDA(At, 0, 1); PG8_STAGE(PG8_SB(0, 0), b2, voffB); PG8_STAGE(PG8_SB(0, 1), b2 + hstep, voffB); PG8_STAGE(PG8_SA(0, 0), a2, voffA);
            PG8_WAIT_V(8); PG8_WAIT_L(0); PG8_BAR; PG8_MMA(1, 0, At, B0); PG8_MMA(1, 1, At, B1); PG8_BAR; PG8_SCHED;
            PG8_LDB(B0, 1, 0); PG8_LDB(B1, 1, 1); PG8_SCHED; PG8_LDA(At, 1, 0); PG8_STAGE(PG8_SA(0, 1), a2 + hstep, voffA);
            PG8_WAIT_V(8); PG8_WAIT_L(0); PG8_BAR; PG8_MMA(0, 0, At, B0); PG8_MMA(0, 1, At, B1); PG8_BAR; PG8_SCHED;
            PG8_LDA(At, 1, 1); PG8_STAGE(PG8_SB(1, 0), b3, voffB); PG8_STAGE(PG8_SB(1, 1), b3 + hstep, voffB); PG8_STAGE(PG8_SA(1, 0), a3, voffA);
            PG8_WAIT_V(8); PG8_WAIT_L(0); PG8_BAR; PG8_MMA(1, 0, At, B0); PG8_MMA(1, 1, At, B1); PG8_BAR; PG8_SCHED;
            } else {
            PG8_LDB(B0, 0, 0); PG8_SCHED; PG8_LDA(At, 0, 0); PG8_STAGE(PG8_SA(1, 1), a1 + hstep, voffA);
            PG8_WAIT_L(8); PG8_BAR; PG8_WAIT_L(0); PG8_MMA(0, 0, At, B0); PG8_BAR; PG8_SCHED;
            PG8_LDB(B1, 0, 1); PG8_STAGE(PG8_SB(0, 0), b2, voffB);
            PG8_BAR; PG8_WAIT_L(0); PG8_MMA(0, 1, At, B1); PG8_BAR;
            PG8_LDA(At, 0, 1); PG8_STAGE(PG8_SA(0, 0), a2, voffA);
            PG8_BAR; PG8_WAIT_L(0); PG8_MMA(1, 0, At, B0); PG8_BAR; PG8_SCHED;
            PG8_STAGE(PG8_SB(0, 1), b2 + hstep, voffB);
            PG8_WAIT_V(6); PG8_BAR; PG8_MMA(1, 1, At, B1); PG8_BAR;
            PG8_LDB(B0, 1, 0); PG8_SCHED; PG8_LDA(At, 1, 0); PG8_STAGE(PG8_SA(0, 1), a2 + hstep, voffA);
            PG8_WAIT_L(8); PG8_BAR; PG8_WAIT_L(0); PG8_MMA(0, 0, At, B0); PG8_BAR; PG8_SCHED;
            PG8_LDB(B1, 1, 1); PG8_STAGE(PG8_SB(1, 0), b3, voffB);
            PG8_BAR; PG8_WAIT_L(0); PG8_MMA(0, 1, At, B1); PG8_BAR;
            PG8_LDA(At, 1, 1); PG8_STAGE(PG8_SA(1, 0), a3, voffA);
            PG8_BAR; PG8_WAIT_L(0); PG8_MMA(1, 0, At, B0); PG8_BAR; PG8_SCHED;
            PG8_STAGE(PG8_SB(1, 1), b3 + hstep, voffB);
            PG8_WAIT_V(6); PG8_BAR; PG8_MMA(1, 1, At, B1); PG8_BAR;
            }
        }
        if constexpr (ALIGN_EPI) { if (wr == 0) PG8_BAR; }
        if constexpr (!Epi::AFTER_DRAIN) { E(acc, cur, wr, wc, fr, fq); S.done(cur); }
        if (!has_next) break;
#pragma unroll
        for (int a = 0; a < 2; ++a)
#pragma unroll
            for (int b = 0; b < 2; ++b)
#pragma unroll
                for (int m = 0; m < 4; ++m)
#pragma unroll
                    for (int n = 0; n < 2; ++n) acc[a][b][m][n] = (f32x4){0.f, 0.f, 0.f, 0.f};
        cur = nxt; cA = nA; cB = nB; ++ui;
        if constexpr (ALIGN_EPI) { if (wr == 1) PG8_BAR; }
    }
    PG8_WAIT_V(0);
    if constexpr (!ALIGN_EPI) { if (wr == 0) PG8_BAR; }
    PG8_BAR;
    if constexpr (Epi::AFTER_DRAIN) { E.fused(acc, cur, wr, wc, fr, fq, lds, wid, lane); S.done(cur); }
#undef PG8_SA
#undef PG8_SB
#undef PG8_STAGE
#undef PG8_LDA
#undef PG8_LDB
#undef PG8_MMA
#undef PG8_WAIT_V
#undef PG8_WAIT_L
#undef PG8_BAR
#undef PG8_SCHED
}
}

constexpr int NWAVES = 8;
constexpr int RING_BYTES = 159744, LDSCTL_OFF = RING_BYTES, MISC_OFF = LDSCTL_OFF + 320, LDS_BYTES = 163840;
constexpr int CW_BAR = 4096;
constexpr size_t CTL_ZERO_BYTES = 64 * 1024;
#define GAS __attribute__((address_space(1)))
#define LAS __attribute__((address_space(3)))
typedef float f32x4 __attribute__((ext_vector_type(4)));
typedef unsigned v4u __attribute__((ext_vector_type(4)));
typedef unsigned u32x2 __attribute__((ext_vector_type(2)));
__device__ __forceinline__ float bflo(unsigned w) { return __uint_as_float(w << 16); }
__device__ __forceinline__ float bfhi(unsigned w) { return __uint_as_float(w & 0xffff0000u); }
typedef short bf16x8 __attribute__((ext_vector_type(8)));
__device__ __forceinline__ void unpack8(const v4u& w, float (&f)[8]) { f[0] = bflo(w.x); f[1] = bfhi(w.x); f[2] = bflo(w.y); f[3] = bfhi(w.y); f[4] = bflo(w.z); f[5] = bfhi(w.z); f[6] = bflo(w.w); f[7] = bfhi(w.w); }
__device__ __forceinline__ bf16x8 pack8(const f32x4& a, const f32x4& b) {
    return __builtin_bit_cast(bf16x8, __builtin_convertvector((nf32x8){a.x, a.y, a.z, a.w, b.x, b.y, b.z, b.w}, nbf16x8)); }
typedef GAS unsigned gu32;
#define LDS_WAIT() asm volatile("s_waitcnt lgkmcnt(0)" ::: "memory")
#define LBAR() do { asm volatile("s_waitcnt lgkmcnt(0)" ::: "memory"); __builtin_amdgcn_s_barrier(); asm volatile("" ::: "memory"); } while (0)
#define VM_WAIT() asm volatile("s_waitcnt vmcnt(0)" ::: "memory")
__device__ __forceinline__ unsigned pk2(float lo, float hi) { return __builtin_bit_cast(unsigned, __builtin_convertvector((nf32x2){lo, hi}, nbf16x2)); }

#define XB_TMO      128
#define XB_XCNT(j)  (256  + 64 * (j))
#define XB_XSUB(j)  (1280 + 64 * (j))
#define XB_XGEN(j)  (2304 + 64 * (j))
#define XB_TOP      3328
#define XB_TOPGEN   3392
#define XCD_BAR_WORDS 3456
#define XB_SPIN_CAP (1u << 22)

__device__ __forceinline__ unsigned xb_ld(unsigned* p)              { return __hip_atomic_load(p, __ATOMIC_RELAXED, __HIP_MEMORY_SCOPE_AGENT); }
__device__ __forceinline__ unsigned xb_add(unsigned* p, unsigned v) { return __hip_atomic_fetch_add(p, v, __ATOMIC_RELAXED, __HIP_MEMORY_SCOPE_AGENT); }
__device__ __forceinline__ unsigned xb_xcc_id() { return (unsigned)__builtin_amdgcn_s_getreg((3 << 11) | 20) & 0xFu; }
#define XB_SPIN(cond, bar) do { unsigned _sp = 0; while (cond) { __builtin_amdgcn_s_sleep(1); \
    if ((++_sp & 255u) == 0u) { if (xb_ld(&(bar)[XB_TMO])) break; if (_sp > XB_SPIN_CAP) { atomicAdd(&(bar)[XB_TMO], 1u); break; } } } } while (0)

struct XcdBarrier {
    unsigned* bar; unsigned x;
    volatile LAS unsigned* st;
};

__device__ __forceinline__ XcdBarrier xcd_barrier_post(unsigned* bar, volatile LAS unsigned* st) {
    XcdBarrier b; b.bar = bar; b.x = xb_xcc_id(); b.st = st;
    if (threadIdx.x == 0) (void)xb_add(&bar[XB_XCNT(b.x)], 1u);
    return b;
}
__device__ __forceinline__ void xcd_barrier_complete(unsigned* bar, unsigned x, unsigned& nloc, unsigned& nx) {
    const unsigned G = gridDim.x * gridDim.y * gridDim.z;
    unsigned sum, cnt, mine, sp = 0u;
    for (;;) {
        sum = 0u; cnt = 0u; mine = 0u;
#pragma unroll
        for (unsigned j = 0; j < 16; ++j) { const unsigned c = xb_ld(&bar[XB_XCNT(j)]); sum += c; cnt += (c > 0u) ? 1u : 0u; mine = (j == x) ? c : mine; }
        if (sum == G) break;
        __builtin_amdgcn_s_sleep(1);
        if ((++sp & 255u) == 0u) { if (xb_ld(&bar[XB_TMO])) break; if (sp > XB_SPIN_CAP) { atomicAdd(&bar[XB_TMO], 1u); break; } }
    }
    nloc = mine > 0u ? mine : 1u; nx = cnt > 0u ? cnt : 1u;
}

__device__ __forceinline__ void xcd_barrier(const XcdBarrier& b) {
    asm volatile("s_waitcnt vmcnt(0)" ::: "memory");
    __syncthreads();
    if (threadIdx.x == 0) {
        unsigned* bar = b.bar;
        __builtin_amdgcn_s_waitcnt(0);
        unsigned nloc = b.st[0], nx = b.st[1];
        if (nloc == 0u) { xcd_barrier_complete(bar, b.x, nloc, nx); b.st[0] = nloc; b.st[1] = nx; }
        const unsigned old = xb_add(&bar[XB_XSUB(b.x)], 1u);
        const unsigned gen = old / nloc;
        if (old + 1u == (gen + 1u) * nloc) {
            __builtin_amdgcn_fence(__ATOMIC_RELEASE, "agent");
            asm volatile("s_waitcnt vmcnt(0)" ::: "memory");
            const unsigned og = xb_add(&bar[XB_TOP], 1u);
            const unsigned tg = og / nx;
            if (og + 1u == (tg + 1u) * nx) xb_add(&bar[XB_TOPGEN], 1u);
            else XB_SPIN(xb_ld(&bar[XB_TOPGEN]) == tg, bar);
            __builtin_amdgcn_fence(__ATOMIC_ACQUIRE, "agent");
            xb_add(&bar[XB_XGEN(b.x)], 1u);
            asm volatile("s_waitcnt vmcnt(0)" ::: "memory");
        } else {
            XB_SPIN(xb_ld(&bar[XB_XGEN(b.x)]) == gen, bar);
            __builtin_amdgcn_fence(__ATOMIC_ACQUIRE, "agent");
            asm volatile("s_waitcnt vmcnt(0)" ::: "memory");
        }
    }
    __syncthreads();
}


#define CAS __attribute__((address_space(4)))
typedef const CAS Ptrs KPtrs;
struct Frame {
    LAS unsigned char* lds; volatile LAS unsigned* MISC; gu32* ctl;
    int tid, lane, wave, vcu, G;
    __device__ __forceinline__ KPtrs& P() const { const CAS char* kp = (const CAS char*)__builtin_amdgcn_kernarg_segment_ptr(); asm volatile("" : "+s"(kp)); return *(KPtrs*)kp; }
    __device__ __forceinline__ void refresh() { int t = threadIdx.x; asm volatile("" : "+v"(t)); tid = t; lane = t & 63; wave = __builtin_amdgcn_readfirstlane(t >> 6); }
};

__device__ __forceinline__ void transpose_item(const float* W, int coff, int ld, bf16_t* WT, LAS float* scr, int k0, int lane) {
    float tv[32];
#pragma unroll
    for (int i = 0; i < 32; ++i) tv[i] = W[(size_t)(k0 + 2 * i + (lane >> 5)) * ld + coff];
#pragma unroll
    for (int i = 0; i < 32; ++i) scr[(2 * i + (lane >> 5)) * 33 + (lane & 31)] = tv[i];
    LDS_WAIT(); asm volatile("" ::: "memory");
    const int c = lane & 7;
#pragma unroll
    for (int j = 0; j < 4; ++j) { const int n = (lane >> 3) + 8 * j; const LAS float* s = scr + (8 * c) * 33 + n;
        v4u o; o.x = pk2(s[0 * 33], s[1 * 33]); o.y = pk2(s[2 * 33], s[3 * 33]); o.z = pk2(s[4 * 33], s[5 * 33]); o.w = pk2(s[6 * 33], s[7 * 33]);
        *(GAS v4u*)(WT + (size_t)n * DM + k0 + 8 * c) = o; }
    LDS_WAIT(); asm volatile("" ::: "memory");
}
__device__ __forceinline__ void convert_weights(Frame& F, int l, int gw, int NGW) {
    KPtrs& p = F.P();
    LAS float* scr = (LAS float*)(F.lds + F.wave * 16384);
    constexpr int I_IN = 16 * (NPC / 32), I_OUT = 16 * (DM / 32), I_L = I_IN + I_OUT;
    for (int it = gw; it < I_L; it += NGW) { int r = it;
        if (r < I_IN) { const int kb = r / (NPC / 32), nb = r % (NPC / 32), n0 = 32 * nb;
            const int g = n0 >> 8, i0 = n0 & 255, li = F.lane & 31, dl = c_gt_delta[g];
            const int coff = c_gt_col[g] + (dl ? (i0 >> 1) + (li >> 1) + ((li & 1) ? dl : 0) : i0 + li);
            transpose_item(p.w_in + (size_t)l * DM * INC, coff, INC, (bf16_t*)(p.ws + WS_WIN) + ((size_t)l * NPC + n0) * DM, scr, 64 * kb, F.lane); }
        else { r -= I_IN; const int kb = r / (DM / 32), nb = r % (DM / 32), n0 = 32 * nb;
            transpose_item(p.w_out + (size_t)l * DM * DM, n0 + (F.lane & 31), DM, (bf16_t*)(p.ws + WS_WOUT) + ((size_t)l * DM + n0) * DM, scr, 64 * kb, F.lane); }
    }
}
__device__ __forceinline__ void mod_item(Frame& F, int l, int slab) {
    KPtrs& p = F.P(); const int n0 = slab * 128;
    LAS float* s = (LAS float*)F.lds;
    LAS float* red = s + 17 * DM;
    { float cv[34];
#pragma unroll
      for (int j = 0; j < 34; ++j) { const int i = F.tid + j * NWAVES * 64, b = i >> 10, k = i & 1023; cv[j] = b < 16 ? p.c[b * DM + k] : p.c_ctx[k]; }
#pragma unroll
      for (int j = 0; j < 34; ++j) s[F.tid + j * NWAVES * 64] = fsilu(cv[j]); }
    __syncthreads();
    const int cq = F.tid & 31, kg = F.tid >> 5;
    f32x4 acc[17];
#pragma unroll
    for (int b = 0; b < 17; ++b) acc[b] = (f32x4){0.f, 0.f, 0.f, 0.f};
    const float* w = p.w_ada + (size_t)l * DM * 3072 + n0 + 4 * cq;
#pragma unroll 1
    for (int k0 = kg * 64; k0 < kg * 64 + 64; k0 += 16) { f32x4 wv[16];
#pragma unroll
        for (int kk = 0; kk < 16; ++kk) wv[kk] = *(const f32x4*)(w + (size_t)(k0 + kk) * 3072);
#pragma unroll
        for (int q = 0; q < 4; ++q) {
#pragma unroll
            for (int b = 0; b < 17; ++b) { const f32x4 s4 = *(const LAS f32x4*)(s + b * DM + k0 + 4 * q);
                acc[b] += wv[4 * q] * s4.x + wv[4 * q + 1] * s4.y + wv[4 * q + 2] * s4.z + wv[4 * q + 3] * s4.w; }
            asm volatile("" ::: "memory"); } }
#pragma unroll
    for (int b = 0; b < 17; ++b) {
        float v[4] = {acc[b].x, acc[b].y, acc[b].z, acc[b].w};
#pragma unroll
        for (int e = 0; e < 4; ++e) { auto r = __builtin_amdgcn_permlane32_swap(__float_as_uint(v[e]), __float_as_uint(v[e]), false, false); v[e] = __uint_as_float(r[0]) + __uint_as_float(r[1]); }
        if (F.lane < 32) *(LAS f32x4*)(red + (F.wave * 17 + b) * 128 + 4 * cq) = (f32x4){v[0], v[1], v[2], v[3]}; }
    __syncthreads();
    float* mod = (float*)(p.ws + WS_MOD);
    for (int o = F.tid; o < 17 * 128; o += NWAVES * 64) { const int b = o >> 7, cc = o & 127; float sum = p.b_ada[l * 3072 + n0 + cc];
#pragma unroll
        for (int g = 0; g < 8; ++g) sum += red[(g * 17 + b) * 128 + cc];
        mod[(size_t)(l * 17 + b) * 3072 + n0 + cc] = sum; }
    __syncthreads();
}
__device__ __forceinline__ void phase_pre(Frame& F) {
    KPtrs& p = F.P();
    if (blockIdx.x < 96) mod_item(F, (int)blockIdx.x / 24, (int)blockIdx.x % 24);
    else convert_weights(F, 0, ((int)blockIdx.x - 96) * NWAVES + F.wave, (F.G - 96) * NWAVES);
    { bf16_t* wsb = (bf16_t*)(p.ws + (9u << 20));
      for (int i = F.vcu * NWAVES * 64 + F.tid; i < DEPTH * 4 * 128 * 128 / 4; i += F.G * NWAVES * 64) { const f32x4 v = *(const f32x4*)(p.smlp_w + 4 * (size_t)i);
          unsigned long long o = (unsigned long long)pk2(v.x, v.y) | ((unsigned long long)pk2(v.z, v.w) << 32); *(GAS unsigned long long*)(wsb + 4 * (size_t)i) = o; } }
}

__device__ __forceinline__ void norm_wave_rows(Frame& F, int l, const LAS float* wab, int rbeg, int rend) {
    KPtrs& p = F.P();
    const int lane = F.lane;
    int curb = -1; f32x4 gs[4], sh[4];
    f32x4 vn[2][4]; int bn[2] = {0, 0};
    const bf16_t* const XB = (const bf16_t*)((const char*)p.out + (64u << 20)); const bf16_t* const XCB = (const bf16_t*)(p.ws + WS_XC);
#define NORM_OFF(r_, b_, off_, lat_) do { if ((r_) < MLAT) { b_ = (r_) >> 11; const int tp_ = (r_) & 2047; const int t_ = (l & 1) ? ((tp_ & 31) * 64 + (tp_ >> 5)) : tp_; off_ = ((size_t)b_ * SEQ + t_) * DM; lat_ = true; } \
        else { b_ = 16; off_ = (size_t)((r_) - MLAT) * DM; lat_ = false; } } while (0)
#define NORM_LOAD(r_, slot_) do { if ((r_) < rend) { size_t off_; bool lat_; NORM_OFF(r_, bn[slot_], off_, lat_); \
        if (l == 0) { const GAS f32x4* xr_ = (const GAS f32x4*)((lat_ ? p.x : p.ctx) + off_) + lane; _Pragma("unroll") for (int j = 0; j < 4; ++j) vn[slot_][j] = xr_[64 * j]; } \
        else { const GAS u32x2* xr_ = (const GAS u32x2*)((lat_ ? XB : XCB) + off_) + lane; _Pragma("unroll") for (int j = 0; j < 4; ++j) { const u32x2 w_ = xr_[64 * j]; vn[slot_][j] = (f32x4){bflo(w_.x), bfhi(w_.x), bflo(w_.y), bfhi(w_.y)}; } } } } while (0)
    NORM_LOAD(rbeg, 0); NORM_LOAD(rbeg + 1, 1);
    for (int r0 = rbeg; r0 < rend; r0 += 2) {
#pragma unroll
      for (int u = 0; u < 2; ++u) { const int r = r0 + u; if (r < rend) {
        const int b = bn[u]; f32x4 v[4]; float ss = 0.f;
#pragma unroll
        for (int j = 0; j < 4; ++j) v[j] = vn[u][j];
        NORM_LOAD(r + 2, u);
        if (b != curb) { curb = b; const float* mod = (const float*)(p.ws + WS_MOD) + (size_t)(l * 17 + b) * 3072;
#pragma unroll
            for (int j = 0; j < 4; ++j) { const f32x4 g = *(const f32x4*)(p.norm_g + l * DM + 256 * j + 4 * lane), sc = *(const f32x4*)(mod + 1024 + 256 * j + 4 * lane);
                gs[j] = g * (sc + 1.0f); sh[j] = *(const f32x4*)(mod + 256 * j + 4 * lane); } }
#pragma unroll
        for (int j = 0; j < 4; ++j) { ss += (v[j].x * v[j].x + v[j].y * v[j].y) + (v[j].z * v[j].z + v[j].w * v[j].w); }
        ss = wave_sum(ss);
        const float rstd = 1.0f / sqrtf(ss * (1.0f / DM) + EPS);
        GAS unsigned long long* o8 = (GAS unsigned long long*)((bf16_t*)(p.ws + WS_HY) + (size_t)r * DM) + lane;
#pragma unroll
        for (int j = 0; j < 4; ++j) { v[j] = v[j] * rstd * gs[j] + sh[j]; o8[64 * j] = (unsigned long long)pk2(v[j].x, v[j].y) | ((unsigned long long)pk2(v[j].z, v[j].w) << 32); }
        float acc[16];
#pragma unroll
        for (int n = 0; n < 16; ++n) { float a = 0.f;
#pragma unroll
            for (int j = 0; j < 4; ++j) { const f32x4 w4 = *(const LAS f32x4*)(wab + n * DM + 256 * j + 4 * lane); a += (v[j].x * w4.x + v[j].y * w4.y) + (v[j].z * w4.z + v[j].w * w4.w); }
            acc[n] = a; if ((n & 3) == 3) asm volatile("" ::: "memory"); }
        float r8[8], r4[4], r2[2], r1;
#pragma unroll
        for (int i = 0; i < 8; ++i) { auto q = __builtin_amdgcn_permlane32_swap(__float_as_uint(acc[i]), __float_as_uint(acc[i + 8]), false, false); r8[i] = __uint_as_float(q[0]) + __uint_as_float(q[1]); }
#pragma unroll
        for (int i = 0; i < 4; ++i) { auto q = __builtin_amdgcn_permlane16_swap(__float_as_uint(r8[i]), __float_as_uint(r8[i + 4]), false, false); r4[i] = __uint_as_float(q[0]) + __uint_as_float(q[1]); }
        { const bool up = lane & 8;
#pragma unroll
          for (int i = 0; i < 2; ++i) { const float keep = up ? r4[i + 2] : r4[i], send = up ? r4[i] : r4[i + 2]; r2[i] = keep + dpp_f<0x128>(send); } }
        { const bool up = lane & 4; const float keep = up ? r2[1] : r2[0], send = up ? r2[0] : r2[1]; r1 = keep + __shfl_xor(send, 4); }
        r1 += dpp_f<0x4E>(r1); r1 += dpp_f<0xB1>(r1);
        if ((lane & 3) == 0) ((float*)(p.ws + WS_AB))[(size_t)r * 16 + (lane >> 2)] = r1;
      } }
    }
}
__device__ __forceinline__ void norm_tile16(Frame& F, int l, const LAS bf16_t* wabT, LAS float* tab, int r0, int& curb) {
    KPtrs& p = F.P(); const int lane = F.lane, li = lane & 15, g4 = lane >> 4;
    const bf16_t* const XB = (const bf16_t*)((const char*)p.out + (64u << 20)); const bf16_t* const XCB = (const bf16_t*)(p.ws + WS_XC);
    const int r = r0 + li; int b; const bf16_t* src;
    if (r < MLAT) { b = r >> 11; const int tp = r & 2047; const int t = (l & 1) ? ((tp & 31) * 64 + (tp >> 5)) : tp; src = XB + ((size_t)b * SEQ + t) * DM; }
    else { b = 16; src = XCB + (size_t)(r - MLAT) * DM; }
    v4u xr[32];
#pragma unroll
    for (int s2 = 0; s2 < 32; ++s2) xr[s2] = *(const GAS v4u*)(src + 32 * s2 + 8 * g4);
    const int bt = __builtin_amdgcn_readfirstlane(b);
    if (bt != curb) { curb = bt; const float* mod = (const float*)(p.ws + WS_MOD) + (size_t)(l * 17 + bt) * 3072;
#pragma unroll
        for (int j = 0; j < 4; ++j) { const f32x4 g = *(const f32x4*)(p.norm_g + l * DM + 256 * j + 4 * lane), sc = *(const f32x4*)(mod + 1024 + 256 * j + 4 * lane), sh = *(const f32x4*)(mod + 256 * j + 4 * lane);
            *(LAS f32x4*)(tab + 256 * j + 4 * lane) = g * (sc + 1.0f); *(LAS f32x4*)(tab + 1024 + 256 * j + 4 * lane) = sh; }
        asm volatile("s_waitcnt lgkmcnt(0)" ::: "memory"); }
    float ss = 0.f;
#pragma unroll
    for (int s2 = 0; s2 < 32; ++s2) { float f[8]; unpack8(xr[s2], f);
#pragma unroll
        for (int e = 0; e < 8; ++e) ss += f[e] * f[e]; }
    { auto q = __builtin_amdgcn_permlane16_swap(__float_as_uint(ss), __float_as_uint(ss), false, false); ss = __uint_as_float(q[0]) + __uint_as_float(q[1]); }
    { auto q = __builtin_amdgcn_permlane32_swap(__float_as_uint(ss), __float_as_uint(ss), false, false); ss = __uint_as_float(q[0]) + __uint_as_float(q[1]); }
    const float rstd = 1.0f / sqrtf(ss * (1.0f / DM) + EPS);
#pragma unroll
    for (int s2 = 0; s2 < 32; ++s2) asm volatile("" : "+v"(xr[s2]));
    f32x4 acc = {0.f, 0.f, 0.f, 0.f};
    bf16_t* hrow = (bf16_t*)(p.ws + WS_HY) + (size_t)r * DM + 8 * g4;
#pragma unroll
    for (int s2 = 0; s2 < 32; ++s2) { float f[8]; unpack8(xr[s2], f);
        const f32x4 ga = *(const LAS f32x4*)(tab + 32 * s2 + 8 * g4), gb = *(const LAS f32x4*)(tab + 32 * s2 + 8 * g4 + 4), sa = *(const LAS f32x4*)(tab + 1024 + 32 * s2 + 8 * g4), sb = *(const LAS f32x4*)(tab + 1024 + 32 * s2 + 8 * g4 + 4);
        const f32x4 ha = (f32x4){f[0], f[1], f[2], f[3]} * rstd * ga + sa, hb = (f32x4){f[4], f[5], f[6], f[7]} * rstd * gb + sb;
        const bf16x8 hf = pack8(ha, hb);
        *(GAS bf16x8*)(hrow + 32 * s2) = hf;
        const bf16x8 wf = *(const LAS bf16x8*)(wabT + li * DM + 32 * s2 + 8 * g4);
        acc = __builtin_amdgcn_mfma_f32_16x16x32_bf16(hf, wf, acc, 0, 0, 0);
        if ((s2 & 1) == 1) asm volatile("" ::: "memory"); }
    float* AB = (float*)(p.ws + WS_AB) + (size_t)(r0 + 4 * g4) * 16 + li;
#pragma unroll
    for (int rr = 0; rr < 4; ++rr) AB[rr * 16] = acc[rr];
}
constexpr int CW_CTXC = 9216, CW_NORMQ = 13312;
__device__ __forceinline__ void norm_stage_wab(Frame& F, int l, LAS float* wab) {
    KPtrs& p = F.P();
    float wv[32];
#pragma unroll
    for (int q = 0; q < 32; ++q) { const int i = F.tid + q * NWAVES * 64; wv[q] = p.w_in[(size_t)l * DM * INC + (size_t)(i >> 4) * INC + 768 + (i & 15)]; }
#pragma unroll
    for (int q = 0; q < 32; ++q) { const int i = F.tid + q * NWAVES * 64; wab[(i & 15) * DM + (i >> 4)] = wv[q]; }
    __syncthreads();
}
__device__ __forceinline__ void phase_norm(Frame& F, int l) {
    KPtrs& p = F.P();
    LAS float* wab = (LAS float*)F.lds;
    if (l == 0) {
        norm_stage_wab(F, l, wab);
        constexpr int RPW = MTOT / (256 * NWAVES);
        const int gw = F.vcu * NWAVES + F.wave;
        norm_wave_rows(F, l, wab, gw * RPW, (gw + 1) * RPW < MTOT ? (gw + 1) * RPW : MTOT);
        __syncthreads();
        return;
    }
    const LAS bf16_t* wabT = (const LAS bf16_t*)F.lds; LAS float* tab = (LAS float*)(F.lds + 32768 + F.wave * 8192); int curb = -1;
#define NORM_STAGE_WAB() do { float wv_[32];   \
        _Pragma("unroll") for (int q_ = 0; q_ < 32; ++q_) { const int i_ = F.tid + q_ * NWAVES * 64; wv_[q_] = p.w_in[(size_t)l * DM * INC + (size_t)(i_ >> 4) * INC + 768 + (i_ & 15)]; } \
        _Pragma("unroll") for (int q_ = 0; q_ < 32; ++q_) { const int i_ = F.tid + q_ * NWAVES * 64; ((LAS bf16_t*)F.lds)[(i_ & 15) * DM + (i_ >> 4)] = f2bf(wv_[q_]); } \
        __syncthreads(); } while (0)
    if (blockIdx.x < 64) {
        const int pmc = (int)blockIdx.x >> 2, pn = (int)blockIdx.x & 3, lp = l - 1;
        pg8::Gemm g{(const bf16_t*)(p.ws + WS_HY) + (size_t)MLAT * DM, (const bf16_t*)(p.ws + WS_WOUT) + (size_t)lp * DM * DM, MCTX, DM, DM};
        pg8::OneUnit S{{pmc, pn}};
        bf16_t* const XCB = (bf16_t*)(p.ws + WS_XC);
        pg8::EpiResid E{nullptr, nullptr, lp == 0 ? (const void*)p.ctx : (const void*)XCB, XCB, (const float*)(p.ws + WS_MOD) + (size_t)lp * 17 * 3072, 0, MLAT, SEQ, DM, lp == 0 ? 1 : 0, MLAT};
        pg8::gemm_phase<pg8::EpiResid, pg8::OneUnit, false, true>(F.lds, g, S, E);
        F.refresh();
        asm volatile("s_waitcnt vmcnt(0)" ::: "memory");
        __syncthreads();
        if (F.tid == 0) { __builtin_amdgcn_fence(__ATOMIC_RELEASE, "agent"); asm volatile("s_waitcnt vmcnt(0)" ::: "memory");
            (void)__hip_atomic_fetch_add(F.ctl + CW_CTXC + (l * 16 + pmc) * 64, 1u, __ATOMIC_RELAXED, __HIP_MEMORY_SCOPE_AGENT); }
    } else {
        NORM_STAGE_WAB();
        const int wi = ((int)blockIdx.x - 64) * NWAVES + F.wave;
        for (int t = wi; t < MLAT / 16; t += 1536) norm_tile16(F, l, wabT, tab, 16 * t, curb);
        if (blockIdx.x >= 128) { __syncthreads(); convert_weights(F, l, ((int)blockIdx.x - 128) * NWAVES + F.wave, 1024); }
        else {
            const int q = (int)blockIdx.x - 64, pmc = q >> 2;
            if (F.tid == 0) { gu32* cnt = F.ctl + CW_CTXC + (l * 16 + pmc) * 64; unsigned spins = 0;
                while (__hip_atomic_load(cnt, __ATOMIC_RELAXED, __HIP_MEMORY_SCOPE_AGENT) < 4u && ++spins < (1u << 22)) __builtin_amdgcn_s_sleep(2);
                __builtin_amdgcn_fence(__ATOMIC_ACQUIRE, "agent"); asm volatile("s_waitcnt vmcnt(0)" ::: "memory"); }
            __syncthreads();
            if (F.wave < 4) norm_tile16(F, l, wabT, tab, MLAT + 64 * q + 16 * F.wave, curb);
        }
    }
#undef NORM_STAGE_WAB
    __syncthreads();
}

__device__ __forceinline__ void phase_final(Frame& F) {
    KPtrs& p = F.P(); const int lane = F.lane;
    const int gw = F.vcu * NWAVES + F.wave, NGW = F.G * NWAVES;
    const bf16_t* X = (const bf16_t*)(p.ws + WS_P);
    f32x4 g[4];
#pragma unroll
    for (int j = 0; j < 4; ++j) g[j] = *(const f32x4*)(p.final_g + 256 * j + 4 * lane);
    for (int r0 = gw; r0 < MLAT; r0 += 4 * NGW) {
        u32x2 raw[4][4];
#pragma unroll
        for (int u = 0; u < 4; ++u) { const int r = r0 + u * NGW; if (r < MLAT) { const GAS u32x2* xr = (const GAS u32x2*)(X + (size_t)r * DM) + lane;
#pragma unroll
            for (int j = 0; j < 4; ++j) raw[u][j] = xr[64 * j]; } }
#pragma unroll
        for (int u = 0; u < 4; ++u) { const int r = r0 + u * NGW; if (r < MLAT) {
            f32x4 v[4]; float ss = 0.f;
#pragma unroll
            for (int j = 0; j < 4; ++j) { v[j] = (f32x4){bflo(raw[u][j].x), bfhi(raw[u][j].x), bflo(raw[u][j].y), bfhi(raw[u][j].y)}; ss += (v[j].x * v[j].x + v[j].y * v[j].y) + (v[j].z * v[j].z + v[j].w * v[j].w); }
            ss = wave_sum(ss);
            const float rstd = 1.0f / sqrtf(ss * (1.0f / DM) + EPS);
            GAS f32x4* xo = (GAS f32x4*)(p.out + (size_t)r * DM) + lane;
#pragma unroll
            for (int j = 0; j < 4; ++j) xo[64 * j] = v[j] * rstd * g[j]; } }
    }
}

__device__ __forceinline__ void phase_gemm1(Frame& F, int l) {
    KPtrs& p = F.P();
    pg8::Gemm g{(const bf16_t*)(p.ws + WS_HY), (const bf16_t*)(p.ws + WS_WIN) + (size_t)l * NPC * DM, MTOT, NPC, DM};
    pg8::StaticOrder S; S.init(MTOT, NPC, F.G, (int)blockIdx.x);
    pg8::EpiP E{(bf16_t*)(p.ws + WS_P), PTILE_ELEMS};
    pg8::gemm_phase<pg8::EpiP, pg8::StaticOrder, true, true>(F.lds, g, S, E);
}
__device__ __forceinline__ void phase_gemm2(Frame& F, int l) {
    KPtrs& p = F.P();
    const int M = MLAT;
    pg8::Gemm g{(const bf16_t*)(p.ws + WS_HY), (const bf16_t*)(p.ws + WS_WOUT) + (size_t)l * DM * DM, M, DM, DM};
    pg8::StaticOrder S; S.init(M, DM, F.G, (int)blockIdx.x);
    bf16_t* const XB = (bf16_t*)((char*)p.out + (64u << 20));
    bf16_t* const XCB = (bf16_t*)(p.ws + WS_XC);
    pg8::EpiResid E{l == 0 ? (const void*)p.x : (const void*)XB, l == DEPTH - 1 ? (bf16_t*)(p.ws + WS_P) : XB, l == 0 ? (const void*)p.ctx : (const void*)XCB, XCB,
                    (const float*)(p.ws + WS_MOD) + (size_t)l * 17 * 3072, l & 1, MLAT, SEQ, DM, l == 0 ? 1 : 0, 0};
    pg8::gemm_phase<pg8::EpiResid, pg8::StaticOrder, true, true>(F.lds, g, S, E);
}


typedef short s16x4 __attribute__((ext_vector_type(4)));
__device__ __forceinline__ const bf16_t* ptile_d(KPtrs& p, int t) { return (const bf16_t*)(p.ws + WS_P) + (size_t)t * PTILE_ELEMS; }
constexpr size_t WS_WSB = 9 * MiB;

__device__ __forceinline__ void mix_unit_B(Frame& F, int l, int row0) {
    KPtrs& p = F.P(); const int oct = F.tid & 31, tg = F.tid >> 5;
    int start, len; row_seq(row0, start, len);
    const bf16_t *CX = ptile_d(p, T_CX), *BGS = ptile_d(p, T_BGS);
    float w[3][8];
#pragma unroll
    for (int j = 0; j < 3; ++j) { const f32x4 a = *(const f32x4*)(p.short_conv_w + (size_t)(l * 3 + j) * BW + 8 * oct), b = *(const f32x4*)(p.short_conv_w + (size_t)(l * 3 + j) * BW + 8 * oct + 4);
        w[j][0] = a.x; w[j][1] = a.y; w[j][2] = a.z; w[j][3] = a.w; w[j][4] = b.x; w[j][5] = b.y; w[j][6] = b.z; w[j][7] = b.w; }
    const int r0 = row0 + tg * 8;
    float cx[10][8];
    { v4u ca[10];
#pragma unroll
      for (int i = 0; i < 10; ++i) { int r = r0 + i - 1; r = r < start ? start : (r >= start + len ? start + len - 1 : r); ca[i] = *(const GAS v4u*)(CX + (size_t)r * 256 + 8 * oct); }
#pragma unroll
      for (int i = 0; i < 10; ++i) unpack8(ca[i], cx[i]);
      const bool lo_ok = r0 - 1 >= start, hi_ok = r0 + 8 < start + len;
#pragma unroll
      for (int e = 0; e < 8; ++e) { cx[0][e] = lo_ok ? cx[0][e] : 0.f; cx[9][e] = hi_ok ? cx[9][e] : 0.f; } }
#pragma unroll
    for (int i = 0; i < 8; ++i) { const int r = r0 + i;
        const v4u bgw = *(const GAS v4u*)(BGS + (size_t)r * 256 + 8 * oct); float bg[8], y[8]; unpack8(bgw, bg);
#pragma unroll
        for (int e = 0; e < 8; ++e) y[e] = bg[e] * (w[0][e] * cx[i][e] + w[1][e] * cx[i + 1][e] + w[2][e] * cx[i + 2][e]);
        v4u o; o.x = pk2(y[0], y[1]); o.y = pk2(y[2], y[3]); o.z = pk2(y[4], y[5]); o.w = pk2(y[6], y[7]);
        *(GAS v4u*)((bf16_t*)(p.ws + WS_HY) + (size_t)r * DM + 256 + 8 * oct) = o; }
}

constexpr int MIX_ND = MTOT / 128, MIX_NC = MTOT / 64, MIX_NB = MTOT / 128, MIX_NU = MIX_ND + MIX_NC + MIX_NB, CW_MIXQ = 8192, NPF = 12;
__device__ __forceinline__ void mix_prefetch(Frame& F, int l, int u, v4u (&pf)[NPF]) {
    KPtrs& p = F.P(); const int tid = F.tid, lane = F.lane, wave = F.wave;
    if (u < MIX_ND) {
        const bf16_t* VV = ptile_d(p, T_VV) + (size_t)(u * 128 + wave * 16) * 256 + 4 * lane;
#pragma unroll
        for (int k = 0; k < 8; ++k) { const u32x2 a = *(const GAS u32x2*)(VV + (size_t)(2 * k) * 256), b = *(const GAS u32x2*)(VV + (size_t)(2 * k + 1) * 256); pf[k] = (v4u){a.x, a.y, b.x, b.y}; }
        pf[10] = *(const GAS v4u*)(p.smlp_ln_g + l * BW + 4 * lane); pf[11] = *(const GAS v4u*)(p.smlp_ln_b + l * BW + 4 * lane);
        asm volatile("; PF_D" ::: "memory");
    } else if (u < MIX_ND + MIX_NC) {
        const int row0 = (u - MIX_ND) * 64; int start, len; row_seq(row0, start, len);
        const bf16_t* GL = ptile_d(p, T_GLU);
#pragma unroll
        for (int k = 0; k < 6; ++k) { const int idx = tid + k * NWAVES * 64, i = idx >> 5, oct = idx & 31; int r = row0 - 15 + i; r = r < start ? start : (r >= start + len ? start + len - 1 : r);
            pf[k] = *(const GAS v4u*)(GL + (size_t)r * 256 + 8 * oct); }
        asm volatile("; PF_C" ::: "memory");
    }
}
__device__ __forceinline__ f32x4 asf4(const v4u& w) { return __builtin_bit_cast(f32x4, w); }

__device__ __forceinline__ void mix_unit_C(Frame& F, int l, int row0, v4u (&pf)[NPF], int nxt) {
    KPtrs& p = F.P(); const int tid = F.tid, lane = F.lane, wave = F.wave;
    int start, len; row_seq(row0, start, len);
    LAS float* glu = (LAS float*)F.lds;
#pragma unroll
    for (int k = 0; k < 6; ++k) { const int idx = tid + k * NWAVES * 64, i = idx >> 5, oct = idx & 31, r = row0 - 15 + i;
        if (i < 94) { const bool ok = r >= start && r < start + len; float fa[8]; unpack8(pf[k], fa);
            const f32x4 o0 = {ok ? fa[0] : 0.f, ok ? fa[1] : 0.f, ok ? fa[2] : 0.f, ok ? fa[3] : 0.f}, o1 = {ok ? fa[4] : 0.f, ok ? fa[5] : 0.f, ok ? fa[6] : 0.f, ok ? fa[7] : 0.f};
            *(LAS f32x4*)(glu + i * 256 + 8 * oct) = o0; *(LAS f32x4*)(glu + i * 256 + 8 * oct + 4) = o1; } }
    float wt[32]; u32x2 gate[8];
#pragma unroll
    for (int j = 0; j < 32; ++j) wt[j] = j < 31 ? p.conf_conv_w[(size_t)(l * 31 + j) * BW + (tid & 255)] : p.conf_conv_b[l * BW + (tid & 255)];
    { const bf16_t* GC = ptile_d(p, T_GC);
#pragma unroll
      for (int i = 0; i < 8; ++i) gate[i] = *(const GAS u32x2*)(GC + (size_t)(row0 + wave * 8 + i) * 256 + 4 * lane); }
    const f32x4 lg = *(const f32x4*)(p.conf_ln_g + l * BW + 4 * lane), lb = *(const f32x4*)(p.conf_ln_b + l * BW + 4 * lane);
    mix_prefetch(F, l, nxt, pf);
    LBAR();
    const int c = tid & 255, th = tid >> 8;
    float z[32];
#pragma unroll
    for (int hb = 0; hb < 2; ++hb) {
        float win[46];
#pragma unroll
        for (int i = 0; i < 46; ++i) win[i] = glu[(th * 32 + hb * 16 + i) * 256 + c];
#pragma unroll
        for (int i = 0; i < 16; ++i) z[hb * 16 + i] = wt[31];
#pragma unroll
        for (int j = 0; j < 31; ++j)
#pragma unroll
            for (int i = 0; i < 16; ++i) z[hb * 16 + i] += wt[j] * win[i + j];
    }
    LBAR();
#pragma unroll
    for (int i = 0; i < 32; ++i) glu[(th * 32 + i) * 256 + c] = z[i];
    LBAR();
#pragma unroll
    for (int i = 0; i < 8; ++i) { const int t = wave * 8 + i, r = row0 + t;
        const f32x4 zz = *(const LAS f32x4*)(glu + t * 256 + 4 * lane);
        const float mean = wave_sum((zz.x + zz.y) + (zz.z + zz.w)) * (1.f / 256.f);
        const f32x4 d = zz - mean;
        const float var = wave_sum((d.x * d.x + d.y * d.y) + (d.z * d.z + d.w * d.w)) * (1.f / 256.f);
        const float rstd = 1.0f / sqrtf(var + EPS);
        const f32x4 ln = d * rstd * lg + lb;
        const u32x2 gw = gate[i];
        u32x2 o; o.x = pk2(fsilu(ln.x) * bflo(gw.x), fsilu(ln.y) * bfhi(gw.x)); o.y = pk2(fsilu(ln.z) * bflo(gw.y), fsilu(ln.w) * bfhi(gw.y));
        *(GAS u32x2*)((bf16_t*)(p.ws + WS_HY) + (size_t)r * DM + 512 + 4 * lane) = o; }
    LBAR();
}

__device__ __forceinline__ void mix_unit_D(Frame& F, int l, int row0, v4u (&pf)[NPF], int nxt) {
    KPtrs& p = F.P(); const int lane = F.lane, wave = F.wave;
    constexpr int VS = 528;
    LAS unsigned char* vl = F.lds;
    const bf16_t* UG = ptile_d(p, T_UG);
    const int g = wave >> 1, ph = wave & 1, li = lane & 15, lg4 = lane >> 4;
    bf16x8 wf[4][4];
    { const bf16_t* W = (const bf16_t*)(p.ws + WS_WSB) + (size_t)(l * 4 + g) * 128 * 128;
#pragma unroll
      for (int ks = 0; ks < 4; ++ks)
#pragma unroll
          for (int pt = 0; pt < 4; ++pt) wf[ks][pt] = *(const GAS bf16x8*)(W + (size_t)(64 * ph + 16 * pt + li) * 128 + 32 * ks + 8 * lg4); }
    { const f32x4 lg = asf4(pf[10]), lb = asf4(pf[11]);
#pragma unroll
      for (int i = 0; i < 16; ++i) { const int q = wave * 16 + i; const u32x2 raw = (i & 1) ? (u32x2){pf[i >> 1].z, pf[i >> 1].w} : (u32x2){pf[i >> 1].x, pf[i >> 1].y};
        const f32x4 v = {bflo(raw.x), bfhi(raw.x), bflo(raw.y), bfhi(raw.y)};
        const float mean = wave_sum((v.x + v.y) + (v.z + v.w)) * (1.f / 256.f);
        const f32x4 d = v - mean;
        const float var = wave_sum((d.x * d.x + d.y * d.y) + (d.z * d.z + d.w * d.w)) * (1.f / 256.f);
        const float rstd = 1.0f / sqrtf(var + EPS);
        const f32x4 y = d * rstd * lg + lb;
        u32x2 o; o.x = pk2(y.x, y.y); o.y = pk2(y.z, y.w);
        *(LAS u32x2*)(vl + q * VS + 8 * lane) = o; } }
    LBAR();
    f32x4 acc[4][4];
#pragma unroll
    for (int a = 0; a < 4; ++a)
#pragma unroll
        for (int b = 0; b < 4; ++b) acc[a][b] = (f32x4){0.f, 0.f, 0.f, 0.f};
#pragma unroll
    for (int ks = 0; ks < 4; ++ks) {
        bf16x8 af[4];
#pragma unroll
        for (int ct = 0; ct < 4; ++ct) { LAS unsigned char* a = vl + (32 * ks + 8 * lg4 + (li >> 2)) * VS + (64 * g + 16 * ct + 4 * (li & 3)) * 2;
            const s16x4 lo = __builtin_amdgcn_ds_read_tr16_b64_v4i16((LAS s16x4*)a), hi = __builtin_amdgcn_ds_read_tr16_b64_v4i16((LAS s16x4*)(a + 4 * VS));
            af[ct] = (bf16x8){lo[0], lo[1], lo[2], lo[3], hi[0], hi[1], hi[2], hi[3]}; }
#pragma unroll
        for (int ct = 0; ct < 4; ++ct)
#pragma unroll
            for (int pt = 0; pt < 4; ++pt) acc[ct][pt] = __builtin_amdgcn_mfma_f32_16x16x32_bf16(af[ct], wf[ks][pt], acc[ct][pt], 0, 0, 0);
    }
    u32x2 uw[4][4]; float bs[4];
#pragma unroll
    for (int pt = 0; pt < 4; ++pt) { const int prow = 64 * ph + 16 * pt + li; const size_t r = (size_t)row0 + prow; bs[pt] = p.smlp_b[(l * 4 + g) * 128 + prow];
#pragma unroll
        for (int ct = 0; ct < 4; ++ct) { const int c = 64 * g + 16 * ct + 4 * lg4; uw[pt][ct] = *(const GAS u32x2*)(UG + r * 256 + c); } }
    mix_prefetch(F, l, nxt, pf);
#pragma unroll
    for (int pt = 0; pt < 4; ++pt) { const int prow = 64 * ph + 16 * pt + li; const size_t r = (size_t)row0 + prow;
#pragma unroll
        for (int ct = 0; ct < 4; ++ct) { const int c = 64 * g + 16 * ct + 4 * lg4;
            const f32x4 m = acc[ct][pt] + bs[pt]; const u32x2 u2 = uw[pt][ct];
            u32x2 o; o.x = pk2(bflo(u2.x) * m.x, bfhi(u2.x) * m.y); o.y = pk2(bflo(u2.y) * m.z, bfhi(u2.y) * m.w);
            *(GAS u32x2*)((bf16_t*)(p.ws + WS_HY) + r * DM + 768 + c) = o; } }
    LBAR();
}

__device__ __forceinline__ void phase_mix(Frame& F, int l) {
    gu32* ctr = F.ctl + CW_MIXQ + 64 * l;
    volatile LAS unsigned* Q = F.MISC;
    unsigned fetched = 0;
    if (F.tid == 0) { Q[0] = __hip_atomic_fetch_add(ctr, 1u, __ATOMIC_RELAXED, __HIP_MEMORY_SCOPE_AGENT); Q[1] = __hip_atomic_fetch_add(ctr, 1u, __ATOMIC_RELAXED, __HIP_MEMORY_SCOPE_AGENT); }
    LBAR();
    int cur = (int)Q[0], nxt = (int)Q[1];
    v4u pf[NPF];
    F.refresh();
    if (cur < MIX_NU) mix_prefetch(F, l, cur, pf);
#define MIX_ROUND(CALL) do { LBAR();   \
        if (F.tid == 0) fetched = __hip_atomic_fetch_add(ctr, 1u, __ATOMIC_RELAXED, __HIP_MEMORY_SCOPE_AGENT);   \
        F.refresh(); CALL; if (F.tid == 0) Q[0] = fetched; LBAR(); cur = nxt; nxt = (int)Q[0]; } while (0)
    while (cur < MIX_ND) MIX_ROUND(mix_unit_D(F, l, cur * 128, pf, nxt));
    while (cur < MIX_ND + MIX_NC) MIX_ROUND(mix_unit_C(F, l, (cur - MIX_ND) * 64, pf, nxt));
    while (cur < MIX_NU) MIX_ROUND(mix_unit_B(F, l, (cur - MIX_ND - MIX_NC) * 128));
#undef MIX_ROUND
}

constexpr size_t WS_REC = 212 * MiB, WS_OB16 = 476 * MiB;
constexpr int REC_BYTES = 53248, R_NW = 0, R_Q = 8192, R_U = 16384, R_VEC = 32768, R_ATTN = 33792, R_KT = 41984;
constexpr int NITEM = 2304;
constexpr int L_Q = 0, L_K = 4352, L_V = 8704, L_GKK = 13056, L_GQK = 17408, L_QB = 21760, L_KB = 24064, L_AO = 21760, L_AD = 26368, L_DF = 28928, L_SM = 30208, L_XS = 0, GS = 68, SMD = 256;

__device__ __forceinline__ float dpp_xor1(float v) { return __int_as_float(__builtin_amdgcn_mov_dpp(__float_as_int(v), 0xB1, 0xF, 0xF, true)); }

__device__ __forceinline__ void prep_decode(int item, int& b, int& h, int& row0) {
    if (item < 2048) { b = item >> 7; h = (item >> 5) & 3; const int n = item & 31; row0 = b * SEQ + 64 * n; }
    else { const int it = item - 2048; b = it >> 4; h = (it >> 2) & 3; const int n = it & 3; row0 = MLAT + b * CTXL + 64 * n; }
}
__device__ __forceinline__ void prep_load(Frame& F, int l, int item, v4u (&raw)[6], float (&abn)[4], v4u (&wq)[6]) {
    KPtrs& p = F.P(); int b, h, row0; prep_decode(item, b, h, row0); int start, len; row_seq(row0, start, len);
    const int tq = F.tid < 384 ? F.tid : 383, tg = tq / 24, o = tq % 24, part = o >> 3, oo = o & 7;
    const bf16_t* T = ptile_d(p, part) + h * 64 + 8 * oo;
#pragma unroll
    for (int i = 0; i < 6; ++i) { int r = row0 + 4 * tg - 1 + i; r = r < start ? start : (r >= start + len ? start + len - 1 : r); raw[i] = *(const GAS v4u*)(T + (size_t)r * 256); }
    if ((F.wave & 3) == 0) { const int dir = F.wave >> 2, tok = dir ? 63 - F.lane : F.lane; const float* AB = (const float*)(p.ws + WS_AB) + ((size_t)row0 + tok) * 16;
        abn[0] = AB[dir * 4 + h]; abn[1] = AB[8 + dir * 4 + h]; abn[2] = p.a_log[(l * 2 + dir) * 4 + h]; abn[3] = p.dt_bias[(l * 2 + dir) * 4 + h]; }
    { const float* wc = p.qkv_conv_w + (size_t)l * 3 * 768 + part * 256 + h * 64 + 8 * oo;
#pragma unroll
      for (int j = 0; j < 3; ++j) { wq[2 * j] = *(const GAS v4u*)(wc + j * 768); wq[2 * j + 1] = *(const GAS v4u*)(wc + j * 768 + 4); } }
}
__device__ __forceinline__ void prep_item(Frame& F, int l, int item, v4u (&raw)[6], float (&abn)[4], v4u (&wq)[6], int next_item) {
    KPtrs& p = F.P(); const int tid = F.tid, lane = F.lane, wave = F.wave;
    int b, h, row0; prep_decode(item, b, h, row0);
    int start, len; row_seq(row0, start, len);
    LAS float* lf = (LAS float*)F.lds;
    if (tid < 384) { const int tg = tid / 24, o = tid % 24, part = o >> 3, oo = o & 7;
        float w[3][8], x[6][8];
#pragma unroll
        for (int j = 0; j < 3; ++j) { const f32x4 w0 = __builtin_bit_cast(f32x4, wq[2 * j]), w1 = __builtin_bit_cast(f32x4, wq[2 * j + 1]);
            w[j][0] = w0.x; w[j][1] = w0.y; w[j][2] = w0.z; w[j][3] = w0.w; w[j][4] = w1.x; w[j][5] = w1.y; w[j][6] = w1.z; w[j][7] = w1.w; }
#pragma unroll
        for (int i = 0; i < 6; ++i) unpack8(raw[i], x[i]);
        const bool lo_ok = row0 + 4 * tg - 1 >= start, hi_ok = row0 + 4 * tg + 4 < start + len;
#pragma unroll
        for (int e = 0; e < 8; ++e) { x[0][e] = lo_ok ? x[0][e] : 0.f; x[5][e] = hi_ok ? x[5][e] : 0.f; }
#pragma unroll
        for (int t = 0; t < 4; ++t) { float a[8];
#pragma unroll
            for (int e = 0; e < 8; ++e) a[e] = fsilu(w[0][e] * x[t][e] + w[1][e] * x[t + 1][e] + w[2][e] * x[t + 2][e]);
            LAS float* dst = lf + part * 4352 + (4 * tg + t) * 68 + 8 * oo;
            *(LAS f32x4*)dst = (f32x4){a[0], a[1], a[2], a[3]}; *(LAS f32x4*)(dst + 4) = (f32x4){a[4], a[5], a[6], a[7]}; } }
    if ((wave & 3) == 0) { const int dir = wave >> 2, i = lane;
        const float sx = abn[0] + abn[3];
        const float sp = sx > 15.f ? sx : __builtin_amdgcn_logf(1.f + fexp(sx)) * 0.69314718056f;
        const float g = -fexp(abn[2]) * sp;
        const float beta = fsigmoid(abn[1]);
        float gc = g;
        gc += dpp_f<0x111>(gc); gc += dpp_f<0x112>(gc); gc += dpp_f<0x114>(gc); gc += dpp_f<0x118>(gc);
        gc += __int_as_float(__builtin_amdgcn_update_dpp(0, __float_as_int(gc), 0x142, 0xA, 0xF, false));
        gc += __int_as_float(__builtin_amdgcn_update_dpp(0, __float_as_int(gc), 0x143, 0xC, 0xF, false));
        LAS float* sm = lf + L_SM + dir * SMD; const float eg = fexp(gc); sm[i] = gc; sm[64 + i] = beta; sm[128 + i] = eg; sm[192 + i] = beta * eg; }
    prep_load(F, l, next_item, raw, abn, wq);
    LBAR();
    { const int row = tid >> 2, part = row >> 6, t = row & 63, qt = tid & 3; LAS float* src = lf + part * 4352 + t * 68 + 16 * qt;
      f32x4 v[4]; float ss = 0.f;
#pragma unroll
      for (int i = 0; i < 4; ++i) { v[i] = *(LAS f32x4*)(src + 4 * i); ss += (v[i].x * v[i].x + v[i].y * v[i].y) + (v[i].z * v[i].z + v[i].w * v[i].w); }
      ss += __shfl_xor(ss, 1); ss += __shfl_xor(ss, 2);
      const float sc = (1.0f / sqrtf(ss + EPS)) * (part == 0 ? 0.125f : 1.0f);
#pragma unroll
      for (int i = 0; i < 4; ++i) { v[i] = v[i] * sc; *(LAS f32x4*)(src + 4 * i) = v[i]; }
      LAS unsigned char* bdst = (LAS unsigned char*)(lf + (part ? L_KB : L_QB)) + t * 144 + 32 * qt;
      v4u o; o.x = pk2(v[0].x, v[0].y); o.y = pk2(v[0].z, v[0].w); o.z = pk2(v[1].x, v[1].y); o.w = pk2(v[1].z, v[1].w); *(LAS v4u*)bdst = o;
      o.x = pk2(v[2].x, v[2].y); o.y = pk2(v[2].z, v[2].w); o.z = pk2(v[3].x, v[3].y); o.w = pk2(v[3].z, v[3].w); *(LAS v4u*)(bdst + 16) = o; }
    LBAR();
    { const int mat = wave >> 2, it = wave & 3, li = lane & 15, g4 = lane >> 4;
      const LAS unsigned char* Ab = (const LAS unsigned char*)(lf + (mat ? L_QB : L_KB)); const LAS unsigned char* Kb = (const LAS unsigned char*)(lf + L_KB);
      bf16x8 af[2];
#pragma unroll
      for (int s2 = 0; s2 < 2; ++s2) af[s2] = *(const LAS bf16x8*)(Ab + (16 * it + li) * 144 + (32 * s2 + 8 * g4) * 2);
      LAS float* G = lf + (mat ? L_GQK : L_GKK);
#pragma unroll
      for (int jt = 0; jt < 4; ++jt) { f32x4 acc = {0.f, 0.f, 0.f, 0.f};
#pragma unroll
          for (int s2 = 0; s2 < 2; ++s2) { const bf16x8 bq = *(const LAS bf16x8*)(Kb + (16 * jt + li) * 144 + (32 * s2 + 8 * g4) * 2); acc = __builtin_amdgcn_mfma_f32_16x16x32_bf16(af[s2], bq, acc, 0, 0, 0); }
#pragma unroll
          for (int r = 0; r < 4; ++r) G[(16 * it + 4 * g4 + r) * GS + 16 * jt + li] = acc[r]; } }
    LBAR();
    const int dir = tid >> 8, td = tid & 255;
    const LAS float* sm = lf + L_SM + dir * SMD;
    unsigned char* rec = p.ws + WS_REC + (size_t)(item * 2 + dir) * REC_BYTES;
    { const int i = td >> 2, jq = td & 3, ti = dir ? 63 - i : i; const float gi = sm[i], bi = sm[64 + i];
      const LAS float* grow = lf + L_GKK + ti * GS + (dir ? 48 - 16 * jq : 16 * jq);
      float gv[16], gc[16];
#pragma unroll
      for (int k = 0; k < 4; ++k) { const f32x4 a = *(const LAS f32x4*)(grow + 4 * k), c = *(const LAS f32x4*)(sm + 16 * jq + 4 * k);
          gv[4 * k] = a.x; gv[4 * k + 1] = a.y; gv[4 * k + 2] = a.z; gv[4 * k + 3] = a.w; gc[4 * k] = c.x; gc[4 * k + 1] = c.y; gc[4 * k + 2] = c.z; gc[4 * k + 3] = c.w; }
      float val[16];
#pragma unroll
      for (int jj = 0; jj < 16; ++jj) { const int j = 16 * jq + jj; const float G = dir ? gv[15 - jj] : gv[jj];
          const float v = bi * G * fexp(fminf(gi - gc[jj], 0.f)); val[jj] = (i > j) ? v : 0.f; }
      { const bool below = jq < (i >> 4);
        v4u o0, o1; o0.x = below ? pk2(-val[0], -val[1]) : 0u; o0.y = below ? pk2(-val[2], -val[3]) : 0u; o0.z = below ? pk2(-val[4], -val[5]) : 0u; o0.w = below ? pk2(-val[6], -val[7]) : 0u;
        o1.x = below ? pk2(-val[8], -val[9]) : 0u; o1.y = below ? pk2(-val[10], -val[11]) : 0u; o1.z = below ? pk2(-val[12], -val[13]) : 0u; o1.w = below ? pk2(-val[14], -val[15]) : 0u;
        LAS unsigned char* ao = (LAS unsigned char*)(lf + L_AO) + dir * 9216 + i * 144 + 32 * jq; *(LAS v4u*)ao = o0; *(LAS v4u*)(ao + 16) = o1; }
      if (jq == (i >> 4)) { LAS float* ad = lf + L_AD + dir * 1280 + (i >> 4) * 320 + (i & 15) * 20;
#pragma unroll
          for (int k = 0; k < 4; ++k) *(LAS f32x4*)(ad + 4 * k) = (f32x4){val[4 * k], val[4 * k + 1], val[4 * k + 2], val[4 * k + 3]}; } }
#pragma unroll
    for (int k = 0; k < 2; ++k) { const int f = td + 256 * k, ms = f >> 6, ll = f & 63, m = ms >> 1, s = ms & 1, rr = 16 * m + (ll & 15), cb = 32 * s + 4 * (ll >> 4);
        float va[8], vq[8], vk[8];
        const int ti = dir ? 63 - rr : rr; const float gi = sm[rr];
#pragma unroll
        for (int hh = 0; hh < 2; ++hh) { const int c0 = cb + 16 * hh;
            const f32x4 g4 = *(const LAS f32x4*)(lf + L_GQK + ti * GS + (dir ? 60 - c0 : c0)), s4 = *(const LAS f32x4*)(sm + c0), q4 = *(const LAS f32x4*)(lf + L_Q + ti * 68 + c0);
            const float gq[4] = {dir ? g4.w : g4.x, dir ? g4.z : g4.y, dir ? g4.y : g4.z, dir ? g4.x : g4.w}, sc[4] = {s4.x, s4.y, s4.z, s4.w}, qq[4] = {q4.x, q4.y, q4.z, q4.w};
#pragma unroll
            for (int e = 0; e < 4; ++e) { const int c = c0 + e, tc = dir ? 63 - c : c;
                const float v = gq[e] * fexp(fminf(gi - sc[e], 0.f)); va[4 * hh + e] = (rr >= c) ? v : 0.f;
                vq[4 * hh + e] = qq[e];
                vk[4 * hh + e] = lf[L_K + tc * 68 + rr]; } }
        v4u o; o.x = pk2(va[0], va[1]); o.y = pk2(va[2], va[3]); o.z = pk2(va[4], va[5]); o.w = pk2(va[6], va[7]); *(GAS v4u*)(rec + R_ATTN + f * 16) = o;
        o.x = pk2(vq[0], vq[1]); o.y = pk2(vq[2], vq[3]); o.z = pk2(vq[4], vq[5]); o.w = pk2(vq[6], vq[7]); *(GAS v4u*)(rec + R_Q + f * 16) = o;
        o.x = pk2(vk[0], vk[1]); o.y = pk2(vk[2], vk[3]); o.z = pk2(vk[4], vk[5]); o.w = pk2(vk[6], vk[7]); *(GAS v4u*)(rec + R_KT + f * 16) = o; }
    if (td < 64) { float* vec = (float*)(rec + R_VEC); vec[td] = sm[128 + td]; vec[64 + td] = expf(sm[63] - sm[td]); if (td == 0) vec[128] = expf(sm[63]); }
    const int li = lane & 15, g4 = lane >> 4, nt0 = 2 * (wave & 3);
    f32x4 Rt[2][4];
#pragma unroll
    for (int t = 0; t < 2; ++t) { const int nt = nt0 + t; const LAS float* src = lf + (nt < 4 ? L_V + 16 * nt + li : L_K + 16 * (nt - 4) + li); const LAS float* scl = sm + (nt < 4 ? 64 : 192);
#pragma unroll
        for (int m = 0; m < 4; ++m) { const f32x4 sc = *(const LAS f32x4*)(scl + 16 * m + 4 * g4); const int i0 = 16 * m + 4 * g4;
            Rt[t][m] = (f32x4){src[(dir ? 63 - i0 : i0) * 68] * sc.x, src[(dir ? 62 - i0 : i0 + 1) * 68] * sc.y, src[(dir ? 61 - i0 : i0 + 2) * 68] * sc.z, src[(dir ? 60 - i0 : i0 + 3) * 68] * sc.w}; } }
    LBAR();
    if ((wave & 3) == 0) { const int blk = lane >> 4, c = lane & 15; const LAS float* Ad = lf + L_AD + dir * 1280 + blk * 320;
        float x[16];
#pragma unroll
        for (int r = 0; r < 16; ++r) x[r] = 0.f;
#pragma unroll
        for (int hb = 0; hb < 4; ++hb) {
            f32x4 arow[4][4];
#pragma unroll
            for (int rr = 0; rr < 4; ++rr)
#pragma unroll
                for (int q = 0; q < (4 * hb + rr + 3) / 4; ++q) arow[rr][q] = *(const LAS f32x4*)(Ad + (4 * hb + rr) * 20 + 4 * q);
#pragma unroll
            for (int rr = 0; rr < 4; ++rr) { const int r = 4 * hb + rr; float acc = (r == c) ? 1.f : 0.f;
#pragma unroll
                for (int q = 0; q < (r + 3) / 4; ++q) { const f32x4 a = arow[rr][q]; acc -= (a.x * x[4 * q] + a.y * x[4 * q + 1]) + (a.z * x[4 * q + 2] + a.w * x[4 * q + 3]); }
                x[r] = acc; } }
        LAS bf16_t* DF = (LAS bf16_t*)(lf + L_DF) + dir * 1280 + blk * 320;
#pragma unroll
        for (int r = 0; r < 16; ++r) DF[r * 20 + c] = f2bf(x[r]); }
    LBAR();
    { const LAS unsigned char* ao = (const LAS unsigned char*)(lf + L_AO) + dir * 9216; const LAS unsigned char* df = (const LAS unsigned char*)(lf + L_DF) + dir * 2560;
      const f32x4 zero4 = {0.f, 0.f, 0.f, 0.f};
      f32x4 X[2][4];
#pragma unroll
      for (int t = 0; t < 2; ++t)
#pragma unroll
          for (int m = 0; m < 4; ++m) X[t][m] = zero4;
#pragma unroll
      for (int m = 0; m < 4; ++m) {
          const u32x2 dw = *(const LAS u32x2*)(df + m * 640 + li * 40 + g4 * 8);
          const bf16x8 dfrag = __builtin_bit_cast(bf16x8, (v4u){dw.x, dw.y, 0u, 0u});
          f32x4 acc[2] = {Rt[0][m], Rt[1][m]};
#pragma unroll
          for (int s2 = 0; s2 < (m + 1) / 2; ++s2) { const u32x2 lo = *(const LAS u32x2*)(ao + (16 * m + li) * 144 + (32 * s2 + 4 * g4) * 2), hi = *(const LAS u32x2*)(ao + (16 * m + li) * 144 + (32 * s2 + 16 + 4 * g4) * 2);
              const bf16x8 afrag = __builtin_bit_cast(bf16x8, (v4u){lo.x, lo.y, hi.x, hi.y});
#pragma unroll
              for (int t = 0; t < 2; ++t) acc[t] = __builtin_amdgcn_mfma_f32_16x16x32_bf16(afrag, pack8(X[t][2 * s2], X[t][2 * s2 + 1]), acc[t], 0, 0, 0); }
#pragma unroll
          for (int t = 0; t < 2; ++t) X[t][m] = __builtin_amdgcn_mfma_f32_16x16x32_bf16(dfrag, pack8(acc[t], zero4), zero4, 0, 0, 0); }
      LAS float* XS = lf + L_XS + dir * 8448;
#pragma unroll
      for (int t = 0; t < 2; ++t)
#pragma unroll
          for (int m = 0; m < 4; ++m)
#pragma unroll
              for (int r = 0; r < 4; ++r) XS[(16 * m + 4 * g4 + r) * 132 + 16 * (nt0 + t) + li] = X[t][m][r]; }
    LBAR();
    { const LAS float* XS = lf + L_XS + dir * 8448;
#pragma unroll
      for (int k = 0; k < 2; ++k) { const int f = td + 256 * k, ms = f >> 6, ll = f & 63, m = ms >> 1, s = ms & 1, rr = 16 * m + (ll & 15), cb = 32 * s + 4 * (ll >> 4);
          float v[8];
#pragma unroll
          for (int e = 0; e < 8; ++e) v[e] = -XS[rr * 132 + 64 + cb + 16 * (e >> 2) + (e & 3)];
          v4u o; o.x = pk2(v[0], v[1]); o.y = pk2(v[2], v[3]); o.z = pk2(v[4], v[5]); o.w = pk2(v[6], v[7]); *(GAS v4u*)(rec + R_NW + f * 16) = o; }
#pragma unroll
      for (int k = 0; k < 4; ++k) { const int u = td + 256 * k, w = u >> 8, m = (u >> 6) & 3, ll = u & 63, r0 = 16 * m + 4 * (ll >> 4), c = 16 * w + (ll & 15);
          const f32x4 o = {XS[r0 * 132 + c], XS[(r0 + 1) * 132 + c], XS[(r0 + 2) * 132 + c], XS[(r0 + 3) * 132 + c]};
          *(GAS u32x2*)(rec + R_U + u * 8) = (u32x2){pk2(o.x, o.y), pk2(o.z, o.w)}; } }
    LBAR();
}
__device__ __forceinline__ void phase_prep(Frame& F, int l) {
    v4u raw[6], wq[6]; float abn[4] = {0.f, 0.f, 0.f, 0.f};
    F.refresh();
    if (F.vcu < NITEM) prep_load(F, l, F.vcu, raw, abn, wq);
    for (int it = F.vcu; it < NITEM; it += F.G) { F.refresh(); prep_item(F, l, it, raw, abn, wq, it + F.G < NITEM ? it + F.G : it); }
}

__device__ __forceinline__ void scan_rec(int b, int h, int dir, int step, int& cid, int& row0) {
    if (step < 4) { const int n = dir ? 3 - step : step; cid = 2048 + (b * 4 + h) * 4 + n; row0 = MLAT + b * CTXL + 64 * n; }
    else { const int n = dir ? 35 - step : step - 4; cid = (b * 4 + h) * 32 + n; row0 = b * SEQ + 64 * n; }
}
__device__ __forceinline__ void phase_scan(Frame& F, int l) {
    KPtrs& p = F.P();
    const int bx = (int)blockIdx.x, xq = bx >> 3, half = xq & 1, s = (bx & 7) * 16 + (xq >> 1), b = s >> 3, h = (s >> 1) & 3, dir = s & 1, lane = F.lane;
    constexpr int NSTEP = 36, PIECES = 7;
    if (F.wave >= 2) {
        const int lw = F.wave - 2;
#define SCAN_ISSUE(t_) do { int cid_, row0_; scan_rec(b, h, dir, (t_), cid_, row0_); const unsigned char* rec_ = p.ws + WS_REC + (size_t)(cid_ * 2 + dir) * REC_BYTES + lane * 16; \
            LAS unsigned char* slot_ = F.lds + ((t_) % 3) * REC_BYTES; \
            _Pragma("unroll") for (int k_ = 0; k_ < PIECES; ++k_) { const int j_ = lw + 6 * k_; if (j_ < 37) { \
                const int pc_ = j_ < 16 ? j_ : j_ < 20 ? 4 * half + j_ : j_ == 20 ? 32 : j_ + 12; \
                __builtin_amdgcn_global_load_lds((const GAS unsigned*)(rec_ + pc_ * 1024), (LAS unsigned*)(slot_ + pc_ * 1024), 16, 0, 0); } } } while (0)
        SCAN_ISSUE(0); SCAN_ISSUE(1);
        for (int t = 0; t < NSTEP; ++t) {
            if (t + 1 >= NSTEP) asm volatile("s_waitcnt vmcnt(0)" ::: "memory"); else if (lw == 0) asm volatile("s_waitcnt vmcnt(7)" ::: "memory"); else asm volatile("s_waitcnt vmcnt(6)" ::: "memory");
            asm volatile("" ::: "memory"); __builtin_amdgcn_s_barrier(); asm volatile("" ::: "memory");
            if (t + 2 < NSTEP) SCAN_ISSUE(t + 2);
        }
#undef SCAN_ISSUE
        return;
    }
    const int w = 2 * half + F.wave, li = lane & 15, g4 = lane >> 4;
    f32x4 S[4];
#pragma unroll
    for (int m = 0; m < 4; ++m) S[m] = (f32x4){0.f, 0.f, 0.f, 0.f};
    bf16_t* O = (bf16_t*)(p.ws + WS_OB16) + (size_t)dir * MTOT * 256;
    for (int step = 0; step < NSTEP; ++step) {
        int cid, row0; scan_rec(b, h, dir, step, cid, row0);
        asm volatile("s_waitcnt lgkmcnt(0)" ::: "memory"); __builtin_amdgcn_s_barrier(); asm volatile("" ::: "memory");
        const LAS unsigned char* rec = F.lds + (step % 3) * REC_BYTES;
        bf16x8 nw[4][2], qf[4][2], at[4][2], kt[4][2]; f32x4 av[4], ao[4], a2[4], egc4[4], edl4[4];
#pragma unroll
        for (int m = 0; m < 4; ++m) {
#pragma unroll
            for (int s2 = 0; s2 < 2; ++s2) { nw[m][s2] = *(const LAS bf16x8*)(rec + R_NW + ((m * 2 + s2) * 64 + lane) * 16); qf[m][s2] = *(const LAS bf16x8*)(rec + R_Q + ((m * 2 + s2) * 64 + lane) * 16); }
            { const u32x2 uw = *(const LAS u32x2*)(rec + R_U + ((w * 4 + m) * 64 + lane) * 8); av[m] = (f32x4){bflo(uw.x), bfhi(uw.x), bflo(uw.y), bfhi(uw.y)}; } ao[m] = (f32x4){0.f, 0.f, 0.f, 0.f}; }
        const float gl = *(const LAS float*)(rec + R_VEC + 512);
        bf16x8 Bs[2] = {pack8(S[0], S[1]), pack8(S[2], S[3])};
#pragma unroll
        for (int m = 0; m < 4; ++m)
#pragma unroll
            for (int s2 = 0; s2 < 2; ++s2) { av[m] = __builtin_amdgcn_mfma_f32_16x16x32_bf16(nw[m][s2], Bs[s2], av[m], 0, 0, 0); ao[m] = __builtin_amdgcn_mfma_f32_16x16x32_bf16(qf[m][s2], Bs[s2], ao[m], 0, 0, 0); }
#pragma unroll
        for (int m = 0; m < 4; ++m) {
#pragma unroll
            for (int s2 = 0; s2 < 2; ++s2) { at[m][s2] = *(const LAS bf16x8*)(rec + R_ATTN + ((m * 2 + s2) * 64 + lane) * 16); kt[m][s2] = *(const LAS bf16x8*)(rec + R_KT + ((m * 2 + s2) * 64 + lane) * 16); }
            edl4[m] = *(const LAS f32x4*)(rec + R_VEC + 256 + (16 * m + 4 * g4) * 4); egc4[m] = *(const LAS f32x4*)(rec + R_VEC + (16 * m + 4 * g4) * 4); a2[m] = (f32x4){0.f, 0.f, 0.f, 0.f}; }
        bf16x8 Bv[2] = {pack8(av[0], av[1]), pack8(av[2], av[3])};
        bf16x8 Bvs[2] = {pack8(av[0] * edl4[0], av[1] * edl4[1]), pack8(av[2] * edl4[2], av[3] * edl4[3])};
#pragma unroll
        for (int m = 0; m < 4; ++m) S[m] = S[m] * gl;
#pragma unroll
        for (int m = 0; m < 4; ++m)
#pragma unroll
            for (int s2 = 0; s2 < 2; ++s2) { a2[m] = __builtin_amdgcn_mfma_f32_16x16x32_bf16(at[m][s2], Bv[s2], a2[m], 0, 0, 0); S[m] = __builtin_amdgcn_mfma_f32_16x16x32_bf16(kt[m][s2], Bvs[s2], S[m], 0, 0, 0); }
#pragma unroll
        for (int m = 0; m < 4; ++m) { const f32x4 o = egc4[m] * ao[m] + a2[m];
#pragma unroll
            for (int r = 0; r < 4; ++r) { const int i = 16 * m + 4 * g4 + r, tok = dir ? 63 - i : i;
                O[(size_t)(row0 + tok) * 256 + h * 64 + 16 * w + li] = f2bf(o[r]); } }
    }
}

__device__ __forceinline__ void phase_comb(Frame& F, int l) {
    KPtrs& p = F.P(); const int lane = F.lane;
    const int gw = F.vcu * NWAVES + F.wave, NGW = F.G * NWAVES;
    const bf16_t* OF = (const bf16_t*)(p.ws + WS_OB16); const bf16_t* OB = OF + (size_t)MTOT * 256; const bf16_t* GA = ptile_d(p, T_GA);
    const f32x4 ng = *(const f32x4*)(p.gdn_norm_g + l * 64 + 4 * (lane & 15));
    const int nrow = (l == DEPTH - 1) ? MLAT : MTOT;
    u32x2 an, cn, gn;
    if (gw < nrow) { an = *(const GAS u32x2*)(OF + (size_t)gw * 256 + 4 * lane); cn = *(const GAS u32x2*)(OB + (size_t)gw * 256 + 4 * lane); gn = *(const GAS u32x2*)(GA + (size_t)gw * 256 + 4 * lane); }
    for (int r = gw; r < nrow; r += NGW) {
        const u32x2 a = an, c = cn, gt = gn;
        if (r + NGW < nrow) { const size_t r2 = (size_t)(r + NGW); an = *(const GAS u32x2*)(OF + r2 * 256 + 4 * lane); cn = *(const GAS u32x2*)(OB + r2 * 256 + 4 * lane); gn = *(const GAS u32x2*)(GA + r2 * 256 + 4 * lane); }
        const f32x4 o = {bflo(a.x) + bflo(c.x), bfhi(a.x) + bfhi(c.x), bflo(a.y) + bflo(c.y), bfhi(a.y) + bfhi(c.y)};
        float ss = (o.x * o.x + o.y * o.y) + (o.z * o.z + o.w * o.w);
        ss = row16_sum(ss);
        const float rs = 1.0f / sqrtf(ss * (1.f / 64.f) + EPS);
        u32x2 y; y.x = pk2(o.x * rs * ng.x * bflo(gt.x), o.y * rs * ng.y * bfhi(gt.x)); y.y = pk2(o.z * rs * ng.z * bflo(gt.y), o.w * rs * ng.w * bfhi(gt.y));
        *(GAS u32x2*)((bf16_t*)(p.ws + WS_HY) + (size_t)r * DM + 4 * lane) = y;
    }
}

constexpr int PH_FINAL = 1 + 7 * DEPTH, PH_END = PH_FINAL + 1;
struct Args { Ptrs p; int ph_lo, ph_hi; };
__global__ void __launch_bounds__(NWAVES * 64, 2) mega(Args args) {
    extern __shared__ __attribute__((aligned(16))) unsigned char lds[];
    Frame F;
    F.lds = (LAS unsigned char*)lds; F.MISC = (volatile LAS unsigned*)(F.lds + MISC_OFF);
    F.tid = threadIdx.x; F.lane = F.tid & 63; F.wave = __builtin_amdgcn_readfirstlane(F.tid >> 6);
    F.G = gridDim.x; { const int bx = blockIdx.x; F.vcu = (F.G % 8 == 0) ? (bx % 8) * (F.G / 8) + bx / 8 : bx; }
    F.ctl = (gu32*)(args.p.ws + WS_CTL);
    for (int u = F.tid; u < (LDS_BYTES - LDSCTL_OFF) / 4; u += NWAVES * 64) ((LAS unsigned*)(F.lds + LDSCTL_OFF))[u] = 0u;
    __syncthreads();
    const bool multi = args.ph_hi - args.ph_lo > 1;
    XcdBarrier bar; bar.bar = (unsigned*)(F.ctl + CW_BAR); bar.x = 0; bar.st = nullptr;
    if (multi) bar = xcd_barrier_post((unsigned*)(F.ctl + CW_BAR), F.MISC + 8);
    for (int ph = args.ph_lo; ph < args.ph_hi; ++ph) {
        F.refresh();
#if PROBE_S >= 0
        const bool amp = (PROBE_S == 7) ? (ph == 0) : (PROBE_S == 8) ? (ph == PH_FINAL) : (ph > 0 && ph < PH_FINAL && (ph - 1) % 7 == PROBE_S);
        const unsigned long long t0 = __builtin_amdgcn_s_memrealtime();
#endif
        if (ph == 0) phase_pre(F);
        else if (ph == PH_FINAL) phase_final(F);
        else { const int l = (ph - 1) / 7, s = (ph - 1) % 7;
            if (s == 0) phase_norm(F, l);
            else if (s == 1) phase_gemm1(F, l);
            else if (s == 2) phase_mix(F, l);
            else if (s == 3) phase_prep(F, l);
            else if (s == 4) phase_scan(F, l);
            else if (s == 5) phase_comb(F, l);
            else if (s == 6) phase_gemm2(F, l);
        }
        if (ph + 1 < args.ph_hi) xcd_barrier(bar);
#if PROBE_S >= 0
        if (amp) { const unsigned long long dt = __builtin_amdgcn_s_memrealtime() - t0; while (__builtin_amdgcn_s_memrealtime() - t0 < 2 * dt) __builtin_amdgcn_s_sleep(4); }
#endif
    }
}

extern "C" void kernel_launch(void* const* d_in, const int* in_sizes, int n_in, void* d_out, int out_size, void* d_ws, size_t ws_size, hipStream_t stream) {
    static int grid = 0;
    if (grid == 0) {
        if (n_in != 23 || out_size != MLAT * DM || ws_size < WS_END) { fprintf(stderr, "kernel_launch: unexpected shapes (n_in %d out %d ws %zu)\n", n_in, out_size, ws_size); grid = -1; return; }
        int dev = 0, cus = 0;
        if (hipGetDevice(&dev) != hipSuccess || hipDeviceGetAttribute(&cus, hipDeviceAttributeMultiprocessorCount, dev) != hipSuccess) { grid = -1; return; }
        if (hipFuncSetAttribute((const void*)mega, hipFuncAttributeMaxDynamicSharedMemorySize, LDS_BYTES) != hipSuccess) { fprintf(stderr, "kernel_launch: hipFuncSetAttribute failed\n"); grid = -1; return; }
        grid = cus;
        if (grid != 256) fprintf(stderr, "kernel_launch: %d CUs (built for 256)\n", grid);
    }
    if (grid < 0) return;
    hipMemsetAsync((char*)d_ws + WS_CTL, 0, CTL_ZERO_BYTES, stream);
    Args a{};
    const float** f = (const float**)&a.p;
    for (int i = 0; i < 23; ++i) f[i] = (const float*)d_in[i];
    a.p.out = (float*)d_out; a.p.ws = (unsigned char*)d_ws;
    a.ph_lo = 0; a.ph_hi = PH_END;
    hipLaunchKernelGGL(mega, dim3(grid), dim3(NWAVES * 64), LDS_BYTES, stream, a);
}
```

```cpp
#include <hip/hip_runtime.h>
#ifndef PROBE_S
#define PROBE_S (-1)
#endif
#include <cstdio>
#include <cstdint>

typedef unsigned short bf16_t;
__device__ __forceinline__ float bf2f(bf16_t v) { return __uint_as_float(((unsigned)v) << 16); }
typedef __bf16 nbf16x2 __attribute__((ext_vector_type(2)));
typedef __bf16 nbf16x8 __attribute__((ext_vector_type(8)));
typedef float nf32x2 __attribute__((ext_vector_type(2)));
typedef float nf32x8 __attribute__((ext_vector_type(8)));
__device__ __forceinline__ bf16_t f2bf(float f) { return __builtin_bit_cast(bf16_t, (__bf16)f); }

constexpr int DM = 1024, NB = 16, SEQ = 2048, DEPTH = 4, CTXL = 256, HD = 64, BW = 256, HA = 4;
constexpr int INC = 3600, NPC = 3584, NTILE = 10;
constexpr int MLAT = NB * SEQ, MCTX = NB * CTXL, MTOT = MLAT + MCTX;
constexpr float EPS = 1e-6f;
__device__ __constant__ int c_gt_col[14]   = {0, 256, 512, 2576,   784, 784 + 128,    1040, 1040 + 128,  1552, 1552 + 128,  2064, 2064 + 128,  2320, 3088};
__device__ __constant__ int c_gt_delta[14] = {0, 0,   0,   0,      2048, 2048,        256, 256,          256, 256,          1280, 1280,        0,    0};
enum { T_Q = 0, T_K = 1, T_V = 2, T_GA = 3, T_BGS = 4, T_CX = 5, T_GLU = 6, T_UG = 7, T_VV = 8, T_GC = 9 };

constexpr size_t MiB = 1u << 20;
constexpr size_t WS_CTL = 0, WS_MOD = 1 * MiB, WS_AB = 2 * MiB, WS_GB = 5 * MiB, WS_STAT = 8 * MiB, WS_XC = 16 * MiB, WS_WIN = 32 * MiB, WS_WOUT = 60 * MiB,
                 WS_HY = 68 * MiB, WS_P = 140 * MiB, WS_OFB = 392 * MiB, WS_END = 512 * MiB;
constexpr size_t PTILE_ELEMS = (size_t)MTOT * 256;
constexpr size_t WS_QKV = WS_P + 4 * PTILE_ELEMS * 2;

struct Ptrs {
    const float *x, *c, *ctx, *c_ctx, *norm_g, *w_ada, *b_ada, *w_in, *qkv_conv_w, *a_log, *dt_bias, *gdn_norm_g, *short_conv_w, *conf_conv_w, *conf_conv_b,
        *conf_ln_g, *conf_ln_b, *smlp_ln_g, *smlp_ln_b, *smlp_w, *smlp_b, *w_out, *final_g;
    float* out; unsigned char* ws;
};

__device__ __forceinline__ float silu_f(float x) { return x / (1.f + expf(-x)); }
__device__ __forceinline__ float sigmoid_f(float x) { return 1.f / (1.f + expf(-x)); }
__device__ __forceinline__ float softplus_f(float x) { return x > 20.f ? x : log1pf(expf(x)); }
__device__ __forceinline__ float fexp(float x) { return __builtin_amdgcn_exp2f(x * 1.44269504089f); }
__device__ __forceinline__ float fsigmoid(float x) { return __builtin_amdgcn_rcpf(1.f + fexp(-x)); }
__device__ __forceinline__ float fsilu(float x) { return x * fsigmoid(x); }

__device__ __forceinline__ float block_sum256(float v, float* red) {
#pragma unroll
    for (int o = 32; o > 0; o >>= 1) v += __shfl_xor(v, o);
    __syncthreads();
    if ((threadIdx.x & 63) == 0) red[threadIdx.x >> 6] = v;
    __syncthreads();
    return red[0] + red[1] + red[2] + red[3];
}
template <int CTRL> __device__ __forceinline__ float dpp_f(float v) { return __int_as_float(__builtin_amdgcn_mov_dpp(__float_as_int(v), CTRL, 0xF, 0xF, true)); }
__device__ __forceinline__ float row16_sum(float v) {
    v += dpp_f<0xB1>(v); v += dpp_f<0x4E>(v); v += dpp_f<0x141>(v); v += dpp_f<0x140>(v); return v; }
__device__ __forceinline__ float wave_sum(float v) {
    v = row16_sum(v);
    { auto r = __builtin_amdgcn_permlane16_swap(__float_as_uint(v), __float_as_uint(v), false, false); v = __uint_as_float(r[0]) + __uint_as_float(r[1]); }
    { auto r = __builtin_amdgcn_permlane32_swap(__float_as_uint(v), __float_as_uint(v), false, false); v = __uint_as_float(r[0]) + __uint_as_float(r[1]); }
    return v; }

__device__ __forceinline__ void row_seq(int row, int& start, int& len) { if (row < MLAT) { start = row & ~(SEQ - 1); len = SEQ; } else { start = row & ~(CTXL - 1); len = CTXL; } }

namespace pg8 {
#define PG8_LAS __attribute__((address_space(3)))
typedef unsigned short bf16_t;
typedef short bf16x8 __attribute__((ext_vector_type(8)));
typedef float f32x4 __attribute__((ext_vector_type(4)));
typedef unsigned u32x4 __attribute__((ext_vector_type(4)));
constexpr int BM = 256, BK = 64, HALF = 128, HTB = HALF * BK * 2  , STAGE_BYTES = 8 * HTB, NXCD = 8, WGM = 8;

__host__ __device__ __forceinline__ int lds_byte(int r, int c) { const int st = (r >> 4) * 2 + (c >> 5), rr = r & 15, cc = c & 31, ob = rr * 64 + cc * 2; return st * 1024 + (ob ^ (((ob >> 9) & 1) << 5)); }
__host__ __device__ __forceinline__ void stage_rc(int b, int& R, int& C) { const int st = b / 1024, sb = b % 1024, swz = sb ^ (((sb >> 9) & 1) << 5); R = (st >> 1) * 16 + swz / 64; C = (st & 1) * 32 + (swz % 64) / 2; }
__host__ __device__ __forceinline__ int perm32(int rho) { const int n = rho >> 4, i = rho & 15; return 8 * (i >> 2) + 4 * n + (i & 3); }

struct Unit { int pm, pn; };
struct Gemm { const bf16_t* A; const bf16_t* Bt; int M, N, K; };

struct StaticOrder {
    int nM, nN, nwg, G, c;
    __host__ __device__ void init(int M, int N, int G_, int c_) { nM = M / BM; nN = N / BM; nwg = nM * nN; G = G_; c = c_; }
    __host__ __device__ bool next(int i, Unit& u) const {
        const long L = (long)i * G + c; if (L >= nwg) return false;
        int wgid = (int)L; { const int q = nwg / NXCD, r = nwg % NXCD, xcd = wgid % NXCD, off = wgid / NXCD; wgid = (xcd < r ? xcd * (q + 1) : r * (q + 1) + (xcd - r) * q) + off; }
        const int nig = WGM * nN, gid = wgid / nig, fm = gid * WGM, gsz = (nM - fm) < WGM ? (nM - fm) : WGM;
        u.pm = fm + ((wgid % nig) % gsz); u.pn = (wgid % nig) / gsz; return true;
    }
    __device__ __forceinline__ void a_ready(const Unit&) const {}
    __device__ __forceinline__ void done(const Unit&) const {}
};


__device__ __forceinline__ unsigned cvt_pk_bf16(float lo, float hi) { return __builtin_bit_cast(unsigned, __builtin_convertvector((nf32x2){lo, hi}, nbf16x2)); }
struct EpiP {
    static constexpr bool PERM = true, AFTER_DRAIN = false;
    static constexpr int NVM = 16;
    bf16_t* P; size_t tile_elems;
    __device__ __forceinline__ void operator()(const f32x4 (&acc)[2][2][4][2], const Unit& u, int wr, int wc, int fr, int fq) const {
        const int row0 = u.pm * BM + wr * 64 + fr, g = u.pn;
        if (g < 4 || g > 11) {
            bf16_t* base = P + (size_t)(g < 4 ? g : g - 4) * tile_elems + wc * 32 + 8 * fq + (size_t)row0 * 256;
            if (g == 3 || g == 13) plain<true>(acc, base); else plain<false>(acc, base);
        } else {
            const int pr = (g - 4) >> 1;
            bf16_t* base = P + (size_t)(4 + pr) * tile_elems + 128 * (g & 1) + wc * 16 + 4 * fq + (size_t)row0 * 256;
            if (pr == 1) pairs<1>(acc, base); else if (pr == 2) pairs<2>(acc, base); else pairs<0>(acc, base);
        }
    }
    template <bool GATE> __device__ __forceinline__ void plain(const f32x4 (&acc)[2][2][4][2], bf16_t* base) const {
#pragma unroll
        for (int ai = 0; ai < 2; ++ai)
#pragma unroll
            for (int m = 0; m < 4; ++m) { bf16_t* rowp = base + (size_t)(ai * HALF + m * 16) * 256;
#pragma unroll
                for (int bj = 0; bj < 2; ++bj) { f32x4 v0 = acc[ai][bj][m][0], v1 = acc[ai][bj][m][1];
                    if (GATE) {
#pragma unroll
                        for (int e = 0; e < 4; ++e) { v0[e] = v0[e] * __builtin_amdgcn_rcpf(1.f + __builtin_amdgcn_exp2f(-1.44269504089f * v0[e])); v1[e] = v1[e] * __builtin_amdgcn_rcpf(1.f + __builtin_amdgcn_exp2f(-1.44269504089f * v1[e])); } }
                    u32x4 w; w.x = cvt_pk_bf16(v0[0], v0[1]); w.y = cvt_pk_bf16(v0[2], v0[3]); w.z = cvt_pk_bf16(v1[0], v1[1]); w.w = cvt_pk_bf16(v1[2], v1[3]);
                    *(u32x4*)(rowp + bj * HALF) = w; } }
    }
    template <int OP> __device__ __forceinline__ void pairs(const f32x4 (&acc)[2][2][4][2], bf16_t* base) const {
#pragma unroll
        for (int ai = 0; ai < 2; ++ai)
#pragma unroll
            for (int m = 0; m < 4; ++m) { bf16_t* rowp = base + (size_t)(ai * HALF + m * 16) * 256;
#pragma unroll
                for (int bj = 0; bj < 2; ++bj) { const f32x4 v0 = acc[ai][bj][m][0], v1 = acc[ai][bj][m][1];
                    const float a4[4] = {v0[0], v0[2], v1[0], v1[2]}, b4[4] = {v0[1], v0[3], v1[1], v1[3]}; float o[4];
#pragma unroll
                    for (int e = 0; e < 4; ++e) {
                        if (OP == 1) o[e] = a4[e] * b4[e];
                        else { const float sg = __builtin_amdgcn_rcpf(1.f + __builtin_amdgcn_exp2f(-1.44269504089f * b4[e])); o[e] = OP == 2 ? a4[e] * sg : a4[e] * (b4[e] * sg); } }
                    typedef unsigned u32x2v __attribute__((ext_vector_type(2)));
                    u32x2v w; w.x = cvt_pk_bf16(o[0], o[1]); w.y = cvt_pk_bf16(o[2], o[3]);
                    *(u32x2v*)(rowp + bj * 64) = w; } }
    }
};
struct OneUnit {
    Unit u0;
    __device__ __forceinline__ bool next(int i, Unit& u) const { if (i != 0) return false; u = u0; return true; }
    __device__ __forceinline__ void a_ready(const Unit&) const {}
    __device__ __forceinline__ void done(const Unit&) const {}
};
struct EpiResid {
    static constexpr bool PERM = true, AFTER_DRAIN = false;
    static constexpr int NVM = 32;
    const void* x_old; bf16_t* x_new; const void* xc_old; bf16_t* xc_new; const float* mod_l; int odd, mlat, seq, dm, f32in, row_off;
    __device__ __forceinline__ void operator()(f32x4 (&acc)[2][2][4][2], const Unit& u, int wr, int wc, int fr, int fq) const {
        const int rbase = row_off + u.pm * BM; const bool lat = rbase < mlat; const int b = lat ? rbase / seq : 16;
        const int col = u.pn * BM + wc * 32 + 8 * fq;
        { const float* gate = mod_l + (size_t)b * 3072 + 2048 + col;
#pragma unroll
          for (int bj = 0; bj < 2; ++bj)
#pragma unroll
            for (int n = 0; n < 2; ++n) { const f32x4 g = *(const f32x4*)(gate + bj * HALF + 4 * n);
#pragma unroll
                for (int ai = 0; ai < 2; ++ai)
#pragma unroll
                    for (int m = 0; m < 4; ++m) acc[ai][bj][m][n] = acc[ai][bj][m][n] * g; } }
        const void* ob = lat ? x_old : xc_old; bf16_t* nb = lat ? x_new : xc_new;
#pragma unroll
        for (int ai = 0; ai < 2; ++ai)
#pragma unroll
          for (int mh = 0; mh < 2; ++mh) {
            f32x4 o[2][2][2]; unsigned offs[2];
#pragma unroll
            for (int mm = 0; mm < 2; ++mm) { const int r = rbase + ai * HALF + wr * 64 + (2 * mh + mm) * 16 + fr;
                if (lat) { const int tp = r % seq; const int t = odd ? ((tp & 31) * 64 + (tp >> 5)) : tp; offs[mm] = (unsigned)(((r / seq) * seq + t) * dm + col); }
                else offs[mm] = (unsigned)((r - mlat) * dm + col); }
            if (f32in) {
#pragma unroll
                for (int mm = 0; mm < 2; ++mm)
#pragma unroll
                    for (int bj = 0; bj < 2; ++bj)
#pragma unroll
                        for (int n = 0; n < 2; ++n) o[mm][bj][n] = *(const f32x4*)((const float*)ob + offs[mm] + bj * HALF + 4 * n);
            } else {
#pragma unroll
                for (int mm = 0; mm < 2; ++mm)
#pragma unroll
                    for (int bj = 0; bj < 2; ++bj) { const u32x4 w = *(const u32x4*)((const bf16_t*)ob + offs[mm] + bj * HALF);
                        o[mm][bj][0] = (f32x4){__uint_as_float(w.x << 16), __uint_as_float(w.x & 0xffff0000u), __uint_as_float(w.y << 16), __uint_as_float(w.y & 0xffff0000u)};
                        o[mm][bj][1] = (f32x4){__uint_as_float(w.z << 16), __uint_as_float(w.z & 0xffff0000u), __uint_as_float(w.w << 16), __uint_as_float(w.w & 0xffff0000u)}; }
            }
#pragma unroll
            for (int mm = 0; mm < 2; ++mm)
#pragma unroll
                for (int bj = 0; bj < 2; ++bj) { const f32x4 v0 = o[mm][bj][0] + acc[ai][bj][2 * mh + mm][0], v1 = o[mm][bj][1] + acc[ai][bj][2 * mh + mm][1];
                    u32x4 w; w.x = cvt_pk_bf16(v0[0], v0[1]); w.y = cvt_pk_bf16(v0[2], v0[3]); w.z = cvt_pk_bf16(v1[0], v1[1]); w.w = cvt_pk_bf16(v1[2], v1[3]);
                    *(u32x4*)(nb + offs[mm] + bj * HALF) = w; }
            asm volatile("" ::: "memory");
          }
    }
};
template <class Epi, class Sched, bool ALIGN_EPI = false, bool SP2 = false>
__device__ __forceinline__ void gemm_phase(PG8_LAS unsigned char* lds, const Gemm g, const Sched& S, const Epi& E) {
    int tid_ = threadIdx.x; asm volatile("" : "+v"(tid_));
    const int tid = tid_, wid = __builtin_amdgcn_readfirstlane(tid >> 6), lane = tid & 63, wr = wid >> 2, wc = wid & 3, fr = lane & 15, fq = lane >> 4;
    const int K = g.K, nt = K / BK;
    constexpr bool DEFER = ALIGN_EPI && SP2;
    unsigned voffA, voffB;
    { int R, C; stage_rc(tid * 16, R, C); const int Rb = Epi::PERM ? ((R & ~31) + perm32(R & 31)) : R;
        voffA = (unsigned)(R * K + C) * 2u; voffB = (unsigned)(Rb * K + C) * 2u; }
    const size_t qstep = (size_t)64 * K * 2;
    const size_t kstep = (size_t)(BK * 2);
    const size_t hstep = (size_t)HALF * K * 2;
    const size_t tstep = 2 * hstep;
    const unsigned ldsw = (unsigned)wid * 1024u;
    const int aoff = lds_byte(wr * 64 + fr, fq * 8), boff = lds_byte(wc * 32 + fr, fq * 8);
#define PG8_SA(b, h) (((b) * 2 + (h)) * HTB)
#define PG8_SB(b, h) ((4 + (b) * 2 + (h)) * HTB)
#define PG8_STAGE(bufoff, gbase, voff) do { const char* sb_ = (const char*)(gbase); asm volatile("" : "+s"(sb_));     \
        _Pragma("unroll") for (int _i = 0; _i < 2; ++_i) \
        __builtin_amdgcn_global_load_lds((const unsigned*)(sb_ + (size_t)_i * qstep + (voff)), (PG8_LAS unsigned*)(lds + (bufoff) + ldsw + _i * 8192), 16, 0, 0); } while (0)
#define PG8_LDA(dst, b, h) do { _Pragma("unroll") for (int m = 0; m < 4; ++m) _Pragma("unroll") for (int k = 0; k < 2; ++k) dst[m][k] = *(const PG8_LAS bf16x8*)(lds + PG8_SA(b, h) + aoff + m * 2048 + k * 1024); } while (0)
#define PG8_LDB(dst, b, h) do { _Pragma("unroll") for (int n = 0; n < 2; ++n) _Pragma("unroll") for (int k = 0; k < 2; ++k) dst[n][k] = *(const PG8_LAS bf16x8*)(lds + PG8_SB(b, h) + boff + n * 2048 + k * 1024); } while (0)
#define PG8_MMA(ai, bj, At, Bt) do { __builtin_amdgcn_s_setprio(1); _Pragma("unroll") for (int m = 0; m < 4; ++m) _Pragma("unroll") for (int n = 0; n < 2; ++n) _Pragma("unroll") for (int k = 0; k < 2; ++k) \
        acc[ai][bj][m][n] = __builtin_amdgcn_mfma_f32_16x16x32_bf16(Bt[n][k], At[m][k], acc[ai][bj][m][n], 0, 0, 0); __builtin_amdgcn_s_setprio(0); } while (0)
#define PG8_MMAZ(ai, bj, At, Bt) do { __builtin_amdgcn_s_setprio(1); _Pragma("unroll") for (int m = 0; m < 4; ++m) _Pragma("unroll") for (int n = 0; n < 2; ++n) { \
        acc[ai][bj][m][n] = __builtin_amdgcn_mfma_f32_16x16x32_bf16(Bt[n][0], At[m][0], (f32x4){0.f, 0.f, 0.f, 0.f}, 0, 0, 0); \
        acc[ai][bj][m][n] = __builtin_amdgcn_mfma_f32_16x16x32_bf16(Bt[n][1], At[m][1], acc[ai][bj][m][n], 0, 0, 0); } __builtin_amdgcn_s_setprio(0); } while (0)
#define PG8_MMAX(FR, ai, bj, At, Bt) do { if (FR) PG8_MMAZ(ai, bj, At, Bt); else PG8_MMA(ai, bj, At, Bt); } while (0)
#define PG8_WAIT_V(n) asm volatile("s_waitcnt vmcnt(" #n ")" ::: "memory")
#define PG8_WAIT_L(n) asm volatile("s_waitcnt lgkmcnt(" #n ")" ::: "memory")
#define PG8_WAIT_VX(f) do { if (f) asm volatile("s_waitcnt vmcnt(%0)" :: "i"(8 + Epi::NVM) : "memory"); else PG8_WAIT_V(8); } while (0)
#define PG8_BAR __builtin_amdgcn_s_barrier()
#define PG8_SCHED __builtin_amdgcn_sched_barrier(0)
    Unit cur, nxt; int ui = 0;
    if (!S.next(0, cur)) return;
    f32x4 acc[2][2][4][2];
    if constexpr (!DEFER) {
#pragma unroll
    for (int a = 0; a < 2; ++a)
#pragma unroll
        for (int b = 0; b < 2; ++b)
#pragma unroll
            for (int m = 0; m < 4; ++m)
#pragma unroll
                for (int n = 0; n < 2; ++n) acc[a][b][m][n] = (f32x4){0.f, 0.f, 0.f, 0.f};
    }
    bf16x8 At[4][2], B0[2][2], B1[2][2];
    const char* cA = (const char*)g.A + (size_t)cur.pm * tstep; const char* cB = (const char*)g.Bt + (size_t)cur.pn * tstep;
    S.a_ready(cur);
    if constexpr (DEFER) {
        PG8_STAGE(PG8_SB(0, 0), cB, voffB); PG8_STAGE(PG8_SB(0, 1), cB + hstep, voffB); PG8_STAGE(PG8_SA(0, 0), cA, voffA); PG8_STAGE(PG8_SA(0, 1), cA + hstep, voffA);
        PG8_STAGE(PG8_SB(1, 0), cB + kstep, voffB); PG8_STAGE(PG8_SB(1, 1), cB + hstep + kstep, voffB); PG8_STAGE(PG8_SA(1, 0), cA + kstep, voffA); PG8_STAGE(PG8_SA(1, 1), cA + hstep + kstep, voffA);
        PG8_WAIT_V(0); PG8_BAR;
        if (wr == 1) PG8_BAR;
    } else if constexpr (SP2) {
        PG8_STAGE(PG8_SB(0, 0), cB, voffB); PG8_STAGE(PG8_SB(0, 1), cB + hstep, voffB); PG8_STAGE(PG8_SA(0, 0), cA, voffA); PG8_STAGE(PG8_SA(0, 1), cA + hstep, voffA);
        if (wr == 1) PG8_BAR;
        PG8_WAIT_V(2); PG8_BAR;
        PG8_STAGE(PG8_SB(1, 0), cB + kstep, voffB); PG8_STAGE(PG8_SA(1, 0), cA + kstep, voffA); PG8_STAGE(PG8_SB(1, 1), cB + hstep + kstep, voffB);
        PG8_WAIT_V(6); PG8_BAR;
    } else {
        PG8_STAGE(PG8_SB(0, 0), cB, voffB); PG8_STAGE(PG8_SA(0, 0), cA, voffA); PG8_STAGE(PG8_SB(0, 1), cB + hstep, voffB); PG8_STAGE(PG8_SA(0, 1), cA + hstep, voffA);
        if (wr == 1) PG8_BAR;
        PG8_WAIT_V(4); PG8_BAR;
        PG8_STAGE(PG8_SB(1, 0), cB + kstep, voffB); PG8_STAGE(PG8_SA(1, 0), cA + kstep, voffA); PG8_STAGE(PG8_SB(1, 1), cB + hstep + kstep, voffB);
        PG8_WAIT_V(6); PG8_BAR;
    }
    for (;;) {
        const bool has_next = S.next(ui + 1, nxt);
        const char* nA = has_next ? (const char*)g.A + (size_t)nxt.pm * tstep : cA; const char* nB = has_next ? (const char*)g.Bt + (size_t)nxt.pn * tstep : cB;
#define PG8_ITER_SP2(FR) do { \
            const bool last = (t == nt - 2); \
            const char* a1 = cA + (size_t)(t + 1) * kstep;                                             \
            const char* a2 = last ? nA : cA + (size_t)(t + 2) * kstep; const char* b2 = last ? nB : cB + (size_t)(t + 2) * kstep;     \
            const char* a3 = a2 + kstep; const char* b3 = b2 + kstep;                                \
            if (last && has_next) S.a_ready(nxt); \
              \
            PG8_LDB(B0, 0, 0); PG8_LDB(B1, 0, 1); PG8_SCHED; PG8_LDA(At, 0, 0); if (!(FR)) PG8_STAGE(PG8_SA(1, 1), a1 + hstep, voffA); \
            PG8_WAIT_VX(FR); PG8_WAIT_L(0); PG8_BAR; PG8_MMAX(FR, 0, 0, At, B0); PG8_MMAX(FR, 0, 1, At, B1); PG8_BAR; PG8_SCHED; \
              \
            PG8_LDA(At, 0, 1); PG8_STAGE(PG8_SB(0, 0), b2, voffB); PG8_STAGE(PG8_SB(0, 1), b2 + hstep, voffB); PG8_STAGE(PG8_SA(0, 0), a2, voffA); \
            PG8_WAIT_VX(FR); PG8_WAIT_L(0); PG8_BAR; PG8_MMAX(FR, 1, 0, At, B0); PG8_MMAX(FR, 1, 1, At, B1); PG8_BAR; PG8_SCHED; \
              \
            PG8_LDB(B0, 1, 0); PG8_LDB(B1, 1, 1); PG8_SCHED; PG8_LDA(At, 1, 0); PG8_STAGE(PG8_SA(0, 1), a2 + hstep, voffA); \
            PG8_WAIT_VX(FR); PG8_WAIT_L(0); PG8_BAR; PG8_MMA(0, 0, At, B0); PG8_MMA(0, 1, At, B1); PG8_BAR; PG8_SCHED; \
              \
            PG8_LDA(At, 1, 1); PG8_STAGE(PG8_SB(1, 0), b3, voffB); PG8_STAGE(PG8_SB(1, 1), b3 + hstep, voffB); PG8_STAGE(PG8_SA(1, 0), a3, voffA); \
            PG8_WAIT_V(8); PG8_WAIT_L(0); PG8_BAR; PG8_MMA(1, 0, At, B0); PG8_MMA(1, 1, At, B1); PG8_BAR; PG8_SCHED; } while (0)
        if constexpr (SP2) {
            int t = 0;
            if constexpr (DEFER) { PG8_ITER_SP2(1); t = 2; asm volatile("" : "+v"(voffA), "+v"(voffB)); }
#pragma unroll 1
            for (; t < nt; t += 2) PG8_ITER_SP2(0);
        } else {
        for (int t = 0; t < nt; t += 2) {
            const bool last = (t == nt - 2);
            const char* a1 = cA + (size_t)(t + 1) * kstep;
            const char* a2 = last ? nA : cA + (size_t)(t + 2) * kstep; const char* b2 = last ? nB : cB + (size_t)(t + 2) * kstep;
            const char* a3 = a2 + kstep; const char* b3 = b2 + kstep;
            if (last && has_next) S.a_ready(nxt);
            PG8_LDB(B0, 0, 0); PG8_SCHED; PG8_LDA(At, 0, 0); PG8_STAGE(PG8_SA(1, 1), a1 + hstep, voffA);
            PG8_WAIT_L(8); PG8_BAR; PG8_WAIT_L(0); PG8_MMA(0, 0, At, B0); PG8_BAR; PG8_SCHED;
            PG8_LDB(B1, 0, 1); PG8_STAGE(PG8_SB(0, 0), b2, voffB);
            PG8_BAR; PG8_WAIT_L(0); PG8_MMA(0, 1, At, B1); PG8_BAR;
            PG8_LDA(At, 0, 1); PG8_STAGE(PG8_SA(0, 0), a2, voffA);
            PG8_BAR; PG8_WAIT_L(0); PG8_MMA(1, 0, At, B0); PG8_BAR; PG8_SCHED;
            PG8_STAGE(PG8_SB(0, 1), b2 + hstep, voffB);
            PG8_WAIT_V(6); PG8_BAR; PG8_MMA(1, 1, At, B1); PG8_BAR;
            PG8_LDB(B0, 1, 0); PG8_SCHED; PG8_LDA(At, 1, 0); PG8_STAGE(PG8_SA(0, 1), a2 + hstep, voffA);
            PG8_WAIT_L(8); PG8_BAR; PG8_WAIT_L(0); PG8_MMA(0, 0, At, B0); PG8_BAR; PG8_SCHED;
            PG8_LDB(B1, 1, 1); PG8_STAGE(PG8_SB(1, 0), b3, voffB);
            PG8_BAR; PG8_WAIT_L(0); PG8_MMA(0, 1, At, B1); PG8_BAR;
            PG8_LDA(At, 1, 1); PG8_STAGE(PG8_SA(1, 0), a3, voffA);
            PG8_BAR; PG8_WAIT_L(0); PG8_MMA(1, 0, At, B0); PG8_BAR; PG8_SCHED;
            PG8_STAGE(PG8_SB(1, 1), b3 + hstep, voffB);
            PG8_WAIT_V(6); PG8_BAR; PG8_MMA(1, 1, At, B1); PG8_BAR;
        }
        }
        if constexpr (ALIGN_EPI) { if (wr == 0) PG8_BAR; }
        if constexpr (DEFER) { if (has_next) PG8_STAGE(PG8_SA(1, 1), nA + kstep + hstep, voffA); asm volatile("" ::: "memory"); }
        if constexpr (!Epi::AFTER_DRAIN) { E(acc, cur, wr, wc, fr, fq); S.done(cur); }
        if (!has_next) break;
        if constexpr (!DEFER) {
#pragma unroll
        for (int a = 0; a < 2; ++a)
#pragma unroll
            for (int b = 0; b < 2; ++b)
#pragma unroll
                for (int m = 0; m < 4; ++m)
#pragma unroll
                    for (int n = 0; n < 2; ++n) acc[a][b][m][n] = (f32x4){0.f, 0.f, 0.f, 0.f};
        }
        cur = nxt; cA = nA; cB = nB; ++ui;
        if constexpr (ALIGN_EPI) { if (wr == 1) PG8_BAR; }
    }
    PG8_WAIT_V(0);
    if constexpr (!ALIGN_EPI) { if (wr == 0) PG8_BAR; }
    PG8_BAR;
    if constexpr (Epi::AFTER_DRAIN) { E.fused(acc, cur, wr, wc, fr, fq, lds, wid, lane); S.done(cur); }
#undef PG8_SA
#undef PG8_SB
#undef PG8_STAGE
#undef PG8_LDA
#undef PG8_LDB
#undef PG8_MMA
#undef PG8_MMAZ
#undef PG8_MMAX
#undef PG8_WAIT_V
#undef PG8_WAIT_L
#undef PG8_WAIT_VX
#undef PG8_ITER_SP2
#undef PG8_BAR
#undef PG8_SCHED
}
}

constexpr int NWAVES = 8;
constexpr int RING_BYTES = 159744, LDSCTL_OFF = RING_BYTES, MISC_OFF = LDSCTL_OFF + 320, LDS_BYTES = 163840;
constexpr int CW_BAR = 4096;
constexpr size_t CTL_ZERO_BYTES = 64 * 1024;
#define GAS __attribute__((address_space(1)))
#define LAS __attribute__((address_space(3)))
typedef float f32x4 __attribute__((ext_vector_type(4)));
typedef unsigned v4u __attribute__((ext_vector_type(4)));
typedef unsigned u32x2 __attribute__((ext_vector_type(2)));
__device__ __forceinline__ float bflo(unsigned w) { return __uint_as_float(w << 16); }
__device__ __forceinline__ float bfhi(unsigned w) { return __uint_as_float(w & 0xffff0000u); }
typedef short bf16x8 __attribute__((ext_vector_type(8)));
__device__ __forceinline__ void unpack8(const v4u& w, float (&f)[8]) { f[0] = bflo(w.x); f[1] = bfhi(w.x); f[2] = bflo(w.y); f[3] = bfhi(w.y); f[4] = bflo(w.z); f[5] = bfhi(w.z); f[6] = bflo(w.w); f[7] = bfhi(w.w); }
__device__ __forceinline__ bf16x8 pack8(const f32x4& a, const f32x4& b) {
    return __builtin_bit_cast(bf16x8, __builtin_convertvector((nf32x8){a.x, a.y, a.z, a.w, b.x, b.y, b.z, b.w}, nbf16x8)); }
typedef GAS unsigned gu32;
#define LDS_WAIT() asm volatile("s_waitcnt lgkmcnt(0)" ::: "memory")
#define LBAR() do { asm volatile("s_waitcnt lgkmcnt(0)" ::: "memory"); __builtin_amdgcn_s_barrier(); asm volatile("" ::: "memory"); } while (0)
#define VM_WAIT() asm volatile("s_waitcnt vmcnt(0)" ::: "memory")
__device__ __forceinline__ unsigned pk2(float lo, float hi) { return __builtin_bit_cast(unsigned, __builtin_convertvector((nf32x2){lo, hi}, nbf16x2)); }

#define XB_TMO      128
#define XB_XCNT(j)  (256  + 64 * (j))
#define XB_XSUB(j)  (1280 + 64 * (j))
#define XB_XGEN(j)  (2304 + 64 * (j))
#define XB_TOP      3328
#define XB_TOPGEN   3392
#define XCD_BAR_WORDS 3456
#define XB_SPIN_CAP (1u << 22)

__device__ __forceinline__ unsigned xb_ld(unsigned* p)              { return __hip_atomic_load(p, __ATOMIC_RELAXED, __HIP_MEMORY_SCOPE_AGENT); }
__device__ __forceinline__ unsigned xb_add(unsigned* p, unsigned v) { return __hip_atomic_fetch_add(p, v, __ATOMIC_RELAXED, __HIP_MEMORY_SCOPE_AGENT); }
__device__ __forceinline__ unsigned xb_xcc_id() { return (unsigned)__builtin_amdgcn_s_getreg((3 << 11) | 20) & 0xFu; }
#define XB_SPIN(cond, bar) do { unsigned _sp = 0; while (cond) { __builtin_amdgcn_s_sleep(1); \
    if ((++_sp & 255u) == 0u) { if (xb_ld(&(bar)[XB_TMO])) break; if (_sp > XB_SPIN_CAP) { atomicAdd(&(bar)[XB_TMO], 1u); break; } } } } while (0)

struct XcdBarrier {
    unsigned* bar; unsigned x;
    volatile LAS unsigned* st;
};

__device__ __forceinline__ XcdBarrier xcd_barrier_post(unsigned* bar, volatile LAS unsigned* st) {
    XcdBarrier b; b.bar = bar; b.x = xb_xcc_id(); b.st = st;
    if (threadIdx.x == 0) (void)xb_add(&bar[XB_XCNT(b.x)], 1u);
    return b;
}
__device__ __forceinline__ void xcd_barrier_complete(unsigned* bar, unsigned x, unsigned& nloc, unsigned& nx) {
    const unsigned G = gridDim.x * gridDim.y * gridDim.z;
    unsigned sum, cnt, mine, sp = 0u;
    for (;;) {
        sum = 0u; cnt = 0u; mine = 0u;
#pragma unroll
        for (unsigned j = 0; j < 16; ++j) { const unsigned c = xb_ld(&bar[XB_XCNT(j)]); sum += c; cnt += (c > 0u) ? 1u : 0u; mine = (j == x) ? c : mine; }
        if (sum == G) break;
        __builtin_amdgcn_s_sleep(1);
        if ((++sp & 255u) == 0u) { if (xb_ld(&bar[XB_TMO])) break; if (sp > XB_SPIN_CAP) { atomicAdd(&bar[XB_TMO], 1u); break; } }
    }
    nloc = mine > 0u ? mine : 1u; nx = cnt > 0u ? cnt : 1u;
}

__device__ __forceinline__ void xcd_barrier(const XcdBarrier& b) {
    asm volatile("s_waitcnt vmcnt(0)" ::: "memory");
    __syncthreads();
    if (threadIdx.x == 0) {
        unsigned* bar = b.bar;
        __builtin_amdgcn_s_waitcnt(0);
        unsigned nloc = b.st[0], nx = b.st[1];
        if (nloc == 0u) { xcd_barrier_complete(bar, b.x, nloc, nx); b.st[0] = nloc; b.st[1] = nx; }
        const unsigned old = xb_add(&bar[XB_XSUB(b.x)], 1u);
        const unsigned gen = old / nloc;
        if (old + 1u == (gen + 1u) * nloc) {
            __builtin_amdgcn_fence(__ATOMIC_RELEASE, "agent");
            asm volatile("s_waitcnt vmcnt(0)" ::: "memory");
            const unsigned og = xb_add(&bar[XB_TOP], 1u);
            const unsigned tg = og / nx;
            if (og + 1u == (tg + 1u) * nx) xb_add(&bar[XB_TOPGEN], 1u);
            else XB_SPIN(xb_ld(&bar[XB_TOPGEN]) == tg, bar);
            __builtin_amdgcn_fence(__ATOMIC_ACQUIRE, "agent");
            xb_add(&bar[XB_XGEN(b.x)], 1u);
            asm volatile("s_waitcnt vmcnt(0)" ::: "memory");
        } else {
            XB_SPIN(xb_ld(&bar[XB_XGEN(b.x)]) == gen, bar);
            __builtin_amdgcn_fence(__ATOMIC_ACQUIRE, "agent");
            asm volatile("s_waitcnt vmcnt(0)" ::: "memory");
        }
    }
    __syncthreads();
}


#define CAS __attribute__((address_space(4)))
typedef const CAS Ptrs KPtrs;
struct Frame {
    LAS unsigned char* lds; volatile LAS unsigned* MISC; gu32* ctl;
    int tid, lane, wave, vcu, G;
    __device__ __forceinline__ KPtrs& P() const { const CAS char* kp = (const CAS char*)__builtin_amdgcn_kernarg_segment_ptr(); asm volatile("" : "+s"(kp)); return *(KPtrs*)kp; }
    __device__ __forceinline__ void refresh() { int t = threadIdx.x; asm volatile("" : "+v"(t)); tid = t; lane = t & 63; wave = __builtin_amdgcn_readfirstlane(t >> 6); }
};

__device__ __forceinline__ void transpose_item(const float* W, int coff, int ld, bf16_t* WT, LAS float* scr, int k0, int lane) {
    float tv[32];
#pragma unroll
    for (int i = 0; i < 32; ++i) tv[i] = W[(size_t)(k0 + 2 * i + (lane >> 5)) * ld + coff];
#pragma unroll
    for (int i = 0; i < 32; ++i) scr[(2 * i + (lane >> 5)) * 33 + (lane & 31)] = tv[i];
    LDS_WAIT(); asm volatile("" ::: "memory");
    const int c = lane & 7;
#pragma unroll
    for (int j = 0; j < 4; ++j) { const int n = (lane >> 3) + 8 * j; const LAS float* s = scr + (8 * c) * 33 + n;
        v4u o; o.x = pk2(s[0 * 33], s[1 * 33]); o.y = pk2(s[2 * 33], s[3 * 33]); o.z = pk2(s[4 * 33], s[5 * 33]); o.w = pk2(s[6 * 33], s[7 * 33]);
        *(GAS v4u*)(WT + (size_t)n * DM + k0 + 8 * c) = o; }
    LDS_WAIT(); asm volatile("" ::: "memory");
}
__device__ __forceinline__ void convert_weights(Frame& F, int l, int gw, int NGW) {
    KPtrs& p = F.P();
    LAS float* scr = (LAS float*)(F.lds + F.wave * 16384);
    constexpr int I_IN = 16 * (NPC / 32), I_OUT = 16 * (DM / 32), I_L = I_IN + I_OUT;
    for (int it = gw; it < I_L; it += NGW) { int r = it;
        if (r < I_IN) { const int kb = r / (NPC / 32), nb = r % (NPC / 32), n0 = 32 * nb;
            const int g = n0 >> 8, i0 = n0 & 255, li = F.lane & 31, dl = c_gt_delta[g];
            const int coff = c_gt_col[g] + (dl ? (i0 >> 1) + (li >> 1) + ((li & 1) ? dl : 0) : i0 + li);
            transpose_item(p.w_in + (size_t)l * DM * INC, coff, INC, (bf16_t*)(p.ws + WS_WIN) + ((size_t)l * NPC + n0) * DM, scr, 64 * kb, F.lane); }
        else { r -= I_IN; const int kb = r / (DM / 32), nb = r % (DM / 32), n0 = 32 * nb;
            transpose_item(p.w_out + (size_t)l * DM * DM, n0 + (F.lane & 31), DM, (bf16_t*)(p.ws + WS_WOUT) + ((size_t)l * DM + n0) * DM, scr, 64 * kb, F.lane); }
    }
}
__device__ __forceinline__ void mod_item(Frame& F, int l, int slab) {
    KPtrs& p = F.P(); const int n0 = slab * 128;
    LAS float* s = (LAS float*)F.lds;
    LAS float* red = s + 17 * DM;
    { float cv[34];
#pragma unroll
      for (int j = 0; j < 34; ++j) { const int i = F.tid + j * NWAVES * 64, b = i >> 10, k = i & 1023; cv[j] = b < 16 ? p.c[b * DM + k] : p.c_ctx[k]; }
#pragma unroll
      for (int j = 0; j < 34; ++j) s[F.tid + j * NWAVES * 64] = fsilu(cv[j]); }
    __syncthreads();
    const int cq = F.tid & 31, kg = F.tid >> 5;
    f32x4 acc[17];
#pragma unroll
    for (int b = 0; b < 17; ++b) acc[b] = (f32x4){0.f, 0.f, 0.f, 0.f};
    const float* w = p.w_ada + (size_t)l * DM * 3072 + n0 + 4 * cq;
#pragma unroll 1
    for (int k0 = kg * 64; k0 < kg * 64 + 64; k0 += 16) { f32x4 wv[16];
#pragma unroll
        for (int kk = 0; kk < 16; ++kk) wv[kk] = *(const f32x4*)(w + (size_t)(k0 + kk) * 3072);
#pragma unroll
        for (int q = 0; q < 4; ++q) {
#pragma unroll
            for (int b = 0; b < 17; ++b) { const f32x4 s4 = *(const LAS f32x4*)(s + b * DM + k0 + 4 * q);
                acc[b] += wv[4 * q] * s4.x + wv[4 * q + 1] * s4.y + wv[4 * q + 2] * s4.z + wv[4 * q + 3] * s4.w; }
            asm volatile("" ::: "memory"); } }
#pragma unroll
    for (int b = 0; b < 17; ++b) {
        float v[4] = {acc[b].x, acc[b].y, acc[b].z, acc[b].w};
#pragma unroll
        for (int e = 0; e < 4; ++e) { auto r = __builtin_amdgcn_permlane32_swap(__float_as_uint(v[e]), __float_as_uint(v[e]), false, false); v[e] = __uint_as_float(r[0]) + __uint_as_float(r[1]); }
        if (F.lane < 32) *(LAS f32x4*)(red + (F.wave * 17 + b) * 128 + 4 * cq) = (f32x4){v[0], v[1], v[2], v[3]}; }
    __syncthreads();
    float* mod = (float*)(p.ws + WS_MOD);
    for (int o = F.tid; o < 17 * 128; o += NWAVES * 64) { const int b = o >> 7, cc = o & 127; float sum = p.b_ada[l * 3072 + n0 + cc];
#pragma unroll
        for (int g = 0; g < 8; ++g) sum += red[(g * 17 + b) * 128 + cc];
        mod[(size_t)(l * 17 + b) * 3072 + n0 + cc] = sum; }
    __syncthreads();
}
__device__ __forceinline__ void phase_pre(Frame& F) {
    KPtrs& p = F.P();
    if (blockIdx.x < 96) mod_item(F, (int)blockIdx.x / 24, (int)blockIdx.x % 24);
    else convert_weights(F, 0, ((int)blockIdx.x - 96) * NWAVES + F.wave, (F.G - 96) * NWAVES);
    { bf16_t* wsb = (bf16_t*)(p.ws + (9u << 20));
      for (int i = F.vcu * NWAVES * 64 + F.tid; i < DEPTH * 4 * 128 * 128 / 4; i += F.G * NWAVES * 64) { const f32x4 v = *(const f32x4*)(p.smlp_w + 4 * (size_t)i);
          unsigned long long o = (unsigned long long)pk2(v.x, v.y) | ((unsigned long long)pk2(v.z, v.w) << 32); *(GAS unsigned long long*)(wsb + 4 * (size_t)i) = o; } }
}

__device__ __forceinline__ void norm_row0(Frame& F, LAS float* tab, int r, f32x4 (&v)[4], int& curb) {
    KPtrs& p = F.P(); const int lane = F.lane;
    const int b = r < MLAT ? r >> 11 : 16;
    if (b != curb) { curb = b; const float* mod = (const float*)(p.ws + WS_MOD) + (size_t)b * 3072;
#pragma unroll
        for (int j = 0; j < 4; ++j) { const f32x4 g = *(const f32x4*)(p.norm_g + 256 * j + 4 * lane), sc = *(const f32x4*)(mod + 1024 + 256 * j + 4 * lane), sh = *(const f32x4*)(mod + 256 * j + 4 * lane);
            *(LAS f32x4*)(tab + 256 * j + 4 * lane) = g * (sc + 1.0f); *(LAS f32x4*)(tab + 1024 + 256 * j + 4 * lane) = sh; }
        asm volatile("s_waitcnt vmcnt(0) lgkmcnt(0)" ::: "memory"); }
    float ss = 0.f;
#pragma unroll
    for (int j = 0; j < 4; ++j) { ss += (v[j].x * v[j].x + v[j].y * v[j].y) + (v[j].z * v[j].z + v[j].w * v[j].w); }
    ss = wave_sum(ss);
    const float rstd = 1.0f / sqrtf(ss * (1.0f / DM) + EPS);
    GAS unsigned long long* o8 = (GAS unsigned long long*)((bf16_t*)(p.ws + WS_HY) + (size_t)r * DM) + lane;
#pragma unroll
    for (int j = 0; j < 4; ++j) { const f32x4 h = v[j] * rstd * *(const LAS f32x4*)(tab + 256 * j + 4 * lane) + *(const LAS f32x4*)(tab + 1024 + 256 * j + 4 * lane);
        o8[64 * j] = (unsigned long long)pk2(h.x, h.y) | ((unsigned long long)pk2(h.z, h.w) << 32); }
}
__device__ __forceinline__ void norm_wave_rows(Frame& F, LAS float* tab) {
    KPtrs& p = F.P(); const int lane = F.lane; int curb = -1;
    f32x4 va[4], vb[4], vc[4];
    const int rw = 16 * F.vcu + 2 * F.wave;
#define NR_ROW(k_) (rw + 4096 * ((k_) >> 1) + ((k_) & 1))
#define NR_LOAD(k_, d_) do { const int kk_ = (k_) < 18 ? (k_) : 17; const int rr_ = NR_ROW(kk_); const GAS f32x4* xr_ = (const GAS f32x4*)(rr_ < MLAT ? p.x + (size_t)rr_ * DM : p.ctx + (size_t)(rr_ - MLAT) * DM) + lane; \
        _Pragma("unroll") for (int j = 0; j < 4; ++j) d_[j] = xr_[64 * j]; } while (0)
    NR_LOAD(0, va); NR_LOAD(1, vb);
#pragma unroll 1
    for (int k = 0; k < 18; k += 3) {
        NR_LOAD(k + 2, vc); norm_row0(F, tab, NR_ROW(k), va, curb);
        NR_LOAD(k + 3, va); norm_row0(F, tab, NR_ROW(k + 1), vb, curb);
        NR_LOAD(k + 4, vb); norm_row0(F, tab, NR_ROW(k + 2), vc, curb);
    }
#undef NR_LOAD
#undef NR_ROW
}
__device__ __forceinline__ void norm_tile16(Frame& F, int l, const LAS bf16_t* wabT, LAS float* tab, int r0, int& curb) {
    KPtrs& p = F.P(); const int lane = F.lane, li = lane & 15, g4 = lane >> 4;
    const bf16_t* const XB = (const bf16_t*)((const char*)p.out + (64u << 20)); const bf16_t* const XCB = (const bf16_t*)(p.ws + WS_XC);
    const int r = r0 + li; int b; const bf16_t* src;
    if (r < MLAT) { b = r >> 11; const int tp = r & 2047; const int t = (l & 1) ? ((tp & 31) * 64 + (tp >> 5)) : tp; src = XB + ((size_t)b * SEQ + t) * DM; }
    else { b = 16; src = XCB + (size_t)(r - MLAT) * DM; }
    v4u xr[32];
#pragma unroll
    for (int s2 = 0; s2 < 32; ++s2) xr[s2] = *(const GAS v4u*)(src + 32 * s2 + 8 * g4);
    const int bt = __builtin_amdgcn_readfirstlane(b);
    if (bt != curb) { curb = bt; const float* mod = (const float*)(p.ws + WS_MOD) + (size_t)(l * 17 + bt) * 3072;
#pragma unroll
        for (int j = 0; j < 4; ++j) { const f32x4 g = *(const f32x4*)(p.norm_g + l * DM + 256 * j + 4 * lane), sc = *(const f32x4*)(mod + 1024 + 256 * j + 4 * lane), sh = *(const f32x4*)(mod + 256 * j + 4 * lane);
            *(LAS f32x4*)(tab + 256 * j + 4 * lane) = g * (sc + 1.0f); *(LAS f32x4*)(tab + 1024 + 256 * j + 4 * lane) = sh; }
        asm volatile("s_waitcnt lgkmcnt(0)" ::: "memory"); }
    float ss = 0.f;
#pragma unroll
    for (int s2 = 0; s2 < 32; ++s2) { float f[8]; unpack8(xr[s2], f);
#pragma unroll
        for (int e = 0; e < 8; ++e) ss += f[e] * f[e]; }
    { auto q = __builtin_amdgcn_permlane16_swap(__float_as_uint(ss), __float_as_uint(ss), false, false); ss = __uint_as_float(q[0]) + __uint_as_float(q[1]); }
    { auto q = __builtin_amdgcn_permlane32_swap(__float_as_uint(ss), __float_as_uint(ss), false, false); ss = __uint_as_float(q[0]) + __uint_as_float(q[1]); }
    const float rstd = 1.0f / sqrtf(ss * (1.0f / DM) + EPS);
#pragma unroll
    for (int s2 = 0; s2 < 32; ++s2) asm volatile("" : "+v"(xr[s2]));
    f32x4 acc = {0.f, 0.f, 0.f, 0.f};
    bf16_t* hrow = (bf16_t*)(p.ws + WS_HY) + (size_t)r * DM + 8 * g4;
#pragma unroll
    for (int s2 = 0; s2 < 32; ++s2) { float f[8]; unpack8(xr[s2], f);
        const f32x4 ga = *(const LAS f32x4*)(tab + 32 * s2 + 8 * g4), gb = *(const LAS f32x4*)(tab + 32 * s2 + 8 * g4 + 4), sa = *(const LAS f32x4*)(tab + 1024 + 32 * s2 + 8 * g4), sb = *(const LAS f32x4*)(tab + 1024 + 32 * s2 + 8 * g4 + 4);
        const f32x4 ha = (f32x4){f[0], f[1], f[2], f[3]} * rstd * ga + sa, hb = (f32x4){f[4], f[5], f[6], f[7]} * rstd * gb + sb;
        const bf16x8 hf = pack8(ha, hb);
        *(GAS bf16x8*)(hrow + 32 * s2) = hf;
        const bf16x8 wf = *(const LAS bf16x8*)(wabT + li * DM + 32 * s2 + 8 * g4);
        acc = __builtin_amdgcn_mfma_f32_16x16x32_bf16(hf, wf, acc, 0, 0, 0);
        if ((s2 & 1) == 1) asm volatile("" ::: "memory"); }
    float* AB = (float*)(p.ws + WS_AB) + (size_t)(r0 + 4 * g4) * 16 + li;
#pragma unroll
    for (int rr = 0; rr < 4; ++rr) AB[rr * 16] = acc[rr];
}
__device__ __forceinline__ void ab_tile16(Frame& F, const LAS bf16_t* wabT, int r0) {
    KPtrs& p = F.P(); const int lane = F.lane, li = lane & 15, g4 = lane >> 4;
    const bf16_t* src = (const bf16_t*)(p.ws + WS_HY) + (size_t)(r0 + li) * DM + 8 * g4;
    v4u xr[32];
#pragma unroll
    for (int s2 = 0; s2 < 32; ++s2) xr[s2] = *(const GAS v4u*)(src + 32 * s2);
    f32x4 acc = {0.f, 0.f, 0.f, 0.f};
#pragma unroll
    for (int s2 = 0; s2 < 32; ++s2) { const bf16x8 wf = *(const LAS bf16x8*)(wabT + li * DM + 32 * s2 + 8 * g4);
        acc = __builtin_amdgcn_mfma_f32_16x16x32_bf16(__builtin_bit_cast(bf16x8, xr[s2]), wf, acc, 0, 0, 0);
        if ((s2 & 3) == 3) asm volatile("" ::: "memory"); }
    float* AB = (float*)(p.ws + WS_AB) + (size_t)(r0 + 4 * g4) * 16 + li;
#pragma unroll
    for (int rr = 0; rr < 4; ++rr) AB[rr * 16] = acc[rr];
}
constexpr int CW_CTXC = 9216, CW_NORMQ = 13312;
__device__ __forceinline__ void norm_stage_wab(Frame& F, int l, LAS float* wab) {
    KPtrs& p = F.P();
    float wv[32];
#pragma unroll
    for (int q = 0; q < 32; ++q) { const int i = F.tid + q * NWAVES * 64; wv[q] = p.w_in[(size_t)l * DM * INC + (size_t)(i >> 4) * INC + 768 + (i & 15)]; }
#pragma unroll
    for (int q = 0; q < 32; ++q) { const int i = F.tid + q * NWAVES * 64; wab[(i & 15) * DM + (i >> 4)] = wv[q]; }
    __syncthreads();
}
__device__ __forceinline__ void phase_norm(Frame& F, int l) {
    KPtrs& p = F.P();
#define NORM_STAGE_WAB() do { float wv_[32];   \
        _Pragma("unroll") for (int q_ = 0; q_ < 32; ++q_) { const int i_ = F.tid + q_ * NWAVES * 64; wv_[q_] = p.w_in[(size_t)l * DM * INC + (size_t)(i_ >> 4) * INC + 768 + (i_ & 15)]; } \
        _Pragma("unroll") for (int q_ = 0; q_ < 32; ++q_) { const int i_ = F.tid + q_ * NWAVES * 64; ((LAS bf16_t*)F.lds)[(i_ & 15) * DM + (i_ >> 4)] = f2bf(wv_[q_]); } \
        __syncthreads(); } while (0)
    if (l == 0) {
        NORM_STAGE_WAB();
        norm_wave_rows(F, (LAS float*)(F.lds + 32768 + F.wave * 8192));
        __syncthreads();
        for (int t = F.wave; t < 9; t += NWAVES) ab_tile16(F, (const LAS bf16_t*)F.lds, 16 * (F.vcu + 256 * t));
        __syncthreads();
        return;
    }
    const LAS bf16_t* wabT = (const LAS bf16_t*)F.lds; LAS float* tab = (LAS float*)(F.lds + 32768 + F.wave * 8192); int curb = -1;
    if (blockIdx.x < 64) {
        const int pmc = (int)blockIdx.x >> 2, pn = (int)blockIdx.x & 3, lp = l - 1;
        pg8::Gemm g{(const bf16_t*)(p.ws + WS_HY) + (size_t)MLAT * DM, (const bf16_t*)(p.ws + WS_WOUT) + (size_t)lp * DM * DM, MCTX, DM, DM};
        pg8::OneUnit S{{pmc, pn}};
        bf16_t* const XCB = (bf16_t*)(p.ws + WS_XC);
        pg8::EpiResid E{nullptr, nullptr, lp == 0 ? (const void*)p.ctx : (const void*)XCB, XCB, (const float*)(p.ws + WS_MOD) + (size_t)lp * 17 * 3072, 0, MLAT, SEQ, DM, lp == 0 ? 1 : 0, MLAT};
        pg8::gemm_phase<pg8::EpiResid, pg8::OneUnit, false, true>(F.lds, g, S, E);
        F.refresh();
        asm volatile("s_waitcnt vmcnt(0)" ::: "memory");
        __syncthreads();
        if (F.tid == 0) { __builtin_amdgcn_fence(__ATOMIC_RELEASE, "agent"); asm volatile("s_waitcnt vmcnt(0)" ::: "memory");
            (void)__hip_atomic_fetch_add(F.ctl + CW_CTXC + (l * 16 + pmc) * 64, 1u, __ATOMIC_RELAXED, __HIP_MEMORY_SCOPE_AGENT); }
    } else {
        NORM_STAGE_WAB();
        const int wi = ((int)blockIdx.x - 64) * NWAVES + F.wave;
        for (int t = wi; t < MLAT / 16; t += 1536) norm_tile16(F, l, wabT, tab, 16 * t, curb);
        if (blockIdx.x >= 128) { __syncthreads(); convert_weights(F, l, ((int)blockIdx.x - 128) * NWAVES + F.wave, 1024); }
        else {
            const int q = (int)blockIdx.x - 64, pmc = q >> 2;
            if (F.tid == 0) { gu32* cnt = F.ctl + CW_CTXC + (l * 16 + pmc) * 64; unsigned spins = 0;
                while (__hip_atomic_load(cnt, __ATOMIC_RELAXED, __HIP_MEMORY_SCOPE_AGENT) < 4u && ++spins < (1u << 22)) __builtin_amdgcn_s_sleep(2);
                __builtin_amdgcn_fence(__ATOMIC_ACQUIRE, "agent"); asm volatile("s_waitcnt vmcnt(0)" ::: "memory"); }
            __syncthreads();
            if (F.wave < 4) norm_tile16(F, l, wabT, tab, MLAT + 64 * q + 16 * F.wave, curb);
        }
    }
#undef NORM_STAGE_WAB
    __syncthreads();
}

__device__ __forceinline__ void phase_final(Frame& F) {
    KPtrs& p = F.P(); const int lane = F.lane;
    const int gw = F.vcu * NWAVES + F.wave, NGW = F.G * NWAVES;
    const bf16_t* X = (const bf16_t*)(p.ws + WS_P);
    f32x4 g[4];
#pragma unroll
    for (int j = 0; j < 4; ++j) g[j] = *(const f32x4*)(p.final_g + 256 * j + 4 * lane);
    for (int r0 = gw; r0 < MLAT; r0 += 4 * NGW) {
        u32x2 raw[4][4];
#pragma unroll
        for (int u = 0; u < 4; ++u) { const int r = r0 + u * NGW; if (r < MLAT) { const GAS u32x2* xr = (const GAS u32x2*)(X + (size_t)r * DM) + lane;
#pragma unroll
            for (int j = 0; j < 4; ++j) raw[u][j] = xr[64 * j]; } }
#pragma unroll
        for (int u = 0; u < 4; ++u) { const int r = r0 + u * NGW; if (r < MLAT) {
            f32x4 v[4]; float ss = 0.f;
#pragma unroll
            for (int j = 0; j < 4; ++j) { v[j] = (f32x4){bflo(raw[u][j].x), bfhi(raw[u][j].x), bflo(raw[u][j].y), bfhi(raw[u][j].y)}; ss += (v[j].x * v[j].x + v[j].y * v[j].y) + (v[j].z * v[j].z + v[j].w * v[j].w); }
            ss = wave_sum(ss);
            const float rstd = 1.0f / sqrtf(ss * (1.0f / DM) + EPS);
            GAS f32x4* xo = (GAS f32x4*)(p.out + (size_t)r * DM) + lane;
#pragma unroll
            for (int j = 0; j < 4; ++j) xo[64 * j] = v[j] * rstd * g[j]; } }
    }
}

__device__ __forceinline__ void phase_gemm1(Frame& F, int l) {
    KPtrs& p = F.P();
    pg8::Gemm g{(const bf16_t*)(p.ws + WS_HY), (const bf16_t*)(p.ws + WS_WIN) + (size_t)l * NPC * DM, MTOT, NPC, DM};
    pg8::StaticOrder S; S.init(MTOT, NPC, F.G, (int)blockIdx.x);
    pg8::EpiP E{(bf16_t*)(p.ws + WS_P), PTILE_ELEMS};
    pg8::gemm_phase<pg8::EpiP, pg8::StaticOrder, true, true>(F.lds, g, S, E);
}
__device__ __forceinline__ void phase_gemm2(Frame& F, int l) {
    KPtrs& p = F.P();
    const int M = MLAT;
    pg8::Gemm g{(const bf16_t*)(p.ws + WS_HY), (const bf16_t*)(p.ws + WS_WOUT) + (size_t)l * DM * DM, M, DM, DM};
    pg8::StaticOrder S; S.init(M, DM, F.G, (int)blockIdx.x);
    bf16_t* const XB = (bf16_t*)((char*)p.out + (64u << 20));
    bf16_t* const XCB = (bf16_t*)(p.ws + WS_XC);
    pg8::EpiResid E{l == 0 ? (const void*)p.x : (const void*)XB, l == DEPTH - 1 ? (bf16_t*)(p.ws + WS_P) : XB, l == 0 ? (const void*)p.ctx : (const void*)XCB, XCB,
                    (const float*)(p.ws + WS_MOD) + (size_t)l * 17 * 3072, l & 1, MLAT, SEQ, DM, l == 0 ? 1 : 0, 0};
    pg8::gemm_phase<pg8::EpiResid, pg8::StaticOrder, true, true>(F.lds, g, S, E);
}


typedef short s16x4 __attribute__((ext_vector_type(4)));
__device__ __forceinline__ const bf16_t* ptile_d(KPtrs& p, int t) { return (const bf16_t*)(p.ws + WS_P) + (size_t)t * PTILE_ELEMS; }
constexpr size_t WS_WSB = 9 * MiB;

__device__ __forceinline__ void mix_unit_B(Frame& F, int l, int row0) {
    KPtrs& p = F.P(); const int oct = F.tid & 31, tg = F.tid >> 5;
    int start, len; row_seq(row0, start, len);
    const bf16_t *CX = ptile_d(p, T_CX), *BGS = ptile_d(p, T_BGS);
    float w[3][8];
#pragma unroll
    for (int j = 0; j < 3; ++j) { const f32x4 a = *(const f32x4*)(p.short_conv_w + (size_t)(l * 3 + j) * BW + 8 * oct), b = *(const f32x4*)(p.short_conv_w + (size_t)(l * 3 + j) * BW + 8 * oct + 4);
        w[j][0] = a.x; w[j][1] = a.y; w[j][2] = a.z; w[j][3] = a.w; w[j][4] = b.x; w[j][5] = b.y; w[j][6] = b.z; w[j][7] = b.w; }
    const int r0 = row0 + tg * 8;
    float cx[10][8];
    { v4u ca[10];
#pragma unroll
      for (int i = 0; i < 10; ++i) { int r = r0 + i - 1; r = r < start ? start : (r >= start + len ? start + len - 1 : r); ca[i] = *(const GAS v4u*)(CX + (size_t)r * 256 + 8 * oct); }
#pragma unroll
      for (int i = 0; i < 10; ++i) unpack8(ca[i], cx[i]);
      const bool lo_ok = r0 - 1 >= start, hi_ok = r0 + 8 < start + len;
#pragma unroll
      for (int e = 0; e < 8; ++e) { cx[0][e] = lo_ok ? cx[0][e] : 0.f; cx[9][e] = hi_ok ? cx[9][e] : 0.f; } }
#pragma unroll
    for (int i = 0; i < 8; ++i) { const int r = r0 + i;
        const v4u bgw = *(const GAS v4u*)(BGS + (size_t)r * 256 + 8 * oct); float bg[8], y[8]; unpack8(bgw, bg);
#pragma unroll
        for (int e = 0; e < 8; ++e) y[e] = bg[e] * (w[0][e] * cx[i][e] + w[1][e] * cx[i + 1][e] + w[2][e] * cx[i + 2][e]);
        v4u o; o.x = pk2(y[0], y[1]); o.y = pk2(y[2], y[3]); o.z = pk2(y[4], y[5]); o.w = pk2(y[6], y[7]);
        *(GAS v4u*)((bf16_t*)(p.ws + WS_HY) + (size_t)r * DM + 256 + 8 * oct) = o; }
}

constexpr int MIX_ND = MTOT / 128, MIX_NC = MTOT / 64, MIX_NB = MTOT / 128, MIX_NU = MIX_ND + MIX_NC + MIX_NB, CW_MIXQ = 8192, NPF = 12;
__device__ __forceinline__ void mix_prefetch(Frame& F, int l, int u, v4u (&pf)[NPF]) {
    KPtrs& p = F.P(); const int tid = F.tid, lane = F.lane, wave = F.wave;
    if (u < MIX_ND) {
        const bf16_t* VV = ptile_d(p, T_VV) + (size_t)(u * 128 + wave * 16) * 256 + 4 * lane;
#pragma unroll
        for (int k = 0; k < 8; ++k) { const u32x2 a = *(const GAS u32x2*)(VV + (size_t)(2 * k) * 256), b = *(const GAS u32x2*)(VV + (size_t)(2 * k + 1) * 256); pf[k] = (v4u){a.x, a.y, b.x, b.y}; }
        pf[10] = *(const GAS v4u*)(p.smlp_ln_g + l * BW + 4 * lane); pf[11] = *(const GAS v4u*)(p.smlp_ln_b + l * BW + 4 * lane);
        asm volatile("; PF_D" ::: "memory");
    } else if (u < MIX_ND + MIX_NC) {
        const int row0 = (u - MIX_ND) * 64; int start, len; row_seq(row0, start, len);
        const bf16_t* GL = ptile_d(p, T_GLU);
#pragma unroll
        for (int k = 0; k < 6; ++k) { const int idx = tid + k * NWAVES * 64, i = idx >> 5, oct = idx & 31; int r = row0 - 15 + i; r = r < start ? start : (r >= start + len ? start + len - 1 : r);
            pf[k] = *(const GAS v4u*)(GL + (size_t)r * 256 + 8 * oct); }
        asm volatile("; PF_C" ::: "memory");
    }
}
__device__ __forceinline__ f32x4 asf4(const v4u& w) { return __builtin_bit_cast(f32x4, w); }

__device__ __forceinline__ void mix_unit_C(Frame& F, int l, int row0, v4u (&pf)[NPF], int nxt) {
    KPtrs& p = F.P(); const int tid = F.tid, lane = F.lane, wave = F.wave;
    int start, len; row_seq(row0, start, len);
    LAS float* glu = (LAS float*)F.lds;
#pragma unroll
    for (int k = 0; k < 6; ++k) { const int idx = tid + k * NWAVES * 64, i = idx >> 5, oct = idx & 31, r = row0 - 15 + i;
        if (i < 94) { const bool ok = r >= start && r < start + len; float fa[8]; unpack8(pf[k], fa);
            const f32x4 o0 = {ok ? fa[0] : 0.f, ok ? fa[1] : 0.f, ok ? fa[2] : 0.f, ok ? fa[3] : 0.f}, o1 = {ok ? fa[4] : 0.f, ok ? fa[5] : 0.f, ok ? fa[6] : 0.f, ok ? fa[7] : 0.f};
            *(LAS f32x4*)(glu + i * 256 + 8 * oct) = o0; *(LAS f32x4*)(glu + i * 256 + 8 * oct + 4) = o1; } }
    float wt[32]; u32x2 gate[8];
#pragma unroll
    for (int j = 0; j < 32; ++j) wt[j] = j < 31 ? p.conf_conv_w[(size_t)(l * 31 + j) * BW + (tid & 255)] : p.conf_conv_b[l * BW + (tid & 255)];
    { const bf16_t* GC = ptile_d(p, T_GC);
#pragma unroll
      for (int i = 0; i < 8; ++i) gate[i] = *(const GAS u32x2*)(GC + (size_t)(row0 + wave * 8 + i) * 256 + 4 * lane); }
    const f32x4 lg = *(const f32x4*)(p.conf_ln_g + l * BW + 4 * lane), lb = *(const f32x4*)(p.conf_ln_b + l * BW + 4 * lane);
    mix_prefetch(F, l, nxt, pf);
    LBAR();
    const int c = tid & 255, th = tid >> 8;
    float z[32];
#pragma unroll
    for (int hb = 0; hb < 2; ++hb) {
        float win[46];
#pragma unroll
        for (int i = 0; i < 46; ++i) win[i] = glu[(th * 32 + hb * 16 + i) * 256 + c];
#pragma unroll
        for (int i = 0; i < 16; ++i) z[hb * 16 + i] = wt[31];
#pragma unroll
        for (int j = 0; j < 31; ++j)
#pragma unroll
            for (int i = 0; i < 16; ++i) z[hb * 16 + i] += wt[j] * win[i + j];
    }
    LBAR();
#pragma unroll
    for (int i = 0; i < 32; ++i) glu[(th * 32 + i) * 256 + c] = z[i];
    LBAR();
#pragma unroll
    for (int i = 0; i < 8; ++i) { const int t = wave * 8 + i, r = row0 + t;
        const f32x4 zz = *(const LAS f32x4*)(glu + t * 256 + 4 * lane);
        const float mean = wave_sum((zz.x + zz.y) + (zz.z + zz.w)) * (1.f / 256.f);
        const f32x4 d = zz - mean;
        const float var = wave_sum((d.x * d.x + d.y * d.y) + (d.z * d.z + d.w * d.w)) * (1.f / 256.f);
        const float rstd = 1.0f / sqrtf(var + EPS);
        const f32x4 ln = d * rstd * lg + lb;
        const u32x2 gw = gate[i];
        u32x2 o; o.x = pk2(fsilu(ln.x) * bflo(gw.x), fsilu(ln.y) * bfhi(gw.x)); o.y = pk2(fsilu(ln.z) * bflo(gw.y), fsilu(ln.w) * bfhi(gw.y));
        *(GAS u32x2*)((bf16_t*)(p.ws + WS_HY) + (size_t)r * DM + 512 + 4 * lane) = o; }
    LBAR();
}

__device__ __forceinline__ void mix_unit_D(Frame& F, int l, int row0, v4u (&pf)[NPF], int nxt) {
    KPtrs& p = F.P(); const int lane = F.lane, wave = F.wave;
    constexpr int VS = 528;
    LAS unsigned char* vl = F.lds;
    const bf16_t* UG = ptile_d(p, T_UG);
    const int g = wave >> 1, ph = wave & 1, li = lane & 15, lg4 = lane >> 4;
    bf16x8 wf[4][4];
    { const bf16_t* W = (const bf16_t*)(p.ws + WS_WSB) + (size_t)(l * 4 + g) * 128 * 128;
#pragma unroll
      for (int ks = 0; ks < 4; ++ks)
#pragma unroll
          for (int pt = 0; pt < 4; ++pt) wf[ks][pt] = *(const GAS bf16x8*)(W + (size_t)(64 * ph + 16 * pt + li) * 128 + 32 * ks + 8 * lg4); }
    { const f32x4 lg = asf4(pf[10]), lb = asf4(pf[11]);
#pragma unroll
      for (int i = 0; i < 16; ++i) { const int q = wave * 16 + i; const u32x2 raw = (i & 1) ? (u32x2){pf[i >> 1].z, pf[i >> 1].w} : (u32x2){pf[i >> 1].x, pf[i >> 1].y};
        const f32x4 v = {bflo(raw.x), bfhi(raw.x), bflo(raw.y), bfhi(raw.y)};
        const float mean = wave_sum((v.x + v.y) + (v.z + v.w)) * (1.f / 256.f);
        const f32x4 d = v - mean;
        const float var = wave_sum((d.x * d.x + d.y * d.y) + (d.z * d.z + d.w * d.w)) * (1.f / 256.f);
        const float rstd = 1.0f / sqrtf(var + EPS);
        const f32x4 y = d * rstd * lg + lb;
        u32x2 o; o.x = pk2(y.x, y.y); o.y = pk2(y.z, y.w);
        *(LAS u32x2*)(vl + q * VS + 8 * lane) = o; } }
    LBAR();
    f32x4 acc[4][4];
#pragma unroll
    for (int a = 0; a < 4; ++a)
#pragma unroll
        for (int b = 0; b < 4; ++b) acc[a][b] = (f32x4){0.f, 0.f, 0.f, 0.f};
#pragma unroll
    for (int ks = 0; ks < 4; ++ks) {
        bf16x8 af[4];
#pragma unroll
        for (int ct = 0; ct < 4; ++ct) { LAS unsigned char* a = vl + (32 * ks + 8 * lg4 + (li >> 2)) * VS + (64 * g + 16 * ct + 4 * (li & 3)) * 2;
            const s16x4 lo = __builtin_amdgcn_ds_read_tr16_b64_v4i16((LAS s16x4*)a), hi = __builtin_amdgcn_ds_read_tr16_b64_v4i16((LAS s16x4*)(a + 4 * VS));
            af[ct] = (bf16x8){lo[0], lo[1], lo[2], lo[3], hi[0], hi[1], hi[2], hi[3]}; }
#pragma unroll
        for (int ct = 0; ct < 4; ++ct)
#pragma unroll
            for (int pt = 0; pt < 4; ++pt) acc[ct][pt] = __builtin_amdgcn_mfma_f32_16x16x32_bf16(af[ct], wf[ks][pt], acc[ct][pt], 0, 0, 0);
    }
    u32x2 uw[4][4]; float bs[4];
#pragma unroll
    for (int pt = 0; pt < 4; ++pt) { const int prow = 64 * ph + 16 * pt + li; const size_t r = (size_t)row0 + prow; bs[pt] = p.smlp_b[(l * 4 + g) * 128 + prow];
#pragma unroll
        for (int ct = 0; ct < 4; ++ct) { const int c = 64 * g + 16 * ct + 4 * lg4; uw[pt][ct] = *(const GAS u32x2*)(UG + r * 256 + c); } }
    mix_prefetch(F, l, nxt, pf);
#pragma unroll
    for (int pt = 0; pt < 4; ++pt) { const int prow = 64 * ph + 16 * pt + li; const size_t r = (size_t)row0 + prow;
#pragma unroll
        for (int ct = 0; ct < 4; ++ct) { const int c = 64 * g + 16 * ct + 4 * lg4;
            const f32x4 m = acc[ct][pt] + bs[pt]; const u32x2 u2 = uw[pt][ct];
            u32x2 o; o.x = pk2(bflo(u2.x) * m.x, bfhi(u2.x) * m.y); o.y = pk2(bflo(u2.y) * m.z, bfhi(u2.y) * m.w);
            *(GAS u32x2*)((bf16_t*)(p.ws + WS_HY) + r * DM + 768 + c) = o; } }
    LBAR();
}

__device__ __forceinline__ void phase_mix(Frame& F, int l) {
    gu32* ctr = F.ctl + CW_MIXQ + 64 * l;
    volatile LAS unsigned* Q = F.MISC;
    unsigned fetched = 0;
    if (F.tid == 0) { Q[0] = __hip_atomic_fetch_add(ctr, 1u, __ATOMIC_RELAXED, __HIP_MEMORY_SCOPE_AGENT); Q[1] = __hip_atomic_fetch_add(ctr, 1u, __ATOMIC_RELAXED, __HIP_MEMORY_SCOPE_AGENT); }
    LBAR();
    int cur = (int)Q[0], nxt = (int)Q[1];
    v4u pf[NPF];
    F.refresh();
    if (cur < MIX_NU) mix_prefetch(F, l, cur, pf);
#define MIX_ROUND(CALL) do { LBAR();   \
        if (F.tid == 0) fetched = __hip_atomic_fetch_add(ctr, 1u, __ATOMIC_RELAXED, __HIP_MEMORY_SCOPE_AGENT);   \
        F.refresh(); CALL; if (F.tid == 0) Q[0] = fetched; LBAR(); cur = nxt; nxt = (int)Q[0]; } while (0)
    while (cur < MIX_ND) MIX_ROUND(mix_unit_D(F, l, cur * 128, pf, nxt));
    while (cur < MIX_ND + MIX_NC) MIX_ROUND(mix_unit_C(F, l, (cur - MIX_ND) * 64, pf, nxt));
    while (cur < MIX_NU) MIX_ROUND(mix_unit_B(F, l, (cur - MIX_ND - MIX_NC) * 128));
#undef MIX_ROUND
}

constexpr size_t WS_REC = 212 * MiB, WS_OB16 = 476 * MiB;
constexpr int REC_BYTES = 53248, R_NW = 0, R_Q = 8192, R_U = 16384, R_VEC = 32768, R_ATTN = 33792, R_KT = 41984;
constexpr int NITEM = 2304;
constexpr int L_Q = 0, L_K = 4352, L_V = 8704, L_GKK = 13056, L_GQK = 17408, L_QB = 21760, L_KB = 24064, L_AO = 21760, L_AD = 26368, L_DF = 28928, L_SM = 30208, L_XS = 0, GS = 68, SMD = 256;

__device__ __forceinline__ float dpp_xor1(float v) { return __int_as_float(__builtin_amdgcn_mov_dpp(__float_as_int(v), 0xB1, 0xF, 0xF, true)); }

__device__ __forceinline__ void prep_decode(int item, int& b, int& h, int& row0) {
    if (item < 2048) { b = item >> 7; h = (item >> 5) & 3; const int n = item & 31; row0 = b * SEQ + 64 * n; }
    else { const int it = item - 2048; b = it >> 4; h = (it >> 2) & 3; const int n = it & 3; row0 = MLAT + b * CTXL + 64 * n; }
}
__device__ __forceinline__ void prep_load(Frame& F, int l, int item, v4u (&raw)[6], float (&abn)[4], v4u (&wq)[6]) {
    KPtrs& p = F.P(); int b, h, row0; prep_decode(item, b, h, row0); int start, len; row_seq(row0, start, len);
    const int tq = F.tid < 384 ? F.tid : 383, tg = tq / 24, o = tq % 24, part = o >> 3, oo = o & 7;
    const bf16_t* T = ptile_d(p, part) + h * 64 + 8 * oo;
#pragma unroll
    for (int i = 0; i < 6; ++i) { int r = row0 + 4 * tg - 1 + i; r = r < start ? start : (r >= start + len ? start + len - 1 : r); raw[i] = *(const GAS v4u*)(T + (size_t)r * 256); }
    if ((F.wave & 3) == 0) { const int dir = F.wave >> 2, tok = dir ? 63 - F.lane : F.lane; const float* AB = (const float*)(p.ws + WS_AB) + ((size_t)row0 + tok) * 16;
        abn[0] = AB[dir * 4 + h]; abn[1] = AB[8 + dir * 4 + h]; abn[2] = p.a_log[(l * 2 + dir) * 4 + h]; abn[3] = p.dt_bias[(l * 2 + dir) * 4 + h]; }
    { const float* wc = p.qkv_conv_w + (size_t)l * 3 * 768 + part * 256 + h * 64 + 8 * oo;
#pragma unroll
      for (int j = 0; j < 3; ++j) { wq[2 * j] = *(const GAS v4u*)(wc + j * 768); wq[2 * j + 1] = *(const GAS v4u*)(wc + j * 768 + 4); } }
}
__device__ __forceinline__ void prep_item(Frame& F, int l, int item, v4u (&raw)[6], float (&abn)[4], v4u (&wq)[6], int next_item) {
    KPtrs& p = F.P(); const int tid = F.tid, lane = F.lane, wave = F.wave;
    int b, h, row0; prep_decode(item, b, h, row0);
    int start, len; row_seq(row0, start, len);
    LAS float* lf = (LAS float*)F.lds;
    if (tid < 384) { const int tg = tid / 24, o = tid % 24, part = o >> 3, oo = o & 7;
        float w[3][8], x[6][8];
#pragma unroll
        for (int j = 0; j < 3; ++j) { const f32x4 w0 = __builtin_bit_cast(f32x4, wq[2 * j]), w1 = __builtin_bit_cast(f32x4, wq[2 * j + 1]);
            w[j][0] = w0.x; w[j][1] = w0.y; w[j][2] = w0.z; w[j][3] = w0.w; w[j][4] = w1.x; w[j][5] = w1.y; w[j][6] = w1.z; w[j][7] = w1.w; }
#pragma unroll
        for (int i = 0; i < 6; ++i) unpack8(raw[i], x[i]);
        const bool lo_ok = row0 + 4 * tg - 1 >= start, hi_ok = row0 + 4 * tg + 4 < start + len;
#pragma unroll
        for (int e = 0; e < 8; ++e) { x[0][e] = lo_ok ? x[0][e] : 0.f; x[5][e] = hi_ok ? x[5][e] : 0.f; }
#pragma unroll
        for (int t = 0; t < 4; ++t) { float a[8];
#pragma unroll
            for (int e = 0; e < 8; ++e) a[e] = fsilu(w[0][e] * x[t][e] + w[1][e] * x[t + 1][e] + w[2][e] * x[t + 2][e]);
            LAS float* dst = lf + part * 4352 + (4 * tg + t) * 68 + 8 * oo;
            *(LAS f32x4*)dst = (f32x4){a[0], a[1], a[2], a[3]}; *(LAS f32x4*)(dst + 4) = (f32x4){a[4], a[5], a[6], a[7]}; } }
    if ((wave & 3) == 0) { const int dir = wave >> 2, i = lane;
        const float sx = abn[0] + abn[3];
        const float sp = sx > 15.f ? sx : __builtin_amdgcn_logf(1.f + fexp(sx)) * 0.69314718056f;
        const float g = -fexp(abn[2]) * sp;
        const float beta = fsigmoid(abn[1]);
        float gc = g;
        gc += dpp_f<0x111>(gc); gc += dpp_f<0x112>(gc); gc += dpp_f<0x114>(gc); gc += dpp_f<0x118>(gc);
        gc += __int_as_float(__builtin_amdgcn_update_dpp(0, __float_as_int(gc), 0x142, 0xA, 0xF, false));
        gc += __int_as_float(__builtin_amdgcn_update_dpp(0, __float_as_int(gc), 0x143, 0xC, 0xF, false));
        LAS float* sm = lf + L_SM + dir * SMD; const float eg = fexp(gc); sm[i] = gc; sm[64 + i] = beta; sm[128 + i] = eg; sm[192 + i] = beta * eg; }
    prep_load(F, l, next_item, raw, abn, wq);
    LBAR();
    { const int row = tid >> 2, part = row >> 6, t = row & 63, qt = tid & 3; LAS float* src = lf + part * 4352 + t * 68 + 16 * qt;
      f32x4 v[4]; float ss = 0.f;
#pragma unroll
      for (int i = 0; i < 4; ++i) { v[i] = *(LAS f32x4*)(src + 4 * i); ss += (v[i].x * v[i].x + v[i].y * v[i].y) + (v[i].z * v[i].z + v[i].w * v[i].w); }
      ss += __shfl_xor(ss, 1); ss += __shfl_xor(ss, 2);
      const float sc = (1.0f / sqrtf(ss + EPS)) * (part == 0 ? 0.125f : 1.0f);
#pragma unroll
      for (int i = 0; i < 4; ++i) { v[i] = v[i] * sc; *(LAS f32x4*)(src + 4 * i) = v[i]; }
      LAS unsigned char* bdst = (LAS unsigned char*)(lf + (part ? L_KB : L_QB)) + t * 144 + 32 * qt;
      v4u o; o.x = pk2(v[0].x, v[0].y); o.y = pk2(v[0].z, v[0].w); o.z = pk2(v[1].x, v[1].y); o.w = pk2(v[1].z, v[1].w); *(LAS v4u*)bdst = o;
      o.x = pk2(v[2].x, v[2].y); o.y = pk2(v[2].z, v[2].w); o.z = pk2(v[3].x, v[3].y); o.w = pk2(v[3].z, v[3].w); *(LAS v4u*)(bdst + 16) = o; }
    LBAR();
    { const int mat = wave >> 2, it = wave & 3, li = lane & 15, g4 = lane >> 4;
      const LAS unsigned char* Ab = (const LAS unsigned char*)(lf + (mat ? L_QB : L_KB)); const LAS unsigned char* Kb = (const LAS unsigned char*)(lf + L_KB);
      bf16x8 af[2];
#pragma unroll
      for (int s2 = 0; s2 < 2; ++s2) af[s2] = *(const LAS bf16x8*)(Ab + (16 * it + li) * 144 + (32 * s2 + 8 * g4) * 2);
      LAS float* G = lf + (mat ? L_GQK : L_GKK);
#pragma unroll
      for (int jt = 0; jt < 4; ++jt) { f32x4 acc = {0.f, 0.f, 0.f, 0.f};
#pragma unroll
          for (int s2 = 0; s2 < 2; ++s2) { const bf16x8 bq = *(const LAS bf16x8*)(Kb + (16 * jt + li) * 144 + (32 * s2 + 8 * g4) * 2); acc = __builtin_amdgcn_mfma_f32_16x16x32_bf16(af[s2], bq, acc, 0, 0, 0); }
#pragma unroll
          for (int r = 0; r < 4; ++r) G[(16 * it + 4 * g4 + r) * GS + 16 * jt + li] = acc[r]; } }
    LBAR();
    const int dir = tid >> 8, td = tid & 255;
    const LAS float* sm = lf + L_SM + dir * SMD;
    unsigned char* rec = p.ws + WS_REC + (size_t)(item * 2 + dir) * REC_BYTES;
    { const int i = td >> 2, jq = td & 3, ti = dir ? 63 - i : i; const float gi = sm[i], bi = sm[64 + i];
      const LAS float* grow = lf + L_GKK + ti * GS + (dir ? 48 - 16 * jq : 16 * jq);
      float gv[16], gc[16];
#pragma unroll
      for (int k = 0; k < 4; ++k) { const f32x4 a = *(const LAS f32x4*)(grow + 4 * k), c = *(const LAS f32x4*)(sm + 16 * jq + 4 * k);
          gv[4 * k] = a.x; gv[4 * k + 1] = a.y; gv[4 * k + 2] = a.z; gv[4 * k + 3] = a.w; gc[4 * k] = c.x; gc[4 * k + 1] = c.y; gc[4 * k + 2] = c.z; gc[4 * k + 3] = c.w; }
      float val[16];
#pragma unroll
      for (int jj = 0; jj < 16; ++jj) { const int j = 16 * jq + jj; const float G = dir ? gv[15 - jj] : gv[jj];
          const float v = bi * G * fexp(fminf(gi - gc[jj], 0.f)); val[jj] = (i > j) ? v : 0.f; }
      { const bool below = jq < (i >> 4);
        v4u o0, o1; o0.x = below ? pk2(-val[0], -val[1]) : 0u; o0.y = below ? pk2(-val[2], -val[3]) : 0u; o0.z = below ? pk2(-val[4], -val[5]) : 0u; o0.w = below ? pk2(-val[6], -val[7]) : 0u;
        o1.x = below ? pk2(-val[8], -val[9]) : 0u; o1.y = below ? pk2(-val[10], -val[11]) : 0u; o1.z = below ? pk2(-val[12], -val[13]) : 0u; o1.w = below ? pk2(-val[14], -val[15]) : 0u;
        LAS unsigned char* ao = (LAS unsigned char*)(lf + L_AO) + dir * 9216 + i * 144 + 32 * jq; *(LAS v4u*)ao = o0; *(LAS v4u*)(ao + 16) = o1; }
      if (jq == (i >> 4)) { LAS float* ad = lf + L_AD + dir * 1280 + (i >> 4) * 320 + (i & 15) * 20;
#pragma unroll
          for (int k = 0; k < 4; ++k) *(LAS f32x4*)(ad + 4 * k) = (f32x4){val[4 * k], val[4 * k + 1], val[4 * k + 2], val[4 * k + 3]}; } }
#pragma unroll
    for (int k = 0; k < 2; ++k) { const int f = td + 256 * k, ms = f >> 6, ll = f & 63, m = ms >> 1, s = ms & 1, rr = 16 * m + (ll & 15), cb = 32 * s + 4 * (ll >> 4);
        float va[8], vq[8], vk[8];
        const int ti = dir ? 63 - rr : rr; const float gi = sm[rr];
#pragma unroll
        for (int hh = 0; hh < 2; ++hh) { const int c0 = cb + 16 * hh;
            const f32x4 g4 = *(const LAS f32x4*)(lf + L_GQK + ti * GS + (dir ? 60 - c0 : c0)), s4 = *(const LAS f32x4*)(sm + c0), q4 = *(const LAS f32x4*)(lf + L_Q + ti * 68 + c0);
            const float gq[4] = {dir ? g4.w : g4.x, dir ? g4.z : g4.y, dir ? g4.y : g4.z, dir ? g4.x : g4.w}, sc[4] = {s4.x, s4.y, s4.z, s4.w}, qq[4] = {q4.x, q4.y, q4.z, q4.w};
#pragma unroll
            for (int e = 0; e < 4; ++e) { const int c = c0 + e, tc = dir ? 63 - c : c;
                const float v = gq[e] * fexp(fminf(gi - sc[e], 0.f)); va[4 * hh + e] = (rr >= c) ? v : 0.f;
                vq[4 * hh + e] = qq[e];
                vk[4 * hh + e] = lf[L_K + tc * 68 + rr]; } }
        v4u o; o.x = pk2(va[0], va[1]); o.y = pk2(va[2], va[3]); o.z = pk2(va[4], va[5]); o.w = pk2(va[6], va[7]); *(GAS v4u*)(rec + R_ATTN + f * 16) = o;
        o.x = pk2(vq[0], vq[1]); o.y = pk2(vq[2], vq[3]); o.z = pk2(vq[4], vq[5]); o.w = pk2(vq[6], vq[7]); *(GAS v4u*)(rec + R_Q + f * 16) = o;
        o.x = pk2(vk[0], vk[1]); o.y = pk2(vk[2], vk[3]); o.z = pk2(vk[4], vk[5]); o.w = pk2(vk[6], vk[7]); *(GAS v4u*)(rec + R_KT + f * 16) = o; }
    if (td < 64) { float* vec = (float*)(rec + R_VEC); vec[td] = sm[128 + td]; vec[64 + td] = expf(sm[63] - sm[td]); if (td == 0) vec[128] = expf(sm[63]); }
    const int li = lane & 15, g4 = lane >> 4, nt0 = 2 * (wave & 3);
    f32x4 Rt[2][4];
#pragma unroll
    for (int t = 0; t < 2; ++t) { const int nt = nt0 + t; const LAS float* src = lf + (nt < 4 ? L_V + 16 * nt + li : L_K + 16 * (nt - 4) + li); const LAS float* scl = sm + (nt < 4 ? 64 : 192);
#pragma unroll
        for (int m = 0; m < 4; ++m) { const f32x4 sc = *(const LAS f32x4*)(scl + 16 * m + 4 * g4); const int i0 = 16 * m + 4 * g4;
            Rt[t][m] = (f32x4){src[(dir ? 63 - i0 : i0) * 68] * sc.x, src[(dir ? 62 - i0 : i0 + 1) * 68] * sc.y, src[(dir ? 61 - i0 : i0 + 2) * 68] * sc.z, src[(dir ? 60 - i0 : i0 + 3) * 68] * sc.w}; } }
    LBAR();
    if ((wave & 3) == 0) { const int blk = lane >> 4, c = lane & 15; const LAS float* Ad = lf + L_AD + dir * 1280 + blk * 320;
        float x[16];
#pragma unroll
        for (int r = 0; r < 16; ++r) x[r] = 0.f;
#pragma unroll
        for (int hb = 0; hb < 4; ++hb) {
            f32x4 arow[4][4];
#pragma unroll
            for (int rr = 0; rr < 4; ++rr)
#pragma unroll
                for (int q = 0; q < (4 * hb + rr + 3) / 4; ++q) arow[rr][q] = *(const LAS f32x4*)(Ad + (4 * hb + rr) * 20 + 4 * q);
#pragma unroll
            for (int rr = 0; rr < 4; ++rr) { const int r = 4 * hb + rr; float acc = (r == c) ? 1.f : 0.f;
#pragma unroll
                for (int q = 0; q < (r + 3) / 4; ++q) { const f32x4 a = arow[rr][q]; acc -= (a.x * x[4 * q] + a.y * x[4 * q + 1]) + (a.z * x[4 * q + 2] + a.w * x[4 * q + 3]); }
                x[r] = acc; } }
        LAS bf16_t* DF = (LAS bf16_t*)(lf + L_DF) + dir * 1280 + blk * 320;
#pragma unroll
        for (int r = 0; r < 16; ++r) DF[r * 20 + c] = f2bf(x[r]); }
    LBAR();
    { const LAS unsigned char* ao = (const LAS unsigned char*)(lf + L_AO) + dir * 9216; const LAS unsigned char* df = (const LAS unsigned char*)(lf + L_DF) + dir * 2560;
      const f32x4 zero4 = {0.f, 0.f, 0.f, 0.f};
      f32x4 X[2][4];
#pragma unroll
      for (int t = 0; t < 2; ++t)
#pragma unroll
          for (int m = 0; m < 4; ++m) X[t][m] = zero4;
#pragma unroll
      for (int m = 0; m < 4; ++m) {
          const u32x2 dw = *(const LAS u32x2*)(df + m * 640 + li * 40 + g4 * 8);
          const bf16x8 dfrag = __builtin_bit_cast(bf16x8, (v4u){dw.x, dw.y, 0u, 0u});
          f32x4 acc[2] = {Rt[0][m], Rt[1][m]};
#pragma unroll
          for (int s2 = 0; s2 < (m + 1) / 2; ++s2) { const u32x2 lo = *(const LAS u32x2*)(ao + (16 * m + li) * 144 + (32 * s2 + 4 * g4) * 2), hi = *(const LAS u32x2*)(ao + (16 * m + li) * 144 + (32 * s2 + 16 + 4 * g4) * 2);
              const bf16x8 afrag = __builtin_bit_cast(bf16x8, (v4u){lo.x, lo.y, hi.x, hi.y});
#pragma unroll
              for (int t = 0; t < 2; ++t) acc[t] = __builtin_amdgcn_mfma_f32_16x16x32_bf16(afrag, pack8(X[t][2 * s2], X[t][2 * s2 + 1]), acc[t], 0, 0, 0); }
#pragma unroll
          for (int t = 0; t < 2; ++t) X[t][m] = __builtin_amdgcn_mfma_f32_16x16x32_bf16(dfrag, pack8(acc[t], zero4), zero4, 0, 0, 0); }
      LAS float* XS = lf + L_XS + dir * 8448;
#pragma unroll
      for (int t = 0; t < 2; ++t)
#pragma unroll
          for (int m = 0; m < 4; ++m)
#pragma unroll
              for (int r = 0; r < 4; ++r) XS[(16 * m + 4 * g4 + r) * 132 + 16 * (nt0 + t) + li] = X[t][m][r]; }
    LBAR();
    { const LAS float* XS = lf + L_XS + dir * 8448;
#pragma unroll
      for (int k = 0; k < 2; ++k) { const int f = td + 256 * k, ms = f >> 6, ll = f & 63, m = ms >> 1, s = ms & 1, rr = 16 * m + (ll & 15), cb = 32 * s + 4 * (ll >> 4);
          float v[8];
#pragma unroll
          for (int e = 0; e < 8; ++e) v[e] = -XS[rr * 132 + 64 + cb + 16 * (e >> 2) + (e & 3)];
          v4u o; o.x = pk2(v[0], v[1]); o.y = pk2(v[2], v[3]); o.z = pk2(v[4], v[5]); o.w = pk2(v[6], v[7]); *(GAS v4u*)(rec + R_NW + f * 16) = o; }
#pragma unroll
      for (int k = 0; k < 4; ++k) { const int u = td + 256 * k, w = u >> 8, m = (u >> 6) & 3, ll = u & 63, r0 = 16 * m + 4 * (ll >> 4), c = 16 * w + (ll & 15);
          const f32x4 o = {XS[r0 * 132 + c], XS[(r0 + 1) * 132 + c], XS[(r0 + 2) * 132 + c], XS[(r0 + 3) * 132 + c]};
          *(GAS u32x2*)(rec + R_U + u * 8) = (u32x2){pk2(o.x, o.y), pk2(o.z, o.w)}; } }
    LBAR();
}
__device__ __forceinline__ void phase_prep(Frame& F, int l) {
    v4u raw[6], wq[6]; float abn[4] = {0.f, 0.f, 0.f, 0.f};
    F.refresh();
    if (F.vcu < NITEM) prep_load(F, l, F.vcu, raw, abn, wq);
    for (int it = F.vcu; it < NITEM; it += F.G) { F.refresh(); prep_item(F, l, it, raw, abn, wq, it + F.G < NITEM ? it + F.G : it); }
}

__device__ __forceinline__ void scan_rec(int b, int h, int dir, int step, int& cid, int& row0) {
    if (step < 4) { const int n = dir ? 3 - step : step; cid = 2048 + (b * 4 + h) * 4 + n; row0 = MLAT + b * CTXL + 64 * n; }
    else { const int n = dir ? 35 - step : step - 4; cid = (b * 4 + h) * 32 + n; row0 = b * SEQ + 64 * n; }
}
__device__ __forceinline__ void phase_scan(Frame& F, int l) {
    KPtrs& p = F.P();
    const int bx = (int)blockIdx.x, xq = bx >> 3, half = xq & 1, s = (bx & 7) * 16 + (xq >> 1), b = s >> 3, h = (s >> 1) & 3, dir = s & 1, lane = F.lane;
    constexpr int NSTEP = 36, PIECES = 7;
    if (F.wave >= 2) {
        const int lw = F.wave - 2;
#define SCAN_ISSUE(t_) do { int cid_, row0_; scan_rec(b, h, dir, (t_), cid_, row0_); const unsigned char* rec_ = p.ws + WS_REC + (size_t)(cid_ * 2 + dir) * REC_BYTES + lane * 16; \
            LAS unsigned char* slot_ = F.lds + ((t_) % 3) * REC_BYTES; \
            _Pragma("unroll") for (int k_ = 0; k_ < PIECES; ++k_) { const int j_ = lw + 6 * k_; if (j_ < 37) { \
                const int pc_ = j_ < 16 ? j_ : j_ < 20 ? 4 * half + j_ : j_ == 20 ? 32 : j_ + 12; \
                __builtin_amdgcn_global_load_lds((const GAS unsigned*)(rec_ + pc_ * 1024), (LAS unsigned*)(slot_ + pc_ * 1024), 16, 0, 0); } } } while (0)
        SCAN_ISSUE(0); SCAN_ISSUE(1);
        for (int t = 0; t < NSTEP; ++t) {
            if (t + 1 >= NSTEP) asm volatile("s_waitcnt vmcnt(0)" ::: "memory"); else if (lw == 0) asm volatile("s_waitcnt vmcnt(7)" ::: "memory"); else asm volatile("s_waitcnt vmcnt(6)" ::: "memory");
            asm volatile("" ::: "memory"); __builtin_amdgcn_s_barrier(); asm volatile("" ::: "memory");
            if (t + 2 < NSTEP) SCAN_ISSUE(t + 2);
        }
#undef SCAN_ISSUE
        return;
    }
    const int w = 2 * half + F.wave, li = lane & 15, g4 = lane >> 4;
    f32x4 S[4];
#pragma unroll
    for (int m = 0; m < 4; ++m) S[m] = (f32x4){0.f, 0.f, 0.f, 0.f};
    bf16_t* O = (bf16_t*)(p.ws + WS_OB16) + (size_t)dir * MTOT * 256;
    for (int step = 0; step < NSTEP; ++step) {
        int cid, row0; scan_rec(b, h, dir, step, cid, row0);
        asm volatile("s_waitcnt lgkmcnt(0)" ::: "memory"); __builtin_amdgcn_s_barrier(); asm volatile("" ::: "memory");
        const LAS unsigned char* rec = F.lds + (step % 3) * REC_BYTES;
        bf16x8 nw[4][2], qf[4][2], at[4][2], kt[4][2]; f32x4 av[4], ao[4], a2[4], egc4[4], edl4[4];
#pragma unroll
        for (int m = 0; m < 4; ++m) {
#pragma unroll
            for (int s2 = 0; s2 < 2; ++s2) { nw[m][s2] = *(const LAS bf16x8*)(rec + R_NW + ((m * 2 + s2) * 64 + lane) * 16); qf[m][s2] = *(const LAS bf16x8*)(rec + R_Q + ((m * 2 + s2) * 64 + lane) * 16); }
            { const u32x2 uw = *(const LAS u32x2*)(rec + R_U + ((w * 4 + m) * 64 + lane) * 8); av[m] = (f32x4){bflo(uw.x), bfhi(uw.x), bflo(uw.y), bfhi(uw.y)}; } ao[m] = (f32x4){0.f, 0.f, 0.f, 0.f}; }
        const float gl = *(const LAS float*)(rec + R_VEC + 512);
        bf16x8 Bs[2] = {pack8(S[0], S[1]), pack8(S[2], S[3])};
#pragma unroll
        for (int m = 0; m < 4; ++m)
#pragma unroll
            for (int s2 = 0; s2 < 2; ++s2) { av[m] = __builtin_amdgcn_mfma_f32_16x16x32_bf16(nw[m][s2], Bs[s2], av[m], 0, 0, 0); ao[m] = __builtin_amdgcn_mfma_f32_16x16x32_bf16(qf[m][s2], Bs[s2], ao[m], 0, 0, 0); }
#pragma unroll
        for (int m = 0; m < 4; ++m) {
#pragma unroll
            for (int s2 = 0; s2 < 2; ++s2) { at[m][s2] = *(const LAS bf16x8*)(rec + R_ATTN + ((m * 2 + s2) * 64 + lane) * 16); kt[m][s2] = *(const LAS bf16x8*)(rec + R_KT + ((m * 2 + s2) * 64 + lane) * 16); }
            edl4[m] = *(const LAS f32x4*)(rec + R_VEC + 256 + (16 * m + 4 * g4) * 4); egc4[m] = *(const LAS f32x4*)(rec + R_VEC + (16 * m + 4 * g4) * 4); a2[m] = (f32x4){0.f, 0.f, 0.f, 0.f}; }
        bf16x8 Bv[2] = {pack8(av[0], av[1]), pack8(av[2], av[3])};
        bf16x8 Bvs[2] = {pack8(av[0] * edl4[0], av[1] * edl4[1]), pack8(av[2] * edl4[2], av[3] * edl4[3])};
#pragma unroll
        for (int m = 0; m < 4; ++m) S[m] = S[m] * gl;
#pragma unroll
        for (int m = 0; m < 4; ++m)
#pragma unroll
            for (int s2 = 0; s2 < 2; ++s2) { a2[m] = __builtin_amdgcn_mfma_f32_16x16x32_bf16(at[m][s2], Bv[s2], a2[m], 0, 0, 0); S[m] = __builtin_amdgcn_mfma_f32_16x16x32_bf16(kt[m][s2], Bvs[s2], S[m], 0, 0, 0); }
#pragma unroll
        for (int m = 0; m < 4; ++m) { const f32x4 o = egc4[m] * ao[m] + a2[m];
#pragma unroll
            for (int r = 0; r < 4; ++r) { const int i = 16 * m + 4 * g4 + r, tok = dir ? 63 - i : i;
                O[(size_t)(row0 + tok) * 256 + h * 64 + 16 * w + li] = f2bf(o[r]); } }
    }
}

__device__ __forceinline__ void phase_comb(Frame& F, int l) {
    KPtrs& p = F.P(); const int lane = F.lane;
    const int gw = F.vcu * NWAVES + F.wave, NGW = F.G * NWAVES;
    const bf16_t* OF = (const bf16_t*)(p.ws + WS_OB16); const bf16_t* OB = OF + (size_t)MTOT * 256; const bf16_t* GA = ptile_d(p, T_GA);
    const f32x4 ng = *(const f32x4*)(p.gdn_norm_g + l * 64 + 4 * (lane & 15));
    const int nrow = (l == DEPTH - 1) ? MLAT : MTOT;
    u32x2 an, cn, gn;
    if (gw < nrow) { an = *(const GAS u32x2*)(OF + (size_t)gw * 256 + 4 * lane); cn = *(const GAS u32x2*)(OB + (size_t)gw * 256 + 4 * lane); gn = *(const GAS u32x2*)(GA + (size_t)gw * 256 + 4 * lane); }
    for (int r = gw; r < nrow; r += NGW) {
        const u32x2 a = an, c = cn, gt = gn;
        if (r + NGW < nrow) { const size_t r2 = (size_t)(r + NGW); an = *(const GAS u32x2*)(OF + r2 * 256 + 4 * lane); cn = *(const GAS u32x2*)(OB + r2 * 256 + 4 * lane); gn = *(const GAS u32x2*)(GA + r2 * 256 + 4 * lane); }
        const f32x4 o = {bflo(a.x) + bflo(c.x), bfhi(a.x) + bfhi(c.x), bflo(a.y) + bflo(c.y), bfhi(a.y) + bfhi(c.y)};
        float ss = (o.x * o.x + o.y * o.y) + (o.z * o.z + o.w * o.w);
        ss = row16_sum(ss);
        const float rs = 1.0f / sqrtf(ss * (1.f / 64.f) + EPS);
        u32x2 y; y.x = pk2(o.x * rs * ng.x * bflo(gt.x), o.y * rs * ng.y * bfhi(gt.x)); y.y = pk2(o.z * rs * ng.z * bflo(gt.y), o.w * rs * ng.w * bfhi(gt.y));
        *(GAS u32x2*)((bf16_t*)(p.ws + WS_HY) + (size_t)r * DM + 4 * lane) = y;
    }
}

constexpr int PH_FINAL = 1 + 7 * DEPTH, PH_END = PH_FINAL + 1;
struct Args { Ptrs p; int ph_lo, ph_hi; };
__global__ void __launch_bounds__(NWAVES * 64, 2) mega(Args args) {
    extern __shared__ __attribute__((aligned(16))) unsigned char lds[];
    Frame F;
    F.lds = (LAS unsigned char*)lds; F.MISC = (volatile LAS unsigned*)(F.lds + MISC_OFF);
    F.tid = threadIdx.x; F.lane = F.tid & 63; F.wave = __builtin_amdgcn_readfirstlane(F.tid >> 6);
    F.G = gridDim.x; { const int bx = blockIdx.x; F.vcu = (F.G % 8 == 0) ? (bx % 8) * (F.G / 8) + bx / 8 : bx; }
    F.ctl = (gu32*)(args.p.ws + WS_CTL);
    for (int u = F.tid; u < (LDS_BYTES - LDSCTL_OFF) / 4; u += NWAVES * 64) ((LAS unsigned*)(F.lds + LDSCTL_OFF))[u] = 0u;
    __syncthreads();
    const bool multi = args.ph_hi - args.ph_lo > 1;
    XcdBarrier bar; bar.bar = (unsigned*)(F.ctl + CW_BAR); bar.x = 0; bar.st = nullptr;
    if (multi) bar = xcd_barrier_post((unsigned*)(F.ctl + CW_BAR), F.MISC + 8);
    for (int ph = args.ph_lo; ph < args.ph_hi; ++ph) {
        F.refresh();
#if PROBE_S >= 0
        const bool amp = (PROBE_S == 7) ? (ph == 0) : (PROBE_S == 8) ? (ph == PH_FINAL) : (ph > 0 && ph < PH_FINAL && (ph - 1) % 7 == PROBE_S);
        const unsigned long long t0 = __builtin_amdgcn_s_memrealtime();
#endif
        if (ph == 0) phase_pre(F);
        else if (ph == PH_FINAL) phase_final(F);
        else { const int l = (ph - 1) / 7, s = (ph - 1) % 7;
            if (s == 0) phase_norm(F, l);
            else if (s == 1) phase_gemm1(F, l);
            else if (s == 2) phase_mix(F, l);
            else if (s == 3) phase_prep(F, l);
            else if (s == 4) phase_scan(F, l);
            else if (s == 5) phase_comb(F, l);
            else if (s == 6) phase_gemm2(F, l);
        }
        if (ph + 1 < args.ph_hi) xcd_barrier(bar);
#if PROBE_S >= 0
        if (amp) { const unsigned long long dt = __builtin_amdgcn_s_memrealtime() - t0; while (__builtin_amdgcn_s_memrealtime() - t0 < 2 * dt) __builtin_amdgcn_s_sleep(4); }
#endif
    }
}

extern "C" void kernel_launch(void* const* d_in, const int* in_sizes, int n_in, void* d_out, int out_size, void* d_ws, size_t ws_size, hipStream_t stream) {
    static int grid = 0;
    if (grid == 0) {
        if (n_in != 23 || out_size != MLAT * DM || ws_size < WS_END) { fprintf(stderr, "kernel_launch: unexpected shapes (n_in %d out %d ws %zu)\n", n_in, out_size, ws_size); grid = -1; return; }
        int dev = 0, cus = 0;
        if (hipGetDevice(&dev) != hipSuccess || hipDeviceGetAttribute(&cus, hipDeviceAttributeMultiprocessorCount, dev) != hipSuccess) { grid = -1; return; }
        if (hipFuncSetAttribute((const void*)mega, hipFuncAttributeMaxDynamicSharedMemorySize, LDS_BYTES) != hipSuccess) { fprintf(stderr, "kernel_launch: hipFuncSetAttribute failed\n"); grid = -1; return; }
        grid = cus;
        if (grid != 256) fprintf(stderr, "kernel_launch: %d CUs (built for 256)\n", grid);
    }
    if (grid < 0) return;
    hipMemsetAsync((char*)d_ws + WS_CTL, 0, CTL_ZERO_BYTES, stream);
    Args a{};
    const float** f = (const float**)&a.p;
    for (int i = 0; i < 23; ++i) f[i] = (const float*)d_in[i];
    a.p.out = (float*)d_out; a.p.ws = (unsigned char*)d_ws;
    a.ph_lo = 0; a.ph_hi = PH_END;
    hipLaunchKernelGGL(mega, dim3(grid), dim3(NWAVES * 64), LDS_BYTES, stream, a);
}
```

```cpp
#include <hip/hip_runtime.h>
#ifndef PROBE_S
#define PROBE_S (-1)
#endif
#include <cstdio>
#include <cstdint>

typedef unsigned short bf16_t;
__device__ __forceinline__ float bf2f(bf16_t v) { return __uint_as_float(((unsigned)v) << 16); }
typedef __bf16 nbf16x2 __attribute__((ext_vector_type(2)));
typedef __bf16 nbf16x8 __attribute__((ext_vector_type(8)));
typedef float nf32x2 __attribute__((ext_vector_type(2)));
typedef float nf32x8 __attribute__((ext_vector_type(8)));
__device__ __forceinline__ bf16_t f2bf(float f) { return __builtin_bit_cast(bf16_t, (__bf16)f); }

constexpr int DM = 1024, NB = 16, SEQ = 2048, DEPTH = 4, CTXL = 256, HD = 64, BW = 256, HA = 4;
constexpr int INC = 3600, NPC = 3584, NTILE = 10;
constexpr int MLAT = NB * SEQ, MCTX = NB * CTXL, MTOT = MLAT + MCTX;
constexpr float EPS = 1e-6f;
__device__ __constant__ int c_gt_col[14]   = {0, 256, 512, 2576,   784, 784 + 128,    1040, 1040 + 128,  1552, 1552 + 128,  2064, 2064 + 128,  2320, 3088};
__device__ __constant__ int c_gt_delta[14] = {0, 0,   0,   0,      2048, 2048,        256, 256,          256, 256,          1280, 1280,        0,    0};
enum { T_Q = 0, T_K = 1, T_V = 2, T_GA = 3, T_BGS = 4, T_CX = 5, T_GLU = 6, T_UG = 7, T_VV = 8, T_GC = 9 };

constexpr size_t MiB = 1u << 20;
constexpr size_t WS_CTL = 0, WS_MOD = 1 * MiB, WS_AB = 2 * MiB, WS_GB = 5 * MiB, WS_STAT = 8 * MiB, WS_XC = 16 * MiB, WS_WIN = 32 * MiB, WS_WOUT = 60 * MiB,
                 WS_HY = 68 * MiB, WS_P = 140 * MiB, WS_OFB = 392 * MiB, WS_END = 512 * MiB;
constexpr size_t PTILE_ELEMS = (size_t)MTOT * 256;
constexpr size_t WS_QKV = WS_P + 4 * PTILE_ELEMS * 2;

struct Ptrs {
    const float *x, *c, *ctx, *c_ctx, *norm_g, *w_ada, *b_ada, *w_in, *qkv_conv_w, *a_log, *dt_bias, *gdn_norm_g, *short_conv_w, *conf_conv_w, *conf_conv_b,
        *conf_ln_g, *conf_ln_b, *smlp_ln_g, *smlp_ln_b, *smlp_w, *smlp_b, *w_out, *final_g;
    float* out; unsigned char* ws;
};

__device__ __forceinline__ float silu_f(float x) { return x / (1.f + expf(-x)); }
__device__ __forceinline__ float sigmoid_f(float x) { return 1.f / (1.f + expf(-x)); }
__device__ __forceinline__ float softplus_f(float x) { return x > 20.f ? x : log1pf(expf(x)); }
__device__ __forceinline__ float fexp(float x) { return __builtin_amdgcn_exp2f(x * 1.44269504089f); }
__device__ __forceinline__ float fsigmoid(float x) { return __builtin_amdgcn_rcpf(1.f + fexp(-x)); }
__device__ __forceinline__ float fsilu(float x) { return x * fsigmoid(x); }

__device__ __forceinline__ float block_sum256(float v, float* red) {
#pragma unroll
    for (int o = 32; o > 0; o >>= 1) v += __shfl_xor(v, o);
    __syncthreads();
    if ((threadIdx.x & 63) == 0) red[threadIdx.x >> 6] = v;
    __syncthreads();
    return red[0] + red[1] + red[2] + red[3];
}
template <int CTRL> __device__ __forceinline__ float dpp_f(float v) { return __int_as_float(__builtin_amdgcn_mov_dpp(__float_as_int(v), CTRL, 0xF, 0xF, true)); }
__device__ __forceinline__ float row16_sum(float v) {
    v += dpp_f<0xB1>(v); v += dpp_f<0x4E>(v); v += dpp_f<0x141>(v); v += dpp_f<0x140>(v); return v; }
__device__ __forceinline__ float wave_sum(float v) {
    v = row16_sum(v);
    { auto r = __builtin_amdgcn_permlane16_swap(__float_as_uint(v), __float_as_uint(v), false, false); v = __uint_as_float(r[0]) + __uint_as_float(r[1]); }
    { auto r = __builtin_amdgcn_permlane32_swap(__float_as_uint(v), __float_as_uint(v), false, false); v = __uint_as_float(r[0]) + __uint_as_float(r[1]); }
    return v; }

__device__ __forceinline__ void row_seq(int row, int& start, int& len) { if (row < MLAT) { start = row & ~(SEQ - 1); len = SEQ; } else { start = row & ~(CTXL - 1); len = CTXL; } }

namespace pg8 {
#define PG8_LAS __attribute__((address_space(3)))
typedef unsigned short bf16_t;
typedef short bf16x8 __attribute__((ext_vector_type(8)));
typedef float f32x4 __attribute__((ext_vector_type(4)));
typedef unsigned u32x4 __attribute__((ext_vector_type(4)));
constexpr int BM = 256, BK = 64, HALF = 128, HTB = HALF * BK * 2  , STAGE_BYTES = 8 * HTB, NXCD = 8, WGM = 8;

__host__ __device__ __forceinline__ int lds_byte(int r, int c) { const int st = (r >> 4) * 2 + (c >> 5), rr = r & 15, cc = c & 31, ob = rr * 64 + cc * 2; return st * 1024 + (ob ^ (((ob >> 9) & 1) << 5)); }
__host__ __device__ __forceinline__ void stage_rc(int b, int& R, int& C) { const int st = b / 1024, sb = b % 1024, swz = sb ^ (((sb >> 9) & 1) << 5); R = (st >> 1) * 16 + swz / 64; C = (st & 1) * 32 + (swz % 64) / 2; }
__host__ __device__ __forceinline__ int perm32(int rho) { const int n = rho >> 4, i = rho & 15; return 8 * (i >> 2) + 4 * n + (i & 3); }

struct Unit { int pm, pn; };
struct Gemm { const bf16_t* A; const bf16_t* Bt; int M, N, K; };

struct StaticOrder {
    int nM, nN, nwg, G, c;
    __host__ __device__ void init(int M, int N, int G_, int c_) { nM = M / BM; nN = N / BM; nwg = nM * nN; G = G_; c = c_; }
    __host__ __device__ bool next(int i, Unit& u) const {
        const long L = (long)i * G + c; if (L >= nwg) return false;
        int wgid = (int)L; { const int q = nwg / NXCD, r = nwg % NXCD, xcd = wgid % NXCD, off = wgid / NXCD; wgid = (xcd < r ? xcd * (q + 1) : r * (q + 1) + (xcd - r) * q) + off; }
        const int nig = WGM * nN, gid = wgid / nig, fm = gid * WGM, gsz = (nM - fm) < WGM ? (nM - fm) : WGM;
        u.pm = fm + ((wgid % nig) % gsz); u.pn = (wgid % nig) / gsz; return true;
    }
    __device__ __forceinline__ void a_ready(const Unit&) const {}
    __device__ __forceinline__ void done(const Unit&) const {}
};


__device__ __forceinline__ unsigned cvt_pk_bf16(float lo, float hi) { return __builtin_bit_cast(unsigned, __builtin_convertvector((nf32x2){lo, hi}, nbf16x2)); }
struct EpiP {
    static constexpr bool PERM = true, AFTER_DRAIN = false;
    static constexpr int NVM = 16;
    bf16_t* P; size_t tile_elems;
    __device__ __forceinline__ void operator()(const f32x4 (&acc)[2][2][4][2], const Unit& u, int wr, int wc, int fr, int fq) const {
        const int row0 = u.pm * BM + wr * 64 + fr, g = u.pn;
        if (g < 4 || g > 11) {
            bf16_t* base = P + (size_t)(g < 4 ? g : g - 4) * tile_elems + wc * 32 + 8 * fq + (size_t)row0 * 256;
            if (g == 3 || g == 13) plain<true>(acc, base); else plain<false>(acc, base);
        } else {
            const int pr = (g - 4) >> 1;
            bf16_t* base = P + (size_t)(4 + pr) * tile_elems + 128 * (g & 1) + wc * 16 + 4 * fq + (size_t)row0 * 256;
            if (pr == 1) pairs<1>(acc, base); else if (pr == 2) pairs<2>(acc, base); else pairs<0>(acc, base);
        }
    }
    template <bool GATE> __device__ __forceinline__ void plain(const f32x4 (&acc)[2][2][4][2], bf16_t* base) const {
#pragma unroll
        for (int ai = 0; ai < 2; ++ai)
#pragma unroll
            for (int m = 0; m < 4; ++m) { bf16_t* rowp = base + (size_t)(ai * HALF + m * 16) * 256;
#pragma unroll
                for (int bj = 0; bj < 2; ++bj) { f32x4 v0 = acc[ai][bj][m][0], v1 = acc[ai][bj][m][1];
                    if (GATE) {
#pragma unroll
                        for (int e = 0; e < 4; ++e) { v0[e] = v0[e] * __builtin_amdgcn_rcpf(1.f + __builtin_amdgcn_exp2f(-1.44269504089f * v0[e])); v1[e] = v1[e] * __builtin_amdgcn_rcpf(1.f + __builtin_amdgcn_exp2f(-1.44269504089f * v1[e])); } }
                    u32x4 w; w.x = cvt_pk_bf16(v0[0], v0[1]); w.y = cvt_pk_bf16(v0[2], v0[3]); w.z = cvt_pk_bf16(v1[0], v1[1]); w.w = cvt_pk_bf16(v1[2], v1[3]);
                    *(u32x4*)(rowp + bj * HALF) = w; } }
    }
    template <int OP> __device__ __forceinline__ void pairs(const f32x4 (&acc)[2][2][4][2], bf16_t* base) const {
#pragma unroll
        for (int ai = 0; ai < 2; ++ai)
#pragma unroll
            for (int m = 0; m < 4; ++m) { bf16_t* rowp = base + (size_t)(ai * HALF + m * 16) * 256;
#pragma unroll
                for (int bj = 0; bj < 2; ++bj) { const f32x4 v0 = acc[ai][bj][m][0], v1 = acc[ai][bj][m][1];
                    const float a4[4] = {v0[0], v0[2], v1[0], v1[2]}, b4[4] = {v0[1], v0[3], v1[1], v1[3]}; float o[4];
#pragma unroll
                    for (int e = 0; e < 4; ++e) {
                        if (OP == 1) o[e] = a4[e] * b4[e];
                        else { const float sg = __builtin_amdgcn_rcpf(1.f + __builtin_amdgcn_exp2f(-1.44269504089f * b4[e])); o[e] = OP == 2 ? a4[e] * sg : a4[e] * (b4[e] * sg); } }
                    typedef unsigned u32x2v __attribute__((ext_vector_type(2)));
                    u32x2v w; w.x = cvt_pk_bf16(o[0], o[1]); w.y = cvt_pk_bf16(o[2], o[3]);
                    *(u32x2v*)(rowp + bj * 64) = w; } }
    }
};
struct OneUnit {
    Unit u0;
    __device__ __forceinline__ bool next(int i, Unit& u) const { if (i != 0) return false; u = u0; return true; }
    __device__ __forceinline__ void a_ready(const Unit&) const {}
    __device__ __forceinline__ void done(const Unit&) const {}
};
struct EpiResid {
    static constexpr bool PERM = true, AFTER_DRAIN = false;
    static constexpr int NVM = 32;
    const void* x_old; bf16_t* x_new; const void* xc_old; bf16_t* xc_new; const float* mod_l; int odd, mlat, seq, dm, f32in, row_off;
    __device__ __forceinline__ void operator()(f32x4 (&acc)[2][2][4][2], const Unit& u, int wr, int wc, int fr, int fq) const {
        const bool lat = row_off + u.pm * BM < mlat;
        if (f32in) { if (lat) body<true, true>(acc, u, wr, wc, fr, fq); else body<true, false>(acc, u, wr, wc, fr, fq); }
        else { if (lat) body<false, true>(acc, u, wr, wc, fr, fq); else body<false, false>(acc, u, wr, wc, fr, fq); }
    }
    template <bool F32IN, bool LAT> __device__ __forceinline__ void body(f32x4 (&acc)[2][2][4][2], const Unit& u, int wr, int wc, int fr, int fq) const {
        const int rbase = row_off + u.pm * BM; const int b = LAT ? rbase / seq : 16;
        const int col = u.pn * BM + wc * 32 + 8 * fq;
        { const float* gate = mod_l + (size_t)b * 3072 + 2048 + col;
#pragma unroll
          for (int bj = 0; bj < 2; ++bj)
#pragma unroll
            for (int n = 0; n < 2; ++n) { const f32x4 g = *(const f32x4*)(gate + bj * HALF + 4 * n);
#pragma unroll
                for (int ai = 0; ai < 2; ++ai)
#pragma unroll
                    for (int m = 0; m < 4; ++m) acc[ai][bj][m][n] = acc[ai][bj][m][n] * g; } }
        const void* ob = LAT ? x_old : xc_old; bf16_t* nb = LAT ? x_new : xc_new;
        constexpr int NA = F32IN ? 1 : 2;
#pragma unroll
        for (int h = 0; h < 2 / NA; ++h) {
            unsigned offs[NA][4]; u32x4 raw[NA][4][2]; f32x4 rawf[F32IN ? 4 : 1][2][2];
#pragma unroll
            for (int a = 0; a < NA; ++a)
#pragma unroll
                for (int m = 0; m < 4; ++m) { const int r = rbase + (h + a) * HALF + wr * 64 + m * 16 + fr;
                    if (LAT) { const int tp = r % seq; const int tq = (tp & 31) * 64 + (tp >> 5); const int t = odd ? tq : tp; offs[a][m] = (unsigned)(((r / seq) * seq + t) * dm + col); }
                    else offs[a][m] = (unsigned)((r - mlat) * dm + col); }
#pragma unroll
            for (int a = 0; a < NA; ++a)
#pragma unroll
                for (int m = 0; m < 4; ++m)
#pragma unroll
                    for (int bj = 0; bj < 2; ++bj) {
                        if constexpr (F32IN) { rawf[m][bj][0] = *(const f32x4*)((const float*)ob + offs[a][m] + bj * HALF); rawf[m][bj][1] = *(const f32x4*)((const float*)ob + offs[a][m] + bj * HALF + 4); }
                        else raw[a][m][bj] = *(const u32x4*)((const bf16_t*)ob + offs[a][m] + bj * HALF); }
#pragma unroll
            for (int a = 0; a < NA; ++a)
#pragma unroll
                for (int m = 0; m < 4; ++m)
#pragma unroll
                    for (int bj = 0; bj < 2; ++bj) { f32x4 o0, o1;
                        if constexpr (F32IN) { o0 = rawf[m][bj][0]; o1 = rawf[m][bj][1]; }
                        else { const u32x4 w = raw[a][m][bj];
                            o0 = (f32x4){__uint_as_float(w.x << 16), __uint_as_float(w.x & 0xffff0000u), __uint_as_float(w.y << 16), __uint_as_float(w.y & 0xffff0000u)};
                            o1 = (f32x4){__uint_as_float(w.z << 16), __uint_as_float(w.z & 0xffff0000u), __uint_as_float(w.w << 16), __uint_as_float(w.w & 0xffff0000u)}; }
                        const f32x4 v0 = o0 + acc[h + a][bj][m][0], v1 = o1 + acc[h + a][bj][m][1];
                        u32x4 w; w.x = cvt_pk_bf16(v0[0], v0[1]); w.y = cvt_pk_bf16(v0[2], v0[3]); w.z = cvt_pk_bf16(v1[0], v1[1]); w.w = cvt_pk_bf16(v1[2], v1[3]);
                        *(u32x4*)(nb + offs[a][m] + bj * HALF) = w; }
            asm volatile("" ::: "memory");
        }
    }
};
template <class Epi, class Sched, bool ALIGN_EPI = false, bool SP2 = false>
__device__ __forceinline__ void gemm_phase(PG8_LAS unsigned char* lds, const Gemm g, const Sched& S, const Epi& E) {
    int tid_ = threadIdx.x; asm volatile("" : "+v"(tid_));
    const int tid = tid_, wid = __builtin_amdgcn_readfirstlane(tid >> 6), lane = tid & 63, wr = wid >> 2, wc = wid & 3, fr = lane & 15, fq = lane >> 4;
    const int K = g.K, nt = K / BK;
    constexpr bool DEFER = ALIGN_EPI && SP2;
    unsigned voffA, voffB;
    { int R, C; stage_rc(tid * 16, R, C); const int Rb = Epi::PERM ? ((R & ~31) + perm32(R & 31)) : R;
        voffA = (unsigned)(R * K + C) * 2u; voffB = (unsigned)(Rb * K + C) * 2u; }
    const size_t qstep = (size_t)64 * K * 2;
    const size_t kstep = (size_t)(BK * 2);
    const size_t hstep = (size_t)HALF * K * 2;
    const size_t tstep = 2 * hstep;
    const unsigned ldsw = (unsigned)wid * 1024u;
    const int aoff = lds_byte(wr * 64 + fr, fq * 8), boff = lds_byte(wc * 32 + fr, fq * 8);
#define PG8_SA(b, h) (((b) * 2 + (h)) * HTB)
#define PG8_SB(b, h) ((4 + (b) * 2 + (h)) * HTB)
#define PG8_STAGE(bufoff, gbase, voff) do { const char* sb_ = (const char*)(gbase); asm volatile("" : "+s"(sb_));     \
        _Pragma("unroll") for (int _i = 0; _i < 2; ++_i) \
        __builtin_amdgcn_global_load_lds((const unsigned*)(sb_ + (size_t)_i * qstep + (voff)), (PG8_LAS unsigned*)(lds + (bufoff) + ldsw + _i * 8192), 16, 0, 0); } while (0)
#define PG8_LDA(dst, b, h) do { _Pragma("unroll") for (int m = 0; m < 4; ++m) _Pragma("unroll") for (int k = 0; k < 2; ++k) dst[m][k] = *(const PG8_LAS bf16x8*)(lds + PG8_SA(b, h) + aoff + m * 2048 + k * 1024); } while (0)
#define PG8_LDB(dst, b, h) do { _Pragma("unroll") for (int n = 0; n < 2; ++n) _Pragma("unroll") for (int k = 0; k < 2; ++k) dst[n][k] = *(const PG8_LAS bf16x8*)(lds + PG8_SB(b, h) + boff + n * 2048 + k * 1024); } while (0)
#define PG8_MMA(ai, bj, At, Bt) do { __builtin_amdgcn_s_setprio(1); _Pragma("unroll") for (int m = 0; m < 4; ++m) _Pragma("unroll") for (int n = 0; n < 2; ++n) _Pragma("unroll") for (int k = 0; k < 2; ++k) \
        acc[ai][bj][m][n] = __builtin_amdgcn_mfma_f32_16x16x32_bf16(Bt[n][k], At[m][k], acc[ai][bj][m][n], 0, 0, 0); __builtin_amdgcn_s_setprio(0); } while (0)
#define PG8_MMAZ(ai, bj, At, Bt) do { __builtin_amdgcn_s_setprio(1); _Pragma("unroll") for (int m = 0; m < 4; ++m) _Pragma("unroll") for (int n = 0; n < 2; ++n) { \
        acc[ai][bj][m][n] = __builtin_amdgcn_mfma_f32_16x16x32_bf16(Bt[n][0], At[m][0], (f32x4){0.f, 0.f, 0.f, 0.f}, 0, 0, 0); \
        acc[ai][bj][m][n] = __builtin_amdgcn_mfma_f32_16x16x32_bf16(Bt[n][1], At[m][1], acc[ai][bj][m][n], 0, 0, 0); } __builtin_amdgcn_s_setprio(0); } while (0)
#define PG8_MMAX(FR, ai, bj, At, Bt) do { if (FR) PG8_MMAZ(ai, bj, At, Bt); else PG8_MMA(ai, bj, At, Bt); } while (0)
#define PG8_WAIT_V(n) asm volatile("s_waitcnt vmcnt(" #n ")" ::: "memory")
#define PG8_WAIT_L(n) asm volatile("s_waitcnt lgkmcnt(" #n ")" ::: "memory")
#define PG8_WAIT_VX(f) do { if (f) asm volatile("s_waitcnt vmcnt(%0)" :: "i"(8 + Epi::NVM) : "memory"); else PG8_WAIT_V(8); } while (0)
#define PG8_BAR __builtin_amdgcn_s_barrier()
#define PG8_SCHED __builtin_amdgcn_sched_barrier(0)
    Unit cur, nxt; int ui = 0;
    if (!S.next(0, cur)) return;
    f32x4 acc[2][2][4][2];
    if constexpr (!DEFER) {
#pragma unroll
    for (int a = 0; a < 2; ++a)
#pragma unroll
        for (int b = 0; b < 2; ++b)
#pragma unroll
            for (int m = 0; m < 4; ++m)
#pragma unroll
                for (int n = 0; n < 2; ++n) acc[a][b][m][n] = (f32x4){0.f, 0.f, 0.f, 0.f};
    }
    bf16x8 At[4][2], B0[2][2], B1[2][2];
    const char* cA = (const char*)g.A + (size_t)cur.pm * tstep; const char* cB = (const char*)g.Bt + (size_t)cur.pn * tstep;
    S.a_ready(cur);
    if constexpr (DEFER) {
        PG8_STAGE(PG8_SB(0, 0), cB, voffB); PG8_STAGE(PG8_SB(0, 1), cB + hstep, voffB); PG8_STAGE(PG8_SA(0, 0), cA, voffA); PG8_STAGE(PG8_SA(0, 1), cA + hstep, voffA);
        PG8_STAGE(PG8_SB(1, 0), cB + kstep, voffB); PG8_STAGE(PG8_SB(1, 1), cB + hstep + kstep, voffB); PG8_STAGE(PG8_SA(1, 0), cA + kstep, voffA); PG8_STAGE(PG8_SA(1, 1), cA + hstep + kstep, voffA);
        PG8_WAIT_V(0); PG8_BAR;
        if (wr == 1) PG8_BAR;
    } else if constexpr (SP2) {
        PG8_STAGE(PG8_SB(0, 0), cB, voffB); PG8_STAGE(PG8_SB(0, 1), cB + hstep, voffB); PG8_STAGE(PG8_SA(0, 0), cA, voffA); PG8_STAGE(PG8_SA(0, 1), cA + hstep, voffA);
        if (wr == 1) PG8_BAR;
        PG8_WAIT_V(2); PG8_BAR;
        PG8_STAGE(PG8_SB(1, 0), cB + kstep, voffB); PG8_STAGE(PG8_SA(1, 0), cA + kstep, voffA); PG8_STAGE(PG8_SB(1, 1), cB + hstep + kstep, voffB);
        PG8_WAIT_V(6); PG8_BAR;
    } else {
        PG8_STAGE(PG8_SB(0, 0), cB, voffB); PG8_STAGE(PG8_SA(0, 0), cA, voffA); PG8_STAGE(PG8_SB(0, 1), cB + hstep, voffB); PG8_STAGE(PG8_SA(0, 1), cA + hstep, voffA);
        if (wr == 1) PG8_BAR;
        PG8_WAIT_V(4); PG8_BAR;
        PG8_STAGE(PG8_SB(1, 0), cB + kstep, voffB); PG8_STAGE(PG8_SA(1, 0), cA + kstep, voffA); PG8_STAGE(PG8_SB(1, 1), cB + hstep + kstep, voffB);
        PG8_WAIT_V(6); PG8_BAR;
    }
    for (;;) {
        const bool has_next = S.next(ui + 1, nxt);
        const char* nA = has_next ? (const char*)g.A + (size_t)nxt.pm * tstep : cA; const char* nB = has_next ? (const char*)g.Bt + (size_t)nxt.pn * tstep : cB;
#define PG8_ITER_SP2(FR) do { \
            const bool last = (t == nt - 2); \
            const char* a1 = cA + (size_t)(t + 1) * kstep;                                             \
            const char* a2 = last ? nA : cA + (size_t)(t + 2) * kstep; const char* b2 = last ? nB : cB + (size_t)(t + 2) * kstep;     \
            const char* a3 = a2 + kstep; const char* b3 = b2 + kstep;                                \
            if (last && has_next) S.a_ready(nxt); \
              \
            PG8_LDB(B0, 0, 0); PG8_LDB(B1, 0, 1); PG8_SCHED; PG8_LDA(At, 0, 0); if (!(FR)) PG8_STAGE(PG8_SA(1, 1), a1 + hstep, voffA); \
            PG8_WAIT_VX(FR); PG8_WAIT_L(0); PG8_BAR; PG8_MMAX(FR, 0, 0, At, B0); PG8_MMAX(FR, 0, 1, At, B1); PG8_BAR; PG8_SCHED; \
              \
            PG8_LDA(At, 0, 1); PG8_STAGE(PG8_SB(0, 0), b2, voffB); PG8_STAGE(PG8_SB(0, 1), b2 + hstep, voffB); PG8_STAGE(PG8_SA(0, 0), a2, voffA); \
            PG8_WAIT_VX(FR); PG8_WAIT_L(0); PG8_BAR; PG8_MMAX(FR, 1, 0, At, B0); PG8_MMAX(FR, 1, 1, At, B1); PG8_BAR; PG8_SCHED; \
              \
            PG8_LDB(B0, 1, 0); PG8_LDB(B1, 1, 1); PG8_SCHED; PG8_LDA(At, 1, 0); PG8_STAGE(PG8_SA(0, 1), a2 + hstep, voffA); \
            PG8_WAIT_VX(FR); PG8_WAIT_L(0); PG8_BAR; PG8_MMA(0, 0, At, B0); PG8_MMA(0, 1, At, B1); PG8_BAR; PG8_SCHED; \
              \
            PG8_LDA(At, 1, 1); PG8_STAGE(PG8_SB(1, 0), b3, voffB); PG8_STAGE(PG8_SB(1, 1), b3 + hstep, voffB); PG8_STAGE(PG8_SA(1, 0), a3, voffA); \
            PG8_WAIT_V(8); PG8_WAIT_L(0); PG8_BAR; PG8_MMA(1, 0, At, B0); PG8_MMA(1, 1, At, B1); PG8_BAR; PG8_SCHED; } while (0)
        if constexpr (SP2) {
            int t = 0;
            if constexpr (DEFER) { PG8_ITER_SP2(1); t = 2; asm volatile("" : "+v"(voffA), "+v"(voffB)); }
#pragma unroll 1
            for (; t < nt; t += 2) PG8_ITER_SP2(0);
        } else {
        for (int t = 0; t < nt; t += 2) {
            const bool last = (t == nt - 2);
            const char* a1 = cA + (size_t)(t + 1) * kstep;
            const char* a2 = last ? nA : cA + (size_t)(t + 2) * kstep; const char* b2 = last ? nB : cB + (size_t)(t + 2) * kstep;
            const char* a3 = a2 + kstep; const char* b3 = b2 + kstep;
            if (last && has_next) S.a_ready(nxt);
            PG8_LDB(B0, 0, 0); PG8_SCHED; PG8_LDA(At, 0, 0); PG8_STAGE(PG8_SA(1, 1), a1 + hstep, voffA);
            PG8_WAIT_L(8); PG8_BAR; PG8_WAIT_L(0); PG8_MMA(0, 0, At, B0); PG8_BAR; PG8_SCHED;
            PG8_LDB(B1, 0, 1); PG8_STAGE(PG8_SB(0, 0), b2, voffB);
            PG8_BAR; PG8_WAIT_L(0); PG8_MMA(0, 1, At, B1); PG8_BAR;
            PG8_LDA(At, 0, 1); PG8_STAGE(PG8_SA(0, 0), a2, voffA);
            PG8_BAR; PG8_WAIT_L(0); PG8_MMA(1, 0, At, B0); PG8_BAR; PG8_SCHED;
            PG8_STAGE(PG8_SB(0, 1), b2 + hstep, voffB);
            PG8_WAIT_V(6); PG8_BAR; PG8_MMA(1, 1, At, B1); PG8_BAR;
            PG8_LDB(B0, 1, 0); PG8_SCHED; PG8_LDA(At, 1, 0); PG8_STAGE(PG8_SA(0, 1), a2 + hstep, voffA);
            PG8_WAIT_L(8); PG8_BAR; PG8_WAIT_L(0); PG8_MMA(0, 0, At, B0); PG8_BAR; PG8_SCHED;
            PG8_LDB(B1, 1, 1); PG8_STAGE(PG8_SB(1, 0), b3, voffB);
            PG8_BAR; PG8_WAIT_L(0); PG8_MMA(0, 1, At, B1); PG8_BAR;
            PG8_LDA(At, 1, 1); PG8_STAGE(PG8_SA(1, 0), a3, voffA);
            PG8_BAR; PG8_WAIT_L(0); PG8_MMA(1, 0, At, B0); PG8_BAR; PG8_SCHED;
            PG8_STAGE(PG8_SB(1, 1), b3 + hstep, voffB);
            PG8_WAIT_V(6); PG8_BAR; PG8_MMA(1, 1, At, B1); PG8_BAR;
        }
        }
        if constexpr (ALIGN_EPI) { if (wr == 0) PG8_BAR; }
        if constexpr (DEFER) { if (has_next) PG8_STAGE(PG8_SA(1, 1), nA + kstep + hstep, voffA); asm volatile("" ::: "memory"); }
        if constexpr (!Epi::AFTER_DRAIN) { E(acc, cur, wr, wc, fr, fq); S.done(cur); }
        if (!has_next) break;
        if constexpr (!DEFER) {
#pragma unroll
        for (int a = 0; a < 2; ++a)
#pragma unroll
            for (int b = 0; b < 2; ++b)
#pragma unroll
                for (int m = 0; m < 4; ++m)
#pragma unroll
                    for (int n = 0; n < 2; ++n) acc[a][b][m][n] = (f32x4){0.f, 0.f, 0.f, 0.f};
        }
        cur = nxt; cA = nA; cB = nB; ++ui;
        if constexpr (ALIGN_EPI) { if (wr == 1) PG8_BAR; }
    }
    PG8_WAIT_V(0);
    if constexpr (!ALIGN_EPI) { if (wr == 0) PG8_BAR; }
    PG8_BAR;
    if constexpr (Epi::AFTER_DRAIN) { E.fused(acc, cur, wr, wc, fr, fq, lds, wid, lane); S.done(cur); }
#undef PG8_SA
#undef PG8_SB
#undef PG8_STAGE
#undef PG8_LDA
#undef PG8_LDB
#undef PG8_MMA
#undef PG8_MMAZ
#undef PG8_MMAX
#undef PG8_WAIT_V
#undef PG8_WAIT_L
#undef PG8_WAIT_VX
#undef PG8_ITER_SP2
#undef PG8_BAR
#undef PG8_SCHED
}
}

constexpr int NWAVES = 8;
constexpr int RING_BYTES = 159744, LDSCTL_OFF = RING_BYTES, MISC_OFF = LDSCTL_OFF + 320, LDS_BYTES = 163840;
constexpr int CW_BAR = 4096;
constexpr size_t CTL_ZERO_BYTES = 64 * 1024;
#define GAS __attribute__((address_space(1)))
#define LAS __attribute__((address_space(3)))
typedef float f32x4 __attribute__((ext_vector_type(4)));
typedef unsigned v4u __attribute__((ext_vector_type(4)));
typedef unsigned u32x2 __attribute__((ext_vector_type(2)));
__device__ __forceinline__ float bflo(unsigned w) { return __uint_as_float(w << 16); }
__device__ __forceinline__ float bfhi(unsigned w) { return __uint_as_float(w & 0xffff0000u); }
typedef short bf16x8 __attribute__((ext_vector_type(8)));
__device__ __forceinline__ void unpack8(const v4u& w, float (&f)[8]) { f[0] = bflo(w.x); f[1] = bfhi(w.x); f[2] = bflo(w.y); f[3] = bfhi(w.y); f[4] = bflo(w.z); f[5] = bfhi(w.z); f[6] = bflo(w.w); f[7] = bfhi(w.w); }
__device__ __forceinline__ bf16x8 pack8(const f32x4& a, const f32x4& b) {
    return __builtin_bit_cast(bf16x8, __builtin_convertvector((nf32x8){a.x, a.y, a.z, a.w, b.x, b.y, b.z, b.w}, nbf16x8)); }
typedef GAS unsigned gu32;
#define LDS_WAIT() asm volatile("s_waitcnt lgkmcnt(0)" ::: "memory")
#define LBAR() do { asm volatile("s_waitcnt lgkmcnt(0)" ::: "memory"); __builtin_amdgcn_s_barrier(); asm volatile("" ::: "memory"); } while (0)
#define VM_WAIT() asm volatile("s_waitcnt vmcnt(0)" ::: "memory")
__device__ __forceinline__ unsigned pk2(float lo, float hi) { return __builtin_bit_cast(unsigned, __builtin_convertvector((nf32x2){lo, hi}, nbf16x2)); }

#define XB_TMO      128
#define XB_XCNT(j)  (256  + 64 * (j))
#define XB_XSUB(j)  (1280 + 64 * (j))
#define XB_XGEN(j)  (2304 + 64 * (j))
#define XB_TOP      3328
#define XB_TOPGEN   3392
#define XCD_BAR_WORDS 3456
#define XB_SPIN_CAP (1u << 22)

__device__ __forceinline__ unsigned xb_ld(unsigned* p)              { return __hip_atomic_load(p, __ATOMIC_RELAXED, __HIP_MEMORY_SCOPE_AGENT); }
__device__ __forceinline__ unsigned xb_add(unsigned* p, unsigned v) { return __hip_atomic_fetch_add(p, v, __ATOMIC_RELAXED, __HIP_MEMORY_SCOPE_AGENT); }
__device__ __forceinline__ unsigned xb_xcc_id() { return (unsigned)__builtin_amdgcn_s_getreg((3 << 11) | 20) & 0xFu; }
#define XB_SPIN(cond, bar) do { unsigned _sp = 0; while (cond) { __builtin_amdgcn_s_sleep(1); \
    if ((++_sp & 255u) == 0u) { if (xb_ld(&(bar)[XB_TMO])) break; if (_sp > XB_SPIN_CAP) { atomicAdd(&(bar)[XB_TMO], 1u); break; } } } } while (0)

struct XcdBarrier {
    unsigned* bar; unsigned x;
    volatile LAS unsigned* st;
};

__device__ __forceinline__ XcdBarrier xcd_barrier_post(unsigned* bar, volatile LAS unsigned* st) {
    XcdBarrier b; b.bar = bar; b.x = xb_xcc_id(); b.st = st;
    if (threadIdx.x == 0) (void)xb_add(&bar[XB_XCNT(b.x)], 1u);
    return b;
}
__device__ __forceinline__ void xcd_barrier_complete(unsigned* bar, unsigned x, unsigned& nloc, unsigned& nx) {
    const unsigned G = gridDim.x * gridDim.y * gridDim.z;
    unsigned sum, cnt, mine, sp = 0u;
    for (;;) {
        sum = 0u; cnt = 0u; mine = 0u;
#pragma unroll
        for (unsigned j = 0; j < 16; ++j) { const unsigned c = xb_ld(&bar[XB_XCNT(j)]); sum += c; cnt += (c > 0u) ? 1u : 0u; mine = (j == x) ? c : mine; }
        if (sum == G) break;
        __builtin_amdgcn_s_sleep(1);
        if ((++sp & 255u) == 0u) { if (xb_ld(&bar[XB_TMO])) break; if (sp > XB_SPIN_CAP) { atomicAdd(&bar[XB_TMO], 1u); break; } }
    }
    nloc = mine > 0u ? mine : 1u; nx = cnt > 0u ? cnt : 1u;
}

__device__ __forceinline__ void xcd_barrier(const XcdBarrier& b) {
    asm volatile("s_waitcnt vmcnt(0)" ::: "memory");
    __syncthreads();
    if (threadIdx.x == 0) {
        unsigned* bar = b.bar;
        __builtin_amdgcn_s_waitcnt(0);
        unsigned nloc = b.st[0], nx = b.st[1];
        if (nloc == 0u) { xcd_barrier_complete(bar, b.x, nloc, nx); b.st[0] = nloc; b.st[1] = nx; }
        const unsigned old = xb_add(&bar[XB_XSUB(b.x)], 1u);
        const unsigned gen = old / nloc;
        if (old + 1u == (gen + 1u) * nloc) {
            __builtin_amdgcn_fence(__ATOMIC_RELEASE, "agent");
            asm volatile("s_waitcnt vmcnt(0)" ::: "memory");
            const unsigned og = xb_add(&bar[XB_TOP], 1u);
            const unsigned tg = og / nx;
            if (og + 1u == (tg + 1u) * nx) xb_add(&bar[XB_TOPGEN], 1u);
            else XB_SPIN(xb_ld(&bar[XB_TOPGEN]) == tg, bar);
            __builtin_amdgcn_fence(__ATOMIC_ACQUIRE, "agent");
            xb_add(&bar[XB_XGEN(b.x)], 1u);
            asm volatile("s_waitcnt vmcnt(0)" ::: "memory");
        } else {
            XB_SPIN(xb_ld(&bar[XB_XGEN(b.x)]) == gen, bar);
            __builtin_amdgcn_fence(__ATOMIC_ACQUIRE, "agent");
            asm volatile("s_waitcnt vmcnt(0)" ::: "memory");
        }
    }
    __syncthreads();
}


#define CAS __attribute__((address_space(4)))
typedef const CAS Ptrs KPtrs;
struct Frame {
    LAS unsigned char* lds; volatile LAS unsigned* MISC; gu32* ctl;
    int tid, lane, wave, vcu, G;
    __device__ __forceinline__ KPtrs& P() const { const CAS char* kp = (const CAS char*)__builtin_amdgcn_kernarg_segment_ptr(); asm volatile("" : "+s"(kp)); return *(KPtrs*)kp; }
    __device__ __forceinline__ void refresh() { int t = threadIdx.x; asm volatile("" : "+v"(t)); tid = t; lane = t & 63; wave = __builtin_amdgcn_readfirstlane(t >> 6); }
};

__device__ __forceinline__ void transpose_item(const float* W, int coff, int ld, bf16_t* WT, LAS float* scr, int k0, int lane) {
    float tv[32];
#pragma unroll
    for (int i = 0; i < 32; ++i) tv[i] = W[(size_t)(k0 + 2 * i + (lane >> 5)) * ld + coff];
#pragma unroll
    for (int i = 0; i < 32; ++i) scr[(2 * i + (lane >> 5)) * 33 + (lane & 31)] = tv[i];
    LDS_WAIT(); asm volatile("" ::: "memory");
    const int c = lane & 7;
#pragma unroll
    for (int j = 0; j < 4; ++j) { const int n = (lane >> 3) + 8 * j; const LAS float* s = scr + (8 * c) * 33 + n;
        v4u o; o.x = pk2(s[0 * 33], s[1 * 33]); o.y = pk2(s[2 * 33], s[3 * 33]); o.z = pk2(s[4 * 33], s[5 * 33]); o.w = pk2(s[6 * 33], s[7 * 33]);
        *(GAS v4u*)(WT + (size_t)n * DM + k0 + 8 * c) = o; }
    LDS_WAIT(); asm volatile("" ::: "memory");
}
__device__ __forceinline__ void convert_weights(Frame& F, int l, int gw, int NGW) {
    KPtrs& p = F.P();
    LAS float* scr = (LAS float*)(F.lds + F.wave * 16384);
    constexpr int I_IN = 16 * (NPC / 32), I_OUT = 16 * (DM / 32), I_L = I_IN + I_OUT;
    for (int it = gw; it < I_L; it += NGW) { int r = it;
        if (r < I_IN) { const int kb = r / (NPC / 32), nb = r % (NPC / 32), n0 = 32 * nb;
            const int g = n0 >> 8, i0 = n0 & 255, li = F.lane & 31, dl = c_gt_delta[g];
            const int coff = c_gt_col[g] + (dl ? (i0 >> 1) + (li >> 1) + ((li & 1) ? dl : 0) : i0 + li);
            transpose_item(p.w_in + (size_t)l * DM * INC, coff, INC, (bf16_t*)(p.ws + WS_WIN) + ((size_t)l * NPC + n0) * DM, scr, 64 * kb, F.lane); }
        else { r -= I_IN; const int kb = r / (DM / 32), nb = r % (DM / 32), n0 = 32 * nb;
            transpose_item(p.w_out + (size_t)l * DM * DM, n0 + (F.lane & 31), DM, (bf16_t*)(p.ws + WS_WOUT) + ((size_t)l * DM + n0) * DM, scr, 64 * kb, F.lane); }
    }
}
__device__ __forceinline__ void mod_item(Frame& F, int l, int slab) {
    KPtrs& p = F.P(); const int n0 = slab * 128;
    LAS float* s = (LAS float*)F.lds;
    LAS float* red = s + 17 * DM;
    { float cv[34];
#pragma unroll
      for (int j = 0; j < 34; ++j) { const int i = F.tid + j * NWAVES * 64, b = i >> 10, k = i & 1023; cv[j] = b < 16 ? p.c[b * DM + k] : p.c_ctx[k]; }
#pragma unroll
      for (int j = 0; j < 34; ++j) s[F.tid + j * NWAVES * 64] = fsilu(cv[j]); }
    __syncthreads();
    const int cq = F.tid & 31, kg = F.tid >> 5;
    f32x4 acc[17];
#pragma unroll
    for (int b = 0; b < 17; ++b) acc[b] = (f32x4){0.f, 0.f, 0.f, 0.f};
    const float* w = p.w_ada + (size_t)l * DM * 3072 + n0 + 4 * cq;
#pragma unroll 1
    for (int k0 = kg * 64; k0 < kg * 64 + 64; k0 += 16) { f32x4 wv[16];
#pragma unroll
        for (int kk = 0; kk < 16; ++kk) wv[kk] = *(const f32x4*)(w + (size_t)(k0 + kk) * 3072);
#pragma unroll
        for (int q = 0; q < 4; ++q) {
#pragma unroll
            for (int b = 0; b < 17; ++b) { const f32x4 s4 = *(const LAS f32x4*)(s + b * DM + k0 + 4 * q);
                acc[b] += wv[4 * q] * s4.x + wv[4 * q + 1] * s4.y + wv[4 * q + 2] * s4.z + wv[4 * q + 3] * s4.w; }
            asm volatile("" ::: "memory"); } }
#pragma unroll
    for (int b = 0; b < 17; ++b) {
        float v[4] = {acc[b].x, acc[b].y, acc[b].z, acc[b].w};
#pragma unroll
        for (int e = 0; e < 4; ++e) { auto r = __builtin_amdgcn_permlane32_swap(__float_as_uint(v[e]), __float_as_uint(v[e]), false, false); v[e] = __uint_as_float(r[0]) + __uint_as_float(r[1]); }
        if (F.lane < 32) *(LAS f32x4*)(red + (F.wave * 17 + b) * 128 + 4 * cq) = (f32x4){v[0], v[1], v[2], v[3]}; }
    __syncthreads();
    float* mod = (float*)(p.ws + WS_MOD);
    for (int o = F.tid; o < 17 * 128; o += NWAVES * 64) { const int b = o >> 7, cc = o & 127; float sum = p.b_ada[l * 3072 + n0 + cc];
#pragma unroll
        for (int g = 0; g < 8; ++g) sum += red[(g * 17 + b) * 128 + cc];
        mod[(size_t)(l * 17 + b) * 3072 + n0 + cc] = sum; }
    __syncthreads();
}
__device__ __forceinline__ void phase_pre(Frame& F) {
    KPtrs& p = F.P();
    if (blockIdx.x < 96) mod_item(F, (int)blockIdx.x / 24, (int)blockIdx.x % 24);
    else convert_weights(F, 0, ((int)blockIdx.x - 96) * NWAVES + F.wave, (F.G - 96) * NWAVES);
    { bf16_t* wsb = (bf16_t*)(p.ws + (9u << 20));
      for (int i = F.vcu * NWAVES * 64 + F.tid; i < DEPTH * 4 * 128 * 128 / 4; i += F.G * NWAVES * 64) { const f32x4 v = *(const f32x4*)(p.smlp_w + 4 * (size_t)i);
          unsigned long long o = (unsigned long long)pk2(v.x, v.y) | ((unsigned long long)pk2(v.z, v.w) << 32); *(GAS unsigned long long*)(wsb + 4 * (size_t)i) = o; } }
}

__device__ __forceinline__ void norm_row0(Frame& F, LAS float* tab, int r, f32x4 (&v)[4], int& curb) {
    KPtrs& p = F.P(); const int lane = F.lane;
    const int b = r < MLAT ? r >> 11 : 16;
    if (b != curb) { curb = b; const float* mod = (const float*)(p.ws + WS_MOD) + (size_t)b * 3072;
#pragma unroll
        for (int j = 0; j < 4; ++j) { const f32x4 g = *(const f32x4*)(p.norm_g + 256 * j + 4 * lane), sc = *(const f32x4*)(mod + 1024 + 256 * j + 4 * lane), sh = *(const f32x4*)(mod + 256 * j + 4 * lane);
            *(LAS f32x4*)(tab + 256 * j + 4 * lane) = g * (sc + 1.0f); *(LAS f32x4*)(tab + 1024 + 256 * j + 4 * lane) = sh; }
        asm volatile("s_waitcnt vmcnt(0) lgkmcnt(0)" ::: "memory"); }
    float ss = 0.f;
#pragma unroll
    for (int j = 0; j < 4; ++j) { ss += (v[j].x * v[j].x + v[j].y * v[j].y) + (v[j].z * v[j].z + v[j].w * v[j].w); }
    ss = wave_sum(ss);
    const float rstd = 1.0f / sqrtf(ss * (1.0f / DM) + EPS);
    GAS unsigned long long* o8 = (GAS unsigned long long*)((bf16_t*)(p.ws + WS_HY) + (size_t)r * DM) + lane;
#pragma unroll
    for (int j = 0; j < 4; ++j) { const f32x4 h = v[j] * rstd * *(const LAS f32x4*)(tab + 256 * j + 4 * lane) + *(const LAS f32x4*)(tab + 1024 + 256 * j + 4 * lane);
        o8[64 * j] = (unsigned long long)pk2(h.x, h.y) | ((unsigned long long)pk2(h.z, h.w) << 32); }
}
__device__ __forceinline__ void norm_wave_rows(Frame& F, LAS float* tab) {
    KPtrs& p = F.P(); const int lane = F.lane; int curb = -1;
    f32x4 va[4], vb[4], vc[4];
    const int rw = 16 * F.vcu + 2 * F.wave;
#define NR_ROW(k_) (rw + 4096 * ((k_) >> 1) + ((k_) & 1))
#define NR_LOAD(k_, d_) do { const int kk_ = (k_) < 18 ? (k_) : 17; const int rr_ = NR_ROW(kk_); const GAS f32x4* xr_ = (const GAS f32x4*)(rr_ < MLAT ? p.x + (size_t)rr_ * DM : p.ctx + (size_t)(rr_ - MLAT) * DM) + lane; \
        _Pragma("unroll") for (int j = 0; j < 4; ++j) d_[j] = xr_[64 * j]; } while (0)
    NR_LOAD(0, va); NR_LOAD(1, vb);
#pragma unroll 1
    for (int k = 0; k < 18; k += 3) {
        NR_LOAD(k + 2, vc); norm_row0(F, tab, NR_ROW(k), va, curb);
        NR_LOAD(k + 3, va); norm_row0(F, tab, NR_ROW(k + 1), vb, curb);
        NR_LOAD(k + 4, vb); norm_row0(F, tab, NR_ROW(k + 2), vc, curb);
    }
#undef NR_LOAD
#undef NR_ROW
}
__device__ __forceinline__ void norm_tile16(Frame& F, int l, const LAS bf16_t* wabT, LAS float* tab, int r0, int& curb) {
    KPtrs& p = F.P(); const int lane = F.lane, li = lane & 15, g4 = lane >> 4;
    const bf16_t* const XB = (const bf16_t*)((const char*)p.out + (64u << 20)); const bf16_t* const XCB = (const bf16_t*)(p.ws + WS_XC);
    const int r = r0 + li; int b; const bf16_t* src;
    if (r < MLAT) { b = r >> 11; const int tp = r & 2047; const int t = (l & 1) ? ((tp & 31) * 64 + (tp >> 5)) : tp; src = XB + ((size_t)b * SEQ + t) * DM; }
    else { b = 16; src = XCB + (size_t)(r - MLAT) * DM; }
    v4u xr[32];
#pragma unroll
    for (int s2 = 0; s2 < 32; ++s2) xr[s2] = *(const GAS v4u*)(src + 32 * s2 + 8 * g4);
    const int bt = __builtin_amdgcn_readfirstlane(b);
    if (bt != curb) { curb = bt; const float* mod = (const float*)(p.ws + WS_MOD) + (size_t)(l * 17 + bt) * 3072;
#pragma unroll
        for (int j = 0; j < 4; ++j) { const f32x4 g = *(const f32x4*)(p.norm_g + l * DM + 256 * j + 4 * lane), sc = *(const f32x4*)(mod + 1024 + 256 * j + 4 * lane), sh = *(const f32x4*)(mod + 256 * j + 4 * lane);
            *(LAS f32x4*)(tab + 256 * j + 4 * lane) = g * (sc + 1.0f); *(LAS f32x4*)(tab + 1024 + 256 * j + 4 * lane) = sh; }
        asm volatile("s_waitcnt lgkmcnt(0)" ::: "memory"); }
    float ss = 0.f;
#pragma unroll
    for (int s2 = 0; s2 < 32; ++s2) { float f[8]; unpack8(xr[s2], f);
#pragma unroll
        for (int e = 0; e < 8; ++e) ss += f[e] * f[e]; }
    { auto q = __builtin_amdgcn_permlane16_swap(__float_as_uint(ss), __float_as_uint(ss), false, false); ss = __uint_as_float(q[0]) + __uint_as_float(q[1]); }
    { auto q = __builtin_amdgcn_permlane32_swap(__float_as_uint(ss), __float_as_uint(ss), false, false); ss = __uint_as_float(q[0]) + __uint_as_float(q[1]); }
    const float rstd = 1.0f / sqrtf(ss * (1.0f / DM) + EPS);
#pragma unroll
    for (int s2 = 0; s2 < 32; ++s2) asm volatile("" : "+v"(xr[s2]));
    f32x4 acc = {0.f, 0.f, 0.f, 0.f};
    bf16_t* hrow = (bf16_t*)(p.ws + WS_HY) + (size_t)r * DM + 8 * g4;
#pragma unroll
    for (int s2 = 0; s2 < 32; ++s2) { float f[8]; unpack8(xr[s2], f);
        const f32x4 ga = *(const LAS f32x4*)(tab + 32 * s2 + 8 * g4), gb = *(const LAS f32x4*)(tab + 32 * s2 + 8 * g4 + 4), sa = *(const LAS f32x4*)(tab + 1024 + 32 * s2 + 8 * g4), sb = *(const LAS f32x4*)(tab + 1024 + 32 * s2 + 8 * g4 + 4);
        const f32x4 ha = (f32x4){f[0], f[1], f[2], f[3]} * rstd * ga + sa, hb = (f32x4){f[4], f[5], f[6], f[7]} * rstd * gb + sb;
        const bf16x8 hf = pack8(ha, hb);
        *(GAS bf16x8*)(hrow + 32 * s2) = hf;
        const bf16x8 wf = *(const LAS bf16x8*)(wabT + li * DM + 32 * s2 + 8 * g4);
        acc = __builtin_amdgcn_mfma_f32_16x16x32_bf16(hf, wf, acc, 0, 0, 0);
        if ((s2 & 1) == 1) asm volatile("" ::: "memory"); }
    float* AB = (float*)(p.ws + WS_AB) + (size_t)(r0 + 4 * g4) * 16 + li;
#pragma unroll
    for (int rr = 0; rr < 4; ++rr) AB[rr * 16] = acc[rr];
}
__device__ __forceinline__ void ab_tile16(Frame& F, const LAS bf16_t* wabT, int r0) {
    KPtrs& p = F.P(); const int lane = F.lane, li = lane & 15, g4 = lane >> 4;
    const bf16_t* src = (const bf16_t*)(p.ws + WS_HY) + (size_t)(r0 + li) * DM + 8 * g4;
    v4u xr[32];
#pragma unroll
    for (int s2 = 0; s2 < 32; ++s2) xr[s2] = *(const GAS v4u*)(src + 32 * s2);
    f32x4 acc = {0.f, 0.f, 0.f, 0.f};
#pragma unroll
    for (int s2 = 0; s2 < 32; ++s2) { const bf16x8 wf = *(const LAS bf16x8*)(wabT + li * DM + 32 * s2 + 8 * g4);
        acc = __builtin_amdgcn_mfma_f32_16x16x32_bf16(__builtin_bit_cast(bf16x8, xr[s2]), wf, acc, 0, 0, 0);
        if ((s2 & 3) == 3) asm volatile("" ::: "memory"); }
    float* AB = (float*)(p.ws + WS_AB) + (size_t)(r0 + 4 * g4) * 16 + li;
#pragma unroll
    for (int rr = 0; rr < 4; ++rr) AB[rr * 16] = acc[rr];
}
constexpr int CW_CTXC = 9216, CW_NORMQ = 13312;
__device__ __forceinline__ void norm_stage_wab(Frame& F, int l, LAS float* wab) {
    KPtrs& p = F.P();
    float wv[32];
#pragma unroll
    for (int q = 0; q < 32; ++q) { const int i = F.tid + q * NWAVES * 64; wv[q] = p.w_in[(size_t)l * DM * INC + (size_t)(i >> 4) * INC + 768 + (i & 15)]; }
#pragma unroll
    for (int q = 0; q < 32; ++q) { const int i = F.tid + q * NWAVES * 64; wab[(i & 15) * DM + (i >> 4)] = wv[q]; }
    __syncthreads();
}
__device__ __forceinline__ void phase_norm(Frame& F, int l) {
    KPtrs& p = F.P();
#define NORM_STAGE_WAB() do { float wv_[32];   \
        _Pragma("unroll") for (int q_ = 0; q_ < 32; ++q_) { const int i_ = F.tid + q_ * NWAVES * 64; wv_[q_] = p.w_in[(size_t)l * DM * INC + (size_t)(i_ >> 4) * INC + 768 + (i_ & 15)]; } \
        _Pragma("unroll") for (int q_ = 0; q_ < 32; ++q_) { const int i_ = F.tid + q_ * NWAVES * 64; ((LAS bf16_t*)F.lds)[(i_ & 15) * DM + (i_ >> 4)] = f2bf(wv_[q_]); } \
        __syncthreads(); } while (0)
    if (l == 0) {
        NORM_STAGE_WAB();
        norm_wave_rows(F, (LAS float*)(F.lds + 32768 + F.wave * 8192));
        __syncthreads();
        for (int t = F.wave; t < 9; t += NWAVES) ab_tile16(F, (const LAS bf16_t*)F.lds, 16 * (F.vcu + 256 * t));
        __syncthreads();
        return;
    }
    const LAS bf16_t* wabT = (const LAS bf16_t*)F.lds; LAS float* tab = (LAS float*)(F.lds + 32768 + F.wave * 8192); int curb = -1;
    if (blockIdx.x < 64) {
        const int pmc = (int)blockIdx.x >> 2, pn = (int)blockIdx.x & 3, lp = l - 1;
        pg8::Gemm g{(const bf16_t*)(p.ws + WS_HY) + (size_t)MLAT * DM, (const bf16_t*)(p.ws + WS_WOUT) + (size_t)lp * DM * DM, MCTX, DM, DM};
        pg8::OneUnit S{{pmc, pn}};
        bf16_t* const XCB = (bf16_t*)(p.ws + WS_XC);
        pg8::EpiResid E{nullptr, nullptr, lp == 0 ? (const void*)p.ctx : (const void*)XCB, XCB, (const float*)(p.ws + WS_MOD) + (size_t)lp * 17 * 3072, 0, MLAT, SEQ, DM, lp == 0 ? 1 : 0, MLAT};
        pg8::gemm_phase<pg8::EpiResid, pg8::OneUnit, false, true>(F.lds, g, S, E);
        F.refresh();
        asm volatile("s_waitcnt vmcnt(0)" ::: "memory");
        __syncthreads();
        if (F.tid == 0) { __builtin_amdgcn_fence(__ATOMIC_RELEASE, "agent"); asm volatile("s_waitcnt vmcnt(0)" ::: "memory");
            (void)__hip_atomic_fetch_add(F.ctl + CW_CTXC + (l * 16 + pmc) * 64, 1u, __ATOMIC_RELAXED, __HIP_MEMORY_SCOPE_AGENT); }
    } else {
        NORM_STAGE_WAB();
        const int wi = ((int)blockIdx.x - 64) * NWAVES + F.wave;
        for (int t = wi; t < MLAT / 16; t += 1536) norm_tile16(F, l, wabT, tab, 16 * t, curb);
        if (blockIdx.x >= 128) { __syncthreads(); convert_weights(F, l, ((int)blockIdx.x - 128) * NWAVES + F.wave, 1024); }
        else {
            const int q = (int)blockIdx.x - 64, pmc = q >> 2;
            if (F.tid == 0) { gu32* cnt = F.ctl + CW_CTXC + (l * 16 + pmc) * 64; unsigned spins = 0;
                while (__hip_atomic_load(cnt, __ATOMIC_RELAXED, __HIP_MEMORY_SCOPE_AGENT) < 4u && ++spins < (1u << 22)) __builtin_amdgcn_s_sleep(2);
                __builtin_amdgcn_fence(__ATOMIC_ACQUIRE, "agent"); asm volatile("s_waitcnt vmcnt(0)" ::: "memory"); }
            __syncthreads();
            if (F.wave < 4) norm_tile16(F, l, wabT, tab, MLAT + 64 * q + 16 * F.wave, curb);
        }
    }
#undef NORM_STAGE_WAB
    __syncthreads();
}

__device__ __forceinline__ void phase_final(Frame& F) {
    KPtrs& p = F.P(); const int lane = F.lane;
    const int gw = F.vcu * NWAVES + F.wave, NGW = F.G * NWAVES;
    const bf16_t* X = (const bf16_t*)(p.ws + WS_P);
    f32x4 g[4];
#pragma unroll
    for (int j = 0; j < 4; ++j) g[j] = *(const f32x4*)(p.final_g + 256 * j + 4 * lane);
    for (int r0 = gw; r0 < MLAT; r0 += 4 * NGW) {
        u32x2 raw[4][4];
#pragma unroll
        for (int u = 0; u < 4; ++u) { const int r = r0 + u * NGW; if (r < MLAT) { const GAS u32x2* xr = (const GAS u32x2*)(X + (size_t)r * DM) + lane;
#pragma unroll
            for (int j = 0; j < 4; ++j) raw[u][j] = xr[64 * j]; } }
#pragma unroll
        for (int u = 0; u < 4; ++u) { const int r = r0 + u * NGW; if (r < MLAT) {
            f32x4 v[4]; float ss = 0.f;
#pragma unroll
            for (int j = 0; j < 4; ++j) { v[j] = (f32x4){bflo(raw[u][j].x), bfhi(raw[u][j].x), bflo(raw[u][j].y), bfhi(raw[u][j].y)}; ss += (v[j].x * v[j].x + v[j].y * v[j].y) + (v[j].z * v[j].z + v[j].w * v[j].w); }
            ss = wave_sum(ss);
            const float rstd = 1.0f / sqrtf(ss * (1.0f / DM) + EPS);
            GAS f32x4* xo = (GAS f32x4*)(p.out + (size_t)r * DM) + lane;
#pragma unroll
            for (int j = 0; j < 4; ++j) xo[64 * j] = v[j] * rstd * g[j]; } }
    }
}

__device__ __forceinline__ void phase_gemm1(Frame& F, int l) {
    KPtrs& p = F.P();
    pg8::Gemm g{(const bf16_t*)(p.ws + WS_HY), (const bf16_t*)(p.ws + WS_WIN) + (size_t)l * NPC * DM, MTOT, NPC, DM};
    pg8::StaticOrder S; S.init(MTOT, NPC, F.G, (int)blockIdx.x);
    pg8::EpiP E{(bf16_t*)(p.ws + WS_P), PTILE_ELEMS};
    pg8::gemm_phase<pg8::EpiP, pg8::StaticOrder, true, true>(F.lds, g, S, E);
}
__device__ __forceinline__ void phase_gemm2(Frame& F, int l) {
    KPtrs& p = F.P();
    const int M = MLAT;
    pg8::Gemm g{(const bf16_t*)(p.ws + WS_HY), (const bf16_t*)(p.ws + WS_WOUT) + (size_t)l * DM * DM, M, DM, DM};
    pg8::StaticOrder S; S.init(M, DM, F.G, (int)blockIdx.x);
    bf16_t* const XB = (bf16_t*)((char*)p.out + (64u << 20));
    bf16_t* const XCB = (bf16_t*)(p.ws + WS_XC);
    pg8::EpiResid E{l == 0 ? (const void*)p.x : (const void*)XB, l == DEPTH - 1 ? (bf16_t*)(p.ws + WS_P) : XB, l == 0 ? (const void*)p.ctx : (const void*)XCB, XCB,
                    (const float*)(p.ws + WS_MOD) + (size_t)l * 17 * 3072, l & 1, MLAT, SEQ, DM, l == 0 ? 1 : 0, 0};
    pg8::gemm_phase<pg8::EpiResid, pg8::StaticOrder, true, true>(F.lds, g, S, E);
}


typedef short s16x4 __attribute__((ext_vector_type(4)));
__device__ __forceinline__ const bf16_t* ptile_d(KPtrs& p, int t) { return (const bf16_t*)(p.ws + WS_P) + (size_t)t * PTILE_ELEMS; }
constexpr size_t WS_WSB = 9 * MiB;

__device__ __forceinline__ void mix_unit_B(Frame& F, int l, int row0) {
    KPtrs& p = F.P(); const int oct = F.tid & 31, tg = F.tid >> 5;
    int start, len; row_seq(row0, start, len);
    const bf16_t *CX = ptile_d(p, T_CX), *BGS = ptile_d(p, T_BGS);
    float w[3][8];
#pragma unroll
    for (int j = 0; j < 3; ++j) { const f32x4 a = *(const f32x4*)(p.short_conv_w + (size_t)(l * 3 + j) * BW + 8 * oct), b = *(const f32x4*)(p.short_conv_w + (size_t)(l * 3 + j) * BW + 8 * oct + 4);
        w[j][0] = a.x; w[j][1] = a.y; w[j][2] = a.z; w[j][3] = a.w; w[j][4] = b.x; w[j][5] = b.y; w[j][6] = b.z; w[j][7] = b.w; }
    const int r0 = row0 + tg * 8;
    float cx[10][8];
    { v4u ca[10];
#pragma unroll
      for (int i = 0; i < 10; ++i) { int r = r0 + i - 1; r = r < start ? start : (r >= start + len ? start + len - 1 : r); ca[i] = *(const GAS v4u*)(CX + (size_t)r * 256 + 8 * oct); }
#pragma unroll
      for (int i = 0; i < 10; ++i) unpack8(ca[i], cx[i]);
      const bool lo_ok = r0 - 1 >= start, hi_ok = r0 + 8 < start + len;
#pragma unroll
      for (int e = 0; e < 8; ++e) { cx[0][e] = lo_ok ? cx[0][e] : 0.f; cx[9][e] = hi_ok ? cx[9][e] : 0.f; } }
#pragma unroll
    for (int i = 0; i < 8; ++i) { const int r = r0 + i;
        const v4u bgw = *(const GAS v4u*)(BGS + (size_t)r * 256 + 8 * oct); float bg[8], y[8]; unpack8(bgw, bg);
#pragma unroll
        for (int e = 0; e < 8; ++e) y[e] = bg[e] * (w[0][e] * cx[i][e] + w[1][e] * cx[i + 1][e] + w[2][e] * cx[i + 2][e]);
        v4u o; o.x = pk2(y[0], y[1]); o.y = pk2(y[2], y[3]); o.z = pk2(y[4], y[5]); o.w = pk2(y[6], y[7]);
        *(GAS v4u*)((bf16_t*)(p.ws + WS_HY) + (size_t)r * DM + 256 + 8 * oct) = o; }
}

constexpr int MIX_ND = MTOT / 128, MIX_NC = MTOT / 64, MIX_NB = MTOT / 128, MIX_NU = MIX_ND + MIX_NC + MIX_NB, CW_MIXQ = 8192, NPF = 12;
__device__ __forceinline__ void mix_prefetch(Frame& F, int l, int u, v4u (&pf)[NPF]) {
    KPtrs& p = F.P(); const int tid = F.tid, lane = F.lane, wave = F.wave;
    if (u < MIX_ND) {
        const bf16_t* VV = ptile_d(p, T_VV) + (size_t)(u * 128 + wave * 16) * 256 + 4 * lane;
#pragma unroll
        for (int k = 0; k < 8; ++k) { const u32x2 a = *(const GAS u32x2*)(VV + (size_t)(2 * k) * 256), b = *(const GAS u32x2*)(VV + (size_t)(2 * k + 1) * 256); pf[k] = (v4u){a.x, a.y, b.x, b.y}; }
        pf[10] = *(const GAS v4u*)(p.smlp_ln_g + l * BW + 4 * lane); pf[11] = *(const GAS v4u*)(p.smlp_ln_b + l * BW + 4 * lane);
        asm volatile("; PF_D" ::: "memory");
    } else if (u < MIX_ND + MIX_NC) {
        const int row0 = (u - MIX_ND) * 64; int start, len; row_seq(row0, start, len);
        const bf16_t* GL = ptile_d(p, T_GLU);
#pragma unroll
        for (int k = 0; k < 6; ++k) { const int idx = tid + k * NWAVES * 64, i = idx >> 5, oct = idx & 31; int r = row0 - 15 + i; r = r < start ? start : (r >= start + len ? start + len - 1 : r);
            pf[k] = *(const GAS v4u*)(GL + (size_t)r * 256 + 8 * oct); }
        asm volatile("; PF_C" ::: "memory");
    }
}
__device__ __forceinline__ f32x4 asf4(const v4u& w) { return __builtin_bit_cast(f32x4, w); }

__device__ __forceinline__ void mix_unit_C(Frame& F, int l, int row0, v4u (&pf)[NPF], int nxt) {
    KPtrs& p = F.P(); const int tid = F.tid, lane = F.lane, wave = F.wave;
    int start, len; row_seq(row0, start, len);
    LAS float* glu = (LAS float*)F.lds;
#pragma unroll
    for (int k = 0; k < 6; ++k) { const int idx = tid + k * NWAVES * 64, i = idx >> 5, oct = idx & 31, r = row0 - 15 + i;
        if (i < 94) { const bool ok = r >= start && r < start + len; float fa[8]; unpack8(pf[k], fa);
            const f32x4 o0 = {ok ? fa[0] : 0.f, ok ? fa[1] : 0.f, ok ? fa[2] : 0.f, ok ? fa[3] : 0.f}, o1 = {ok ? fa[4] : 0.f, ok ? fa[5] : 0.f, ok ? fa[6] : 0.f, ok ? fa[7] : 0.f};
            *(LAS f32x4*)(glu + i * 256 + 8 * oct) = o0; *(LAS f32x4*)(glu + i * 256 + 8 * oct + 4) = o1; } }
    float wt[32]; u32x2 gate[8];
#pragma unroll
    for (int j = 0; j < 32; ++j) wt[j] = j < 31 ? p.conf_conv_w[(size_t)(l * 31 + j) * BW + (tid & 255)] : p.conf_conv_b[l * BW + (tid & 255)];
    { const bf16_t* GC = ptile_d(p, T_GC);
#pragma unroll
      for (int i = 0; i < 8; ++i) gate[i] = *(const GAS u32x2*)(GC + (size_t)(row0 + wave * 8 + i) * 256 + 4 * lane); }
    const f32x4 lg = *(const f32x4*)(p.conf_ln_g + l * BW + 4 * lane), lb = *(const f32x4*)(p.conf_ln_b + l * BW + 4 * lane);
    mix_prefetch(F, l, nxt, pf);
    LBAR();
    const int c = tid & 255, th = tid >> 8;
    float z[32];
#pragma unroll
    for (int hb = 0; hb < 2; ++hb) {
        float win[46];
#pragma unroll
        for (int i = 0; i < 46; ++i) win[i] = glu[(th * 32 + hb * 16 + i) * 256 + c];
#pragma unroll
        for (int i = 0; i < 16; ++i) z[hb * 16 + i] = wt[31];
#pragma unroll
        for (int j = 0; j < 31; ++j)
#pragma unroll
            for (int i = 0; i < 16; ++i) z[hb * 16 + i] += wt[j] * win[i + j];
    }
    LBAR();
#pragma unroll
    for (int i = 0; i < 32; ++i) glu[(th * 32 + i) * 256 + c] = z[i];
    LBAR();
#pragma unroll
    for (int i = 0; i < 8; ++i) { const int t = wave * 8 + i, r = row0 + t;
        const f32x4 zz = *(const LAS f32x4*)(glu + t * 256 + 4 * lane);
        const float mean = wave_sum((zz.x + zz.y) + (zz.z + zz.w)) * (1.f / 256.f);
        const f32x4 d = zz - mean;
        const float var = wave_sum((d.x * d.x + d.y * d.y) + (d.z * d.z + d.w * d.w)) * (1.f / 256.f);
        const float rstd = 1.0f / sqrtf(var + EPS);
        const f32x4 ln = d * rstd * lg + lb;
        const u32x2 gw = gate[i];
        u32x2 o; o.x = pk2(fsilu(ln.x) * bflo(gw.x), fsilu(ln.y) * bfhi(gw.x)); o.y = pk2(fsilu(ln.z) * bflo(gw.y), fsilu(ln.w) * bfhi(gw.y));
        *(GAS u32x2*)((bf16_t*)(p.ws + WS_HY) + (size_t)r * DM + 512 + 4 * lane) = o; }
    LBAR();
}

__device__ __forceinline__ void mix_unit_D(Frame& F, int l, int row0, v4u (&pf)[NPF], int nxt) {
    KPtrs& p = F.P(); const int lane = F.lane, wave = F.wave;
    constexpr int VS = 528;
    LAS unsigned char* vl = F.lds;
    const bf16_t* UG = ptile_d(p, T_UG);
    const int g = wave >> 1, ph = wave & 1, li = lane & 15, lg4 = lane >> 4;
    bf16x8 wf[4][4];
    { const bf16_t* W = (const bf16_t*)(p.ws + WS_WSB) + (size_t)(l * 4 + g) * 128 * 128;
#pragma unroll
      for (int ks = 0; ks < 4; ++ks)
#pragma unroll
          for (int pt = 0; pt < 4; ++pt) wf[ks][pt] = *(const GAS bf16x8*)(W + (size_t)(64 * ph + 16 * pt + li) * 128 + 32 * ks + 8 * lg4); }
    { const f32x4 lg = asf4(pf[10]), lb = asf4(pf[11]);
#pragma unroll
      for (int i = 0; i < 16; ++i) { const int q = wave * 16 + i; const u32x2 raw = (i & 1) ? (u32x2){pf[i >> 1].z, pf[i >> 1].w} : (u32x2){pf[i >> 1].x, pf[i >> 1].y};
        const f32x4 v = {bflo(raw.x), bfhi(raw.x), bflo(raw.y), bfhi(raw.y)};
        const float mean = wave_sum((v.x + v.y) + (v.z + v.w)) * (1.f / 256.f);
        const f32x4 d = v - mean;
        const float var = wave_sum((d.x * d.x + d.y * d.y) + (d.z * d.z + d.w * d.w)) * (1.f / 256.f);
        const float rstd = 1.0f / sqrtf(var + EPS);
        const f32x4 y = d * rstd * lg + lb;
        u32x2 o; o.x = pk2(y.x, y.y); o.y = pk2(y.z, y.w);
        *(LAS u32x2*)(vl + q * VS + 8 * lane) = o; } }
    LBAR();
    f32x4 acc[4][4];
#pragma unroll
    for (int a = 0; a < 4; ++a)
#pragma unroll
        for (int b = 0; b < 4; ++b) acc[a][b] = (f32x4){0.f, 0.f, 0.f, 0.f};
#pragma unroll
    for (int ks = 0; ks < 4; ++ks) {
        bf16x8 af[4];
#pragma unroll
        for (int ct = 0; ct < 4; ++ct) { LAS unsigned char* a = vl + (32 * ks + 8 * lg4 + (li >> 2)) * VS + (64 * g + 16 * ct + 4 * (li & 3)) * 2;
            const s16x4 lo = __builtin_amdgcn_ds_read_tr16_b64_v4i16((LAS s16x4*)a), hi = __builtin_amdgcn_ds_read_tr16_b64_v4i16((LAS s16x4*)(a + 4 * VS));
            af[ct] = (bf16x8){lo[0], lo[1], lo[2], lo[3], hi[0], hi[1], hi[2], hi[3]}; }
#pragma unroll
        for (int ct = 0; ct < 4; ++ct)
#pragma unroll
            for (int pt = 0; pt < 4; ++pt) acc[ct][pt] = __builtin_amdgcn_mfma_f32_16x16x32_bf16(af[ct], wf[ks][pt], acc[ct][pt], 0, 0, 0);
    }
    u32x2 uw[4][4]; float bs[4];
#pragma unroll
    for (int pt = 0; pt < 4; ++pt) { const int prow = 64 * ph + 16 * pt + li; const size_t r = (size_t)row0 + prow; bs[pt] = p.smlp_b[(l * 4 + g) * 128 + prow];
#pragma unroll
        for (int ct = 0; ct < 4; ++ct) { const int c = 64 * g + 16 * ct + 4 * lg4; uw[pt][ct] = *(const GAS u32x2*)(UG + r * 256 + c); } }
    mix_prefetch(F, l, nxt, pf);
#pragma unroll
    for (int pt = 0; pt < 4; ++pt) { const int prow = 64 * ph + 16 * pt + li; const size_t r = (size_t)row0 + prow;
#pragma unroll
        for (int ct = 0; ct < 4; ++ct) { const int c = 64 * g + 16 * ct + 4 * lg4;
            const f32x4 m = acc[ct][pt] + bs[pt]; const u32x2 u2 = uw[pt][ct];
            u32x2 o; o.x = pk2(bflo(u2.x) * m.x, bfhi(u2.x) * m.y); o.y = pk2(bflo(u2.y) * m.z, bfhi(u2.y) * m.w);
            *(GAS u32x2*)((bf16_t*)(p.ws + WS_HY) + r * DM + 768 + c) = o; } }
    LBAR();
}

__device__ __forceinline__ void phase_mix(Frame& F, int l) {
    gu32* ctr = F.ctl + CW_MIXQ + 64 * l;
    volatile LAS unsigned* Q = F.MISC;
    unsigned fetched = 0;
    if (F.tid == 0) { Q[0] = __hip_atomic_fetch_add(ctr, 1u, __ATOMIC_RELAXED, __HIP_MEMORY_SCOPE_AGENT); Q[1] = __hip_atomic_fetch_add(ctr, 1u, __ATOMIC_RELAXED, __HIP_MEMORY_SCOPE_AGENT); }
    LBAR();
    int cur = (int)Q[0], nxt = (int)Q[1];
    v4u pf[NPF];
    F.refresh();
    if (cur < MIX_NU) mix_prefetch(F, l, cur, pf);
#define MIX_ROUND(CALL) do { LBAR();   \
        if (F.tid == 0) fetched = __hip_atomic_fetch_add(ctr, 1u, __ATOMIC_RELAXED, __HIP_MEMORY_SCOPE_AGENT);   \
        F.refresh(); CALL; if (F.tid == 0) Q[0] = fetched; LBAR(); cur = nxt; nxt = (int)Q[0]; } while (0)
    while (cur < MIX_ND) MIX_ROUND(mix_unit_D(F, l, cur * 128, pf, nxt));
    while (cur < MIX_ND + MIX_NC) MIX_ROUND(mix_unit_C(F, l, (cur - MIX_ND) * 64, pf, nxt));
    while (cur < MIX_NU) MIX_ROUND(mix_unit_B(F, l, (cur - MIX_ND - MIX_NC) * 128));
#undef MIX_ROUND
}

constexpr size_t WS_REC = 212 * MiB, WS_OB16 = 476 * MiB;
constexpr int REC_BYTES = 53248, R_NW = 0, R_Q = 8192, R_U = 16384, R_VEC = 32768, R_ATTN = 33792, R_KT = 41984;
constexpr int NITEM = 2304;
constexpr int L_Q = 0, L_K = 4352, L_V = 8704, L_GKK = 13056, L_GQK = 17408, L_QB = 21760, L_KB = 24064, L_AO = 21760, L_AD = 26368, L_DF = 28928, L_SM = 30208, L_XS = 0, GS = 68, SMD = 256;

__device__ __forceinline__ float dpp_xor1(float v) { return __int_as_float(__builtin_amdgcn_mov_dpp(__float_as_int(v), 0xB1, 0xF, 0xF, true)); }

__device__ __forceinline__ void prep_decode(int item, int& b, int& h, int& row0) {
    if (item < 2048) { b = item >> 7; h = (item >> 5) & 3; const int n = item & 31; row0 = b * SEQ + 64 * n; }
    else { const int it = item - 2048; b = it >> 4; h = (it >> 2) & 3; const int n = it & 3; row0 = MLAT + b * CTXL + 64 * n; }
}
__device__ __forceinline__ void prep_load(Frame& F, int l, int item, v4u (&raw)[6], float (&abn)[4], v4u (&wq)[6]) {
    KPtrs& p = F.P(); int b, h, row0; prep_decode(item, b, h, row0); int start, len; row_seq(row0, start, len);
    const int tq = F.tid < 384 ? F.tid : 383, tg = tq / 24, o = tq % 24, part = o >> 3, oo = o & 7;
    const bf16_t* T = ptile_d(p, part) + h * 64 + 8 * oo;
#pragma unroll
    for (int i = 0; i < 6; ++i) { int r = row0 + 4 * tg - 1 + i; r = r < start ? start : (r >= start + len ? start + len - 1 : r); raw[i] = *(const GAS v4u*)(T + (size_t)r * 256); }
    if ((F.wave & 3) == 0) { const int dir = F.wave >> 2, tok = dir ? 63 - F.lane : F.lane; const float* AB = (const float*)(p.ws + WS_AB) + ((size_t)row0 + tok) * 16;
        abn[0] = AB[dir * 4 + h]; abn[1] = AB[8 + dir * 4 + h]; abn[2] = p.a_log[(l * 2 + dir) * 4 + h]; abn[3] = p.dt_bias[(l * 2 + dir) * 4 + h]; }
    { const float* wc = p.qkv_conv_w + (size_t)l * 3 * 768 + part * 256 + h * 64 + 8 * oo;
#pragma unroll
      for (int j = 0; j < 3; ++j) { wq[2 * j] = *(const GAS v4u*)(wc + j * 768); wq[2 * j + 1] = *(const GAS v4u*)(wc + j * 768 + 4); } }
}
__device__ __forceinline__ void prep_item(Frame& F, int l, int item, v4u (&raw)[6], float (&abn)[4], v4u (&wq)[6], int next_item) {
    KPtrs& p = F.P(); const int tid = F.tid, lane = F.lane, wave = F.wave;
    int b, h, row0; prep_decode(item, b, h, row0);
    int start, len; row_seq(row0, start, len);
    LAS float* lf = (LAS float*)F.lds;
    if (tid < 384) { const int tg = tid / 24, o = tid % 24, part = o >> 3, oo = o & 7;
        float w[3][8], x[6][8];
#pragma unroll
        for (int j = 0; j < 3; ++j) { const f32x4 w0 = __builtin_bit_cast(f32x4, wq[2 * j]), w1 = __builtin_bit_cast(f32x4, wq[2 * j + 1]);
            w[j][0] = w0.x; w[j][1] = w0.y; w[j][2] = w0.z; w[j][3] = w0.w; w[j][4] = w1.x; w[j][5] = w1.y; w[j][6] = w1.z; w[j][7] = w1.w; }
#pragma unroll
        for (int i = 0; i < 6; ++i) unpack8(raw[i], x[i]);
        const bool lo_ok = row0 + 4 * tg - 1 >= start, hi_ok = row0 + 4 * tg + 4 < start + len;
#pragma unroll
        for (int e = 0; e < 8; ++e) { x[0][e] = lo_ok ? x[0][e] : 0.f; x[5][e] = hi_ok ? x[5][e] : 0.f; }
#pragma unroll
        for (int t = 0; t < 4; ++t) { float a[8];
#pragma unroll
            for (int e = 0; e < 8; ++e) a[e] = fsilu(w[0][e] * x[t][e] + w[1][e] * x[t + 1][e] + w[2][e] * x[t + 2][e]);
            LAS float* dst = lf + part * 4352 + (4 * tg + t) * 68 + 8 * oo;
            *(LAS f32x4*)dst = (f32x4){a[0], a[1], a[2], a[3]}; *(LAS f32x4*)(dst + 4) = (f32x4){a[4], a[5], a[6], a[7]}; } }
    if ((wave & 3) == 0) { const int dir = wave >> 2, i = lane;
        const float sx = abn[0] + abn[3];
        const float sp = sx > 15.f ? sx : __builtin_amdgcn_logf(1.f + fexp(sx)) * 0.69314718056f;
        const float g = -fexp(abn[2]) * sp;
        const float beta = fsigmoid(abn[1]);
        float gc = g;
        gc += dpp_f<0x111>(gc); gc += dpp_f<0x112>(gc); gc += dpp_f<0x114>(gc); gc += dpp_f<0x118>(gc);
        gc += __int_as_float(__builtin_amdgcn_update_dpp(0, __float_as_int(gc), 0x142, 0xA, 0xF, false));
        gc += __int_as_float(__builtin_amdgcn_update_dpp(0, __float_as_int(gc), 0x143, 0xC, 0xF, false));
        LAS float* sm = lf + L_SM + dir * SMD; const float eg = fexp(gc); sm[i] = gc; sm[64 + i] = beta; sm[128 + i] = eg; sm[192 + i] = beta * eg; }
    prep_load(F, l, next_item, raw, abn, wq);
    LBAR();
    { const int row = tid >> 2, part = row >> 6, t = row & 63, qt = tid & 3; LAS float* src = lf + part * 4352 + t * 68 + 16 * qt;
      f32x4 v[4]; float ss = 0.f;
#pragma unroll
      for (int i = 0; i < 4; ++i) { v[i] = *(LAS f32x4*)(src + 4 * i); ss += (v[i].x * v[i].x + v[i].y * v[i].y) + (v[i].z * v[i].z + v[i].w * v[i].w); }
      ss += __shfl_xor(ss, 1); ss += __shfl_xor(ss, 2);
      const float sc = (1.0f / sqrtf(ss + EPS)) * (part == 0 ? 0.125f : 1.0f);
#pragma unroll
      for (int i = 0; i < 4; ++i) { v[i] = v[i] * sc; *(LAS f32x4*)(src + 4 * i) = v[i]; }
      LAS unsigned char* bdst = (LAS unsigned char*)(lf + (part ? L_KB : L_QB)) + t * 144 + 32 * qt;
      v4u o; o.x = pk2(v[0].x, v[0].y); o.y = pk2(v[0].z, v[0].w); o.z = pk2(v[1].x, v[1].y); o.w = pk2(v[1].z, v[1].w); *(LAS v4u*)bdst = o;
      o.x = pk2(v[2].x, v[2].y); o.y = pk2(v[2].z, v[2].w); o.z = pk2(v[3].x, v[3].y); o.w = pk2(v[3].z, v[3].w); *(LAS v4u*)(bdst + 16) = o; }
    LBAR();
    { const int mat = wave >> 2, it = wave & 3, li = lane & 15, g4 = lane >> 4;
      const LAS unsigned char* Ab = (const LAS unsigned char*)(lf + (mat ? L_QB : L_KB)); const LAS unsigned char* Kb = (const LAS unsigned char*)(lf + L_KB);
      bf16x8 af[2];
#pragma unroll
      for (int s2 = 0; s2 < 2; ++s2) af[s2] = *(const LAS bf16x8*)(Ab + (16 * it + li) * 144 + (32 * s2 + 8 * g4) * 2);
      LAS float* G = lf + (mat ? L_GQK : L_GKK);
#pragma unroll
      for (int jt = 0; jt < 4; ++jt) { f32x4 acc = {0.f, 0.f, 0.f, 0.f};
#pragma unroll
          for (int s2 = 0; s2 < 2; ++s2) { const bf16x8 bq = *(const LAS bf16x8*)(Kb + (16 * jt + li) * 144 + (32 * s2 + 8 * g4) * 2); acc = __builtin_amdgcn_mfma_f32_16x16x32_bf16(af[s2], bq, acc, 0, 0, 0); }
#pragma unroll
          for (int r = 0; r < 4; ++r) G[(16 * it + 4 * g4 + r) * GS + 16 * jt + li] = acc[r]; } }
    LBAR();
    const int dir = tid >> 8, td = tid & 255;
    const LAS float* sm = lf + L_SM + dir * SMD;
    unsigned char* rec = p.ws + WS_REC + (size_t)(item * 2 + dir) * REC_BYTES;
    { const int i = td >> 2, jq = td & 3, ti = dir ? 63 - i : i; const float gi = sm[i], bi = sm[64 + i];
      const LAS float* grow = lf + L_GKK + ti * GS + (dir ? 48 - 16 * jq : 16 * jq);
      float gv[16], gc[16];
#pragma unroll
      for (int k = 0; k < 4; ++k) { const f32x4 a = *(const LAS f32x4*)(grow + 4 * k), c = *(const LAS f32x4*)(sm + 16 * jq + 4 * k);
          gv[4 * k] = a.x; gv[4 * k + 1] = a.y; gv[4 * k + 2] = a.z; gv[4 * k + 3] = a.w; gc[4 * k] = c.x; gc[4 * k + 1] = c.y; gc[4 * k + 2] = c.z; gc[4 * k + 3] = c.w; }
      float val[16];
#pragma unroll
      for (int jj = 0; jj < 16; ++jj) { const int j = 16 * jq + jj; const float G = dir ? gv[15 - jj] : gv[jj];
          const float v = bi * G * fexp(fminf(gi - gc[jj], 0.f)); val[jj] = (i > j) ? v : 0.f; }
      { const bool below = jq < (i >> 4);
        v4u o0, o1; o0.x = below ? pk2(-val[0], -val[1]) : 0u; o0.y = below ? pk2(-val[2], -val[3]) : 0u; o0.z = below ? pk2(-val[4], -val[5]) : 0u; o0.w = below ? pk2(-val[6], -val[7]) : 0u;
        o1.x = below ? pk2(-val[8], -val[9]) : 0u; o1.y = below ? pk2(-val[10], -val[11]) : 0u; o1.z = below ? pk2(-val[12], -val[13]) : 0u; o1.w = below ? pk2(-val[14], -val[15]) : 0u;
        LAS unsigned char* ao = (LAS unsigned char*)(lf + L_AO) + dir * 9216 + i * 144 + 32 * jq; *(LAS v4u*)ao = o0; *(LAS v4u*)(ao + 16) = o1; }
      if (jq == (i >> 4)) { LAS float* ad = lf + L_AD + dir * 1280 + (i >> 4) * 320 + (i & 15) * 20;
#pragma unroll
          for (int k = 0; k < 4; ++k) *(LAS f32x4*)(ad + 4 * k) = (f32x4){val[4 * k], val[4 * k + 1], val[4 * k + 2], val[4 * k + 3]}; } }
#pragma unroll
    for (int k = 0; k < 2; ++k) { const int f = td + 256 * k, ms = f >> 6, ll = f & 63, m = ms >> 1, s = ms & 1, rr = 16 * m + (ll & 15), cb = 32 * s + 4 * (ll >> 4);
        float va[8], vq[8], vk[8];
        const int ti = dir ? 63 - rr : rr; const float gi = sm[rr];
#pragma unroll
        for (int hh = 0; hh < 2; ++hh) { const int c0 = cb + 16 * hh;
            const f32x4 g4 = *(const LAS f32x4*)(lf + L_GQK + ti * GS + (dir ? 60 - c0 : c0)), s4 = *(const LAS f32x4*)(sm + c0), q4 = *(const LAS f32x4*)(lf + L_Q + ti * 68 + c0);
            const float gq[4] = {dir ? g4.w : g4.x, dir ? g4.z : g4.y, dir ? g4.y : g4.z, dir ? g4.x : g4.w}, sc[4] = {s4.x, s4.y, s4.z, s4.w}, qq[4] = {q4.x, q4.y, q4.z, q4.w};
#pragma unroll
            for (int e = 0; e < 4; ++e) { const int c = c0 + e, tc = dir ? 63 - c : c;
                const float v = gq[e] * fexp(fminf(gi - sc[e], 0.f)); va[4 * hh + e] = (rr >= c) ? v : 0.f;
                vq[4 * hh + e] = qq[e];
                vk[4 * hh + e] = lf[L_K + tc * 68 + rr]; } }
        v4u o; o.x = pk2(va[0], va[1]); o.y = pk2(va[2], va[3]); o.z = pk2(va[4], va[5]); o.w = pk2(va[6], va[7]); *(GAS v4u*)(rec + R_ATTN + f * 16) = o;
        o.x = pk2(vq[0], vq[1]); o.y = pk2(vq[2], vq[3]); o.z = pk2(vq[4], vq[5]); o.w = pk2(vq[6], vq[7]); *(GAS v4u*)(rec + R_Q + f * 16) = o;
        o.x = pk2(vk[0], vk[1]); o.y = pk2(vk[2], vk[3]); o.z = pk2(vk[4], vk[5]); o.w = pk2(vk[6], vk[7]); *(GAS v4u*)(rec + R_KT + f * 16) = o; }
    if (td < 64) { float* vec = (float*)(rec + R_VEC); vec[td] = sm[128 + td]; vec[64 + td] = expf(sm[63] - sm[td]); if (td == 0) vec[128] = expf(sm[63]); }
    const int li = lane & 15, g4 = lane >> 4, nt0 = 2 * (wave & 3);
    f32x4 Rt[2][4];
#pragma unroll
    for (int t = 0; t < 2; ++t) { const int nt = nt0 + t; const LAS float* src = lf + (nt < 4 ? L_V + 16 * nt + li : L_K + 16 * (nt - 4) + li); const LAS float* scl = sm + (nt < 4 ? 64 : 192);
#pragma unroll
        for (int m = 0; m < 4; ++m) { const f32x4 sc = *(const LAS f32x4*)(scl + 16 * m + 4 * g4); const int i0 = 16 * m + 4 * g4;
            Rt[t][m] = (f32x4){src[(dir ? 63 - i0 : i0) * 68] * sc.x, src[(dir ? 62 - i0 : i0 + 1) * 68] * sc.y, src[(dir ? 61 - i0 : i0 + 2) * 68] * sc.z, src[(dir ? 60 - i0 : i0 + 3) * 68] * sc.w}; } }
    LBAR();
    if ((wave & 3) == 0) { const int blk = lane >> 4, c = lane & 15; const LAS float* Ad = lf + L_AD + dir * 1280 + blk * 320;
        float x[16];
#pragma unroll
        for (int r = 0; r < 16; ++r) x[r] = 0.f;
#pragma unroll
        for (int hb = 0; hb < 4; ++hb) {
            f32x4 arow[4][4];
#pragma unroll
            for (int rr = 0; rr < 4; ++rr)
#pragma unroll
                for (int q = 0; q < (4 * hb + rr + 3) / 4; ++q) arow[rr][q] = *(const LAS f32x4*)(Ad + (4 * hb + rr) * 20 + 4 * q);
#pragma unroll
            for (int rr = 0; rr < 4; ++rr) { const int r = 4 * hb + rr; float acc = (r == c) ? 1.f : 0.f;
#pragma unroll
                for (int q = 0; q < (r + 3) / 4; ++q) { const f32x4 a = arow[rr][q]; acc -= (a.x * x[4 * q] + a.y * x[4 * q + 1]) + (a.z * x[4 * q + 2] + a.w * x[4 * q + 3]); }
                x[r] = acc; } }
        LAS bf16_t* DF = (LAS bf16_t*)(lf + L_DF) + dir * 1280 + blk * 320;
#pragma unroll
        for (int r = 0; r < 16; ++r) DF[r * 20 + c] = f2bf(x[r]); }
    LBAR();
    { const LAS unsigned char* ao = (const LAS unsigned char*)(lf + L_AO) + dir * 9216; const LAS unsigned char* df = (const LAS unsigned char*)(lf + L_DF) + dir * 2560;
      const f32x4 zero4 = {0.f, 0.f, 0.f, 0.f};
      f32x4 X[2][4];
#pragma unroll
      for (int t = 0; t < 2; ++t)
#pragma unroll
          for (int m = 0; m < 4; ++m) X[t][m] = zero4;
#pragma unroll
      for (int m = 0; m < 4; ++m) {
          const u32x2 dw = *(const LAS u32x2*)(df + m * 640 + li * 40 + g4 * 8);
          const bf16x8 dfrag = __builtin_bit_cast(bf16x8, (v4u){dw.x, dw.y, 0u, 0u});
          f32x4 acc[2] = {Rt[0][m], Rt[1][m]};
#pragma unroll
          for (int s2 = 0; s2 < (m + 1) / 2; ++s2) { const u32x2 lo = *(const LAS u32x2*)(ao + (16 * m + li) * 144 + (32 * s2 + 4 * g4) * 2), hi = *(const LAS u32x2*)(ao + (16 * m + li) * 144 + (32 * s2 + 16 + 4 * g4) * 2);
              const bf16x8 afrag = __builtin_bit_cast(bf16x8, (v4u){lo.x, lo.y, hi.x, hi.y});
#pragma unroll
              for (int t = 0; t < 2; ++t) acc[t] = __builtin_amdgcn_mfma_f32_16x16x32_bf16(afrag, pack8(X[t][2 * s2], X[t][2 * s2 + 1]), acc[t], 0, 0, 0); }
#pragma unroll
          for (int t = 0; t < 2; ++t) X[t][m] = __builtin_amdgcn_mfma_f32_16x16x32_bf16(dfrag, pack8(acc[t], zero4), zero4, 0, 0, 0); }
      LAS float* XS = lf + L_XS + dir * 8448;
#pragma unroll
      for (int t = 0; t < 2; ++t)
#pragma unroll
          for (int m = 0; m < 4; ++m)
#pragma unroll
              for (int r = 0; r < 4; ++r) XS[(16 * m + 4 * g4 + r) * 132 + 16 * (nt0 + t) + li] = X[t][m][r]; }
    LBAR();
    { const LAS float* XS = lf + L_XS + dir * 8448;
#pragma unroll
      for (int k = 0; k < 2; ++k) { const int f = td + 256 * k, ms = f >> 6, ll = f & 63, m = ms >> 1, s = ms & 1, rr = 16 * m + (ll & 15), cb = 32 * s + 4 * (ll >> 4);
          float v[8];
#pragma unroll
          for (int e = 0; e < 8; ++e) v[e] = -XS[rr * 132 + 64 + cb + 16 * (e >> 2) + (e & 3)];
          v4u o; o.x = pk2(v[0], v[1]); o.y = pk2(v[2], v[3]); o.z = pk2(v[4], v[5]); o.w = pk2(v[6], v[7]); *(GAS v4u*)(rec + R_NW + f * 16) = o; }
#pragma unroll
      for (int k = 0; k < 4; ++k) { const int u = td + 256 * k, w = u >> 8, m = (u >> 6) & 3, ll = u & 63, r0 = 16 * m + 4 * (ll >> 4), c = 16 * w + (ll & 15);
          const f32x4 o = {XS[r0 * 132 + c], XS[(r0 + 1) * 132 + c], XS[(r0 + 2) * 132 + c], XS[(r0 + 3) * 132 + c]};
          *(GAS u32x2*)(rec + R_U + u * 8) = (u32x2){pk2(o.x, o.y), pk2(o.z, o.w)}; } }
    LBAR();
}
__device__ __forceinline__ void phase_prep(Frame& F, int l) {
    v4u raw[6], wq[6]; float abn[4] = {0.f, 0.f, 0.f, 0.f};
    F.refresh();
    if (F.vcu < NITEM) prep_load(F, l, F.vcu, raw, abn, wq);
    for (int it = F.vcu; it < NITEM; it += F.G) { F.refresh(); prep_item(F, l, it, raw, abn, wq, it + F.G < NITEM ? it + F.G : it); }
}

__device__ __forceinline__ void scan_rec(int b, int h, int dir, int step, int& cid, int& row0) {
    if (step < 4) { const int n = dir ? 3 - step : step; cid = 2048 + (b * 4 + h) * 4 + n; row0 = MLAT + b * CTXL + 64 * n; }
    else { const int n = dir ? 35 - step : step - 4; cid = (b * 4 + h) * 32 + n; row0 = b * SEQ + 64 * n; }
}
__device__ __forceinline__ void phase_scan(Frame& F, int l) {
    KPtrs& p = F.P();
    const int bx = (int)blockIdx.x, xq = bx >> 3, half = xq & 1, s = (bx & 7) * 16 + (xq >> 1), b = s >> 3, h = (s >> 1) & 3, dir = s & 1, lane = F.lane;
    constexpr int NSTEP = 36, PIECES = 7;
    if (F.wave >= 2) {
        const int lw = F.wave - 2;
#define SCAN_ISSUE(t_) do { int cid_, row0_; scan_rec(b, h, dir, (t_), cid_, row0_); const unsigned char* rec_ = p.ws + WS_REC + (size_t)(cid_ * 2 + dir) * REC_BYTES + lane * 16; \
            LAS unsigned char* slot_ = F.lds + ((t_) % 3) * REC_BYTES; \
            _Pragma("unroll") for (int k_ = 0; k_ < PIECES; ++k_) { const int j_ = lw + 6 * k_; if (j_ < 37) { \
                const int pc_ = j_ < 16 ? j_ : j_ < 20 ? 4 * half + j_ : j_ == 20 ? 32 : j_ + 12; \
                __builtin_amdgcn_global_load_lds((const GAS unsigned*)(rec_ + pc_ * 1024), (LAS unsigned*)(slot_ + pc_ * 1024), 16, 0, 0); } } } while (0)
        SCAN_ISSUE(0); SCAN_ISSUE(1);
        for (int t = 0; t < NSTEP; ++t) {
            if (t + 1 >= NSTEP) asm volatile("s_waitcnt vmcnt(0)" ::: "memory"); else if (lw == 0) asm volatile("s_waitcnt vmcnt(7)" ::: "memory"); else asm volatile("s_waitcnt vmcnt(6)" ::: "memory");
            asm volatile("" ::: "memory"); __builtin_amdgcn_s_barrier(); asm volatile("" ::: "memory");
            if (t + 2 < NSTEP) SCAN_ISSUE(t + 2);
        }
#undef SCAN_ISSUE
        return;
    }
    const int w = 2 * half + F.wave, li = lane & 15, g4 = lane >> 4;
    f32x4 S[4];
#pragma unroll
    for (int m = 0; m < 4; ++m) S[m] = (f32x4){0.f, 0.f, 0.f, 0.f};
    bf16_t* O = (bf16_t*)(p.ws + WS_OB16) + (size_t)dir * MTOT * 256;
    for (int step = 0; step < NSTEP; ++step) {
        int cid, row0; scan_rec(b, h, dir, step, cid, row0);
        asm volatile("s_waitcnt lgkmcnt(0)" ::: "memory"); __builtin_amdgcn_s_barrier(); asm volatile("" ::: "memory");
        const LAS unsigned char* rec = F.lds + (step % 3) * REC_BYTES;
        bf16x8 nw[4][2], qf[4][2], at[4][2], kt[4][2]; f32x4 av[4], ao[4], a2[4], egc4[4], edl4[4];
#pragma unroll
        for (int m = 0; m < 4; ++m) {
#pragma unroll
            for (int s2 = 0; s2 < 2; ++s2) { nw[m][s2] = *(const LAS bf16x8*)(rec + R_NW + ((m * 2 + s2) * 64 + lane) * 16); qf[m][s2] = *(const LAS bf16x8*)(rec + R_Q + ((m * 2 + s2) * 64 + lane) * 16); }
            { const u32x2 uw = *(const LAS u32x2*)(rec + R_U + ((w * 4 + m) * 64 + lane) * 8); av[m] = (f32x4){bflo(uw.x), bfhi(uw.x), bflo(uw.y), bfhi(uw.y)}; } ao[m] = (f32x4){0.f, 0.f, 0.f, 0.f}; }
        const float gl = *(const LAS float*)(rec + R_VEC + 512);
        bf16x8 Bs[2] = {pack8(S[0], S[1]), pack8(S[2], S[3])};
#pragma unroll
        for (int m = 0; m < 4; ++m)
#pragma unroll
            for (int s2 = 0; s2 < 2; ++s2) { av[m] = __builtin_amdgcn_mfma_f32_16x16x32_bf16(nw[m][s2], Bs[s2], av[m], 0, 0, 0); ao[m] = __builtin_amdgcn_mfma_f32_16x16x32_bf16(qf[m][s2], Bs[s2], ao[m], 0, 0, 0); }
#pragma unroll
        for (int m = 0; m < 4; ++m) {
#pragma unroll
            for (int s2 = 0; s2 < 2; ++s2) { at[m][s2] = *(const LAS bf16x8*)(rec + R_ATTN + ((m * 2 + s2) * 64 + lane) * 16); kt[m][s2] = *(const LAS bf16x8*)(rec + R_KT + ((m * 2 + s2) * 64 + lane) * 16); }
            edl4[m] = *(const LAS f32x4*)(rec + R_VEC + 256 + (16 * m + 4 * g4) * 4); egc4[m] = *(const LAS f32x4*)(rec + R_VEC + (16 * m + 4 * g4) * 4); a2[m] = (f32x4){0.f, 0.f, 0.f, 0.f}; }
        bf16x8 Bv[2] = {pack8(av[0], av[1]), pack8(av[2], av[3])};
        bf16x8 Bvs[2] = {pack8(av[0] * edl4[0], av[1] * edl4[1]), pack8(av[2] * edl4[2], av[3] * edl4[3])};
#pragma unroll
        for (int m = 0; m < 4; ++m) S[m] = S[m] * gl;
#pragma unroll
        for (int m = 0; m < 4; ++m)
#pragma unroll
            for (int s2 = 0; s2 < 2; ++s2) { a2[m] = __builtin_amdgcn_mfma_f32_16x16x32_bf16(at[m][s2], Bv[s2], a2[m], 0, 0, 0); S[m] = __builtin_amdgcn_mfma_f32_16x16x32_bf16(kt[m][s2], Bvs[s2], S[m], 0, 0, 0); }
#pragma unroll
        for (int m = 0; m < 4; ++m) { const f32x4 o = egc4[m] * ao[m] + a2[m];
#pragma unroll
            for (int r = 0; r < 4; ++r) { const int i = 16 * m + 4 * g4 + r, tok = dir ? 63 - i : i;
                O[(size_t)(row0 + tok) * 256 + h * 64 + 16 * w + li] = f2bf(o[r]); } }
    }
}

__device__ __forceinline__ void phase_comb(Frame& F, int l) {
    KPtrs& p = F.P(); const int lane = F.lane;
    const int gw = F.vcu * NWAVES + F.wave, NGW = F.G * NWAVES;
    const bf16_t* OF = (const bf16_t*)(p.ws + WS_OB16); const bf16_t* OB = OF + (size_t)MTOT * 256; const bf16_t* GA = ptile_d(p, T_GA);
    const f32x4 ng = *(const f32x4*)(p.gdn_norm_g + l * 64 + 4 * (lane & 15));
    const int nrow = (l == DEPTH - 1) ? MLAT : MTOT;
    u32x2 an, cn, gn;
    if (gw < nrow) { an = *(const GAS u32x2*)(OF + (size_t)gw * 256 + 4 * lane); cn = *(const GAS u32x2*)(OB + (size_t)gw * 256 + 4 * lane); gn = *(const GAS u32x2*)(GA + (size_t)gw * 256 + 4 * lane); }
    for (int r = gw; r < nrow; r += NGW) {
        const u32x2 a = an, c = cn, gt = gn;
        if (r + NGW < nrow) { const size_t r2 = (size_t)(r + NGW); an = *(const GAS u32x2*)(OF + r2 * 256 + 4 * lane); cn = *(const GAS u32x2*)(OB + r2 * 256 + 4 * lane); gn = *(const GAS u32x2*)(GA + r2 * 256 + 4 * lane); }
        const f32x4 o = {bflo(a.x) + bflo(c.x), bfhi(a.x) + bfhi(c.x), bflo(a.y) + bflo(c.y), bfhi(a.y) + bfhi(c.y)};
        float ss = (o.x * o.x + o.y * o.y) + (o.z * o.z + o.w * o.w);
        ss = row16_sum(ss);
        const float rs = 1.0f / sqrtf(ss * (1.f / 64.f) + EPS);
        u32x2 y; y.x = pk2(o.x * rs * ng.x * bflo(gt.x), o.y * rs * ng.y * bfhi(gt.x)); y.y = pk2(o.z * rs * ng.z * bflo(gt.y), o.w * rs * ng.w * bfhi(gt.y));
        *(GAS u32x2*)((bf16_t*)(p.ws + WS_HY) + (size_t)r * DM + 4 * lane) = y;
    }
}

constexpr int PH_FINAL = 1 + 7 * DEPTH, PH_END = PH_FINAL + 1;
struct Args { Ptrs p; int ph_lo, ph_hi; };
__global__ void __launch_bounds__(NWAVES * 64, 2) mega(Args args) {
    extern __shared__ __attribute__((aligned(16))) unsigned char lds[];
    Frame F;
    F.lds = (LAS unsigned char*)lds; F.MISC = (volatile LAS unsigned*)(F.lds + MISC_OFF);
    F.tid = threadIdx.x; F.lane = F.tid & 63; F.wave = __builtin_amdgcn_readfirstlane(F.tid >> 6);
    F.G = gridDim.x; { const int bx = blockIdx.x; F.vcu = (F.G % 8 == 0) ? (bx % 8) * (F.G / 8) + bx / 8 : bx; }
    F.ctl = (gu32*)(args.p.ws + WS_CTL);
    for (int u = F.tid; u < (LDS_BYTES - LDSCTL_OFF) / 4; u += NWAVES * 64) ((LAS unsigned*)(F.lds + LDSCTL_OFF))[u] = 0u;
    __syncthreads();
    const bool multi = args.ph_hi - args.ph_lo > 1;
    XcdBarrier bar; bar.bar = (unsigned*)(F.ctl + CW_BAR); bar.x = 0; bar.st = nullptr;
    if (multi) bar = xcd_barrier_post((unsigned*)(F.ctl + CW_BAR), F.MISC + 8);
    for (int ph = args.ph_lo; ph < args.ph_hi; ++ph) {
        F.refresh();
#if PROBE_S >= 0
        const bool amp = (PROBE_S == 7) ? (ph == 0) : (PROBE_S == 8) ? (ph == PH_FINAL) : (ph > 0 && ph < PH_FINAL && (ph - 1) % 7 == PROBE_S);
        const unsigned long long t0 = __builtin_amdgcn_s_memrealtime();
#endif
        if (ph == 0) phase_pre(F);
        else if (ph == PH_FINAL) phase_final(F);
        else { const int l = (ph - 1) / 7, s = (ph - 1) % 7;
            if (s == 0) phase_norm(F, l);
            else if (s == 1) phase_gemm1(F, l);
            else if (s == 2) phase_mix(F, l);
            else if (s == 3) phase_prep(F, l);
            else if (s == 4) phase_scan(F, l);
            else if (s == 5) phase_comb(F, l);
            else if (s == 6) phase_gemm2(F, l);
        }
        if (ph + 1 < args.ph_hi) xcd_barrier(bar);
#if PROBE_S >= 0
        if (amp) { const unsigned long long dt = __builtin_amdgcn_s_memrealtime() - t0; while (__builtin_amdgcn_s_memrealtime() - t0 < 2 * dt) __builtin_amdgcn_s_sleep(4); }
#endif
    }
}

extern "C" void kernel_launch(void* const* d_in, const int* in_sizes, int n_in, void* d_out, int out_size, void* d_ws, size_t ws_size, hipStream_t stream) {
    static int grid = 0;
    if (grid == 0) {
        if (n_in != 23 || out_size != MLAT * DM || ws_size < WS_END) { fprintf(stderr, "kernel_launch: unexpected shapes (n_in %d out %d ws %zu)\n", n_in, out_size, ws_size); grid = -1; return; }
        int dev = 0, cus = 0;
        if (hipGetDevice(&dev) != hipSuccess || hipDeviceGetAttribute(&cus, hipDeviceAttributeMultiprocessorCount, dev) != hipSuccess) { grid = -1; return; }
        if (hipFuncSetAttribute((const void*)mega, hipFuncAttributeMaxDynamicSharedMemorySize, LDS_BYTES) != hipSuccess) { fprintf(stderr, "kernel_launch: hipFuncSetAttribute failed\n"); grid = -1; return; }
        grid = cus;
        if (grid != 256) fprintf(stderr, "kernel_launch: %d CUs (built for 256)\n", grid);
    }
    if (grid < 0) return;
    hipMemsetAsync((char*)d_ws + WS_CTL, 0, CTL_ZERO_BYTES, stream);
    Args a{};
    const float** f = (const float**)&a.p;
    for (int i = 0; i < 23; ++i) f[i] = (const float*)d_in[i];
    a.p.out = (float*)d_out; a.p.ws = (unsigned char*)d_ws;
    a.ph_lo = 0; a.ph_hi = PH_END;
    hipLaunchKernelGGL(mega, dim3(grid), dim3(NWAVES * 64), LDS_BYTES, stream, a);
}
```

```cpp
#include <hip/hip_runtime.h>
#ifndef PROBE_S
#define PROBE_S (-1)
#endif
#include <cstdio>
#include <cstdint>

typedef unsigned short bf16_t;
__device__ __forceinline__ float bf2f(bf16_t v) { return __uint_as_float(((unsigned)v) << 16); }
typedef __bf16 nbf16x2 __attribute__((ext_vector_type(2)));
typedef __bf16 nbf16x8 __attribute__((ext_vector_type(8)));
typedef float nf32x2 __attribute__((ext_vector_type(2)));
typedef float nf32x8 __attribute__((ext_vector_type(8)));
__device__ __forceinline__ bf16_t f2bf(float f) { return __builtin_bit_cast(bf16_t, (__bf16)f); }

constexpr int DM = 1024, NB = 16, SEQ = 2048, DEPTH = 4, CTXL = 256, HD = 64, BW = 256, HA = 4;
constexpr int INC = 3600, NPC = 3584, NTILE = 10;
constexpr int MLAT = NB * SEQ, MCTX = NB * CTXL, MTOT = MLAT + MCTX;
constexpr float EPS = 1e-6f;
__device__ __constant__ int c_gt_col[14]   = {0, 256, 512, 2576,   784, 784 + 128,    1040, 1040 + 128,  1552, 1552 + 128,  2064, 2064 + 128,  2320, 3088};
__device__ __constant__ int c_gt_delta[14] = {0, 0,   0,   0,      2048, 2048,        256, 256,          256, 256,          1280, 1280,        0,    0};
enum { T_Q = 0, T_K = 1, T_V = 2, T_GA = 3, T_BGS = 4, T_CX = 5, T_GLU = 6, T_UG = 7, T_VV = 8, T_GC = 9 };

constexpr size_t MiB = 1u << 20;
constexpr size_t WS_CTL = 0, WS_MOD = 1 * MiB, WS_AB = 2 * MiB, WS_GB = 5 * MiB, WS_STAT = 8 * MiB, WS_XC = 16 * MiB, WS_WIN = 32 * MiB, WS_WOUT = 60 * MiB,
                 WS_HY = 68 * MiB, WS_P = 140 * MiB, WS_OFB = 392 * MiB, WS_END = 512 * MiB;
constexpr size_t PTILE_ELEMS = (size_t)MTOT * 256;
constexpr size_t WS_QKV = WS_P + 4 * PTILE_ELEMS * 2;

struct Ptrs {
    const float *x, *c, *ctx, *c_ctx, *norm_g, *w_ada, *b_ada, *w_in, *qkv_conv_w, *a_log, *dt_bias, *gdn_norm_g, *short_conv_w, *conf_conv_w, *conf_conv_b,
        *conf_ln_g, *conf_ln_b, *smlp_ln_g, *smlp_ln_b, *smlp_w, *smlp_b, *w_out, *final_g;
    float* out; unsigned char* ws;
};

__device__ __forceinline__ float silu_f(float x) { return x / (1.f + expf(-x)); }
__device__ __forceinline__ float sigmoid_f(float x) { return 1.f / (1.f + expf(-x)); }
__device__ __forceinline__ float softplus_f(float x) { return x > 20.f ? x : log1pf(expf(x)); }
__device__ __forceinline__ float fexp(float x) { return __builtin_amdgcn_exp2f(x * 1.44269504089f); }
__device__ __forceinline__ float fsigmoid(float x) { return __builtin_amdgcn_rcpf(1.f + fexp(-x)); }
__device__ __forceinline__ float fsilu(float x) { return x * fsigmoid(x); }

__device__ __forceinline__ float block_sum256(float v, float* red) {
#pragma unroll
    for (int o = 32; o > 0; o >>= 1) v += __shfl_xor(v, o);
    __syncthreads();
    if ((threadIdx.x & 63) == 0) red[threadIdx.x >> 6] = v;
    __syncthreads();
    return red[0] + red[1] + red[2] + red[3];
}
template <int CTRL> __device__ __forceinline__ float dpp_f(float v) { return __int_as_float(__builtin_amdgcn_mov_dpp(__float_as_int(v), CTRL, 0xF, 0xF, true)); }
__device__ __forceinline__ float row16_sum(float v) {
    v += dpp_f<0xB1>(v); v += dpp_f<0x4E>(v); v += dpp_f<0x141>(v); v += dpp_f<0x140>(v); return v; }
__device__ __forceinline__ float wave_sum(float v) {
    v = row16_sum(v);
    { auto r = __builtin_amdgcn_permlane16_swap(__float_as_uint(v), __float_as_uint(v), false, false); v = __uint_as_float(r[0]) + __uint_as_float(r[1]); }
    { auto r = __builtin_amdgcn_permlane32_swap(__float_as_uint(v), __float_as_uint(v), false, false); v = __uint_as_float(r[0]) + __uint_as_float(r[1]); }
    return v; }

__device__ __forceinline__ void row_seq(int row, int& start, int& len) { if (row < MLAT) { start = row & ~(SEQ - 1); len = SEQ; } else { start = row & ~(CTXL - 1); len = CTXL; } }

namespace pg8 {
#define PG8_LAS __attribute__((address_space(3)))
typedef unsigned short bf16_t;
typedef short bf16x8 __attribute__((ext_vector_type(8)));
typedef float f32x4 __attribute__((ext_vector_type(4)));
typedef unsigned u32x4 __attribute__((ext_vector_type(4)));
constexpr int BM = 256, BK = 64, HALF = 128, HTB = HALF * BK * 2  , STAGE_BYTES = 8 * HTB, NXCD = 8, WGM = 8;

__host__ __device__ __forceinline__ int lds_byte(int r, int c) { const int st = (r >> 4) * 2 + (c >> 5), rr = r & 15, cc = c & 31, ob = rr * 64 + cc * 2; return st * 1024 + (ob ^ (((ob >> 9) & 1) << 5)); }
__host__ __device__ __forceinline__ void stage_rc(int b, int& R, int& C) { const int st = b / 1024, sb = b % 1024, swz = sb ^ (((sb >> 9) & 1) << 5); R = (st >> 1) * 16 + swz / 64; C = (st & 1) * 32 + (swz % 64) / 2; }
__host__ __device__ __forceinline__ int perm32(int rho) { const int n = rho >> 4, i = rho & 15; return 8 * (i >> 2) + 4 * n + (i & 3); }

struct Unit { int pm, pn; };
struct Gemm { const bf16_t* A; const bf16_t* Bt; int M, N, K; };

struct StaticOrder {
    static constexpr int ROT = 0;
    __device__ __forceinline__ void mid_wait() const {}
    int nM, nN, nwg, G, c;
    __host__ __device__ void init(int M, int N, int G_, int c_) { nM = M / BM; nN = N / BM; nwg = nM * nN; G = G_; c = c_; }
    __host__ __device__ bool next(int i, Unit& u) const {
        const long L = (long)i * G + c; if (L >= nwg) return false;
        int wgid = (int)L; { const int q = nwg / NXCD, r = nwg % NXCD, xcd = wgid % NXCD, off = wgid / NXCD; wgid = (xcd < r ? xcd * (q + 1) : r * (q + 1) + (xcd - r) * q) + off; }
        const int nig = WGM * nN, gid = wgid / nig, fm = gid * WGM, gsz = (nM - fm) < WGM ? (nM - fm) : WGM;
        u.pm = fm + ((wgid % nig) % gsz); u.pn = (wgid % nig) / gsz; return true;
    }
    __device__ __forceinline__ void a_ready(const Unit&) const {}
    __device__ __forceinline__ void done(const Unit&) const {}
};


__device__ __forceinline__ unsigned cvt_pk_bf16(float lo, float hi) { return __builtin_bit_cast(unsigned, __builtin_convertvector((nf32x2){lo, hi}, nbf16x2)); }
struct EpiP {
    static constexpr bool PERM = true, AFTER_DRAIN = false;
    static constexpr int NVM = 16;
    bf16_t* P; size_t tile_elems;
    __device__ __forceinline__ void operator()(const f32x4 (&acc)[2][2][4][2], const Unit& u, int wr, int wc, int fr, int fq) const {
        const int row0 = u.pm * BM + wr * 64 + fr, g = u.pn;
        if (g < 4 || g > 11) {
            bf16_t* base = P + (size_t)(g < 4 ? g : g - 4) * tile_elems + wc * 32 + 8 * fq + (size_t)row0 * 256;
            if (g == 3 || g == 13) plain<true>(acc, base); else plain<false>(acc, base);
        } else {
            const int pr = (g - 4) >> 1;
            bf16_t* base = P + (size_t)(4 + pr) * tile_elems + 128 * (g & 1) + wc * 16 + 4 * fq + (size_t)row0 * 256;
            if (pr == 1) pairs<1>(acc, base); else if (pr == 2) pairs<2>(acc, base); else pairs<0>(acc, base);
        }
    }
    template <bool GATE> __device__ __forceinline__ void plain(const f32x4 (&acc)[2][2][4][2], bf16_t* base) const {
#pragma unroll
        for (int ai = 0; ai < 2; ++ai)
#pragma unroll
            for (int m = 0; m < 4; ++m) { bf16_t* rowp = base + (size_t)(ai * HALF + m * 16) * 256;
#pragma unroll
                for (int bj = 0; bj < 2; ++bj) { f32x4 v0 = acc[ai][bj][m][0], v1 = acc[ai][bj][m][1];
                    if (GATE) {
#pragma unroll
                        for (int e = 0; e < 4; ++e) { v0[e] = v0[e] * __builtin_amdgcn_rcpf(1.f + __builtin_amdgcn_exp2f(-1.44269504089f * v0[e])); v1[e] = v1[e] * __builtin_amdgcn_rcpf(1.f + __builtin_amdgcn_exp2f(-1.44269504089f * v1[e])); } }
                    u32x4 w; w.x = cvt_pk_bf16(v0[0], v0[1]); w.y = cvt_pk_bf16(v0[2], v0[3]); w.z = cvt_pk_bf16(v1[0], v1[1]); w.w = cvt_pk_bf16(v1[2], v1[3]);
                    *(u32x4*)(rowp + bj * HALF) = w; } }
    }
    template <int OP> __device__ __forceinline__ void pairs(const f32x4 (&acc)[2][2][4][2], bf16_t* base) const {
#pragma unroll
        for (int ai = 0; ai < 2; ++ai)
#pragma unroll
            for (int m = 0; m < 4; ++m) { bf16_t* rowp = base + (size_t)(ai * HALF + m * 16) * 256;
#pragma unroll
                for (int bj = 0; bj < 2; ++bj) { const f32x4 v0 = acc[ai][bj][m][0], v1 = acc[ai][bj][m][1];
                    const float a4[4] = {v0[0], v0[2], v1[0], v1[2]}, b4[4] = {v0[1], v0[3], v1[1], v1[3]}; float o[4];
#pragma unroll
                    for (int e = 0; e < 4; ++e) {
                        if (OP == 1) o[e] = a4[e] * b4[e];
                        else { const float sg = __builtin_amdgcn_rcpf(1.f + __builtin_amdgcn_exp2f(-1.44269504089f * b4[e])); o[e] = OP == 2 ? a4[e] * sg : a4[e] * (b4[e] * sg); } }
                    typedef unsigned u32x2v __attribute__((ext_vector_type(2)));
                    u32x2v w; w.x = cvt_pk_bf16(o[0], o[1]); w.y = cvt_pk_bf16(o[2], o[3]);
                    *(u32x2v*)(rowp + bj * 64) = w; } }
    }
};
struct OneUnit {
    static constexpr int ROT = 0;
    __device__ __forceinline__ void mid_wait() const {}
    Unit u0;
    __device__ __forceinline__ bool next(int i, Unit& u) const { if (i != 0) return false; u = u0; return true; }
    __device__ __forceinline__ void a_ready(const Unit&) const {}
    __device__ __forceinline__ void done(const Unit&) const {}
};
struct EpiResid {
    static constexpr bool PERM = true, AFTER_DRAIN = false;
    static constexpr int NVM = 32;
    const void* x_old; bf16_t* x_new; const void* xc_old; bf16_t* xc_new; const float* mod_l; int odd, mlat, seq, dm, f32in, row_off;
    __device__ __forceinline__ void operator()(f32x4 (&acc)[2][2][4][2], const Unit& u, int wr, int wc, int fr, int fq) const {
        const bool lat = row_off + u.pm * BM < mlat;
        if (f32in) { if (lat) body<true, true>(acc, u, wr, wc, fr, fq); else body<true, false>(acc, u, wr, wc, fr, fq); }
        else { if (lat) body<false, true>(acc, u, wr, wc, fr, fq); else body<false, false>(acc, u, wr, wc, fr, fq); }
    }
    template <bool F32IN, bool LAT> __device__ __forceinline__ void body(f32x4 (&acc)[2][2][4][2], const Unit& u, int wr, int wc, int fr, int fq) const {
        const int rbase = row_off + u.pm * BM; const int b = LAT ? rbase / seq : 16;
        const int col = u.pn * BM + wc * 32 + 8 * fq;
        { const float* gate = mod_l + (size_t)b * 3072 + 2048 + col;
#pragma unroll
          for (int bj = 0; bj < 2; ++bj)
#pragma unroll
            for (int n = 0; n < 2; ++n) { const f32x4 g = *(const f32x4*)(gate + bj * HALF + 4 * n);
#pragma unroll
                for (int ai = 0; ai < 2; ++ai)
#pragma unroll
                    for (int m = 0; m < 4; ++m) acc[ai][bj][m][n] = acc[ai][bj][m][n] * g; } }
        const void* ob = LAT ? x_old : xc_old; bf16_t* nb = LAT ? x_new : xc_new;
        constexpr int NA = F32IN ? 1 : 2;
#pragma unroll
        for (int h = 0; h < 2 / NA; ++h) {
            unsigned offs[NA][4]; u32x4 raw[NA][4][2]; f32x4 rawf[F32IN ? 4 : 1][2][2];
#pragma unroll
            for (int a = 0; a < NA; ++a)
#pragma unroll
                for (int m = 0; m < 4; ++m) { const int r = rbase + (h + a) * HALF + wr * 64 + m * 16 + fr;
                    if (LAT) { const int tp = r % seq; const int tq = (tp & 31) * 64 + (tp >> 5); const int t = odd ? tq : tp; offs[a][m] = (unsigned)(((r / seq) * seq + t) * dm + col); }
                    else offs[a][m] = (unsigned)((r - mlat) * dm + col); }
#pragma unroll
            for (int a = 0; a < NA; ++a)
#pragma unroll
                for (int m = 0; m < 4; ++m)
#pragma unroll
                    for (int bj = 0; bj < 2; ++bj) {
                        if constexpr (F32IN) { rawf[m][bj][0] = *(const f32x4*)((const float*)ob + offs[a][m] + bj * HALF); rawf[m][bj][1] = *(const f32x4*)((const float*)ob + offs[a][m] + bj * HALF + 4); }
                        else raw[a][m][bj] = *(const u32x4*)((const bf16_t*)ob + offs[a][m] + bj * HALF); }
#pragma unroll
            for (int a = 0; a < NA; ++a)
#pragma unroll
                for (int m = 0; m < 4; ++m)
#pragma unroll
                    for (int bj = 0; bj < 2; ++bj) { f32x4 o0, o1;
                        if constexpr (F32IN) { o0 = rawf[m][bj][0]; o1 = rawf[m][bj][1]; }
                        else { const u32x4 w = raw[a][m][bj];
                            o0 = (f32x4){__uint_as_float(w.x << 16), __uint_as_float(w.x & 0xffff0000u), __uint_as_float(w.y << 16), __uint_as_float(w.y & 0xffff0000u)};
                            o1 = (f32x4){__uint_as_float(w.z << 16), __uint_as_float(w.z & 0xffff0000u), __uint_as_float(w.w << 16), __uint_as_float(w.w & 0xffff0000u)}; }
                        const f32x4 v0 = o0 + acc[h + a][bj][m][0], v1 = o1 + acc[h + a][bj][m][1];
                        u32x4 w; w.x = cvt_pk_bf16(v0[0], v0[1]); w.y = cvt_pk_bf16(v0[2], v0[3]); w.z = cvt_pk_bf16(v1[0], v1[1]); w.w = cvt_pk_bf16(v1[2], v1[3]);
                        *(u32x4*)(nb + offs[a][m] + bj * HALF) = w; }
            asm volatile("" ::: "memory");
        }
    }
};
template <class Epi, class Sched, bool ALIGN_EPI = false, bool SP2 = false>
__device__ __forceinline__ void gemm_phase(PG8_LAS unsigned char* lds, const Gemm g, const Sched& S, const Epi& E) {
    int tid_ = threadIdx.x; asm volatile("" : "+v"(tid_));
    const int tid = tid_, wid = __builtin_amdgcn_readfirstlane(tid >> 6), lane = tid & 63, wr = wid >> 2, wc = wid & 3, fr = lane & 15, fq = lane >> 4;
    const int K = g.K, nt = K / BK;
    constexpr bool DEFER = ALIGN_EPI && SP2;
    unsigned voffA, voffB;
    { int R, C; stage_rc(tid * 16, R, C); const int Rb = Epi::PERM ? ((R & ~31) + perm32(R & 31)) : R;
        voffA = (unsigned)(R * K + C) * 2u; voffB = (unsigned)(Rb * K + C) * 2u; }
    const size_t qstep = (size_t)64 * K * 2;
    const size_t kstep = (size_t)(BK * 2);
    const size_t hstep = (size_t)HALF * K * 2;
    const size_t tstep = 2 * hstep;
    const unsigned ldsw = (unsigned)wid * 1024u;
    const int aoff = lds_byte(wr * 64 + fr, fq * 8), boff = lds_byte(wc * 32 + fr, fq * 8);
#define PG8_SA(b, h) (((b) * 2 + (h)) * HTB)
#define PG8_SB(b, h) ((4 + (b) * 2 + (h)) * HTB)
#define PG8_STAGE(bufoff, gbase, voff) do { const char* sb_ = (const char*)(gbase); asm volatile("" : "+s"(sb_));     \
        _Pragma("unroll") for (int _i = 0; _i < 2; ++_i) \
        __builtin_amdgcn_global_load_lds((const unsigned*)(sb_ + (size_t)_i * qstep + (voff)), (PG8_LAS unsigned*)(lds + (bufoff) + ldsw + _i * 8192), 16, 0, 0); } while (0)
#define PG8_LDA(dst, b, h) do { _Pragma("unroll") for (int m = 0; m < 4; ++m) _Pragma("unroll") for (int k = 0; k < 2; ++k) dst[m][k] = *(const PG8_LAS bf16x8*)(lds + PG8_SA(b, h) + aoff + m * 2048 + k * 1024); } while (0)
#define PG8_LDB(dst, b, h) do { _Pragma("unroll") for (int n = 0; n < 2; ++n) _Pragma("unroll") for (int k = 0; k < 2; ++k) dst[n][k] = *(const PG8_LAS bf16x8*)(lds + PG8_SB(b, h) + boff + n * 2048 + k * 1024); } while (0)
#define PG8_MMA(ai, bj, At, Bt) do { __builtin_amdgcn_s_setprio(1); _Pragma("unroll") for (int m = 0; m < 4; ++m) _Pragma("unroll") for (int n = 0; n < 2; ++n) _Pragma("unroll") for (int k = 0; k < 2; ++k) \
        acc[ai][bj][m][n] = __builtin_amdgcn_mfma_f32_16x16x32_bf16(Bt[n][k], At[m][k], acc[ai][bj][m][n], 0, 0, 0); __builtin_amdgcn_s_setprio(0); } while (0)
#define PG8_MMAZ(ai, bj, At, Bt) do { __builtin_amdgcn_s_setprio(1); _Pragma("unroll") for (int m = 0; m < 4; ++m) _Pragma("unroll") for (int n = 0; n < 2; ++n) { \
        acc[ai][bj][m][n] = __builtin_amdgcn_mfma_f32_16x16x32_bf16(Bt[n][0], At[m][0], (f32x4){0.f, 0.f, 0.f, 0.f}, 0, 0, 0); \
        acc[ai][bj][m][n] = __builtin_amdgcn_mfma_f32_16x16x32_bf16(Bt[n][1], At[m][1], acc[ai][bj][m][n], 0, 0, 0); } __builtin_amdgcn_s_setprio(0); } while (0)
#define PG8_MMAX(FR, ai, bj, At, Bt) do { if (FR) PG8_MMAZ(ai, bj, At, Bt); else PG8_MMA(ai, bj, At, Bt); } while (0)
#define PG8_WAIT_V(n) asm volatile("s_waitcnt vmcnt(" #n ")" ::: "memory")
#define PG8_WAIT_L(n) asm volatile("s_waitcnt lgkmcnt(" #n ")" ::: "memory")
#define PG8_WAIT_VX(f) do { if (f) asm volatile("s_waitcnt vmcnt(%0)" :: "i"(8 + Epi::NVM) : "memory"); else PG8_WAIT_V(8); } while (0)
#define PG8_BAR __builtin_amdgcn_s_barrier()
#define PG8_SCHED __builtin_amdgcn_sched_barrier(0)
    Unit cur, nxt; int ui = 0;
    if (!S.next(0, cur)) return;
    f32x4 acc[2][2][4][2];
    if constexpr (!DEFER) {
#pragma unroll
    for (int a = 0; a < 2; ++a)
#pragma unroll
        for (int b = 0; b < 2; ++b)
#pragma unroll
            for (int m = 0; m < 4; ++m)
#pragma unroll
                for (int n = 0; n < 2; ++n) acc[a][b][m][n] = (f32x4){0.f, 0.f, 0.f, 0.f};
    }
    bf16x8 At[4][2], B0[2][2], B1[2][2];
    const char* cA = (const char*)g.A + (size_t)cur.pm * tstep; const char* cB = (const char*)g.Bt + (size_t)cur.pn * tstep;
    S.a_ready(cur);
    int rot = Sched::ROT;
    if constexpr (DEFER) {
        const char* pA = cA + (size_t)rot * kstep; const char* pB = cB + (size_t)rot * kstep;
        PG8_STAGE(PG8_SB(0, 0), pB, voffB); PG8_STAGE(PG8_SB(0, 1), pB + hstep, voffB); PG8_STAGE(PG8_SA(0, 0), pA, voffA); PG8_STAGE(PG8_SA(0, 1), pA + hstep, voffA);
        PG8_STAGE(PG8_SB(1, 0), pB + kstep, voffB); PG8_STAGE(PG8_SB(1, 1), pB + hstep + kstep, voffB); PG8_STAGE(PG8_SA(1, 0), pA + kstep, voffA); PG8_STAGE(PG8_SA(1, 1), pA + hstep + kstep, voffA);
        PG8_WAIT_V(0); PG8_BAR;
        if (wr == 1) PG8_BAR;
    } else if constexpr (SP2) {
        PG8_STAGE(PG8_SB(0, 0), cB, voffB); PG8_STAGE(PG8_SB(0, 1), cB + hstep, voffB); PG8_STAGE(PG8_SA(0, 0), cA, voffA); PG8_STAGE(PG8_SA(0, 1), cA + hstep, voffA);
        if (wr == 1) PG8_BAR;
        PG8_WAIT_V(2); PG8_BAR;
        PG8_STAGE(PG8_SB(1, 0), cB + kstep, voffB); PG8_STAGE(PG8_SA(1, 0), cA + kstep, voffA); PG8_STAGE(PG8_SB(1, 1), cB + hstep + kstep, voffB);
        PG8_WAIT_V(6); PG8_BAR;
    } else {
        PG8_STAGE(PG8_SB(0, 0), cB, voffB); PG8_STAGE(PG8_SA(0, 0), cA, voffA); PG8_STAGE(PG8_SB(0, 1), cB + hstep, voffB); PG8_STAGE(PG8_SA(0, 1), cA + hstep, voffA);
        if (wr == 1) PG8_BAR;
        PG8_WAIT_V(4); PG8_BAR;
        PG8_STAGE(PG8_SB(1, 0), cB + kstep, voffB); PG8_STAGE(PG8_SA(1, 0), cA + kstep, voffA); PG8_STAGE(PG8_SB(1, 1), cB + hstep + kstep, voffB);
        PG8_WAIT_V(6); PG8_BAR;
    }
    for (;;) {
        const bool has_next = S.next(ui + 1, nxt);
        const char* nA = has_next ? (const char*)g.A + (size_t)nxt.pm * tstep : cA; const char* nB = has_next ? (const char*)g.Bt + (size_t)nxt.pn * tstep : cB;
#define PG8_ITER_SP2(FR) do { \
            const bool last = (t == nt - 2); \
            if (Sched::ROT != 0 && !(FR)) { if (rot != 0 && t == nt - 2 - Sched::ROT) S.mid_wait(); }     \
            const int k1_ = Sched::ROT != 0 ? ((t + 1 + rot) & (nt - 1)) : t + 1, k2_ = Sched::ROT != 0 ? ((t + 2 + rot) & (nt - 1)) : t + 2; \
            const char* a1 = cA + (size_t)k1_ * kstep;                                                 \
            const char* a2 = last ? nA : cA + (size_t)k2_ * kstep; const char* b2 = last ? nB : cB + (size_t)k2_ * kstep;     \
            const char* a3 = a2 + kstep; const char* b3 = b2 + kstep;                                \
            if (last && has_next) S.a_ready(nxt); \
              \
            PG8_LDB(B0, 0, 0); PG8_LDB(B1, 0, 1); PG8_SCHED; PG8_LDA(At, 0, 0); if (!(FR)) PG8_STAGE(PG8_SA(1, 1), a1 + hstep, voffA); \
            PG8_WAIT_VX(FR); PG8_WAIT_L(0); PG8_BAR; PG8_MMAX(FR, 0, 0, At, B0); PG8_MMAX(FR, 0, 1, At, B1); PG8_BAR; PG8_SCHED; \
              \
            PG8_LDA(At, 0, 1); PG8_STAGE(PG8_SB(0, 0), b2, voffB); PG8_STAGE(PG8_SB(0, 1), b2 + hstep, voffB); PG8_STAGE(PG8_SA(0, 0), a2, voffA); \
            PG8_WAIT_VX(FR); PG8_WAIT_L(0); PG8_BAR; PG8_MMAX(FR, 1, 0, At, B0); PG8_MMAX(FR, 1, 1, At, B1); PG8_BAR; PG8_SCHED; \
              \
            PG8_LDB(B0, 1, 0); PG8_LDB(B1, 1, 1); PG8_SCHED; PG8_LDA(At, 1, 0); PG8_STAGE(PG8_SA(0, 1), a2 + hstep, voffA); \
            PG8_WAIT_VX(FR); PG8_WAIT_L(0); PG8_BAR; PG8_MMA(0, 0, At, B0); PG8_MMA(0, 1, At, B1); PG8_BAR; PG8_SCHED; \
              \
            PG8_LDA(At, 1, 1); PG8_STAGE(PG8_SB(1, 0), b3, voffB); PG8_STAGE(PG8_SB(1, 1), b3 + hstep, voffB); PG8_STAGE(PG8_SA(1, 0), a3, voffA); \
            PG8_WAIT_V(8); PG8_WAIT_L(0); PG8_BAR; PG8_MMA(1, 0, At, B0); PG8_MMA(1, 1, At, B1); PG8_BAR; PG8_SCHED; } while (0)
        if constexpr (SP2) {
            int t = 0;
            if constexpr (DEFER) { PG8_ITER_SP2(1); t = 2; asm volatile("" : "+v"(voffA), "+v"(voffB)); }
#pragma unroll 1
            for (; t < nt; t += 2) PG8_ITER_SP2(0);
        } else {
        for (int t = 0; t < nt; t += 2) {
            const bool last = (t == nt - 2);
            const char* a1 = cA + (size_t)(t + 1) * kstep;
            const char* a2 = last ? nA : cA + (size_t)(t + 2) * kstep; const char* b2 = last ? nB : cB + (size_t)(t + 2) * kstep;
            const char* a3 = a2 + kstep; const char* b3 = b2 + kstep;
            if (last && has_next) S.a_ready(nxt);
            PG8_LDB(B0, 0, 0); PG8_SCHED; PG8_LDA(At, 0, 0); PG8_STAGE(PG8_SA(1, 1), a1 + hstep, voffA);
            PG8_WAIT_L(8); PG8_BAR; PG8_WAIT_L(0); PG8_MMA(0, 0, At, B0); PG8_BAR; PG8_SCHED;
            PG8_LDB(B1, 0, 1); PG8_STAGE(PG8_SB(0, 0), b2, voffB);
            PG8_BAR; PG8_WAIT_L(0); PG8_MMA(0, 1, At, B1); PG8_BAR;
            PG8_LDA(At, 0, 1); PG8_STAGE(PG8_SA(0, 0), a2, voffA);
            PG8_BAR; PG8_WAIT_L(0); PG8_MMA(1, 0, At, B0); PG8_BAR; PG8_SCHED;
            PG8_STAGE(PG8_SB(0, 1), b2 + hstep, voffB);
            PG8_WAIT_V(6); PG8_BAR; PG8_MMA(1, 1, At, B1); PG8_BAR;
            PG8_LDB(B0, 1, 0); PG8_SCHED; PG8_LDA(At, 1, 0); PG8_STAGE(PG8_SA(0, 1), a2 + hstep, voffA);
            PG8_WAIT_L(8); PG8_BAR; PG8_WAIT_L(0); PG8_MMA(0, 0, At, B0); PG8_BAR; PG8_SCHED;
            PG8_LDB(B1, 1, 1); PG8_STAGE(PG8_SB(1, 0), b3, voffB);
            PG8_BAR; PG8_WAIT_L(0); PG8_MMA(0, 1, At, B1); PG8_BAR;
            PG8_LDA(At, 1, 1); PG8_STAGE(PG8_SA(1, 0), a3, voffA);
            PG8_BAR; PG8_WAIT_L(0); PG8_MMA(1, 0, At, B0); PG8_BAR; PG8_SCHED;
            PG8_STAGE(PG8_SB(1, 1), b3 + hstep, voffB);
            PG8_WAIT_V(6); PG8_BAR; PG8_MMA(1, 1, At, B1); PG8_BAR;
        }
        }
        if constexpr (ALIGN_EPI) { if (wr == 0) PG8_BAR; }
        if constexpr (DEFER) { if (has_next) PG8_STAGE(PG8_SA(1, 1), nA + kstep + hstep, voffA); asm volatile("" ::: "memory"); }
        if constexpr (!Epi::AFTER_DRAIN) { E(acc, cur, wr, wc, fr, fq); S.done(cur); }
        if (!has_next) break;
        if constexpr (!DEFER) {
#pragma unroll
        for (int a = 0; a < 2; ++a)
#pragma unroll
            for (int b = 0; b < 2; ++b)
#pragma unroll
                for (int m = 0; m < 4; ++m)
#pragma unroll
                    for (int n = 0; n < 2; ++n) acc[a][b][m][n] = (f32x4){0.f, 0.f, 0.f, 0.f};
        }
        cur = nxt; cA = nA; cB = nB; ++ui; rot = 0;
        if constexpr (ALIGN_EPI) { if (wr == 1) PG8_BAR; }
    }
    PG8_WAIT_V(0);
    if constexpr (!ALIGN_EPI) { if (wr == 0) PG8_BAR; }
    PG8_BAR;
    if constexpr (Epi::AFTER_DRAIN) { E.fused(acc, cur, wr, wc, fr, fq, lds, wid, lane); S.done(cur); }
#undef PG8_SA
#undef PG8_SB
#undef PG8_STAGE
#undef PG8_LDA
#undef PG8_LDB
#undef PG8_MMA
#undef PG8_MMAZ
#undef PG8_MMAX
#undef PG8_WAIT_V
#undef PG8_WAIT_L
#undef PG8_WAIT_VX
#undef PG8_ITER_SP2
#undef PG8_BAR
#undef PG8_SCHED
}
}

constexpr int NWAVES = 8;
constexpr int RING_BYTES = 159744, LDSCTL_OFF = RING_BYTES, MISC_OFF = LDSCTL_OFF + 320, LDS_BYTES = 163840;
constexpr int CW_BAR = 4096;
constexpr size_t CTL_ZERO_BYTES = 64 * 1024;
#define GAS __attribute__((address_space(1)))
#define LAS __attribute__((address_space(3)))
typedef float f32x4 __attribute__((ext_vector_type(4)));
typedef unsigned v4u __attribute__((ext_vector_type(4)));
typedef unsigned u32x2 __attribute__((ext_vector_type(2)));
__device__ __forceinline__ float bflo(unsigned w) { return __uint_as_float(w << 16); }
__device__ __forceinline__ float bfhi(unsigned w) { return __uint_as_float(w & 0xffff0000u); }
typedef short bf16x8 __attribute__((ext_vector_type(8)));
__device__ __forceinline__ void unpack8(const v4u& w, float (&f)[8]) { f[0] = bflo(w.x); f[1] = bfhi(w.x); f[2] = bflo(w.y); f[3] = bfhi(w.y); f[4] = bflo(w.z); f[5] = bfhi(w.z); f[6] = bflo(w.w); f[7] = bfhi(w.w); }
__device__ __forceinline__ bf16x8 pack8(const f32x4& a, const f32x4& b) {
    return __builtin_bit_cast(bf16x8, __builtin_convertvector((nf32x8){a.x, a.y, a.z, a.w, b.x, b.y, b.z, b.w}, nbf16x8)); }
typedef GAS unsigned gu32;
#define LDS_WAIT() asm volatile("s_waitcnt lgkmcnt(0)" ::: "memory")
#define LBAR() do { asm volatile("s_waitcnt lgkmcnt(0)" ::: "memory"); __builtin_amdgcn_s_barrier(); asm volatile("" ::: "memory"); } while (0)
#define VM_WAIT() asm volatile("s_waitcnt vmcnt(0)" ::: "memory")
__device__ __forceinline__ unsigned pk2(float lo, float hi) { return __builtin_bit_cast(unsigned, __builtin_convertvector((nf32x2){lo, hi}, nbf16x2)); }

#define XB_TMO      128
#define XB_XCNT(j)  (256  + 64 * (j))
#define XB_XSUB(j)  (1280 + 64 * (j))
#define XB_XGEN(j)  (2304 + 64 * (j))
#define XB_TOP      3328
#define XB_TOPGEN   3392
#define XCD_BAR_WORDS 3456
#define XB_SPIN_CAP (1u << 22)

__device__ __forceinline__ unsigned xb_ld(unsigned* p)              { return __hip_atomic_load(p, __ATOMIC_RELAXED, __HIP_MEMORY_SCOPE_AGENT); }
__device__ __forceinline__ unsigned xb_add(unsigned* p, unsigned v) { return __hip_atomic_fetch_add(p, v, __ATOMIC_RELAXED, __HIP_MEMORY_SCOPE_AGENT); }
__device__ __forceinline__ unsigned xb_xcc_id() { return (unsigned)__builtin_amdgcn_s_getreg((3 << 11) | 20) & 0xFu; }
#define XB_SPIN(cond, bar) do { unsigned _sp = 0; while (cond) { __builtin_amdgcn_s_sleep(1); \
    if ((++_sp & 255u) == 0u) { if (xb_ld(&(bar)[XB_TMO])) break; if (_sp > XB_SPIN_CAP) { atomicAdd(&(bar)[XB_TMO], 1u); break; } } } } while (0)

struct XcdBarrier {
    unsigned* bar; unsigned x;
    volatile LAS unsigned* st;
};

__device__ __forceinline__ XcdBarrier xcd_barrier_post(unsigned* bar, volatile LAS unsigned* st) {
    XcdBarrier b; b.bar = bar; b.x = xb_xcc_id(); b.st = st;
    if (threadIdx.x == 0) (void)xb_add(&bar[XB_XCNT(b.x)], 1u);
    return b;
}
__device__ __forceinline__ void xcd_barrier_complete(unsigned* bar, unsigned x, unsigned& nloc, unsigned& nx) {
    const unsigned G = gridDim.x * gridDim.y * gridDim.z;
    unsigned sum, cnt, mine, sp = 0u;
    for (;;) {
        sum = 0u; cnt = 0u; mine = 0u;
#pragma unroll
        for (unsigned j = 0; j < 16; ++j) { const unsigned c = xb_ld(&bar[XB_XCNT(j)]); sum += c; cnt += (c > 0u) ? 1u : 0u; mine = (j == x) ? c : mine; }
        if (sum == G) break;
        __builtin_amdgcn_s_sleep(1);
        if ((++sp & 255u) == 0u) { if (xb_ld(&bar[XB_TMO])) break; if (sp > XB_SPIN_CAP) { atomicAdd(&bar[XB_TMO], 1u); break; } }
    }
    nloc = mine > 0u ? mine : 1u; nx = cnt > 0u ? cnt : 1u;
}

__device__ __forceinline__ void xcd_barrier(const XcdBarrier& b, bool nowait = false) {
    asm volatile("s_waitcnt vmcnt(0)" ::: "memory");
    __syncthreads();
    if (threadIdx.x == 0) {
        unsigned* bar = b.bar;
        __builtin_amdgcn_s_waitcnt(0);
        unsigned nloc = b.st[0], nx = b.st[1];
        if (nloc == 0u) { xcd_barrier_complete(bar, b.x, nloc, nx); b.st[0] = nloc; b.st[1] = nx; }
        __builtin_amdgcn_fence(__ATOMIC_ACQUIRE, "agent");
        const unsigned old = xb_add(&bar[XB_XSUB(b.x)], 1u);
        const unsigned gen = old / nloc;
        if (old + 1u == (gen + 1u) * nloc) {
            __builtin_amdgcn_fence(__ATOMIC_RELEASE, "agent");
            asm volatile("s_waitcnt vmcnt(0)" ::: "memory");
            const unsigned og = xb_add(&bar[XB_TOP], 1u);
            const unsigned tg = og / nx;
            if (og + 1u == (tg + 1u) * nx) xb_add(&bar[XB_TOPGEN], 1u);
            else XB_SPIN(xb_ld(&bar[XB_TOPGEN]) == tg, bar);
            __builtin_amdgcn_fence(__ATOMIC_ACQUIRE, "agent");
            xb_add(&bar[XB_XGEN(b.x)], 1u);
            if (nowait) b.st[2] = 0xFFFFFFFFu;
            asm volatile("s_waitcnt vmcnt(0)" ::: "memory");
        } else {
            asm volatile("s_waitcnt vmcnt(0)" ::: "memory");
            if (nowait) b.st[2] = gen;
            else {
                XB_SPIN(xb_ld(&bar[XB_XGEN(b.x)]) == gen, bar);
                asm volatile("s_waitcnt vmcnt(0)" ::: "memory");
            }
        }
    }
    if (!nowait) __syncthreads();
}
__device__ __forceinline__ void xcd_barrier_wait(const XcdBarrier& b) {
    if (threadIdx.x == 0) {
        const unsigned g = b.st[2];
        if (g != 0xFFFFFFFFu) { XB_SPIN(xb_ld(&b.bar[XB_XGEN(b.x)]) == g, b.bar); asm volatile("s_waitcnt vmcnt(0)" ::: "memory"); }
    }
    __syncthreads();
}
struct RotOrder : pg8::StaticOrder {
    static constexpr int ROT = 4;
    const XcdBarrier* b; bool armed;
    __device__ __forceinline__ void mid_wait() const {
        if (armed) {
            if (threadIdx.x == 0) { const unsigned g = b->st[2]; if (g != 0xFFFFFFFFu) XB_SPIN(xb_ld(&b->bar[XB_XGEN(b->x)]) == g, b->bar); }
            asm volatile("" ::: "memory"); __builtin_amdgcn_s_barrier(); asm volatile("" ::: "memory");
        }
    }
};


#define CAS __attribute__((address_space(4)))
typedef const CAS Ptrs KPtrs;
struct Frame {
    LAS unsigned char* lds; volatile LAS unsigned* MISC; gu32* ctl;
    int tid, lane, wave, vcu, G;
    __device__ __forceinline__ KPtrs& P() const { const CAS char* kp = (const CAS char*)__builtin_amdgcn_kernarg_segment_ptr(); asm volatile("" : "+s"(kp)); return *(KPtrs*)kp; }
    __device__ __forceinline__ void refresh() { int t = threadIdx.x; asm volatile("" : "+v"(t)); tid = t; lane = t & 63; wave = __builtin_amdgcn_readfirstlane(t >> 6); }
};

__device__ __forceinline__ void transpose_item(const float* W, int coff, int ld, bf16_t* WT, LAS float* scr, int k0, int lane) {
    float tv[32];
#pragma unroll
    for (int i = 0; i < 32; ++i) tv[i] = W[(size_t)(k0 + 2 * i + (lane >> 5)) * ld + coff];
#pragma unroll
    for (int i = 0; i < 32; ++i) scr[(2 * i + (lane >> 5)) * 33 + (lane & 31)] = tv[i];
    LDS_WAIT(); asm volatile("" ::: "memory");
    const int c = lane & 7;
#pragma unroll
    for (int j = 0; j < 4; ++j) { const int n = (lane >> 3) + 8 * j; const LAS float* s = scr + (8 * c) * 33 + n;
        v4u o; o.x = pk2(s[0 * 33], s[1 * 33]); o.y = pk2(s[2 * 33], s[3 * 33]); o.z = pk2(s[4 * 33], s[5 * 33]); o.w = pk2(s[6 * 33], s[7 * 33]);
        *(GAS v4u*)(WT + (size_t)n * DM + k0 + 8 * c) = o; }
    LDS_WAIT(); asm volatile("" ::: "memory");
}
__device__ __forceinline__ void convert_weights(Frame& F, int l, int gw, int NGW) {
    KPtrs& p = F.P();
    LAS float* scr = (LAS float*)(F.lds + F.wave * 16384);
    constexpr int I_IN = 16 * (NPC / 32), I_OUT = 16 * (DM / 32), I_L = I_IN + I_OUT;
    for (int it = gw; it < I_L; it += NGW) { int r = it;
        if (r < I_IN) { const int kb = r / (NPC / 32), nb = r % (NPC / 32), n0 = 32 * nb;
            const int g = n0 >> 8, i0 = n0 & 255, li = F.lane & 31, dl = c_gt_delta[g];
            const int coff = c_gt_col[g] + (dl ? (i0 >> 1) + (li >> 1) + ((li & 1) ? dl : 0) : i0 + li);
            transpose_item(p.w_in + (size_t)l * DM * INC, coff, INC, (bf16_t*)(p.ws + WS_WIN) + ((size_t)l * NPC + n0) * DM, scr, 64 * kb, F.lane); }
        else { r -= I_IN; const int kb = r / (DM / 32), nb = r % (DM / 32), n0 = 32 * nb;
            transpose_item(p.w_out + (size_t)l * DM * DM, n0 + (F.lane & 31), DM, (bf16_t*)(p.ws + WS_WOUT) + ((size_t)l * DM + n0) * DM, scr, 64 * kb, F.lane); }
    }
}
__device__ __forceinline__ void mod_item(Frame& F, int l, int slab) {
    KPtrs& p = F.P(); const int n0 = slab * 128;
    LAS float* s = (LAS float*)F.lds;
    LAS float* red = s + 17 * DM;
    { float cv[34];
#pragma unroll
      for (int j = 0; j < 34; ++j) { const int i = F.tid + j * NWAVES * 64, b = i >> 10, k = i & 1023; cv[j] = b < 16 ? p.c[b * DM + k] : p.c_ctx[k]; }
#pragma unroll
      for (int j = 0; j < 34; ++j) s[F.tid + j * NWAVES * 64] = fsilu(cv[j]); }
    __syncthreads();
    const int cq = F.tid & 31, kg = F.tid >> 5;
    f32x4 acc[17];
#pragma unroll
    for (int b = 0; b < 17; ++b) acc[b] = (f32x4){0.f, 0.f, 0.f, 0.f};
    const float* w = p.w_ada + (size_t)l * DM * 3072 + n0 + 4 * cq;
#pragma unroll 1
    for (int k0 = kg * 64; k0 < kg * 64 + 64; k0 += 16) { f32x4 wv[16];
#pragma unroll
        for (int kk = 0; kk < 16; ++kk) wv[kk] = *(const f32x4*)(w + (size_t)(k0 + kk) * 3072);
#pragma unroll
        for (int q = 0; q < 4; ++q) {
#pragma unroll
            for (int b = 0; b < 17; ++b) { const f32x4 s4 = *(const LAS f32x4*)(s + b * DM + k0 + 4 * q);
                acc[b] += wv[4 * q] * s4.x + wv[4 * q + 1] * s4.y + wv[4 * q + 2] * s4.z + wv[4 * q + 3] * s4.w; }
            asm volatile("" ::: "memory"); } }
#pragma unroll
    for (int b = 0; b < 17; ++b) {
        float v[4] = {acc[b].x, acc[b].y, acc[b].z, acc[b].w};
#pragma unroll
        for (int e = 0; e < 4; ++e) { auto r = __builtin_amdgcn_permlane32_swap(__float_as_uint(v[e]), __float_as_uint(v[e]), false, false); v[e] = __uint_as_float(r[0]) + __uint_as_float(r[1]); }
        if (F.lane < 32) *(LAS f32x4*)(red + (F.wave * 17 + b) * 128 + 4 * cq) = (f32x4){v[0], v[1], v[2], v[3]}; }
    __syncthreads();
    float* mod = (float*)(p.ws + WS_MOD);
    for (int o = F.tid; o < 17 * 128; o += NWAVES * 64) { const int b = o >> 7, cc = o & 127; float sum = p.b_ada[l * 3072 + n0 + cc];
#pragma unroll
        for (int g = 0; g < 8; ++g) sum += red[(g * 17 + b) * 128 + cc];
        mod[(size_t)(l * 17 + b) * 3072 + n0 + cc] = sum; }
    __syncthreads();
}
__device__ __forceinline__ void phase_pre(Frame& F) {
    KPtrs& p = F.P();
    if (blockIdx.x < 96) mod_item(F, (int)blockIdx.x / 24, (int)blockIdx.x % 24);
    else convert_weights(F, 0, ((int)blockIdx.x - 96) * NWAVES + F.wave, (F.G - 96) * NWAVES);
    { bf16_t* wsb = (bf16_t*)(p.ws + (9u << 20));
      for (int i = F.vcu * NWAVES * 64 + F.tid; i < DEPTH * 4 * 128 * 128 / 4; i += F.G * NWAVES * 64) { const f32x4 v = *(const f32x4*)(p.smlp_w + 4 * (size_t)i);
          unsigned long long o = (unsigned long long)pk2(v.x, v.y) | ((unsigned long long)pk2(v.z, v.w) << 32); *(GAS unsigned long long*)(wsb + 4 * (size_t)i) = o; } }
}

__device__ __forceinline__ void norm_row0(Frame& F, LAS float* tab, int r, f32x4 (&v)[4], int& curb) {
    KPtrs& p = F.P(); const int lane = F.lane;
    const int b = r < MLAT ? r >> 11 : 16;
    if (b != curb) { curb = b; const float* mod = (const float*)(p.ws + WS_MOD) + (size_t)b * 3072;
#pragma unroll
        for (int j = 0; j < 4; ++j) { const f32x4 g = *(const f32x4*)(p.norm_g + 256 * j + 4 * lane), sc = *(const f32x4*)(mod + 1024 + 256 * j + 4 * lane), sh = *(const f32x4*)(mod + 256 * j + 4 * lane);
            *(LAS f32x4*)(tab + 256 * j + 4 * lane) = g * (sc + 1.0f); *(LAS f32x4*)(tab + 1024 + 256 * j + 4 * lane) = sh; }
        asm volatile("s_waitcnt vmcnt(0) lgkmcnt(0)" ::: "memory"); }
    float ss = 0.f;
#pragma unroll
    for (int j = 0; j < 4; ++j) { ss += (v[j].x * v[j].x + v[j].y * v[j].y) + (v[j].z * v[j].z + v[j].w * v[j].w); }
    ss = wave_sum(ss);
    const float rstd = 1.0f / sqrtf(ss * (1.0f / DM) + EPS);
    GAS unsigned long long* o8 = (GAS unsigned long long*)((bf16_t*)(p.ws + WS_HY) + (size_t)r * DM) + lane;
#pragma unroll
    for (int j = 0; j < 4; ++j) { const f32x4 h = v[j] * rstd * *(const LAS f32x4*)(tab + 256 * j + 4 * lane) + *(const LAS f32x4*)(tab + 1024 + 256 * j + 4 * lane);
        o8[64 * j] = (unsigned long long)pk2(h.x, h.y) | ((unsigned long long)pk2(h.z, h.w) << 32); }
}
__device__ __forceinline__ void norm_wave_rows(Frame& F, LAS float* tab) {
    KPtrs& p = F.P(); const int lane = F.lane; int curb = -1;
    f32x4 va[4], vb[4], vc[4];
    const int rw = 16 * F.vcu + 2 * F.wave;
#define NR_ROW(k_) (rw + 4096 * ((k_) >> 1) + ((k_) & 1))
#define NR_LOAD(k_, d_) do { const int kk_ = (k_) < 18 ? (k_) : 17; const int rr_ = NR_ROW(kk_); const GAS f32x4* xr_ = (const GAS f32x4*)(rr_ < MLAT ? p.x + (size_t)rr_ * DM : p.ctx + (size_t)(rr_ - MLAT) * DM) + lane; \
        _Pragma("unroll") for (int j = 0; j < 4; ++j) d_[j] = xr_[64 * j]; } while (0)
    NR_LOAD(0, va); NR_LOAD(1, vb);
#pragma unroll 1
    for (int k = 0; k < 18; k += 3) {
        NR_LOAD(k + 2, vc); norm_row0(F, tab, NR_ROW(k), va, curb);
        NR_LOAD(k + 3, va); norm_row0(F, tab, NR_ROW(k + 1), vb, curb);
        NR_LOAD(k + 4, vb); norm_row0(F, tab, NR_ROW(k + 2), vc, curb);
    }
#undef NR_LOAD
#undef NR_ROW
}
__device__ __forceinline__ void norm_tile16(Frame& F, int l, const LAS bf16_t* wabT, LAS float* tab, int r0, int& curb) {
    KPtrs& p = F.P(); const int lane = F.lane, li = lane & 15, g4 = lane >> 4;
    const bf16_t* const XB = (const bf16_t*)((const char*)p.out + (64u << 20)); const bf16_t* const XCB = (const bf16_t*)(p.ws + WS_XC);
    const int r = r0 + li; int b; const bf16_t* src;
    if (r < MLAT) { b = r >> 11; const int tp = r & 2047; const int t = (l & 1) ? ((tp & 31) * 64 + (tp >> 5)) : tp; src = XB + ((size_t)b * SEQ + t) * DM; }
    else { b = 16; src = XCB + (size_t)(r - MLAT) * DM; }
    v4u xr[32];
#pragma unroll
    for (int s2 = 0; s2 < 32; ++s2) xr[s2] = *(const GAS v4u*)(src + 32 * s2 + 8 * g4);
    const int bt = __builtin_amdgcn_readfirstlane(b);
    if (bt != curb) { curb = bt; const float* mod = (const float*)(p.ws + WS_MOD) + (size_t)(l * 17 + bt) * 3072;
#pragma unroll
        for (int j = 0; j < 4; ++j) { const f32x4 g = *(const f32x4*)(p.norm_g + l * DM + 256 * j + 4 * lane), sc = *(const f32x4*)(mod + 1024 + 256 * j + 4 * lane), sh = *(const f32x4*)(mod + 256 * j + 4 * lane);
            *(LAS f32x4*)(tab + 256 * j + 4 * lane) = g * (sc + 1.0f); *(LAS f32x4*)(tab + 1024 + 256 * j + 4 * lane) = sh; }
        asm volatile("s_waitcnt lgkmcnt(0)" ::: "memory"); }
    float ss;
    { f32x4 g0 = {0.f, 0.f, 0.f, 0.f}, g1 = {0.f, 0.f, 0.f, 0.f};
#pragma unroll
      for (int s2 = 0; s2 < 32; s2 += 2) { const bf16x8 a0 = __builtin_bit_cast(bf16x8, xr[s2]), a1 = __builtin_bit_cast(bf16x8, xr[s2 + 1]);
          g0 = __builtin_amdgcn_mfma_f32_16x16x32_bf16(a0, a0, g0, 0, 0, 0); g1 = __builtin_amdgcn_mfma_f32_16x16x32_bf16(a1, a1, g1, 0, 0, 0); }
      g0 = g0 + g1;
      const int q = li & 3; const float d = q == 0 ? g0[0] : q == 1 ? g0[1] : q == 2 ? g0[2] : g0[3];
      ss = __shfl(d, li + 16 * (li >> 2)); }
    const float rstd = 1.0f / sqrtf(ss * (1.0f / DM) + EPS);
#pragma unroll
    for (int s2 = 0; s2 < 32; ++s2) asm volatile("" : "+v"(xr[s2]));
    f32x4 acc = {0.f, 0.f, 0.f, 0.f};
    bf16_t* hrow = (bf16_t*)(p.ws + WS_HY) + (size_t)r * DM + 8 * g4;
#pragma unroll
    for (int s2 = 0; s2 < 32; ++s2) { float f[8]; unpack8(xr[s2], f);
        const f32x4 ga = *(const LAS f32x4*)(tab + 32 * s2 + 8 * g4), gb = *(const LAS f32x4*)(tab + 32 * s2 + 8 * g4 + 4), sa = *(const LAS f32x4*)(tab + 1024 + 32 * s2 + 8 * g4), sb = *(const LAS f32x4*)(tab + 1024 + 32 * s2 + 8 * g4 + 4);
        const f32x4 ha = (f32x4){f[0], f[1], f[2], f[3]} * rstd * ga + sa, hb = (f32x4){f[4], f[5], f[6], f[7]} * rstd * gb + sb;
        const bf16x8 hf = pack8(ha, hb);
        *(GAS bf16x8*)(hrow + 32 * s2) = hf;
        const bf16x8 wf = *(const LAS bf16x8*)(wabT + li * DM + 32 * s2 + 8 * g4);
        acc = __builtin_amdgcn_mfma_f32_16x16x32_bf16(hf, wf, acc, 0, 0, 0);
        if ((s2 & 1) == 1) asm volatile("" ::: "memory"); }
    float* AB = (float*)(p.ws + WS_AB) + (size_t)(r0 + 4 * g4) * 16 + li;
#pragma unroll
    for (int rr = 0; rr < 4; ++rr) AB[rr * 16] = acc[rr];
}
__device__ __forceinline__ void ab_tile16(Frame& F, const LAS bf16_t* wabT, int r0) {
    KPtrs& p = F.P(); const int lane = F.lane, li = lane & 15, g4 = lane >> 4;
    const bf16_t* src = (const bf16_t*)(p.ws + WS_HY) + (size_t)(r0 + li) * DM + 8 * g4;
    v4u xr[32];
#pragma unroll
    for (int s2 = 0; s2 < 32; ++s2) xr[s2] = *(const GAS v4u*)(src + 32 * s2);
    f32x4 acc = {0.f, 0.f, 0.f, 0.f};
#pragma unroll
    for (int s2 = 0; s2 < 32; ++s2) { const bf16x8 wf = *(const LAS bf16x8*)(wabT + li * DM + 32 * s2 + 8 * g4);
        acc = __builtin_amdgcn_mfma_f32_16x16x32_bf16(__builtin_bit_cast(bf16x8, xr[s2]), wf, acc, 0, 0, 0);
        if ((s2 & 3) == 3) asm volatile("" ::: "memory"); }
    float* AB = (float*)(p.ws + WS_AB) + (size_t)(r0 + 4 * g4) * 16 + li;
#pragma unroll
    for (int rr = 0; rr < 4; ++rr) AB[rr * 16] = acc[rr];
}
constexpr int CW_CTXC = 9216, CW_NORMQ = 13312;
__device__ __forceinline__ void norm_stage_wab(Frame& F, int l, LAS float* wab) {
    KPtrs& p = F.P();
    float wv[32];
#pragma unroll
    for (int q = 0; q < 32; ++q) { const int i = F.tid + q * NWAVES * 64; wv[q] = p.w_in[(size_t)l * DM * INC + (size_t)(i >> 4) * INC + 768 + (i & 15)]; }
#pragma unroll
    for (int q = 0; q < 32; ++q) { const int i = F.tid + q * NWAVES * 64; wab[(i & 15) * DM + (i >> 4)] = wv[q]; }
    __syncthreads();
}
__device__ __forceinline__ void phase_norm(Frame& F, int l, const XcdBarrier& bar, bool& pend) {
    KPtrs& p = F.P();
#define NORM_STAGE_WAB() do { float wv_[32];   \
        _Pragma("unroll") for (int q_ = 0; q_ < 32; ++q_) { const int i_ = F.tid + q_ * NWAVES * 64; wv_[q_] = p.w_in[(size_t)l * DM * INC + (size_t)(i_ >> 4) * INC + 768 + (i_ & 15)]; } \
        _Pragma("unroll") for (int q_ = 0; q_ < 32; ++q_) { const int i_ = F.tid + q_ * NWAVES * 64; ((LAS bf16_t*)F.lds)[(i_ & 15) * DM + (i_ >> 4)] = f2bf(wv_[q_]); } \
        __syncthreads(); } while (0)
    if (l == 0) {
        NORM_STAGE_WAB();
        if (pend) { xcd_barrier_wait(bar); pend = false; }
        norm_wave_rows(F, (LAS float*)(F.lds + 32768 + F.wave * 8192));
        __syncthreads();
        for (int t = F.wave; t < 9; t += NWAVES) ab_tile16(F, (const LAS bf16_t*)F.lds, 16 * (F.vcu + 256 * t));
        __syncthreads();
        return;
    }
    const LAS bf16_t* wabT = (const LAS bf16_t*)F.lds; LAS float* tab = (LAS float*)(F.lds + 32768 + F.wave * 8192); int curb = -1;
    if (blockIdx.x < 64) {
        const int pmc = (int)blockIdx.x >> 2, pn = (int)blockIdx.x & 3, lp = l - 1;
        pg8::Gemm g{(const bf16_t*)(p.ws + WS_HY) + (size_t)MLAT * DM, (const bf16_t*)(p.ws + WS_WOUT) + (size_t)lp * DM * DM, MCTX, DM, DM};
        pg8::OneUnit S{{pmc, pn}};
        bf16_t* const XCB = (bf16_t*)(p.ws + WS_XC);
        pg8::EpiResid E{nullptr, nullptr, lp == 0 ? (const void*)p.ctx : (const void*)XCB, XCB, (const float*)(p.ws + WS_MOD) + (size_t)lp * 17 * 3072, 0, MLAT, SEQ, DM, lp == 0 ? 1 : 0, MLAT};
        pg8::gemm_phase<pg8::EpiResid, pg8::OneUnit, false, true>(F.lds, g, S, E);
        F.refresh();
        asm volatile("s_waitcnt vmcnt(0)" ::: "memory");
        __syncthreads();
        if (F.tid == 0) { __builtin_amdgcn_fence(__ATOMIC_RELEASE, "agent"); asm volatile("s_waitcnt vmcnt(0)" ::: "memory");
            (void)__hip_atomic_fetch_add(F.ctl + CW_CTXC + (l * 16 + pmc) * 64, 1u, __ATOMIC_RELAXED, __HIP_MEMORY_SCOPE_AGENT); }
    } else {
        NORM_STAGE_WAB();
        if (pend) { xcd_barrier_wait(bar); pend = false; }
        const int wi = ((int)blockIdx.x - 64) * NWAVES + F.wave;
        for (int t = wi; t < MLAT / 16; t += 1536) norm_tile16(F, l, wabT, tab, 16 * t, curb);
        if (blockIdx.x >= 128) { __syncthreads(); convert_weights(F, l, ((int)blockIdx.x - 128) * NWAVES + F.wave, 1024); }
        else {
            const int q = (int)blockIdx.x - 64, pmc = q >> 2;
            if (F.tid == 0) { gu32* cnt = F.ctl + CW_CTXC + (l * 16 + pmc) * 64; unsigned spins = 0;
                __builtin_amdgcn_fence(__ATOMIC_ACQUIRE, "agent");
                while (__hip_atomic_load(cnt, __ATOMIC_RELAXED, __HIP_MEMORY_SCOPE_AGENT) < 4u && ++spins < (1u << 22)) __builtin_amdgcn_s_sleep(1);
                asm volatile("s_waitcnt vmcnt(0)" ::: "memory"); }
            __syncthreads();
            if (F.wave < 4) norm_tile16(F, l, wabT, tab, MLAT + 64 * q + 16 * F.wave, curb);
        }
    }
#undef NORM_STAGE_WAB
    __syncthreads();
}

__device__ __forceinline__ void phase_final(Frame& F) {
    KPtrs& p = F.P(); const int lane = F.lane;
    const int gw = F.vcu * NWAVES + F.wave, NGW = F.G * NWAVES;
    const bf16_t* X = (const bf16_t*)(p.ws + WS_P);
    f32x4 g[4];
#pragma unroll
    for (int j = 0; j < 4; ++j) g[j] = *(const f32x4*)(p.final_g + 256 * j + 4 * lane);
    for (int r0 = gw; r0 < MLAT; r0 += 8 * NGW) {
        u32x2 raw[8][4];
#pragma unroll
        for (int u = 0; u < 8; ++u) { const int r = r0 + u * NGW; if (r < MLAT) { const GAS u32x2* xr = (const GAS u32x2*)(X + (size_t)r * DM) + lane;
#pragma unroll
            for (int j = 0; j < 4; ++j) raw[u][j] = xr[64 * j]; } }
#pragma unroll
        for (int u = 0; u < 8; ++u) { const int r = r0 + u * NGW; if (r < MLAT) {
            f32x4 v[4]; float ss = 0.f;
#pragma unroll
            for (int j = 0; j < 4; ++j) { v[j] = (f32x4){bflo(raw[u][j].x), bfhi(raw[u][j].x), bflo(raw[u][j].y), bfhi(raw[u][j].y)}; ss += (v[j].x * v[j].x + v[j].y * v[j].y) + (v[j].z * v[j].z + v[j].w * v[j].w); }
            ss = wave_sum(ss);
            const float rstd = 1.0f / sqrtf(ss * (1.0f / DM) + EPS);
            GAS f32x4* xo = (GAS f32x4*)(p.out + (size_t)r * DM) + lane;
#pragma unroll
            for (int j = 0; j < 4; ++j) xo[64 * j] = v[j] * rstd * g[j]; } }
    }
}

__device__ __forceinline__ void phase_gemm1(Frame& F, int l) {
    KPtrs& p = F.P();
    pg8::Gemm g{(const bf16_t*)(p.ws + WS_HY), (const bf16_t*)(p.ws + WS_WIN) + (size_t)l * NPC * DM, MTOT, NPC, DM};
    pg8::StaticOrder S; S.init(MTOT, NPC, F.G, (int)blockIdx.x);
    pg8::EpiP E{(bf16_t*)(p.ws + WS_P), PTILE_ELEMS};
    pg8::gemm_phase<pg8::EpiP, pg8::StaticOrder, true, true>(F.lds, g, S, E);
}
__device__ __forceinline__ bool phase_gemm2(Frame& F, int l, const XcdBarrier& bar, bool pend) {
    KPtrs& p = F.P();
    const int M = MLAT;
    pg8::Gemm g{(const bf16_t*)(p.ws + WS_HY), (const bf16_t*)(p.ws + WS_WOUT) + (size_t)l * DM * DM, M, DM, DM};
    RotOrder S; S.init(M, DM, F.G, (int)blockIdx.x); S.b = &bar; S.armed = pend;
    bf16_t* const XB = (bf16_t*)((char*)p.out + (64u << 20));
    bf16_t* const XCB = (bf16_t*)(p.ws + WS_XC);
    pg8::EpiResid E{l == 0 ? (const void*)p.x : (const void*)XB, l == DEPTH - 1 ? (bf16_t*)(p.ws + WS_P) : XB, l == 0 ? (const void*)p.ctx : (const void*)XCB, XCB,
                    (const float*)(p.ws + WS_MOD) + (size_t)l * 17 * 3072, l & 1, MLAT, SEQ, DM, l == 0 ? 1 : 0, 0};
    pg8::gemm_phase<pg8::EpiResid, RotOrder, true, true>(F.lds, g, S, E);
    pg8::Unit u0; return pend && !S.next(0, u0);
}


typedef short s16x4 __attribute__((ext_vector_type(4)));
__device__ __forceinline__ const bf16_t* ptile_d(KPtrs& p, int t) { return (const bf16_t*)(p.ws + WS_P) + (size_t)t * PTILE_ELEMS; }
constexpr size_t WS_WSB = 9 * MiB;

__device__ __forceinline__ void mix_unit_B(Frame& F, int l, int row0) {
    KPtrs& p = F.P(); const int oct = F.tid & 31, tg = F.tid >> 5;
    int start, len; row_seq(row0, start, len);
    const bf16_t *CX = ptile_d(p, T_CX), *BGS = ptile_d(p, T_BGS);
    float w[3][8];
#pragma unroll
    for (int j = 0; j < 3; ++j) { const f32x4 a = *(const f32x4*)(p.short_conv_w + (size_t)(l * 3 + j) * BW + 8 * oct), b = *(const f32x4*)(p.short_conv_w + (size_t)(l * 3 + j) * BW + 8 * oct + 4);
        w[j][0] = a.x; w[j][1] = a.y; w[j][2] = a.z; w[j][3] = a.w; w[j][4] = b.x; w[j][5] = b.y; w[j][6] = b.z; w[j][7] = b.w; }
    const int r0 = row0 + tg * 8;
    float cx[10][8];
    { v4u ca[10];
#pragma unroll
      for (int i = 0; i < 10; ++i) { int r = r0 + i - 1; r = r < start ? start : (r >= start + len ? start + len - 1 : r); ca[i] = *(const GAS v4u*)(CX + (size_t)r * 256 + 8 * oct); }
#pragma unroll
      for (int i = 0; i < 10; ++i) unpack8(ca[i], cx[i]);
      const bool lo_ok = r0 - 1 >= start, hi_ok = r0 + 8 < start + len;
#pragma unroll
      for (int e = 0; e < 8; ++e) { cx[0][e] = lo_ok ? cx[0][e] : 0.f; cx[9][e] = hi_ok ? cx[9][e] : 0.f; } }
#pragma unroll
    for (int i = 0; i < 8; ++i) { const int r = r0 + i;
        const v4u bgw = *(const GAS v4u*)(BGS + (size_t)r * 256 + 8 * oct); float bg[8], y[8]; unpack8(bgw, bg);
#pragma unroll
        for (int e = 0; e < 8; ++e) y[e] = bg[e] * (w[0][e] * cx[i][e] + w[1][e] * cx[i + 1][e] + w[2][e] * cx[i + 2][e]);
        v4u o; o.x = pk2(y[0], y[1]); o.y = pk2(y[2], y[3]); o.z = pk2(y[4], y[5]); o.w = pk2(y[6], y[7]);
        *(GAS v4u*)((bf16_t*)(p.ws + WS_HY) + (size_t)r * DM + 256 + 8 * oct) = o; }
}

constexpr int MIX_ND = MTOT / 128, MIX_NC = MTOT / 64, MIX_NB = MTOT / 128, MIX_NU = MIX_ND + MIX_NC + MIX_NB, CW_MIXQ = 8192, NPF = 12;
__device__ __forceinline__ void mix_prefetch(Frame& F, int l, int u, v4u (&pf)[NPF]) {
    KPtrs& p = F.P(); const int tid = F.tid, lane = F.lane, wave = F.wave;
    if (u < MIX_ND) {
        const bf16_t* VV = ptile_d(p, T_VV) + (size_t)(u * 128 + wave * 16) * 256 + 4 * lane;
#pragma unroll
        for (int k = 0; k < 8; ++k) { const u32x2 a = *(const GAS u32x2*)(VV + (size_t)(2 * k) * 256), b = *(const GAS u32x2*)(VV + (size_t)(2 * k + 1) * 256); pf[k] = (v4u){a.x, a.y, b.x, b.y}; }
        pf[10] = *(const GAS v4u*)(p.smlp_ln_g + l * BW + 4 * lane); pf[11] = *(const GAS v4u*)(p.smlp_ln_b + l * BW + 4 * lane);
        asm volatile("; PF_D" ::: "memory");
    } else if (u < MIX_ND + MIX_NC) {
        const int row0 = (u - MIX_ND) * 64; int start, len; row_seq(row0, start, len);
        const bf16_t* GL = ptile_d(p, T_GLU);
#pragma unroll
        for (int k = 0; k < 6; ++k) { const int idx = tid + k * NWAVES * 64, i = idx >> 5, oct = idx & 31; int r = row0 - 15 + i; r = r < start ? start : (r >= start + len ? start + len - 1 : r);
            pf[k] = *(const GAS v4u*)(GL + (size_t)r * 256 + 8 * oct); }
        asm volatile("; PF_C" ::: "memory");
    }
}
__device__ __forceinline__ f32x4 asf4(const v4u& w) { return __builtin_bit_cast(f32x4, w); }

__device__ __forceinline__ void mix_unit_C(Frame& F, int l, int row0, v4u (&pf)[NPF], int nxt) {
    KPtrs& p = F.P(); const int tid = F.tid, lane = F.lane, wave = F.wave;
    int start, len; row_seq(row0, start, len);
    LAS float* glu = (LAS float*)F.lds;
#pragma unroll
    for (int k = 0; k < 6; ++k) { const int idx = tid + k * NWAVES * 64, i = idx >> 5, oct = idx & 31, r = row0 - 15 + i;
        if (i < 94) { const bool ok = r >= start && r < start + len; float fa[8]; unpack8(pf[k], fa);
            const f32x4 o0 = {ok ? fa[0] : 0.f, ok ? fa[1] : 0.f, ok ? fa[2] : 0.f, ok ? fa[3] : 0.f}, o1 = {ok ? fa[4] : 0.f, ok ? fa[5] : 0.f, ok ? fa[6] : 0.f, ok ? fa[7] : 0.f};
            *(LAS f32x4*)(glu + i * 256 + 8 * oct) = o0; *(LAS f32x4*)(glu + i * 256 + 8 * oct + 4) = o1; } }
    float wt[32]; u32x2 gate[8];
#pragma unroll
    for (int j = 0; j < 32; ++j) wt[j] = j < 31 ? p.conf_conv_w[(size_t)(l * 31 + j) * BW + (tid & 255)] : p.conf_conv_b[l * BW + (tid & 255)];
    { const bf16_t* GC = ptile_d(p, T_GC);
#pragma unroll
      for (int i = 0; i < 8; ++i) gate[i] = *(const GAS u32x2*)(GC + (size_t)(row0 + wave * 8 + i) * 256 + 4 * lane); }
    const f32x4 lg = *(const f32x4*)(p.conf_ln_g + l * BW + 4 * lane), lb = *(const f32x4*)(p.conf_ln_b + l * BW + 4 * lane);
    mix_prefetch(F, l, nxt, pf);
    LBAR();
    const int c = tid & 255, th = tid >> 8;
    float z[32];
#pragma unroll
    for (int hb = 0; hb < 2; ++hb) {
        float win[46];
#pragma unroll
        for (int i = 0; i < 46; ++i) win[i] = glu[(th * 32 + hb * 16 + i) * 256 + c];
#pragma unroll
        for (int i = 0; i < 16; ++i) z[hb * 16 + i] = wt[31];
#pragma unroll
        for (int j = 0; j < 31; ++j)
#pragma unroll
            for (int i = 0; i < 16; ++i) z[hb * 16 + i] += wt[j] * win[i + j];
    }
    LBAR();
#pragma unroll
    for (int i = 0; i < 32; ++i) glu[(th * 32 + i) * 256 + c] = z[i];
    LBAR();
#pragma unroll
    for (int i = 0; i < 8; ++i) { const int t = wave * 8 + i, r = row0 + t;
        const f32x4 zz = *(const LAS f32x4*)(glu + t * 256 + 4 * lane);
        const float mean = wave_sum((zz.x + zz.y) + (zz.z + zz.w)) * (1.f / 256.f);
        const f32x4 d = zz - mean;
        const float var = wave_sum((d.x * d.x + d.y * d.y) + (d.z * d.z + d.w * d.w)) * (1.f / 256.f);
        const float rstd = 1.0f / sqrtf(var + EPS);
        const f32x4 ln = d * rstd * lg + lb;
        const u32x2 gw = gate[i];
        u32x2 o; o.x = pk2(fsilu(ln.x) * bflo(gw.x), fsilu(ln.y) * bfhi(gw.x)); o.y = pk2(fsilu(ln.z) * bflo(gw.y), fsilu(ln.w) * bfhi(gw.y));
        *(GAS u32x2*)((bf16_t*)(p.ws + WS_HY) + (size_t)r * DM + 512 + 4 * lane) = o; }
    LBAR();
}

__device__ __forceinline__ void mix_unit_D(Frame& F, int l, int row0, v4u (&pf)[NPF], int nxt) {
    KPtrs& p = F.P(); const int lane = F.lane, wave = F.wave;
    constexpr int VS = 528;
    LAS unsigned char* vl = F.lds;
    const bf16_t* UG = ptile_d(p, T_UG);
    const int g = wave >> 1, ph = wave & 1, li = lane & 15, lg4 = lane >> 4;
    bf16x8 wf[4][4];
    { const bf16_t* W = (const bf16_t*)(p.ws + WS_WSB) + (size_t)(l * 4 + g) * 128 * 128;
#pragma unroll
      for (int ks = 0; ks < 4; ++ks)
#pragma unroll
          for (int pt = 0; pt < 4; ++pt) wf[ks][pt] = *(const GAS bf16x8*)(W + (size_t)(64 * ph + 16 * pt + li) * 128 + 32 * ks + 8 * lg4); }
    { const f32x4 lg = asf4(pf[10]), lb = asf4(pf[11]);
#pragma unroll
      for (int i = 0; i < 16; ++i) { const int q = wave * 16 + i; const u32x2 raw = (i & 1) ? (u32x2){pf[i >> 1].z, pf[i >> 1].w} : (u32x2){pf[i >> 1].x, pf[i >> 1].y};
        const f32x4 v = {bflo(raw.x), bfhi(raw.x), bflo(raw.y), bfhi(raw.y)};
        const float mean = wave_sum((v.x + v.y) + (v.z + v.w)) * (1.f / 256.f);
        const f32x4 d = v - mean;
        const float var = wave_sum((d.x * d.x + d.y * d.y) + (d.z * d.z + d.w * d.w)) * (1.f / 256.f);
        const float rstd = 1.0f / sqrtf(var + EPS);
        const f32x4 y = d * rstd * lg + lb;
        u32x2 o; o.x = pk2(y.x, y.y); o.y = pk2(y.z, y.w);
        *(LAS u32x2*)(vl + q * VS + 8 * lane) = o; } }
    LBAR();
    f32x4 acc[4][4];
#pragma unroll
    for (int a = 0; a < 4; ++a)
#pragma unroll
        for (int b = 0; b < 4; ++b) acc[a][b] = (f32x4){0.f, 0.f, 0.f, 0.f};
#pragma unroll
    for (int ks = 0; ks < 4; ++ks) {
        bf16x8 af[4];
#pragma unroll
        for (int ct = 0; ct < 4; ++ct) { LAS unsigned char* a = vl + (32 * ks + 8 * lg4 + (li >> 2)) * VS + (64 * g + 16 * ct + 4 * (li & 3)) * 2;
            const s16x4 lo = __builtin_amdgcn_ds_read_tr16_b64_v4i16((LAS s16x4*)a), hi = __builtin_amdgcn_ds_read_tr16_b64_v4i16((LAS s16x4*)(a + 4 * VS));
            af[ct] = (bf16x8){lo[0], lo[1], lo[2], lo[3], hi[0], hi[1], hi[2], hi[3]}; }
#pragma unroll
        for (int ct = 0; ct < 4; ++ct)
#pragma unroll
            for (int pt = 0; pt < 4; ++pt) acc[ct][pt] = __builtin_amdgcn_mfma_f32_16x16x32_bf16(af[ct], wf[ks][pt], acc[ct][pt], 0, 0, 0);
    }
    u32x2 uw[4][4]; float bs[4];
#pragma unroll
    for (int pt = 0; pt < 4; ++pt) { const int prow = 64 * ph + 16 * pt + li; const size_t r = (size_t)row0 + prow; bs[pt] = p.smlp_b[(l * 4 + g) * 128 + prow];
#pragma unroll
        for (int ct = 0; ct < 4; ++ct) { const int c = 64 * g + 16 * ct + 4 * lg4; uw[pt][ct] = *(const GAS u32x2*)(UG + r * 256 + c); } }
    mix_prefetch(F, l, nxt, pf);
#pragma unroll
    for (int pt = 0; pt < 4; ++pt) { const int prow = 64 * ph + 16 * pt + li; const size_t r = (size_t)row0 + prow;
#pragma unroll
        for (int ct = 0; ct < 4; ++ct) { const int c = 64 * g + 16 * ct + 4 * lg4;
            const f32x4 m = acc[ct][pt] + bs[pt]; const u32x2 u2 = uw[pt][ct];
            u32x2 o; o.x = pk2(bflo(u2.x) * m.x, bfhi(u2.x) * m.y); o.y = pk2(bflo(u2.y) * m.z, bfhi(u2.y) * m.w);
            *(GAS u32x2*)((bf16_t*)(p.ws + WS_HY) + r * DM + 768 + c) = o; } }
    LBAR();
}

__device__ __forceinline__ void phase_mix(Frame& F, int l) {
    gu32* ctr = F.ctl + CW_MIXQ + 64 * l;
    volatile LAS unsigned* Q = F.MISC;
    unsigned fetched = 0;
    if (F.tid == 0) { Q[0] = __hip_atomic_fetch_add(ctr, 1u, __ATOMIC_RELAXED, __HIP_MEMORY_SCOPE_AGENT); Q[1] = __hip_atomic_fetch_add(ctr, 1u, __ATOMIC_RELAXED, __HIP_MEMORY_SCOPE_AGENT); }
    LBAR();
    int cur = (int)Q[0], nxt = (int)Q[1];
    v4u pf[NPF];
    F.refresh();
    if (cur < MIX_NU) mix_prefetch(F, l, cur, pf);
#define MIX_ROUND(CALL) do { LBAR();   \
        if (F.tid == 0) fetched = __hip_atomic_fetch_add(ctr, 1u, __ATOMIC_RELAXED, __HIP_MEMORY_SCOPE_AGENT);   \
        F.refresh(); CALL; if (F.tid == 0) Q[0] = fetched; LBAR(); cur = nxt; nxt = (int)Q[0]; } while (0)
    while (cur < MIX_ND) MIX_ROUND(mix_unit_D(F, l, cur * 128, pf, nxt));
    while (cur < MIX_ND + MIX_NC) MIX_ROUND(mix_unit_C(F, l, (cur - MIX_ND) * 64, pf, nxt));
    while (cur < MIX_NU) MIX_ROUND(mix_unit_B(F, l, (cur - MIX_ND - MIX_NC) * 128));
#undef MIX_ROUND
}

constexpr size_t WS_REC = 320 * MiB;
constexpr int REC_BYTES = 41984, R_NW = 0, R_Q = 8192, R_U = 16384, R_VEC = 24576, R_ATTN = 25600, R_KT = 33792;
constexpr int NITEM = 2304;
constexpr int L_Q = 0, L_K = 4352, L_V = 8704, L_GKK = 13056, L_GQK = 17408, L_QB = 21760, L_KB = 24064, L_AO = 21760, L_AD = 26368, L_DF = 28928, L_SM = 30208, L_XS = 0, GS = 68, SMD = 256;

__device__ __forceinline__ float dpp_xor1(float v) { return __int_as_float(__builtin_amdgcn_mov_dpp(__float_as_int(v), 0xB1, 0xF, 0xF, true)); }

__device__ __forceinline__ void prep_decode(int item, int& b, int& h, int& row0) {
    if (item < 2048) { b = item >> 7; h = (item >> 5) & 3; const int n = item & 31; row0 = b * SEQ + 64 * n; }
    else { const int it = item - 2048; b = it >> 4; h = (it >> 2) & 3; const int n = it & 3; row0 = MLAT + b * CTXL + 64 * n; }
}
__device__ __forceinline__ void prep_load(Frame& F, int l, int item, v4u (&raw)[6], float (&abn)[4], v4u (&wq)[6]) {
    KPtrs& p = F.P(); int b, h, row0; prep_decode(item, b, h, row0); int start, len; row_seq(row0, start, len);
    const int tq = F.tid < 384 ? F.tid : 383, tg = tq / 24, o = tq % 24, part = o >> 3, oo = o & 7;
    const bf16_t* T = ptile_d(p, part) + h * 64 + 8 * oo;
#pragma unroll
    for (int i = 0; i < 6; ++i) { int r = row0 + 4 * tg - 1 + i; r = r < start ? start : (r >= start + len ? start + len - 1 : r); raw[i] = *(const GAS v4u*)(T + (size_t)r * 256); }
    if ((F.wave & 3) == 0) { const int dir = F.wave >> 2, tok = dir ? 63 - F.lane : F.lane; const float* AB = (const float*)(p.ws + WS_AB) + ((size_t)row0 + tok) * 16;
        abn[0] = AB[dir * 4 + h]; abn[1] = AB[8 + dir * 4 + h]; abn[2] = p.a_log[(l * 2 + dir) * 4 + h]; abn[3] = p.dt_bias[(l * 2 + dir) * 4 + h]; }
    { const float* wc = p.qkv_conv_w + (size_t)l * 3 * 768 + part * 256 + h * 64 + 8 * oo;
#pragma unroll
      for (int j = 0; j < 3; ++j) { wq[2 * j] = *(const GAS v4u*)(wc + j * 768); wq[2 * j + 1] = *(const GAS v4u*)(wc + j * 768 + 4); } }
}
__device__ __forceinline__ void prep_item(Frame& F, int l, int item, v4u (&raw)[6], float (&abn)[4], v4u (&wq)[6], int next_item) {
    KPtrs& p = F.P(); const int tid = F.tid, lane = F.lane, wave = F.wave;
    int b, h, row0; prep_decode(item, b, h, row0);
    int start, len; row_seq(row0, start, len);
    LAS float* lf = (LAS float*)F.lds;
    if (tid < 384) { const int tg = tid / 24, o = tid % 24, part = o >> 3, oo = o & 7;
        float w[3][8], x[6][8];
#pragma unroll
        for (int j = 0; j < 3; ++j) { const f32x4 w0 = __builtin_bit_cast(f32x4, wq[2 * j]), w1 = __builtin_bit_cast(f32x4, wq[2 * j + 1]);
            w[j][0] = w0.x; w[j][1] = w0.y; w[j][2] = w0.z; w[j][3] = w0.w; w[j][4] = w1.x; w[j][5] = w1.y; w[j][6] = w1.z; w[j][7] = w1.w; }
#pragma unroll
        for (int i = 0; i < 6; ++i) unpack8(raw[i], x[i]);
        const bool lo_ok = row0 + 4 * tg - 1 >= start, hi_ok = row0 + 4 * tg + 4 < start + len;
#pragma unroll
        for (int e = 0; e < 8; ++e) { x[0][e] = lo_ok ? x[0][e] : 0.f; x[5][e] = hi_ok ? x[5][e] : 0.f; }
#pragma unroll
        for (int t = 0; t < 4; ++t) { float a[8];
#pragma unroll
            for (int e = 0; e < 8; ++e) a[e] = fsilu(w[0][e] * x[t][e] + w[1][e] * x[t + 1][e] + w[2][e] * x[t + 2][e]);
            LAS float* dst = lf + part * 4352 + (4 * tg + t) * 68 + 8 * oo;
            *(LAS f32x4*)dst = (f32x4){a[0], a[1], a[2], a[3]}; *(LAS f32x4*)(dst + 4) = (f32x4){a[4], a[5], a[6], a[7]}; } }
    if ((wave & 3) == 0) { const int dir = wave >> 2, i = lane;
        const float sx = abn[0] + abn[3];
        const float sp = sx > 15.f ? sx : __builtin_amdgcn_logf(1.f + fexp(sx)) * 0.69314718056f;
        const float g = -fexp(abn[2]) * sp;
        const float beta = fsigmoid(abn[1]);
        float gc = g;
        gc += dpp_f<0x111>(gc); gc += dpp_f<0x112>(gc); gc += dpp_f<0x114>(gc); gc += dpp_f<0x118>(gc);
        gc += __int_as_float(__builtin_amdgcn_update_dpp(0, __float_as_int(gc), 0x142, 0xA, 0xF, false));
        gc += __int_as_float(__builtin_amdgcn_update_dpp(0, __float_as_int(gc), 0x143, 0xC, 0xF, false));
        LAS float* sm = lf + L_SM + dir * SMD; const float eg = fexp(gc); sm[i] = gc; sm[64 + i] = beta; sm[128 + i] = eg; sm[192 + i] = beta * eg; }
    prep_load(F, l, next_item, raw, abn, wq);
    LBAR();
    { const int row = tid >> 2, part = row >> 6, t = row & 63, qt = tid & 3; LAS float* src = lf + part * 4352 + t * 68 + 16 * qt;
      f32x4 v[4]; float ss = 0.f;
#pragma unroll
      for (int i = 0; i < 4; ++i) { v[i] = *(LAS f32x4*)(src + 4 * i); ss += (v[i].x * v[i].x + v[i].y * v[i].y) + (v[i].z * v[i].z + v[i].w * v[i].w); }
      ss += __shfl_xor(ss, 1); ss += __shfl_xor(ss, 2);
      const float sc = (1.0f / sqrtf(ss + EPS)) * (part == 0 ? 0.125f : 1.0f);
#pragma unroll
      for (int i = 0; i < 4; ++i) { v[i] = v[i] * sc; *(LAS f32x4*)(src + 4 * i) = v[i]; }
      LAS unsigned char* bdst = (LAS unsigned char*)(lf + (part ? L_KB : L_QB)) + t * 144 + 32 * qt;
      v4u o; o.x = pk2(v[0].x, v[0].y); o.y = pk2(v[0].z, v[0].w); o.z = pk2(v[1].x, v[1].y); o.w = pk2(v[1].z, v[1].w); *(LAS v4u*)bdst = o;
      o.x = pk2(v[2].x, v[2].y); o.y = pk2(v[2].z, v[2].w); o.z = pk2(v[3].x, v[3].y); o.w = pk2(v[3].z, v[3].w); *(LAS v4u*)(bdst + 16) = o; }
    LBAR();
    { const int mat = wave >> 2, it = wave & 3, li = lane & 15, g4 = lane >> 4;
      const LAS unsigned char* Ab = (const LAS unsigned char*)(lf + (mat ? L_QB : L_KB)); const LAS unsigned char* Kb = (const LAS unsigned char*)(lf + L_KB);
      bf16x8 af[2];
#pragma unroll
      for (int s2 = 0; s2 < 2; ++s2) af[s2] = *(const LAS bf16x8*)(Ab + (16 * it + li) * 144 + (32 * s2 + 8 * g4) * 2);
      LAS float* G = lf + (mat ? L_GQK : L_GKK);
#pragma unroll
      for (int jt = 0; jt < 4; ++jt) { f32x4 acc = {0.f, 0.f, 0.f, 0.f};
#pragma unroll
          for (int s2 = 0; s2 < 2; ++s2) { const bf16x8 bq = *(const LAS bf16x8*)(Kb + (16 * jt + li) * 144 + (32 * s2 + 8 * g4) * 2); acc = __builtin_amdgcn_mfma_f32_16x16x32_bf16(af[s2], bq, acc, 0, 0, 0); }
#pragma unroll
          for (int r = 0; r < 4; ++r) G[(16 * it + 4 * g4 + r) * GS + 16 * jt + li] = acc[r]; } }
    LBAR();
    const int dir = tid >> 8, td = tid & 255;
    const LAS float* sm = lf + L_SM + dir * SMD;
    unsigned char* rec = p.ws + WS_REC + (size_t)(item * 2 + dir) * REC_BYTES;
    { const int i = td >> 2, jq = td & 3, ti = dir ? 63 - i : i; const float gi = sm[i], bi = sm[64 + i];
      const LAS float* grow = lf + L_GKK + ti * GS + (dir ? 48 - 16 * jq : 16 * jq);
      float gv[16], gc[16];
#pragma unroll
      for (int k = 0; k < 4; ++k) { const f32x4 a = *(const LAS f32x4*)(grow + 4 * k), c = *(const LAS f32x4*)(sm + 16 * jq + 4 * k);
          gv[4 * k] = a.x; gv[4 * k + 1] = a.y; gv[4 * k + 2] = a.z; gv[4 * k + 3] = a.w; gc[4 * k] = c.x; gc[4 * k + 1] = c.y; gc[4 * k + 2] = c.z; gc[4 * k + 3] = c.w; }
      float val[16];
#pragma unroll
      for (int jj = 0; jj < 16; ++jj) { const int j = 16 * jq + jj; const float G = dir ? gv[15 - jj] : gv[jj];
          const float v = bi * G * fexp(fminf(gi - gc[jj], 0.f)); val[jj] = (i > j) ? v : 0.f; }
      { const bool below = jq < (i >> 4);
        v4u o0, o1; o0.x = below ? pk2(-val[0], -val[1]) : 0u; o0.y = below ? pk2(-val[2], -val[3]) : 0u; o0.z = below ? pk2(-val[4], -val[5]) : 0u; o0.w = below ? pk2(-val[6], -val[7]) : 0u;
        o1.x = below ? pk2(-val[8], -val[9]) : 0u; o1.y = below ? pk2(-val[10], -val[11]) : 0u; o1.z = below ? pk2(-val[12], -val[13]) : 0u; o1.w = below ? pk2(-val[14], -val[15]) : 0u;
        LAS unsigned char* ao = (LAS unsigned char*)(lf + L_AO) + dir * 9216 + i * 144 + 32 * jq; *(LAS v4u*)ao = o0; *(LAS v4u*)(ao + 16) = o1; }
      if (jq == (i >> 4)) { LAS float* ad = lf + L_AD + dir * 1280 + (i >> 4) * 320 + (i & 15) * 20;
#pragma unroll
          for (int k = 0; k < 4; ++k) *(LAS f32x4*)(ad + 4 * k) = (f32x4){val[4 * k], val[4 * k + 1], val[4 * k + 2], val[4 * k + 3]}; } }
#pragma unroll
    for (int k = 0; k < 2; ++k) { const int f = td + 256 * k, ms = f >> 6, ll = f & 63, m = ms >> 1, s = ms & 1, rr = 16 * m + (ll & 15), cb = 32 * s + 4 * (ll >> 4);
        float va[8], vq[8], vk[8];
        const int ti = dir ? 63 - rr : rr; const float gi = sm[rr];
#pragma unroll
        for (int hh = 0; hh < 2; ++hh) { const int c0 = cb + 16 * hh;
            const f32x4 g4 = *(const LAS f32x4*)(lf + L_GQK + ti * GS + (dir ? 60 - c0 : c0)), s4 = *(const LAS f32x4*)(sm + c0), q4 = *(const LAS f32x4*)(lf + L_Q + ti * 68 + c0);
            const float gq[4] = {dir ? g4.w : g4.x, dir ? g4.z : g4.y, dir ? g4.y : g4.z, dir ? g4.x : g4.w}, sc[4] = {s4.x, s4.y, s4.z, s4.w}, qq[4] = {q4.x, q4.y, q4.z, q4.w};
#pragma unroll
            for (int e = 0; e < 4; ++e) { const int c = c0 + e, tc = dir ? 63 - c : c;
                const float v = gq[e] * fexp(fminf(gi - sc[e], 0.f)); va[4 * hh + e] = (rr >= c) ? v : 0.f;
                vq[4 * hh + e] = qq[e];
                vk[4 * hh + e] = lf[L_K + tc * 68 + rr]; } }
        v4u o; o.x = pk2(va[0], va[1]); o.y = pk2(va[2], va[3]); o.z = pk2(va[4], va[5]); o.w = pk2(va[6], va[7]); *(GAS v4u*)(rec + R_ATTN + f * 16) = o;
        o.x = pk2(vq[0], vq[1]); o.y = pk2(vq[2], vq[3]); o.z = pk2(vq[4], vq[5]); o.w = pk2(vq[6], vq[7]); *(GAS v4u*)(rec + R_Q + f * 16) = o;
        o.x = pk2(vk[0], vk[1]); o.y = pk2(vk[2], vk[3]); o.z = pk2(vk[4], vk[5]); o.w = pk2(vk[6], vk[7]); *(GAS v4u*)(rec + R_KT + f * 16) = o; }
    if (td < 64) { float* vec = (float*)(rec + R_VEC); vec[td] = sm[128 + td]; vec[64 + td] = expf(sm[63] - sm[td]); if (td == 0) vec[128] = expf(sm[63]); }
    const int li = lane & 15, g4 = lane >> 4, nt0 = 2 * (wave & 3);
    f32x4 Rt[2][4];
#pragma unroll
    for (int t = 0; t < 2; ++t) { const int nt = nt0 + t; const LAS float* src = lf + (nt < 4 ? L_V + 16 * nt + li : L_K + 16 * (nt - 4) + li); const LAS float* scl = sm + (nt < 4 ? 64 : 192);
#pragma unroll
        for (int m = 0; m < 4; ++m) { const f32x4 sc = *(const LAS f32x4*)(scl + 16 * m + 4 * g4); const int i0 = 16 * m + 4 * g4;
            Rt[t][m] = (f32x4){src[(dir ? 63 - i0 : i0) * 68] * sc.x, src[(dir ? 62 - i0 : i0 + 1) * 68] * sc.y, src[(dir ? 61 - i0 : i0 + 2) * 68] * sc.z, src[(dir ? 60 - i0 : i0 + 3) * 68] * sc.w}; } }
    LBAR();
    if ((wave & 3) == 0) { const int blk = lane >> 4, c = lane & 15; const LAS float* Ad = lf + L_AD + dir * 1280 + blk * 320;
        float x[16];
#pragma unroll
        for (int r = 0; r < 16; ++r) x[r] = 0.f;
#pragma unroll
        for (int hb = 0; hb < 4; ++hb) {
            f32x4 arow[4][4];
#pragma unroll
            for (int rr = 0; rr < 4; ++rr)
#pragma unroll
                for (int q = 0; q < (4 * hb + rr + 3) / 4; ++q) arow[rr][q] = *(const LAS f32x4*)(Ad + (4 * hb + rr) * 20 + 4 * q);
#pragma unroll
            for (int rr = 0; rr < 4; ++rr) { const int r = 4 * hb + rr; float acc = (r == c) ? 1.f : 0.f;
#pragma unroll
                for (int q = 0; q < (r + 3) / 4; ++q) { const f32x4 a = arow[rr][q]; acc -= (a.x * x[4 * q] + a.y * x[4 * q + 1]) + (a.z * x[4 * q + 2] + a.w * x[4 * q + 3]); }
                x[r] = acc; } }
        LAS bf16_t* DF = (LAS bf16_t*)(lf + L_DF) + dir * 1280 + blk * 320;
#pragma unroll
        for (int r = 0; r < 16; ++r) DF[r * 20 + c] = f2bf(x[r]); }
    LBAR();
    { const LAS unsigned char* ao = (const LAS unsigned char*)(lf + L_AO) + dir * 9216; const LAS unsigned char* df = (const LAS unsigned char*)(lf + L_DF) + dir * 2560;
      const f32x4 zero4 = {0.f, 0.f, 0.f, 0.f};
      f32x4 X[2][4];
#pragma unroll
      for (int t = 0; t < 2; ++t)
#pragma unroll
          for (int m = 0; m < 4; ++m) X[t][m] = zero4;
#pragma unroll
      for (int m = 0; m < 4; ++m) {
          const u32x2 dw = *(const LAS u32x2*)(df + m * 640 + li * 40 + g4 * 8);
          const bf16x8 dfrag = __builtin_bit_cast(bf16x8, (v4u){dw.x, dw.y, 0u, 0u});
          f32x4 acc[2] = {Rt[0][m], Rt[1][m]};
#pragma unroll
          for (int s2 = 0; s2 < (m + 1) / 2; ++s2) { const u32x2 lo = *(const LAS u32x2*)(ao + (16 * m + li) * 144 + (32 * s2 + 4 * g4) * 2), hi = *(const LAS u32x2*)(ao + (16 * m + li) * 144 + (32 * s2 + 16 + 4 * g4) * 2);
              const bf16x8 afrag = __builtin_bit_cast(bf16x8, (v4u){lo.x, lo.y, hi.x, hi.y});
#pragma unroll
              for (int t = 0; t < 2; ++t) acc[t] = __builtin_amdgcn_mfma_f32_16x16x32_bf16(afrag, pack8(X[t][2 * s2], X[t][2 * s2 + 1]), acc[t], 0, 0, 0); }
#pragma unroll
          for (int t = 0; t < 2; ++t) X[t][m] = __builtin_amdgcn_mfma_f32_16x16x32_bf16(dfrag, pack8(acc[t], zero4), zero4, 0, 0, 0); }
      LAS float* XS = lf + L_XS + dir * 8448;
#pragma unroll
      for (int t = 0; t < 2; ++t)
#pragma unroll
          for (int m = 0; m < 4; ++m)
#pragma unroll
              for (int r = 0; r < 4; ++r) XS[(16 * m + 4 * g4 + r) * 132 + 16 * (nt0 + t) + li] = X[t][m][r]; }
    LBAR();
    { const LAS float* XS = lf + L_XS + dir * 8448;
#pragma unroll
      for (int k = 0; k < 2; ++k) { const int f = td + 256 * k, ms = f >> 6, ll = f & 63, m = ms >> 1, s = ms & 1, rr = 16 * m + (ll & 15), cb = 32 * s + 4 * (ll >> 4);
          float v[8];
#pragma unroll
          for (int e = 0; e < 8; ++e) v[e] = -XS[rr * 132 + 64 + cb + 16 * (e >> 2) + (e & 3)];
          v4u o; o.x = pk2(v[0], v[1]); o.y = pk2(v[2], v[3]); o.z = pk2(v[4], v[5]); o.w = pk2(v[6], v[7]); *(GAS v4u*)(rec + R_NW + f * 16) = o; }
#pragma unroll
      for (int k = 0; k < 4; ++k) { const int u = td + 256 * k, w = u >> 8, m = (u >> 6) & 3, ll = u & 63, r0 = 16 * m + 4 * (ll >> 4), c = 16 * w + (ll & 15);
          const f32x4 o = {XS[r0 * 132 + c], XS[(r0 + 1) * 132 + c], XS[(r0 + 2) * 132 + c], XS[(r0 + 3) * 132 + c]};
          *(GAS u32x2*)(rec + R_U + u * 8) = (u32x2){pk2(o.x, o.y), pk2(o.z, o.w)}; } }
    LBAR();
}
__device__ __forceinline__ void phase_prep(Frame& F, int l) {
    v4u raw[6], wq[6]; float abn[4] = {0.f, 0.f, 0.f, 0.f};
    F.refresh();
    if (F.vcu < NITEM) prep_load(F, l, F.vcu, raw, abn, wq);
    for (int it = F.vcu; it < NITEM; it += F.G) { F.refresh(); prep_item(F, l, it, raw, abn, wq, it + F.G < NITEM ? it + F.G : it); }
}

__device__ __forceinline__ void scan_rec(int b, int h, int dir, int step, int& cid, int& row0) {
    if (step < 4) { const int n = dir ? 3 - step : step; cid = 2048 + (b * 4 + h) * 4 + n; row0 = MLAT + b * CTXL + 64 * n; }
    else { const int n = dir ? 35 - step : step - 4; cid = (b * 4 + h) * 32 + n; row0 = b * SEQ + 64 * n; }
}
__device__ __forceinline__ void phase_scan(Frame& F, int l) {
    KPtrs& p = F.P();
    const int bx = (int)blockIdx.x, s = bx, b = s >> 3, h = (s >> 1) & 3, dir = s & 1, lane = F.lane;
    constexpr int NSTEP = 36, PIECES = 10, SLOT = 39 * 1024;
    if (F.wave >= 4) {
        const int lw = F.wave - 4;
#define SCAN_ISSUE(t_) do { int cid_, row0_; scan_rec(b, h, dir, (t_), cid_, row0_); const unsigned char* rec_ = p.ws + WS_REC + (size_t)(cid_ * 2 + dir) * REC_BYTES + lane * 16; \
            LAS unsigned char* slot_ = F.lds + ((t_) & 3) * SLOT; \
            _Pragma("unroll") for (int k_ = 0; k_ < PIECES; ++k_) { const int q_ = lw + 4 * k_; if (q_ < 39) { const int j_ = q_ <= 25 ? q_ : q_ == 26 ? 27 : q_ + 2; \
                __builtin_amdgcn_global_load_lds((const GAS unsigned*)(rec_ + j_ * 1024), (LAS unsigned*)(slot_ + q_ * 1024), 16, 0, 0); } } } while (0)
        SCAN_ISSUE(0); SCAN_ISSUE(1); SCAN_ISSUE(2);
        for (int t = 0; t < NSTEP; ++t) {
            const int young = NSTEP - 1 - t < 2 ? NSTEP - 1 - t : 2;
            if (young == 0) asm volatile("s_waitcnt vmcnt(0)" ::: "memory");
            else if (young == 1) { if (lw == 3) asm volatile("s_waitcnt vmcnt(9)" ::: "memory"); else asm volatile("s_waitcnt vmcnt(10)" ::: "memory"); }
            else if (lw == 3) asm volatile("s_waitcnt vmcnt(18)" ::: "memory"); else asm volatile("s_waitcnt vmcnt(20)" ::: "memory");
            asm volatile("" ::: "memory"); __builtin_amdgcn_s_barrier(); asm volatile("" ::: "memory");
            if (t + 3 < NSTEP) SCAN_ISSUE(t + 3);
        }
#undef SCAN_ISSUE
        return;
    }
    const int w = F.wave, li = lane & 15, g4 = lane >> 4;
    f32x4 S[4];
#pragma unroll
    for (int m = 0; m < 4; ++m) S[m] = (f32x4){0.f, 0.f, 0.f, 0.f};
    bf16_t* O = (bf16_t*)p.out + (size_t)dir * MTOT * 256;
    for (int step = 0; step < NSTEP; ++step) {
        int cid, row0; scan_rec(b, h, dir, step, cid, row0);
        asm volatile("s_waitcnt lgkmcnt(0)" ::: "memory"); __builtin_amdgcn_s_barrier(); asm volatile("" ::: "memory");
        const LAS unsigned char* rec = F.lds + (step & 3) * SLOT;
        bf16x8 nw[4][2], qf[4][2], at[4][2], kt[4][2]; f32x4 av[4], ao[4], a2[4], egc4[4], edl4[4];
#pragma unroll
        for (int m = 0; m < 4; ++m) {
#pragma unroll
            for (int s2 = 0; s2 < 2; ++s2) { nw[m][s2] = *(const LAS bf16x8*)(rec + R_NW + ((m * 2 + s2) * 64 + lane) * 16); qf[m][s2] = *(const LAS bf16x8*)(rec + R_Q + ((m * 2 + s2) * 64 + lane) * 16); }
            { const u32x2 uw = *(const LAS u32x2*)(rec + R_U + ((w * 4 + m) * 64 + lane) * 8); av[m] = (f32x4){bflo(uw.x), bfhi(uw.x), bflo(uw.y), bfhi(uw.y)}; } ao[m] = (f32x4){0.f, 0.f, 0.f, 0.f}; }
        const float gl = *(const LAS float*)(rec + R_VEC + 512);
        bf16x8 Bs[2] = {pack8(S[0], S[1]), pack8(S[2], S[3])};
#pragma unroll
        for (int m = 0; m < 4; ++m)
#pragma unroll
            for (int s2 = 0; s2 < 2; ++s2) { av[m] = __builtin_amdgcn_mfma_f32_16x16x32_bf16(nw[m][s2], Bs[s2], av[m], 0, 0, 0); ao[m] = __builtin_amdgcn_mfma_f32_16x16x32_bf16(qf[m][s2], Bs[s2], ao[m], 0, 0, 0); }
#pragma unroll
        for (int m = 0; m < 4; ++m) {
#pragma unroll
            for (int s2 = 0; s2 < 2; ++s2) { const int qa = m < 2 ? 25 + m : 27 + (m - 2) * 2 + s2;
                at[m][s2] = (m < 2 && s2 == 1) ? (bf16x8){0, 0, 0, 0, 0, 0, 0, 0} : *(const LAS bf16x8*)(rec + qa * 1024 + lane * 16);
                kt[m][s2] = *(const LAS bf16x8*)(rec + (31 + m * 2 + s2) * 1024 + lane * 16); }
            edl4[m] = *(const LAS f32x4*)(rec + R_VEC + 256 + (16 * m + 4 * g4) * 4); egc4[m] = *(const LAS f32x4*)(rec + R_VEC + (16 * m + 4 * g4) * 4); a2[m] = (f32x4){0.f, 0.f, 0.f, 0.f}; }
        bf16x8 Bv[2] = {pack8(av[0], av[1]), pack8(av[2], av[3])};
        bf16x8 Bvs[2] = {pack8(av[0] * edl4[0], av[1] * edl4[1]), pack8(av[2] * edl4[2], av[3] * edl4[3])};
#pragma unroll
        for (int m = 0; m < 4; ++m) S[m] = S[m] * gl;
#pragma unroll
        for (int m = 0; m < 4; ++m)
#pragma unroll
            for (int s2 = 0; s2 < 2; ++s2) { if (!(m < 2 && s2 == 1)) a2[m] = __builtin_amdgcn_mfma_f32_16x16x32_bf16(at[m][s2], Bv[s2], a2[m], 0, 0, 0); S[m] = __builtin_amdgcn_mfma_f32_16x16x32_bf16(kt[m][s2], Bvs[s2], S[m], 0, 0, 0); }
#pragma unroll
        for (int m = 0; m < 4; ++m) { const f32x4 o = egc4[m] * ao[m] + a2[m];
#pragma unroll
            for (int r = 0; r < 4; ++r) { const int i = 16 * m + 4 * g4 + r, tok = dir ? 63 - i : i;
                O[(size_t)(row0 + tok) * 256 + h * 64 + 16 * w + li] = f2bf(o[r]); } }
    }
}

__device__ __forceinline__ void phase_comb(Frame& F, int l) {
    KPtrs& p = F.P(); const int lane = F.lane;
    const int gw = F.vcu * NWAVES + F.wave, NGW = F.G * NWAVES;
    const bf16_t* OF = (const bf16_t*)p.out; const bf16_t* OB = OF + (size_t)MTOT * 256; const bf16_t* GA = ptile_d(p, T_GA);
    const f32x4 ng = *(const f32x4*)(p.gdn_norm_g + l * 64 + 4 * (lane & 15));
    const int nrow = (l == DEPTH - 1) ? MLAT : MTOT;
    constexpr int CB = 6;
#pragma unroll 1
    for (int r0 = gw; r0 < nrow; r0 += CB * NGW) {
        u32x2 a[CB], c[CB], gt[CB];
#pragma unroll
        for (int u = 0; u < CB; ++u) { int r = r0 + u * NGW; r = r < nrow ? r : nrow - 1; const size_t o = (size_t)r * 256 + 4 * lane;
            a[u] = *(const GAS u32x2*)(OF + o); c[u] = *(const GAS u32x2*)(OB + o); gt[u] = *(const GAS u32x2*)(GA + o); }
#pragma unroll
        for (int u = 0; u < CB; ++u) { const int r = r0 + u * NGW;
            const f32x4 o = {bflo(a[u].x) + bflo(c[u].x), bfhi(a[u].x) + bfhi(c[u].x), bflo(a[u].y) + bflo(c[u].y), bfhi(a[u].y) + bfhi(c[u].y)};
            float ss = (o.x * o.x + o.y * o.y) + (o.z * o.z + o.w * o.w);
            ss = row16_sum(ss);
            const float rs = 1.0f / sqrtf(ss * (1.f / 64.f) + EPS);
            u32x2 y; y.x = pk2(o.x * rs * ng.x * bflo(gt[u].x), o.y * rs * ng.y * bfhi(gt[u].x)); y.y = pk2(o.z * rs * ng.z * bflo(gt[u].y), o.w * rs * ng.w * bfhi(gt[u].y));
            if (r < nrow) *(GAS u32x2*)((bf16_t*)(p.ws + WS_HY) + (size_t)r * DM + 4 * lane) = y; }
    }
}

constexpr int PH_FINAL = 1 + 7 * DEPTH, PH_END = PH_FINAL + 1;
struct Args { Ptrs p; int ph_lo, ph_hi; };
__global__ void __launch_bounds__(NWAVES * 64, 2) mega(Args args) {
    extern __shared__ __attribute__((aligned(16))) unsigned char lds[];
    Frame F;
    F.lds = (LAS unsigned char*)lds; F.MISC = (volatile LAS unsigned*)(F.lds + MISC_OFF);
    F.tid = threadIdx.x; F.lane = F.tid & 63; F.wave = __builtin_amdgcn_readfirstlane(F.tid >> 6);
    F.G = gridDim.x; { const int bx = blockIdx.x; F.vcu = (F.G % 8 == 0) ? (bx % 8) * (F.G / 8) + bx / 8 : bx; }
    F.ctl = (gu32*)(args.p.ws + WS_CTL);
    for (int u = F.tid; u < (LDS_BYTES - LDSCTL_OFF) / 4; u += NWAVES * 64) ((LAS unsigned*)(F.lds + LDSCTL_OFF))[u] = 0u;
    __syncthreads();
    const bool multi = args.ph_hi - args.ph_lo > 1;
    XcdBarrier bar; bar.bar = (unsigned*)(F.ctl + CW_BAR); bar.x = 0; bar.st = nullptr;
    if (multi) bar = xcd_barrier_post((unsigned*)(F.ctl + CW_BAR), F.MISC + 8);
    bool pend = false;
    for (int ph = args.ph_lo; ph < args.ph_hi; ++ph) {
        F.refresh();
#if PROBE_S >= 0
        const bool amp = (PROBE_S == 7) ? (ph == 0) : (PROBE_S == 8) ? (ph == PH_FINAL) : (ph > 0 && ph < PH_FINAL && (ph - 1) % 7 == PROBE_S);
        const unsigned long long t0 = __builtin_amdgcn_s_memrealtime();
#endif
        if (ph == 0) phase_pre(F);
        else if (ph == PH_FINAL) phase_final(F);
        else { const int l = (ph - 1) / 7, s = (ph - 1) % 7;
            if (s == 0) phase_norm(F, l, bar, pend);
            else if (s == 1) phase_gemm1(F, l);
            else if (s == 2) phase_prep(F, l);
            else if (s == 3) continue;
            else if (s == 4) { if (blockIdx.x < 128) { phase_scan(F, l); __syncthreads(); F.refresh(); }
                phase_mix(F, l); }
            else if (s == 5) phase_comb(F, l);
            else if (s == 6) pend = phase_gemm2(F, l, bar, pend);
        }
        if (ph + 1 < args.ph_hi) {
            if (pend) { xcd_barrier_wait(bar); pend = false; }
            const int s_ = (ph > 0 && ph < PH_FINAL) ? (ph - 1) % 7 : -1;
            const bool early = multi && ((s_ == 6 && ph + 1 < PH_FINAL) || (s_ == 2 && blockIdx.x >= 128) || s_ == 5 || ph == 0);
            xcd_barrier(bar, early); pend = early;
        }
#if PROBE_S >= 0
        if (amp) { const unsigned long long dt = __builtin_amdgcn_s_memrealtime() - t0; while (__builtin_amdgcn_s_memrealtime() - t0 < 2 * dt) __builtin_amdgcn_s_sleep(4); }
#endif
    }
}

extern "C" void kernel_launch(void* const* d_in, const int* in_sizes, int n_in, void* d_out, int out_size, void* d_ws, size_t ws_size, hipStream_t stream) {
    static int grid = 0;
    if (grid == 0) {
        if (n_in != 23 || out_size != MLAT * DM || ws_size < WS_END) { fprintf(stderr, "kernel_launch: unexpected shapes (n_in %d out %d ws %zu)\n", n_in, out_size, ws_size); grid = -1; return; }
        int dev = 0, cus = 0;
        if (hipGetDevice(&dev) != hipSuccess || hipDeviceGetAttribute(&cus, hipDeviceAttributeMultiprocessorCount, dev) != hipSuccess) { grid = -1; return; }
        if (hipFuncSetAttribute((const void*)mega, hipFuncAttributeMaxDynamicSharedMemorySize, LDS_BYTES) != hipSuccess) { fprintf(stderr, "kernel_launch: hipFuncSetAttribute failed\n"); grid = -1; return; }
        grid = cus;
        if (grid != 256) fprintf(stderr, "kernel_launch: %d CUs (built for 256)\n", grid);
    }
    if (grid < 0) return;
    hipMemsetAsync((char*)d_ws + WS_CTL, 0, CTL_ZERO_BYTES, stream);
    Args a{};
    const float** f = (const float**)&a.p;
    for (int i = 0; i < 23; ++i) f[i] = (const float*)d_in[i];
    a.p.out = (float*)d_out; a.p.ws = (unsigned char*)d_ws;
    a.ph_lo = 0; a.ph_hi = PH_END;
    hipLaunchKernelGGL(mega, dim3(grid), dim3(NWAVES * 64), LDS_BYTES, stream, a);
}
```
